# Optimizing an MI355X kernel written in HIP

```python
import jax
import jax.numpy as jnp
from jax import lax
import numpy as np

D_MODEL = 1024
BATCH = 8
SEQ = 2048
DEPTH = 2
DEC_BATCH = 32
DEC_SEQ = 1
PAST_LEN = 8192
PAGE_SIZE = 128

EXPAND = 2
D_MIX = EXPAND * D_MODEL
C_A = 3 * D_MIX // 8
HD_A = 64
H_A = C_A // HD_A
PATTERNS = ((128, 1), (512, 4), (2048, 16))
MAX_WINDOW = 2048
DIL_BLOCK = 128
C_B = D_MIX // 4
G_B = 8
SGU_CHUNK = 128
C_C = D_MIX - C_A - C_B
K_C = 128
H_C = C_C // K_C
V_C = C_C // H_C
HG_CHUNK = 16
SPLITS = (C_A,) * 4 + (C_B,) * 3 + (C_C,) * 4
N_IN = sum(SPLITS)
EPS = 1e-6
F32 = jnp.float32

kernel_name = 'hybrid_dilated_sgu_hgrn2_step'


def _rms(x, g):
    xf = x.astype(F32)
    y = xf * lax.rsqrt(jnp.mean(xf * xf, axis=-1, keepdims=True) + EPS)
    return (y * g.astype(F32)).astype(x.dtype)


def _layernorm(x, g, b):
    xf = x.astype(F32)
    mu = jnp.mean(xf, axis=-1, keepdims=True)
    xc = xf - mu
    var = jnp.mean(xc * xc, axis=-1, keepdims=True)
    return (xc * lax.rsqrt(var + EPS) * g.astype(F32) + b.astype(F32)).astype(x.dtype)


def _softmax_stats(s):
    m = jnp.max(s, axis=-1, keepdims=True)
    p = jnp.exp(s - m)
    den = jnp.sum(p, axis=-1, keepdims=True)
    return p / den, (m + jnp.log(den))[..., 0]


def _combine_patterns(outs, lses):
    w = jax.nn.softmax(jnp.stack(lses), axis=0)
    return jnp.sum(w[..., None] * jnp.stack(outs), axis=0)


def _dilated_prompt(q, k, v):
    B, S, H, E = q.shape
    outs, lses = [], []
    for win, dil in PATTERNS:
        n_back = win // dil
        L = S // dil
        nb = -(-L // DIL_BLOCK)
        Lp = nb * DIL_BLOCK

        def to_blocks(t):
            t = t.reshape(B, L, dil, H, E).transpose(0, 2, 1, 3, 4)
            t = jnp.pad(t, ((0, 0), (0, 0), (0, Lp - L), (0, 0), (0, 0)))
            return t.reshape(B, dil, nb, DIL_BLOCK, H, E)

        def with_prev(t):
            prev = jnp.pad(t, ((0, 0), (0, 0), (1, 0), (0, 0), (0, 0), (0, 0)))[:, :, :nb]
            return jnp.concatenate([prev, t], axis=3)

        qb = to_blocks(q)
        kb = with_prev(to_blocks(k))
        vb = with_prev(to_blocks(v))
        s = jnp.einsum('brnqhe,brnkhe->brnhqk', qb, kb, preferred_element_type=F32)
        qi = jnp.arange(DIL_BLOCK)[:, None]
        ki = jnp.arange(2 * DIL_BLOCK)[None, :]
        dist = qi + DIL_BLOCK - ki
        exists = jnp.arange(nb)[:, None, None] * DIL_BLOCK - DIL_BLOCK + ki[None] >= 0
        valid = (dist >= 0) & (dist <= n_back) & exists
        s = jnp.where(valid[:, None], s, -jnp.inf)
        p, lse = _softmax_stats(s)
        o = jnp.einsum('brnhqk,brnkhe->brnqhe', p, vb.astype(F32))
        lse = lse.transpose(0, 1, 2, 4, 3)

        def from_blocks(t):
            t = t.reshape((B, dil, Lp) + t.shape[4:])[:, :, :L]
            return jnp.moveaxis(t, 1, 2).reshape((B, S) + t.shape[3:])

        outs.append(from_blocks(o))
        lses.append(from_blocks(lse))
    return _combine_patterns(outs, lses)


def _dilated_step(q, k_new, v_new, k_buf, v_buf):
    T = q.shape[1]
    W = k_buf.shape[1]
    kk = jnp.concatenate([k_buf.astype(k_new.dtype), k_new], axis=1)
    vv = jnp.concatenate([v_buf.astype(v_new.dtype), v_new], axis=1)
    t = jnp.arange(T)[:, None]
    outs, lses = [], []
    for win, dil in PATTERNS:
        back = jnp.arange(win // dil + 1)[None, :] * dil
        valid = PAST_LEN + t - back >= 0
        idx = jnp.clip(W + t - back, 0, W + T - 1)
        kg = kk[:, idx]
        vg = vv[:, idx]
        s = jnp.einsum('bthe,btnhe->bthn', q, kg, preferred_element_type=F32)
        s = jnp.where(valid[None, :, None, :], s, -jnp.inf)
        p, lse = _softmax_stats(s)
        outs.append(jnp.einsum('bthn,btnhe->bthe', p, vg.astype(F32)))
        lses.append(lse)
    return _combine_patterns(outs, lses)


def _sgu(u, v, ln_g, ln_b, w_s, b_s):
    B, L, _ = v.shape
    vn = _layernorm(v, ln_g, ln_b)
    nc = -(-L // SGU_CHUNK)
    Lp = nc * SGU_CHUNK
    vp = jnp.pad(vn, ((0, 0), (0, Lp - L), (0, 0))).reshape(B, nc, SGU_CHUNK, G_B, C_B // G_B)
    tri = jnp.tril(jnp.ones((SGU_CHUNK, SGU_CHUNK), bool))
    w = jnp.where(tri[None], w_s, jnp.zeros_like(w_s))
    mix = jnp.einsum('gts,bnsgc->bntgc', w, vp) + b_s.T[None, None, :, :, None]
    mix = mix.reshape(B, Lp, C_B)[:, :L]
    return u * mix, vn


def _hgrn2(q_pre, f_pre, i, lb, norm_g, S0):
    B, L, _ = q_pre.shape
    nc = -(-L // HG_CHUNK)
    Lp = nc * HG_CHUNK
    fp = f_pre.astype(F32)
    f = lb + (1.0 - lb) * jax.nn.sigmoid(fp)
    k = (1.0 - lb) * jax.nn.sigmoid(-fp)
    g = jnp.log(f)
    q = jax.nn.silu(q_pre.astype(F32))

    def chunks(t, d):
        t = jnp.pad(t.reshape(B, L, H_C, d), ((0, 0), (0, Lp - L), (0, 0), (0, 0)))
        return jnp.moveaxis(t.reshape(B, nc, HG_CHUNK, H_C, d), 1, 0)

    qs, ks, gs = chunks(q, K_C), chunks(k, K_C), chunks(g, K_C)
    vs = chunks(i.astype(F32), V_C)
    tri = jnp.tril(jnp.ones((HG_CHUNK, HG_CHUNK), bool))[None, :, :, None, None]

    def body(S, xs):
        qc, kc, vc, gc = xs
        G = jnp.cumsum(gc, axis=1)
        o_inter = jnp.einsum('bchk,bhkv->bchv', qc * jnp.exp(G), S)
        diff = G[:, :, None] - G[:, None, :]
        D = jnp.exp(jnp.where(tri, diff, -jnp.inf))
        A = jnp.einsum('bthk,btshk,bshk->bths', qc, D, kc)
        o = o_inter + jnp.einsum('bths,bshv->bthv', A, vc)
        G_last = G[:, -1]
        S_new = jnp.exp(G_last)[..., None] * S + jnp.einsum(
            'bshk,bshv->bhkv', kc * jnp.exp(G_last[:, None] - G), vc)
        return S_new, o

    S_fin, o = lax.scan(body, S0, (qs, ks, vs, gs))
    o = jnp.moveaxis(o, 0, 1).reshape(B, Lp, H_C, V_C)[:, :L]
    o = _rms(o, norm_g.reshape(H_C, V_C))
    return o.reshape(B, L, C_C), S_fin


def _project(x, norm_g, w_in, qn_g, kn_g):
    B, L, _ = x.shape
    h = _rms(x, norm_g)
    proj = jnp.einsum('bld,dn->bln', h, w_in)
    cuts = [int(c) for c in np.cumsum(SPLITS)[:-1]]
    aq, ak, av, az, bu, bv, bz, cq, cf, ci, cz = jnp.split(proj, cuts, axis=-1)
    aq = _rms(aq.reshape(B, L, H_A, HD_A), qn_g.reshape(H_A, HD_A)) * (HD_A ** -0.5)
    ak = _rms(ak.reshape(B, L, H_A, HD_A), kn_g.reshape(H_A, HD_A))
    av = av.reshape(B, L, H_A, HD_A)
    return aq, ak, av, az, bu, bv, bz, cq, cf, ci, cz


def _merge(x, o_a, z_a, o_b, z_b, o_c, z_c, w_out):
    B, L, _ = x.shape
    y = jnp.concatenate([
        o_a.reshape(B, L, C_A) * jax.nn.silu(z_a.astype(F32)),
        o_b.astype(F32) * jax.nn.silu(z_b.astype(F32)),
        o_c.astype(F32) * jax.nn.silu(z_c.astype(F32)),
    ], axis=-1).astype(x.dtype)
    return x + jnp.einsum('bln,nd->bld', y, w_out)


def setup_inputs(seed: int = 0) -> dict:
    key = jax.random.key(seed)
    ks = jax.random.split(key, 18)
    nrm = jax.random.normal
    wbuf = min(MAX_WINDOW, PAST_LEN)
    return {
        'x_prompt': nrm(ks[0], (BATCH, SEQ, D_MODEL), F32),
        'x_sample': nrm(ks[1], (DEC_BATCH, DEC_SEQ, D_MODEL), F32),
        'cache_k': nrm(ks[2], (DEPTH, DEC_BATCH, wbuf, H_A, HD_A), F32),
        'cache_v': nrm(ks[3], (DEPTH, DEC_BATCH, wbuf, H_A, HD_A), F32),
        'state_hgrn': 0.5 * nrm(ks[4], (DEPTH, DEC_BATCH, H_C, K_C, V_C), F32),
        'norm_g': 1.0 + 0.02 * nrm(ks[5], (DEPTH, D_MODEL), F32),
        'w_in': nrm(ks[6], (DEPTH, D_MODEL, N_IN), F32) * D_MODEL ** -0.5,
        'q_norm_g': 1.0 + 0.02 * nrm(ks[7], (DEPTH, C_A), F32),
        'k_norm_g': 1.0 + 0.02 * nrm(ks[8], (DEPTH, C_A), F32),
        'sgu_ln_g': 1.0 + 0.02 * nrm(ks[9], (DEPTH, C_B), F32),
        'sgu_ln_b': 0.02 * nrm(ks[10], (DEPTH, C_B), F32),
        'sgu_w': nrm(ks[11], (DEPTH, G_B, SGU_CHUNK, SGU_CHUNK), F32) * SGU_CHUNK ** -0.5,
        'sgu_b': 0.02 * nrm(ks[12], (DEPTH, G_B, SGU_CHUNK), F32),
        'hgrn_lb_logits': 0.5 * nrm(ks[13], (DEPTH, C_C), F32),
        'hgrn_norm_g': 1.0 + 0.02 * nrm(ks[14], (DEPTH, C_C), F32),
        'w_out': nrm(ks[15], (DEPTH, D_MIX, D_MODEL), F32) * D_MIX ** -0.5,
    }


def reference(x_prompt, x_sample, cache_k, cache_v, state_hgrn, norm_g, w_in, q_norm_g, k_norm_g,
              sgu_ln_g, sgu_ln_b, sgu_w, sgu_b, hgrn_lb_logits, hgrn_norm_g, w_out):
    lb_p = jax.nn.softmax(hgrn_lb_logits.astype(F32), axis=0)
    lb_all = jnp.cumsum(lb_p, axis=0) - lb_p[0]
    xp, xs = x_prompt, x_sample
    w_keep = min(MAX_WINDOW, x_prompt.shape[1])
    kp_l, vp_l, ks_l, vs_l, sgu_l, hp_l, hs_l = [], [], [], [], [], [], []
    for l in range(DEPTH):
        aq, ak, av, az, bu, bv, bz, cq, cf, ci, cz = _project(xp, norm_g[l], w_in[l], q_norm_g[l], k_norm_g[l])
        o_a = _dilated_prompt(aq, ak, av)
        o_b, _ = _sgu(bu, bv, sgu_ln_g[l], sgu_ln_b[l], sgu_w[l], sgu_b[l])
        S0 = jnp.zeros((xp.shape[0], H_C, K_C, V_C), F32)
        o_c, S_p = _hgrn2(cq, cf, ci, lb_all[l], hgrn_norm_g[l], S0)
        xp = _merge(xp, o_a, az, o_b, bz, o_c, cz, w_out[l])
        kp_l.append(ak[:, -w_keep:])
        vp_l.append(av[:, -w_keep:])
        hp_l.append(S_p)
        aq, ak, av, az, bu, bv, bz, cq, cf, ci, cz = _project(xs, norm_g[l], w_in[l], q_norm_g[l], k_norm_g[l])
        o_a = _dilated_step(aq, ak, av, cache_k[l], cache_v[l])
        o_b, vn_s = _sgu(bu, bv, sgu_ln_g[l], sgu_ln_b[l], sgu_w[l], sgu_b[l])
        o_c, S_s = _hgrn2(cq, cf, ci, lb_all[l], hgrn_norm_g[l], state_hgrn[l].astype(F32))
        xs = _merge(xs, o_a, az, o_b, bz, o_c, cz, w_out[l])
        ks_l.append(ak)
        vs_l.append(av)
        sgu_l.append(vn_s)
        hs_l.append(S_s)
    y_prompt = xp
    y_sample = xs
    new_k_prompt = jnp.stack(kp_l)
    new_v_prompt = jnp.stack(vp_l)
    new_k_sample = jnp.stack(ks_l)
    new_v_sample = jnp.stack(vs_l)
    new_sgu_v_sample = jnp.stack(sgu_l)
    new_hgrn_prompt = jnp.stack(hp_l)
    new_hgrn_sample = jnp.stack(hs_l)
    return (y_prompt, y_sample, new_k_prompt, new_v_prompt, new_k_sample, new_v_sample,
            new_sgu_v_sample, new_hgrn_prompt, new_hgrn_sample)
```

```cpp
#include <hip/hip_runtime.h>
#include <cstdio>
#include <cstdint>
namespace pg8 {
#define PG8_LAS __attribute__((address_space(3)))
typedef unsigned short bf16_t;
typedef short bf16x8 __attribute__((ext_vector_type(8)));
typedef float f32x4 __attribute__((ext_vector_type(4)));
typedef unsigned u32x4 __attribute__((ext_vector_type(4)));
constexpr int BM = 256, BK = 64, HALF = 128, HTB = HALF * BK * 2  , STAGE_BYTES = 8 * HTB, NXCD = 8, WGM = 8;

__host__ __device__ __forceinline__ int lds_byte(int r, int c) { const int st = (r >> 4) * 2 + (c >> 5), rr = r & 15, cc = c & 31, ob = rr * 64 + cc * 2; return st * 1024 + (ob ^ (((ob >> 9) & 1) << 5)); }
__host__ __device__ __forceinline__ void stage_rc(int b, int& R, int& C) { const int st = b / 1024, sb = b % 1024, swz = sb ^ (((sb >> 9) & 1) << 5); R = (st >> 1) * 16 + swz / 64; C = (st & 1) * 32 + (swz % 64) / 2; }
__host__ __device__ __forceinline__ int perm32(int rho) { const int n = rho >> 4, i = rho & 15; return 8 * (i >> 2) + 4 * n + (i & 3); }

struct Unit { int pm, pn; };
struct Gemm { const bf16_t* A; const bf16_t* Bt; int M, N, K; };

struct StaticOrder {
    int nM, nN, nwg, G, c;
    __host__ __device__ void init(int M, int N, int G_, int c_) { nM = M / BM; nN = N / BM; nwg = nM * nN; G = G_; c = c_; }
    __host__ __device__ bool next(int i, Unit& u) const {
        const long L = (long)i * G + c; if (L >= nwg) return false;
        int wgid = (int)L; { const int q = nwg / NXCD, r = nwg % NXCD, xcd = wgid % NXCD, off = wgid / NXCD; wgid = (xcd < r ? xcd * (q + 1) : r * (q + 1) + (xcd - r) * q) + off; }
        const int nig = WGM * nN, gid = wgid / nig, fm = gid * WGM, gsz = (nM - fm) < WGM ? (nM - fm) : WGM;
        u.pm = fm + ((wgid % nig) % gsz); u.pn = (wgid % nig) / gsz; return true;
    }
    __device__ __forceinline__ void a_ready(const Unit&) const {}
    __device__ __forceinline__ void done(const Unit&) const {}
};


typedef float f32x2 __attribute__((ext_vector_type(2)));
typedef unsigned u32x2 __attribute__((ext_vector_type(2)));
typedef __bf16 bf16x2_t __attribute__((ext_vector_type(2)));
__device__ __forceinline__ unsigned cvtpk(float lo, float hi) { f32x2 v = {lo, hi}; bf16x2_t b = __builtin_convertvector(v, bf16x2_t); return __builtin_bit_cast(unsigned, b); }
__device__ __forceinline__ float fast_sigmoid(float x) { return __builtin_amdgcn_rcpf(1.0f + __expf(-x)); }
__device__ __forceinline__ float silu_f(float x) { return x * fast_sigmoid(x); }

struct EpiProj {
    static constexpr bool PERM = true, AFTER_DRAIN = false, HEADPERM = true;
    const float* ssq;
    const float* gtab;
    unsigned char* ws; float* out; int l;
    size_t o_qkv, s_qkv, o_zb, o_bu, s_bu, o_cq, s_cq, o_cg;
    size_t o_kp, s_kp, o_ks, s_ks;
    __device__ __forceinline__ void st8(bf16_t* p, const f32x4& a, const f32x4& b) const {
        u32x4 w; w.x = cvtpk(a[0], a[1]); w.y = cvtpk(a[2], a[3]); w.z = cvtpk(b[0], b[1]); w.w = cvtpk(b[2], b[3]); *(u32x4*)p = w; }
    __device__ __forceinline__ void operator()(const f32x4 (&acc)[2][2][4][2], const Unit& u, int wr, int wc, int fr, int fq) const {
        const int pn = u.pn;
        int seg, seg0;
        if (pn < 12) { seg = pn / 3; seg0 = seg * 3; }
        else if (pn < 18) { seg = 4 + (pn - 12) / 2; seg0 = 12 + (seg - 4) * 2; }
        else { seg = 7 + (pn - 18) / 3; seg0 = 18 + (seg - 7) * 3; }
        const int cl = (pn - seg0) * 256 + wc * 64 + 8 * fq;
        const int rowb = u.pm * BM + wr * 64 + fr;
        const bool sample = (u.pm == 64);
        f32x4 gv[2][2];
        { const int gi = (seg == 0) ? 0 : (seg == 1 ? 1 : 2); const float* gp = gtab + gi * 768 + (seg == 0 || seg == 1 || seg == 8 ? cl : 0);
#pragma unroll
          for (int bj = 0; bj < 2; ++bj)
#pragma unroll
              for (int n = 0; n < 2; ++n) gv[bj][n] = *(const f32x4*)(gp + 32 * bj + 4 * n); }
#pragma unroll
        for (int ai = 0; ai < 2; ++ai)
#pragma unroll
            for (int m = 0; m < 4; ++m) {
                const int row = rowb + ai * HALF + m * 16;
                const float rs = __builtin_amdgcn_rsqf(ssq[row] * (1.0f / 1024.0f) + 1e-6f);
                f32x4 v[2][2];
#pragma unroll
                for (int bj = 0; bj < 2; ++bj)
#pragma unroll
                    for (int n = 0; n < 2; ++n) v[bj][n] = acc[ai][bj][m][n] * rs;
                if (seg <= 1) {
                    float ss = 0.f;
#pragma unroll
                    for (int bj = 0; bj < 2; ++bj)
#pragma unroll
                        for (int n = 0; n < 2; ++n) { const f32x4 x = v[bj][n]; ss += (x[0] * x[0] + x[1] * x[1]) + (x[2] * x[2] + x[3] * x[3]); }
                    ss += __shfl_xor(ss, 16); ss += __shfl_xor(ss, 32);
                    float r2 = __builtin_amdgcn_rsqf(ss * (1.0f / 64.0f) + 1e-6f);
                    if (seg == 0) r2 *= 0.125f * 1.4426950408889634f;
#pragma unroll
                    for (int bj = 0; bj < 2; ++bj)
#pragma unroll
                        for (int n = 0; n < 2; ++n) v[bj][n] = v[bj][n] * gv[bj][n] * r2;
                }
                if (seg <= 2) {
                    bf16_t* dst = (bf16_t*)(ws + o_qkv + (size_t)seg * s_qkv) + (size_t)row * 768 + cl;
#pragma unroll
                    for (int bj = 0; bj < 2; ++bj) st8(dst + 32 * bj, v[bj][0], v[bj][1]);
                    if (seg >= 1) {
                        const bool okp = !sample, oks = sample && (row - 16384 < 32);
                        float* o = out + (okp ? o_kp + (size_t)(seg - 1) * s_kp + (size_t)row * 768 : o_ks + (size_t)(seg - 1) * s_ks + (size_t)(row - 16384) * 768) + cl;
                        if (okp || oks) {
#pragma unroll
                            for (int bj = 0; bj < 2; ++bj) { *(f32x4*)(o + 32 * bj) = v[bj][0]; *(f32x4*)(o + 32 * bj + 4) = v[bj][1]; }
                        }
                    }
                } else if (seg == 3 || seg == 6 || seg == 10 || seg == 7) {
#pragma unroll
                    for (int bj = 0; bj < 2; ++bj)
#pragma unroll
                        for (int n = 0; n < 2; ++n)
#pragma unroll
                            for (int e = 0; e < 4; ++e) v[bj][n][e] = silu_f(v[bj][n][e]);
                    const size_t zo = (seg == 7) ? o_cq + ((size_t)row * 768 + cl) * 2 : o_zb + ((size_t)row * 2048 + (seg == 3 ? 0 : (seg == 6 ? 768 : 1280)) + cl) * 2;
                    bf16_t* dst = (bf16_t*)(ws + zo);
#pragma unroll
                    for (int bj = 0; bj < 2; ++bj) st8(dst + 32 * bj, v[bj][0], v[bj][1]);
                } else if (seg == 4 || seg == 5) {
                    bf16_t* dst = (bf16_t*)(ws + o_bu + (size_t)(seg - 4) * s_bu) + (size_t)row * 512 + cl;
#pragma unroll
                    for (int bj = 0; bj < 2; ++bj) st8(dst + 32 * bj, v[bj][0], v[bj][1]);
                } else if (seg == 9) {
                    bf16_t* dst = (bf16_t*)(ws + o_cq + 2 * s_cq) + (size_t)row * 768 + cl;
#pragma unroll
                    for (int bj = 0; bj < 2; ++bj) st8(dst + 32 * bj, v[bj][0], v[bj][1]);
                } else {
                    f32x4 kk[2][2];
#pragma unroll
                    for (int bj = 0; bj < 2; ++bj)
#pragma unroll
                        for (int n = 0; n < 2; ++n)
#pragma unroll
                            for (int e = 0; e < 4; ++e) { const float lbv = gv[bj][n][e], sg = fast_sigmoid(v[bj][n][e]);
                                kk[bj][n][e] = (1.0f - lbv) * (1.0f - sg); v[bj][n][e] = __logf(lbv + (1.0f - lbv) * sg); }
                    bf16_t* dk = (bf16_t*)(ws + o_cq + s_cq) + (size_t)row * 768 + cl; float* dg = (float*)(ws + o_cg) + (size_t)row * 768 + cl;
#pragma unroll
                    for (int bj = 0; bj < 2; ++bj) { st8(dk + 32 * bj, kk[bj][0], kk[bj][1]); *(f32x4*)(dg + 32 * bj) = v[bj][0]; *(f32x4*)(dg + 32 * bj + 4) = v[bj][1]; }
                }
                asm volatile("" ::: "memory");
            }
    }
};
struct EpiOut {
    static constexpr bool PERM = false, AFTER_DRAIN = false, HEADPERM = false;
    const float* res; float* out; bf16_t* xb; float* ssq;
    __device__ __forceinline__ void operator()(const f32x4 (&acc)[2][2][4][2], const Unit& u, int wr, int wc, int fr, int fq) const {
        const int col0 = u.pn * BM + wc * 32 + 4 * fq;
#pragma unroll
        for (int ai = 0; ai < 2; ++ai)
#pragma unroll
            for (int m = 0; m < 4; ++m) {
                const int row = u.pm * BM + ai * HALF + wr * 64 + m * 16 + fr; const size_t off = (size_t)row * 1024 + col0; float ss = 0.f;
#pragma unroll
                for (int bj = 0; bj < 2; ++bj)
#pragma unroll
                    for (int n = 0; n < 2; ++n) { const f32x4 o = *(const f32x4*)(res + off + bj * HALF + n * 16) + acc[ai][bj][m][n];
                        *(f32x4*)(out + off + bj * HALF + n * 16) = o; ss += (o[0] * o[0] + o[1] * o[1]) + (o[2] * o[2] + o[3] * o[3]);
                        if (xb) { u32x2 w; w.x = cvtpk(o[0], o[1]); w.y = cvtpk(o[2], o[3]); *(u32x2*)(xb + off + bj * HALF + n * 16) = w; } }
                if (ssq) { ss += __shfl_xor(ss, 16); ss += __shfl_xor(ss, 32); if (fq == 0) atomicAdd(ssq + row, ss); }
                asm volatile("" ::: "memory");
            }
    }
};
template <class Epi, class Sched, bool ALIGN_EPI = false, bool SP2 = false>
__device__ __forceinline__ void gemm_phase(PG8_LAS unsigned char* lds, const Gemm g, const Sched& S, const Epi& E) {
    int tid_ = threadIdx.x; asm volatile("" : "+v"(tid_));
    const int tid = tid_, wid = __builtin_amdgcn_readfirstlane(tid >> 6), lane = tid & 63, wr = wid >> 2, wc = wid & 3, fr = lane & 15, fq = lane >> 4;
    const int K = g.K, nt = K / BK;
    unsigned voffA[2], voffB[2];
#pragma unroll
    for (int i = 0; i < 2; ++i) { int R, C; stage_rc(tid * 16 + i * 8192, R, C); const int Rb = Epi::HEADPERM ? (64 * (R >> 5) + perm32(R & 31)) : (Epi::PERM ? ((R & ~31) + perm32(R & 31)) : R);
        voffA[i] = (unsigned)(R * K + C) * 2u; voffB[i] = (unsigned)(Rb * K + C) * 2u; }
    const size_t kstep = (size_t)(BK * 2);
    const size_t hstep = (size_t)HALF * K * 2;
    const size_t tstep = 2 * hstep; const size_t hstepB = Epi::HEADPERM ? (size_t)32 * K * 2 : hstep;
    const unsigned ldsw = (unsigned)wid * 1024u;
    const int aoff = lds_byte(wr * 64 + fr, fq * 8), boff = lds_byte(wc * 32 + fr, fq * 8);
#define PG8_SA(b, h) (((b) * 2 + (h)) * HTB)
#define PG8_SB(b, h) ((4 + (b) * 2 + (h)) * HTB)
#define PG8_STAGE(bufoff, gbase, voff) do { _Pragma("unroll") for (int _i = 0; _i < 2; ++_i) \
        __builtin_amdgcn_global_load_lds((const unsigned*)((const char*)(gbase) + (voff)[_i]), (PG8_LAS unsigned*)(lds + (bufoff) + ldsw + _i * 8192), 16, 0, 0); } while (0)
#define PG8_LDA(dst, b, h) do { _Pragma("unroll") for (int m = 0; m < 4; ++m) _Pragma("unroll") for (int k = 0; k < 2; ++k) dst[m][k] = *(const PG8_LAS bf16x8*)(lds + PG8_SA(b, h) + aoff + m * 2048 + k * 1024); } while (0)
#define PG8_LDB(dst, b, h) do { _Pragma("unroll") for (int n = 0; n < 2; ++n) _Pragma("unroll") for (int k = 0; k < 2; ++k) dst[n][k] = *(const PG8_LAS bf16x8*)(lds + PG8_SB(b, h) + boff + n * 2048 + k * 1024); } while (0)
#define PG8_MMA(ai, bj, At, Bt) do { __builtin_amdgcn_s_setprio(1); _Pragma("unroll") for (int m = 0; m < 4; ++m) _Pragma("unroll") for (int n = 0; n < 2; ++n) _Pragma("unroll") for (int k = 0; k < 2; ++k) \
        acc[ai][bj][m][n] = __builtin_amdgcn_mfma_f32_16x16x32_bf16(Bt[n][k], At[m][k], acc[ai][bj][m][n], 0, 0, 0); __builtin_amdgcn_s_setprio(0); } while (0)
#define PG8_WAIT_V(n) asm volatile("s_waitcnt vmcnt(" #n ")" ::: "memory")
#define PG8_WAIT_L(n) asm volatile("s_waitcnt lgkmcnt(" #n ")" ::: "memory")
#define PG8_BAR __builtin_amdgcn_s_barrier()
#define PG8_SCHED __builtin_amdgcn_sched_barrier(0)
    Unit cur, nxt; int ui = 0;
    if (!S.next(0, cur)) return;
    f32x4 acc[2][2][4][2];
#pragma unroll
    for (int a = 0; a < 2; ++a)
#pragma unroll
        for (int b = 0; b < 2; ++b)
#pragma unroll
            for (int m = 0; m < 4; ++m)
#pragma unroll
                for (int n = 0; n < 2; ++n) acc[a][b][m][n] = (f32x4){0.f, 0.f, 0.f, 0.f};
    bf16x8 At[4][2], B0[2][2], B1[2][2];
    const char* cA = (const char*)g.A + (size_t)cur.pm * tstep; const char* cB = (const char*)g.Bt + (size_t)cur.pn * tstep;
    S.a_ready(cur);
    if constexpr (SP2) {
        PG8_STAGE(PG8_SB(0, 0), cB, voffB); PG8_STAGE(PG8_SB(0, 1), cB + hstepB, voffB); PG8_STAGE(PG8_SA(0, 0), cA, voffA); PG8_STAGE(PG8_SA(0, 1), cA + hstep, voffA);
        if (wr == 1) PG8_BAR;
        PG8_WAIT_V(2); PG8_BAR;
        PG8_STAGE(PG8_SB(1, 0), cB + kstep, voffB); PG8_STAGE(PG8_SA(1, 0), cA + kstep, voffA); PG8_STAGE(PG8_SB(1, 1), cB + hstepB + kstep, voffB);
        PG8_WAIT_V(6); PG8_BAR;
    } else {
        PG8_STAGE(PG8_SB(0, 0), cB, voffB); PG8_STAGE(PG8_SA(0, 0), cA, voffA); PG8_STAGE(PG8_SB(0, 1), cB + hstepB, voffB); PG8_STAGE(PG8_SA(0, 1), cA + hstep, voffA);
        if (wr == 1) PG8_BAR;
        PG8_WAIT_V(4); PG8_BAR;
        PG8_STAGE(PG8_SB(1, 0), cB + kstep, voffB); PG8_STAGE(PG8_SA(1, 0), cA + kstep, voffA); PG8_STAGE(PG8_SB(1, 1), cB + hstepB + kstep, voffB);
        PG8_WAIT_V(6); PG8_BAR;
    }
    for (;;) {
        const bool has_next = S.next(ui + 1, nxt);
        const char* nA = has_next ? (const char*)g.A + (size_t)nxt.pm * tstep : cA; const char* nB = has_next ? (const char*)g.Bt + (size_t)nxt.pn * tstep : cB;
        for (int t = 0; t < nt; t += 2) {
            const bool last = (t == nt - 2);
            const char* a1 = cA + (size_t)(t + 1) * kstep;
            const char* a2 = last ? nA : cA + (size_t)(t + 2) * kstep; const char* b2 = last ? nB : cB + (size_t)(t + 2) * kstep;
            const char* a3 = a2 + kstep; const char* b3 = b2 + kstep;
            if (last && has_next) S.a_ready(nxt);
            if constexpr (SP2) {
            PG8_LDB(B0, 0, 0); PG8_LDB(B1, 0, 1); PG8_SCHED; PG8_LDA(At, 0, 0); PG8_STAGE(PG8_SA(1, 1), a1 + hstep, voffA);
            PG8_WAIT_V(8); PG8_WAIT_L(0); PG8_BAR; PG8_MMA(0, 0, At, B0); PG8_MMA(0, 1, At, B1); PG8_BAR; PG8_SCHED;
            PG8_LDA(At, 0, 1); PG8_STAGE(PG8_SB(0, 0), b2, voffB); PG8_STAGE(PG8_SB(0, 1), b2 + hstepB, voffB); PG8_STAGE(PG8_SA(0, 0), a2, voffA);
            PG8_WAIT_V(8); PG8_WAIT_L(0); PG8_BAR; PG8_MMA(1, 0, At, B0); PG8_MMA(1, 1, At, B1); PG8_BAR; PG8_SCHED;
            PG8_LDB(B0, 1, 0); PG8_LDB(B1, 1, 1); PG8_SCHED; PG8_LDA(At, 1, 0); PG8_STAGE(PG8_SA(0, 1), a2 + hstep, voffA);
            PG8_WAIT_V(8); PG8_WAIT_L(0); PG8_BAR; PG8_MMA(0, 0, At, B0); PG8_MMA(0, 1, At, B1); PG8_BAR; PG8_SCHED;
            PG8_LDA(At, 1, 1); PG8_STAGE(PG8_SB(1, 0), b3, voffB); PG8_STAGE(PG8_SB(1, 1), b3 + hstepB, voffB); PG8_STAGE(PG8_SA(1, 0), a3, voffA);
            PG8_WAIT_V(8); PG8_WAIT_L(0); PG8_BAR; PG8_MMA(1, 0, At, B0); PG8_MMA(1, 1, At, B1); PG8_BAR; PG8_SCHED;
            } else {
            PG8_LDB(B0, 0, 0); PG8_SCHED; PG8_LDA(At, 0, 0); PG8_STAGE(PG8_SA(1, 1), a1 + hstep, voffA);
            PG8_WAIT_L(8); PG8_BAR; PG8_WAIT_L(0); PG8_MMA(0, 0, At, B0); PG8_BAR; PG8_SCHED;
            PG8_LDB(B1, 0, 1); PG8_STAGE(PG8_SB(0, 0), b2, voffB);
            PG8_BAR; PG8_WAIT_L(0); PG8_MMA(0, 1, At, B1); PG8_BAR;
            PG8_LDA(At, 0, 1); PG8_STAGE(PG8_SA(0, 0), a2, voffA);
            PG8_BAR; PG8_WAIT_L(0); PG8_MMA(1, 0, At, B0); PG8_BAR; PG8_SCHED;
            PG8_STAGE(PG8_SB(0, 1), b2 + hstepB, voffB);
            PG8_WAIT_V(6); PG8_BAR; PG8_MMA(1, 1, At, B1); PG8_BAR;
            PG8_LDB(B0, 1, 0); PG8_SCHED; PG8_LDA(At, 1, 0); PG8_STAGE(PG8_SA(0, 1), a2 + hstep, voffA);
            PG8_WAIT_L(8); PG8_BAR; PG8_WAIT_L(0); PG8_MMA(0, 0, At, B0); PG8_BAR; PG8_SCHED;
            PG8_LDB(B1, 1, 1); PG8_STAGE(PG8_SB(1, 0), b3, voffB);
            PG8_BAR; PG8_WAIT_L(0); PG8_MMA(0, 1, At, B1); PG8_BAR;
            PG8_LDA(At, 1, 1); PG8_STAGE(PG8_SA(1, 0), a3, voffA);
            PG8_BAR; PG8_WAIT_L(0); PG8_MMA(1, 0, At, B0); PG8_BAR; PG8_SCHED;
            PG8_STAGE(PG8_SB(1, 1), b3 + hstepB, voffB);
            PG8_WAIT_V(6); PG8_BAR; PG8_MMA(1, 1, At, B1); PG8_BAR;
            }
        }
        if constexpr (ALIGN_EPI) { if (wr == 0) PG8_BAR; }
        if constexpr (!Epi::AFTER_DRAIN) { E(acc, cur, wr, wc, fr, fq); S.done(cur); }
        if (!has_next) break;
#pragma unroll
        for (int a = 0; a < 2; ++a)
#pragma unroll
            for (int b = 0; b < 2; ++b)
#pragma unroll
                for (int m = 0; m < 4; ++m)
#pragma unroll
                    for (int n = 0; n < 2; ++n) acc[a][b][m][n] = (f32x4){0.f, 0.f, 0.f, 0.f};
        cur = nxt; cA = nA; cB = nB; ++ui;
        if constexpr (ALIGN_EPI) { if (wr == 1) PG8_BAR; }
    }
    PG8_WAIT_V(0);
    if constexpr (!ALIGN_EPI) { if (wr == 0) PG8_BAR; }
    PG8_BAR;
    if constexpr (Epi::AFTER_DRAIN) { E.fused(acc, cur, wr, wc, fr, fq, lds, wid, lane); S.done(cur); }
#undef PG8_SA
#undef PG8_SB
#undef PG8_STAGE
#undef PG8_LDA
#undef PG8_LDB
#undef PG8_MMA
#undef PG8_WAIT_V
#undef PG8_WAIT_L
#undef PG8_BAR
#undef PG8_SCHED
}
}
#define GAS __attribute__((address_space(1)))
#define LAS __attribute__((address_space(3)))
typedef unsigned short bf16;
typedef unsigned v4u __attribute__((ext_vector_type(4)));
typedef float f32x4 __attribute__((ext_vector_type(4)));
typedef short bf16x8 __attribute__((ext_vector_type(8)));
typedef GAS unsigned gu32;
typedef GAS unsigned long long gu64;
#define RLX_AGENT __ATOMIC_RELAXED, __HIP_MEMORY_SCOPE_AGENT
#define LDS_WAIT() asm volatile("s_waitcnt lgkmcnt(0)" ::: "memory")
#define VM_WAIT() asm volatile("s_waitcnt vmcnt(0)" ::: "memory")
__device__ __forceinline__ unsigned long long rt() { return __builtin_amdgcn_s_memrealtime(); }
__device__ __forceinline__ unsigned f2bf(float f) { unsigned u = __builtin_bit_cast(unsigned, f); return (u + 0x7fffu + ((u >> 16) & 1u)) >> 16; }
__device__ __forceinline__ unsigned pk2(float lo, float hi) { return f2bf(lo) | (f2bf(hi) << 16); }

#define XB_TMO      128
#define XB_XCNT(j)  (256  + 64 * (j))
#define XB_XSUB(j)  (1280 + 64 * (j))
#define XB_XGEN(j)  (2304 + 64 * (j))
#define XB_TOP      3328
#define XB_TOPGEN   3392
#define XCD_BAR_WORDS 3456
#define XB_SPIN_CAP (1u << 18)

__device__ __forceinline__ unsigned xb_ld(unsigned* p)              { return __hip_atomic_load(p, __ATOMIC_RELAXED, __HIP_MEMORY_SCOPE_AGENT); }
__device__ __forceinline__ unsigned xb_add(unsigned* p, unsigned v) { return __hip_atomic_fetch_add(p, v, __ATOMIC_RELAXED, __HIP_MEMORY_SCOPE_AGENT); }
__device__ __forceinline__ unsigned xb_xcc_id() { return (unsigned)__builtin_amdgcn_s_getreg((3 << 11) | 20) & 0xFu; }
#define XB_SPIN(cond, bar) do { unsigned _sp = 0; while (cond) { __builtin_amdgcn_s_sleep(1); \
    if ((++_sp & 255u) == 0u) { if (xb_ld(&(bar)[XB_TMO])) break; if (_sp > XB_SPIN_CAP) { atomicAdd(&(bar)[XB_TMO], 1u); break; } } } } while (0)

struct XcdBarrier {
    unsigned* bar; unsigned x;
    volatile LAS unsigned* st;
};

__device__ __forceinline__ XcdBarrier xcd_barrier_post(unsigned* bar, volatile LAS unsigned* st) {
    XcdBarrier b; b.bar = bar; b.x = xb_xcc_id(); b.st = st;
    if (threadIdx.x == 0) (void)xb_add(&bar[XB_XCNT(b.x)], 1u);
    return b;
}
__device__ __forceinline__ void xcd_barrier_complete(unsigned* bar, unsigned x, unsigned& nloc, unsigned& nx) {
    const unsigned G = gridDim.x * gridDim.y * gridDim.z;
    unsigned sum, cnt, mine, sp = 0u;
    for (;;) {
        sum = 0u; cnt = 0u; mine = 0u;
#pragma unroll
        for (unsigned j = 0; j < 16; ++j) { const unsigned c = xb_ld(&bar[XB_XCNT(j)]); sum += c; cnt += (c > 0u) ? 1u : 0u; mine = (j == x) ? c : mine; }
        if (sum == G) break;
        __builtin_amdgcn_s_sleep(1);
        if ((++sp & 255u) == 0u) { if (xb_ld(&bar[XB_TMO])) break; if (sp > XB_SPIN_CAP) { atomicAdd(&bar[XB_TMO], 1u); break; } }
    }
    nloc = mine > 0u ? mine : 1u; nx = cnt > 0u ? cnt : 1u;
}

__device__ __forceinline__ void xcd_barrier(const XcdBarrier& b) {
    asm volatile("s_waitcnt vmcnt(0)" ::: "memory");
    __syncthreads();
    if (threadIdx.x == 0) {
        unsigned* bar = b.bar;
        __builtin_amdgcn_s_waitcnt(0);
        unsigned nloc = b.st[0], nx = b.st[1];
        if (nloc == 0u) { xcd_barrier_complete(bar, b.x, nloc, nx); b.st[0] = nloc; b.st[1] = nx; }
        const unsigned old = xb_add(&bar[XB_XSUB(b.x)], 1u);
        const unsigned gen = old / nloc;
        if (old + 1u == (gen + 1u) * nloc) {
            __builtin_amdgcn_fence(__ATOMIC_RELEASE, "agent");
            asm volatile("s_waitcnt vmcnt(0)" ::: "memory");
            const unsigned og = xb_add(&bar[XB_TOP], 1u);
            const unsigned tg = og / nx;
            if (og + 1u == (tg + 1u) * nx) xb_add(&bar[XB_TOPGEN], 1u);
            else XB_SPIN(xb_ld(&bar[XB_TOPGEN]) == tg, bar);
            __builtin_amdgcn_fence(__ATOMIC_ACQUIRE, "agent");
            xb_add(&bar[XB_XGEN(b.x)], 1u);
            asm volatile("s_waitcnt vmcnt(0)" ::: "memory");
        } else {
            XB_SPIN(xb_ld(&bar[XB_XGEN(b.x)]) == gen, bar);
            __builtin_amdgcn_fence(__ATOMIC_ACQUIRE, "agent");
            asm volatile("s_waitcnt vmcnt(0)" ::: "memory");
        }
    }
    __syncthreads();
}
#ifndef MK_N_LAUNCHES
#define MK_N_LAUNCHES 1
#endif
constexpr int NWAVES = 8;
constexpr int N_PHASES = 11;
constexpr int N_LAUNCHES = MK_N_LAUNCHES;
constexpr int DM = 1024, NIN = 7680, DMIX = 2048;
constexpr int MPR = 16384, MSA = 32, MPAD = 16640, SEQL = 2048;
constexpr float EPSF = 1e-6f;
constexpr size_t O_YP = 0, O_YS = 16777216, O_KP = O_YS + 32768, O_VP = O_KP + 25165824, O_KS = O_VP + 25165824, O_VS = O_KS + 49152,
                 O_SGU = O_VS + 49152, O_HP = O_SGU + 32768, O_HS = O_HP + 1572864, O_END = O_HS + 6291456;
constexpr size_t MiB = 1u << 20;
constexpr size_t alup(size_t x) { return (x + MiB - 1) / MiB * MiB; }
constexpr size_t WS_CTL = 0, CTL_ZERO_BYTES = MiB;
constexpr size_t WS_WIN = MiB;
constexpr size_t WS_WOUT = WS_WIN + alup((size_t)2 * NIN * DM * 2);
constexpr size_t WS_SGW = WS_WOUT + alup((size_t)2 * DM * DMIX * 2);
constexpr size_t WS_LB = WS_SGW + alup((size_t)2 * 8 * 128 * 128 * 2);
constexpr size_t WS_XB = WS_LB + MiB;
constexpr size_t WS_QB = WS_XB + alup((size_t)MPAD * DM * 2);
constexpr size_t WS_KB = WS_QB + alup((size_t)MPAD * 768 * 2);
constexpr size_t WS_VB = WS_KB + alup((size_t)MPAD * 768 * 2);
constexpr size_t WS_ZB = WS_VB + alup((size_t)MPAD * 768 * 2);
constexpr size_t WS_BU = WS_ZB + alup((size_t)MPAD * 2048 * 2);
constexpr size_t WS_BV = WS_BU + alup((size_t)MPAD * 512 * 2);
constexpr size_t WS_CQ = WS_BV + alup((size_t)MPAD * 512 * 2);
constexpr size_t WS_CK = WS_CQ + alup((size_t)MPAD * 768 * 2);
constexpr size_t WS_CI = WS_CK + alup((size_t)MPAD * 768 * 2);
constexpr size_t WS_CG = WS_CI + alup((size_t)MPAD * 768 * 2);
constexpr size_t WS_YB = WS_CG + alup((size_t)MPAD * 768 * 4);
constexpr size_t WS_X1 = WS_YB + alup((size_t)MPAD * 2048 * 2);
constexpr size_t WS_DS = WS_X1 + alup((size_t)MPAD * DM * 4);
constexpr size_t WS_DEC = WS_DS + alup((size_t)48 * 16 * 128 * 128 * 4);
constexpr size_t WS_END = WS_DEC + alup((size_t)48 * 16 * 128 * 4);
constexpr int CW_TMO = 0, CW_CODE = 1, CW_BAR = 4096, CW_Q = 8192;
constexpr size_t CTL_SSQ0 = 256 * 1024, CTL_SSQ1 = 512 * 1024;
constexpr int RING_OFF = 0, LDS_BYTES = 163840, MISC_OFF = LDS_BYTES - 1024;
static_assert(WS_VB - WS_KB == WS_KB - WS_QB && WS_CI - WS_CK == WS_CK - WS_CQ, "equally spaced buffer groups (addressed arithmetically in the in-projection epilogue)");
#define DI __device__ __forceinline__
typedef float f32x16 __attribute__((ext_vector_type(16)));
typedef short s16x4 __attribute__((ext_vector_type(4)));
typedef short v4i16_t __attribute__((ext_vector_type(4)));
typedef float f32x2v __attribute__((ext_vector_type(2)));
typedef unsigned u32x2v __attribute__((ext_vector_type(2)));
typedef __bf16 bf16x2v __attribute__((ext_vector_type(2)));
#define MFMA32(a, b, c) __builtin_amdgcn_mfma_f32_32x32x16_bf16((a), (b), (c), 0, 0, 0)
DI unsigned cvtpk2(float lo, float hi) { f32x2v v = {lo, hi}; bf16x2v b = __builtin_convertvector(v, bf16x2v); return __builtin_bit_cast(unsigned, b); }
DI float bf2f(bf16 u) { return __uint_as_float((unsigned)u << 16); }
DI float bflo(unsigned w) { return __uint_as_float(w << 16); }
DI float bfhi(unsigned w) { return __uint_as_float(w & 0xffff0000u); }
DI int crow(int r, int h) { return (r & 3) + 8 * (r >> 2) + 4 * h; }
DI float wave_sum(float v) {
#pragma unroll
    for (int o = 1; o < 64; o <<= 1) v += __shfl_xor(v, o);
    return v;
}
DI float wave_max(float v) {
#pragma unroll
    for (int o = 1; o < 64; o <<= 1) v = fmaxf(v, __shfl_xor(v, o));
    return v;
}
DI s16x4 trd(LAS const unsigned char* p) { return __builtin_bit_cast(s16x4, __builtin_amdgcn_ds_read_tr16_b64_v4i16((LAS v4i16_t*)p)); }
DI int tr_lane_off(int pitch, int lane, bool perm) { const int i16 = lane & 15, q = i16 >> 2, p = i16 & 3, blk = (lane >> 4) & 1, h = lane >> 5; return ((perm ? 4 * h : 8 * h) + q) * pitch + (16 * blk + 4 * p) * 2; }
DI bf16x8 trfrag(LAS const unsigned char* base, int pitch, int k0, int c0, int laneoff, bool perm) {
    LAS const unsigned char* a = base + k0 * pitch + c0 * 2 + laneoff;
    const s16x4 lo = trd(a), hi = trd(a + (perm ? 8 : 4) * pitch);
    return __builtin_shufflevector(lo, hi, 0, 1, 2, 3, 4, 5, 6, 7);
}
DI bf16x8 pack8(const f32x16& x, int s) { v4u p; p.x = cvtpk2(x[8 * s], x[8 * s + 1]); p.y = cvtpk2(x[8 * s + 2], x[8 * s + 3]); p.z = cvtpk2(x[8 * s + 4], x[8 * s + 5]); p.w = cvtpk2(x[8 * s + 6], x[8 * s + 7]); return __builtin_bit_cast(bf16x8, p); }
DI f32x16 zero16() { f32x16 z;
#pragma unroll
    for (int i = 0; i < 16; ++i) z[i] = 0.f; return z; }

struct Args { const float* in[16]; float* out; unsigned char* ws; int ph_lo, ph_hi; };
struct Ctx {
    LAS unsigned char* lds; volatile LAS unsigned* MISC;
    int tid, lane, wave, vcu, G;
};
typedef __attribute__((address_space(4))) const Args* kaptr_t;
DI kaptr_t kargs() { kaptr_t kp = (kaptr_t)__builtin_amdgcn_kernarg_segment_ptr(); asm volatile("" : "+s"(kp)); return kp; }
#define INP(i) (kargs()->in[i])
#define WSP(off) (kargs()->ws + (off))
#define OUTP() (kargs()->out)
DI void p0_transpose_item(const float* W, int K, int N, bf16* WT, const float* gk, LAS float* scr, int item, int lane) {
    const int nblk = N / 32, kb = item / nblk, nb = item % nblk, k0 = 64 * kb, n0 = 32 * nb;
#pragma unroll 8
    for (int i = 0; i < 32; ++i) { const int kk = 2 * i + (lane >> 5); float w = W[(size_t)(k0 + kk) * N + n0 + (lane & 31)]; if (gk) w *= gk[k0 + kk]; scr[kk * 33 + (lane & 31)] = w; }
    LDS_WAIT(); asm volatile("" ::: "memory");
    const int c = lane & 7;
#pragma unroll
    for (int j = 0; j < 4; ++j) { const int n = (lane >> 3) + 8 * j; const LAS float* s = scr + (8 * c) * 33 + n;
        v4u o; o.x = pk2(s[0 * 33], s[1 * 33]); o.y = pk2(s[2 * 33], s[3 * 33]); o.z = pk2(s[4 * 33], s[5 * 33]); o.w = pk2(s[6 * 33], s[7 * 33]);
        *(GAS v4u*)(WT + (size_t)(n0 + n) * K + k0 + 8 * c) = o; }
    LDS_WAIT(); asm volatile("" ::: "memory");
}
DI void p0_prologue(Ctx& C) { const float* const p_qn_g = ((const float*)INP(7)); const float* const p_kn_g = ((const float*)INP(8)); float* const p_LB = ((float*)WSP(WS_LB)); bf16* const p_SGW = ((bf16*)WSP(WS_SGW)); float* const p_SSQ0 = ((float*)WSP(WS_CTL + CTL_SSQ0)); bf16* const p_WIN = ((bf16*)WSP(WS_WIN)); bf16* const p_WOUT = ((bf16*)WSP(WS_WOUT)); bf16* const p_XB = ((bf16*)WSP(WS_XB)); const float* const p_lb_logits = ((const float*)INP(13)); const float* const p_norm_g = ((const float*)INP(5)); const float* const p_sgu_w = ((const float*)INP(11)); const float* const p_w_in = ((const float*)INP(6)); const float* const p_w_out = ((const float*)INP(15)); const float* const p_x_prompt = ((const float*)INP(0)); const float* const p_x_sample = ((const float*)INP(1));
    LAS float* scr = (LAS float*)(C.lds + RING_OFF + C.wave * 16384);
    const int gw = C.vcu * NWAVES + C.wave, NGW = C.G * NWAVES;
    constexpr int I_IN1 = (DM / 64) * (NIN / 32), I_OUT1 = (DMIX / 64) * (DM / 32);
    constexpr int NITEMS = 2 * I_IN1 + 2 * I_OUT1;
    for (int it = gw; it < NITEMS; it += NGW) {
        int r = it;
        if (r < 2 * I_IN1) { const int l = r / I_IN1; r -= l * I_IN1; p0_transpose_item(p_w_in + (size_t)l * DM * NIN, DM, NIN, p_WIN + (size_t)l * NIN * DM, p_norm_g + l * DM, scr, r, C.lane); continue; }
        r -= 2 * I_IN1; { const int l = r / I_OUT1; r -= l * I_OUT1; p0_transpose_item(p_w_out + (size_t)l * DMIX * DM, DMIX, DM, p_WOUT + (size_t)l * DM * DMIX, nullptr, scr, r, C.lane); }
    }
    for (int m = gw; m < MPAD; m += NGW) {
        GAS unsigned long long* o8 = (GAS unsigned long long*)(p_XB + (size_t)m * DM) + C.lane;
        if (m < MPR + MSA) {
            const float* xrow = (m < MPR) ? p_x_prompt + (size_t)m * DM : p_x_sample + (size_t)(m - MPR) * DM;
            const GAS f32x4* xr = (const GAS f32x4*)xrow + C.lane; f32x4 v[4]; float s = 0.f;
#pragma unroll
            for (int j = 0; j < 4; ++j) { v[j] = xr[64 * j]; s += (v[j].x * v[j].x + v[j].y * v[j].y) + (v[j].z * v[j].z + v[j].w * v[j].w); }
            s = wave_sum(s);
#pragma unroll
            for (int j = 0; j < 4; ++j) o8[64 * j] = (unsigned long long)pk2(v[j].x, v[j].y) | ((unsigned long long)pk2(v[j].z, v[j].w) << 32);
            if (C.lane == 0) p_SSQ0[m] = s;
        } else {
#pragma unroll
            for (int j = 0; j < 4; ++j) o8[64 * j] = 0ull;
            if (C.lane == 0) p_SSQ0[m] = 0.f;
        }
    }
    const int gt = C.vcu * 512 + C.tid, NGT = C.G * 512;
    for (int e = gt; e < 2 * 8 * 128 * 128; e += NGT) { const int s = e & 127, t = (e >> 7) & 127; const float w = p_sgu_w[e]; p_SGW[e] = (bf16)f2bf(s <= t ? w : 0.f); }
    for (int e = gt; e < 2 * 768; e += NGT) { const int l = e / 768, c = e - 768 * l; p_LB[(l * 3 + 0) * 768 + c] = p_qn_g[e]; p_LB[(l * 3 + 1) * 768 + c] = p_kn_g[e]; p_LB[(l * 3 + 2) * 768 + c] = (l == 0) ? 0.f : 1.0f / (1.0f + __expf(p_lb_logits[c] - p_lb_logits[768 + c])); }
}
DI float ex2(float x) { return __builtin_amdgcn_exp2f(x); }
DI float lg2(float x) { return __builtin_amdgcn_logf(x); }

DI void attn_task(const bf16* Qh, const bf16* Kh, const bf16* Vh, int tq0, int dstr, int m0, LAS unsigned char* vst, f32x16 (&o)[2], float& lse, int lane) {
    const int i = lane & 31, h = lane >> 5;
    bf16x8 qf[4];
    { const bf16* qp = Qh + (size_t)(tq0 + dstr * i) * 768 + 8 * h;
#pragma unroll
      for (int s = 0; s < 4; ++s) qf[s] = *(const bf16x8*)(qp + 16 * s); }
    o[0] = zero16(); o[1] = zero16();
    float mrun = -1e30f, l = 0.f;
    const int jstart = (m0 >= 128) ? 0 : ((128 - m0) >> 5);
    const int troff = tr_lane_off(128, lane, true);
    const int wrow = lane >> 3, wch = lane & 7;
    for (int j = jstart; j < 5; ++j) {
        const int kt0 = tq0 + dstr * (32 * j - 128);
        LAS unsigned char* vb = vst + (j & 1) * 4096;
        bf16x8 kf[4];
        { const bf16* kp = Kh + (size_t)(kt0 + dstr * i) * 768 + 8 * h;
#pragma unroll
          for (int s = 0; s < 4; ++s) kf[s] = *(const bf16x8*)(kp + 16 * s); }
#pragma unroll
        for (int it = 0; it < 4; ++it) { const int row = wrow + 8 * it; const v4u v = *(const v4u*)(Vh + (size_t)(kt0 + dstr * row) * 768 + 8 * wch); *(LAS v4u*)(vb + row * 128 + wch * 16) = v; }
        f32x16 st = zero16();
#pragma unroll
        for (int s = 0; s < 4; ++s) st = MFMA32(kf[s], qf[s], st);
        if (j == 0) {
#pragma unroll
            for (int r = 0; r < 16; ++r) if (crow(r, h) < i) st[r] = -1e30f;
        }
        if (j == 4) {
#pragma unroll
            for (int r = 0; r < 16; ++r) if (crow(r, h) > i) st[r] = -1e30f;
        }
        float rm = st[0];
#pragma unroll
        for (int r = 1; r < 16; ++r) rm = fmaxf(rm, st[r]);
        rm = fmaxf(rm, __shfl_xor(rm, 32));
        const float mn = fmaxf(mrun, rm), alpha = ex2(mrun - mn); mrun = mn;
        float ps = 0.f;
#pragma unroll
        for (int r = 0; r < 16; ++r) { st[r] = ex2(st[r] - mn); ps += st[r]; }
        l = l * alpha + ps;
#pragma unroll
        for (int r = 0; r < 16; ++r) { o[0][r] *= alpha; o[1][r] *= alpha; }
        const bf16x8 pb0 = pack8(st, 0), pb1 = pack8(st, 1);
#pragma unroll
        for (int db = 0; db < 2; ++db) {
            o[db] = MFMA32(trfrag(vb, 128, 0, 32 * db, troff, true), pb0, o[db]);
            o[db] = MFMA32(trfrag(vb, 128, 16, 32 * db, troff, true), pb1, o[db]);
        }
    }
    l += __shfl_xor(l, 32);
    const float inv = 1.0f / l;
#pragma unroll
    for (int r = 0; r < 16; ++r) { o[0][r] *= inv; o[1][r] *= inv; }
    lse = mrun + lg2(l);
}
DI void attn_item(const Ctx& C, int item) { bf16* const p_KB = ((bf16*)WSP(WS_KB)); bf16* const p_QB = ((bf16*)WSP(WS_QB)); bf16* const p_VB = ((bf16*)WSP(WS_VB)); bf16* const p_YB = ((bf16*)WSP(WS_YB)); bf16* const p_ZB = ((bf16*)WSP(WS_ZB));
    const int Tb = item & 3, hh = (item >> 2) % 12, b = item / 48, lane = C.lane, wave = C.wave, i = lane & 31, h = lane >> 5;
    const size_t rb = (size_t)b * SEQL;
    const bf16* Qh = p_QB + rb * 768 + hh * 64; const bf16* Kh = p_KB + rb * 768 + hh * 64; const bf16* Vh = p_VB + rb * 768 + hh * 64;
    constexpr int OP = 136;
    LAS unsigned char* oacc = C.lds; LAS float* lsea = (LAS float*)(C.lds + 512 * OP); LAS unsigned char* vst = C.lds + 512 * OP + 2048 + wave * 8192;
#pragma unroll 1
    for (int pat = 0; pat < 3; ++pat) {
#pragma unroll 1
        for (int rep = 0; rep < 2; ++rep) {
            const int t16 = wave + 8 * rep;
            int dstr, tq0, m0, lt0;
            if (pat == 0) { dstr = 1; lt0 = 32 * t16; tq0 = 512 * Tb + lt0; m0 = tq0; }
            else if (pat == 1) { dstr = 4; const int r4 = t16 & 3, u = t16 >> 2; lt0 = 128 * u + r4; tq0 = 512 * Tb + lt0; m0 = 128 * Tb + 32 * u; }
            else { dstr = 16; lt0 = t16; tq0 = 512 * Tb + lt0; m0 = 32 * Tb; }
            f32x16 o[2]; float lse;
            attn_task(Qh, Kh, Vh, tq0, dstr, m0, vst, o, lse, lane);
            const int ltok = lt0 + dstr * i;
            LAS unsigned char* orow = oacc + ltok * OP + 8 * h;
            if (pat > 0) {
                const float a = lsea[ltok], M = fmaxf(a, lse), L = M + lg2(ex2(a - M) + ex2(lse - M)), wa = ex2(a - L), wb = ex2(lse - L);
#pragma unroll
                for (int db = 0; db < 2; ++db)
#pragma unroll
                    for (int g4 = 0; g4 < 4; ++g4) { const u32x2v w = *(LAS const u32x2v*)(orow + (32 * db + 8 * g4) * 2);
                        o[db][4 * g4 + 0] = wa * bflo(w.x) + wb * o[db][4 * g4 + 0]; o[db][4 * g4 + 1] = wa * bfhi(w.x) + wb * o[db][4 * g4 + 1];
                        o[db][4 * g4 + 2] = wa * bflo(w.y) + wb * o[db][4 * g4 + 2]; o[db][4 * g4 + 3] = wa * bfhi(w.y) + wb * o[db][4 * g4 + 3]; }
                lse = L;
            }
            if (pat < 2) {
#pragma unroll
                for (int db = 0; db < 2; ++db)
#pragma unroll
                    for (int g4 = 0; g4 < 4; ++g4) { u32x2v w; w.x = cvtpk2(o[db][4 * g4], o[db][4 * g4 + 1]); w.y = cvtpk2(o[db][4 * g4 + 2], o[db][4 * g4 + 3]); *(LAS u32x2v*)(orow + (32 * db + 8 * g4) * 2) = w; }
                if (h == 0) lsea[ltok] = lse;
            } else {
                const size_t m = rb + 512 * Tb + ltok; const bf16* zp = p_ZB + m * 2048 + hh * 64 + 4 * h; bf16* yp = p_YB + m * 2048 + hh * 64 + 4 * h;
#pragma unroll
                for (int db = 0; db < 2; ++db)
#pragma unroll
                    for (int g4 = 0; g4 < 4; ++g4) { const u32x2v z = *(const u32x2v*)(zp + 32 * db + 8 * g4); u32x2v w;
                        w.x = cvtpk2(o[db][4 * g4] * bflo(z.x), o[db][4 * g4 + 1] * bfhi(z.x)); w.y = cvtpk2(o[db][4 * g4 + 2] * bflo(z.y), o[db][4 * g4 + 3] * bfhi(z.y));
                        *(u32x2v*)(yp + 32 * db + 8 * g4) = w; }
            }
        }
        if (pat < 2) __syncthreads();
    }
}

DI void sgu_item(const Ctx& C, int l, int item) { bf16* const p_BU = ((bf16*)WSP(WS_BU)); bf16* const p_BV = ((bf16*)WSP(WS_BV)); bf16* const p_SGW = ((bf16*)WSP(WS_SGW)); bf16* const p_YB = ((bf16*)WSP(WS_YB)); bf16* const p_ZB = ((bf16*)WSP(WS_ZB)); const float* const p_ln_b = ((const float*)INP(10)); const float* const p_ln_g = ((const float*)INP(9)); const float* const p_sgu_b = ((const float*)INP(12));
    const int b = item >> 4, ch = item & 15, lane = C.lane, wave = C.wave, i = lane & 31, h = lane >> 5; const size_t m0 = (size_t)b * SEQL + ch * 128;
    constexpr int VP = 1040;
    { f32x4 g0 = *(const f32x4*)(p_ln_g + l * 512 + 8 * lane), g1 = *(const f32x4*)(p_ln_g + l * 512 + 8 * lane + 4), b0 = *(const f32x4*)(p_ln_b + l * 512 + 8 * lane), b1 = *(const f32x4*)(p_ln_b + l * 512 + 8 * lane + 4);
#pragma unroll 4
      for (int tt = 0; tt < 16; ++tt) { const int t = 16 * wave + tt; const v4u raw = *(const v4u*)(p_BV + (m0 + t) * 512 + 8 * lane);
        float x[8] = {bflo(raw.x), bfhi(raw.x), bflo(raw.y), bfhi(raw.y), bflo(raw.z), bfhi(raw.z), bflo(raw.w), bfhi(raw.w)};
        float s = 0.f;
#pragma unroll
        for (int e = 0; e < 8; ++e) s += x[e];
        const float mean = wave_sum(s) * (1.0f / 512.0f); float q = 0.f;
#pragma unroll
        for (int e = 0; e < 8; ++e) { x[e] -= mean; q += x[e] * x[e]; }
        const float rstd = __builtin_amdgcn_rsqf(wave_sum(q) * (1.0f / 512.0f) + EPSF);
        v4u w; w.x = cvtpk2(x[0] * rstd * g0[0] + b0[0], x[1] * rstd * g0[1] + b0[1]); w.y = cvtpk2(x[2] * rstd * g0[2] + b0[2], x[3] * rstd * g0[3] + b0[3]);
        w.z = cvtpk2(x[4] * rstd * g1[0] + b1[0], x[5] * rstd * g1[1] + b1[1]); w.w = cvtpk2(x[6] * rstd * g1[2] + b1[2], x[7] * rstd * g1[3] + b1[3]);
        *(LAS v4u*)(C.lds + t * VP + lane * 16) = w; } }
    __syncthreads();
    const int g = wave; const bf16* Wg = p_SGW + (size_t)((l * 8 + g) * 128) * 128; const int troff = tr_lane_off(VP, lane, false);
#pragma unroll
    for (int tb = 0; tb < 4; ++tb) {
        f32x16 acc[2]; acc[0] = zero16(); acc[1] = zero16();
#pragma unroll
        for (int ks = 0; ks < 2 * tb + 2; ++ks) {
            const bf16x8 wf = *(const bf16x8*)(Wg + (32 * tb + i) * 128 + 16 * ks + 8 * h);
#pragma unroll
            for (int cb = 0; cb < 2; ++cb) acc[cb] = MFMA32(trfrag(C.lds, VP, 16 * ks, 64 * g + 32 * cb, troff, false), wf, acc[cb]);
        }
        const int t = 32 * tb + i; const float bias = p_sgu_b[(l * 8 + g) * 128 + t]; const size_t m = m0 + t;
#pragma unroll
        for (int cb = 0; cb < 2; ++cb)
#pragma unroll
            for (int g4 = 0; g4 < 4; ++g4) { const int c0 = 64 * g + 32 * cb + 8 * g4 + 4 * h;
                const u32x2v u = *(const u32x2v*)(p_BU + m * 512 + c0), z = *(const u32x2v*)(p_ZB + m * 2048 + 768 + c0); u32x2v w;
                w.x = cvtpk2(bflo(u.x) * (acc[cb][4 * g4] + bias) * bflo(z.x), bfhi(u.x) * (acc[cb][4 * g4 + 1] + bias) * bfhi(z.x));
                w.y = cvtpk2(bflo(u.y) * (acc[cb][4 * g4 + 2] + bias) * bflo(z.y), bfhi(u.y) * (acc[cb][4 * g4 + 3] + bias) * bfhi(z.y));
                *(u32x2v*)(p_YB + m * 2048 + 768 + c0) = w; }
    }
}

DI void hg1_item(const Ctx& C, int item) { float* const p_CG = ((float*)WSP(WS_CG)); bf16* const p_CI = ((bf16*)WSP(WS_CI)); bf16* const p_CK = ((bf16*)WSP(WS_CK)); float* const p_DEC = ((float*)WSP(WS_DEC)); float* const p_DS = ((float*)WSP(WS_DS));
    const int seg = item & 15, bh = item >> 4, b = bh / 6, hh = bh % 6, tid = C.tid, lane = C.lane, wave = C.wave, i = lane & 31, h = lane >> 5;
    const size_t m0 = (size_t)b * SEQL + seg * 128; const int c = tid & 127, tq = tid >> 7;
    constexpr int PT = 272;
    LAS unsigned char* KP = C.lds; LAS unsigned char* VV = C.lds + 128 * PT; LAS float* part = (LAS float*)(C.lds + 2 * 128 * PT);
    const float* gp = p_CG + (m0 + 32 * tq) * 768 + hh * 128 + c; const bf16* kp = p_CK + (m0 + 32 * tq) * 768 + hh * 128 + c;
    float sum = 0.f;
#pragma unroll 8
    for (int s = 0; s < 32; ++s) sum += gp[(size_t)s * 768];
    part[tq * 128 + c] = sum;
#pragma unroll
    for (int it = 0; it < 4; ++it) { const int idx = tid + 512 * it, row = idx >> 4, chn = idx & 15; *(LAS v4u*)(VV + row * PT + chn * 16) = *(const v4u*)(p_CI + (m0 + row) * 768 + hh * 128 + chn * 8); }
    __syncthreads();
    float off = 0.f, tot = 0.f;
#pragma unroll
    for (int q4 = 0; q4 < 4; ++q4) { const float pv = part[q4 * 128 + c]; tot += pv; if (q4 < tq) off += pv; }
    float run = off;
#pragma unroll 8
    for (int s = 0; s < 32; ++s) { run += gp[(size_t)s * 768]; const float kv = bf2f(kp[(size_t)s * 768]) * __expf(tot - run); *(LAS bf16*)(KP + (32 * tq + s) * PT + c * 2) = (bf16)f2bf(kv); }
    if (tq == 0) p_DEC[(size_t)(bh * 16 + seg) * 128 + c] = __expf(tot);
    __syncthreads();
    const int kb = wave >> 1, vb0 = 2 * (wave & 1), troff = tr_lane_off(PT, lane, false);
    f32x16 acc[2]; acc[0] = zero16(); acc[1] = zero16();
#pragma unroll
    for (int ks = 0; ks < 8; ++ks) { const bf16x8 af = trfrag(KP, PT, 16 * ks, 32 * kb, troff, false);
#pragma unroll
        for (int j2 = 0; j2 < 2; ++j2) acc[j2] = MFMA32(af, trfrag(VV, PT, 16 * ks, 32 * (vb0 + j2), troff, false), acc[j2]); }
    float* dsp = p_DS + (size_t)(bh * 16 + seg) * 16384;
#pragma unroll
    for (int j2 = 0; j2 < 2; ++j2)
#pragma unroll
        for (int r = 0; r < 16; ++r) dsp[(32 * kb + crow(r, h)) * 128 + 32 * (vb0 + j2) + i] = acc[j2][r];
}
DI void hg2_item(const Ctx& C, int l, int item) { float* const p_DEC = ((float*)WSP(WS_DEC)); float* const p_DS = ((float*)WSP(WS_DS)); float* const p_out = OUTP();
    const int bh = item >> 3, sl = item & 7, e = sl * 2048 + C.tid * 4, k = e >> 7;
    f32x4 S = (f32x4){0.f, 0.f, 0.f, 0.f};
#pragma unroll 4
    for (int seg = 0; seg < 16; ++seg) { float* p = p_DS + (size_t)(bh * 16 + seg) * 16384 + e; const f32x4 t = *(const f32x4*)p; const float d = p_DEC[(size_t)(bh * 16 + seg) * 128 + k]; *(f32x4*)p = S; S = S * d + t; }
    *(f32x4*)(p_out + O_HP + (size_t)(l * 48 + bh) * 16384 + e) = S;
}
DI void hg3_item(const Ctx& C, int l, int item) { float* const p_CG = ((float*)WSP(WS_CG)); bf16* const p_CI = ((bf16*)WSP(WS_CI)); bf16* const p_CK = ((bf16*)WSP(WS_CK)); bf16* const p_CQ = ((bf16*)WSP(WS_CQ)); float* const p_DS = ((float*)WSP(WS_DS)); bf16* const p_YB = ((bf16*)WSP(WS_YB)); bf16* const p_ZB = ((bf16*)WSP(WS_ZB)); const float* const p_hn_g = ((const float*)INP(14));
    const int seg = item & 15, bh = item >> 4, b = bh / 6, hh = bh % 6, tid = C.tid, lane = C.lane, wave = C.wave, i = lane & 31, h = lane >> 5;
    const size_t m0 = (size_t)b * SEQL + seg * 128; const int c = tid & 127, tq = tid >> 7;
    constexpr int PT = 272, MB = 128 * PT;
    LAS unsigned char *QT = C.lds, *KD = C.lds + MB, *VV = C.lds + 2 * MB, *SB = C.lds + 3 * MB;
    LAS float* DJ = (LAS float*)(C.lds + 4 * MB); LAS float* RS = DJ + 512;
    { const size_t o0 = (m0 + 32 * tq) * 768 + hh * 128 + c; float run = 0.f;
#pragma unroll 8
      for (int s = 0; s < 32; ++s) { const size_t o = o0 + (size_t)s * 768; run += p_CG[o]; const float q = bf2f(p_CQ[o]), k = bf2f(p_CK[o]);
        *(LAS bf16*)(QT + (32 * tq + s) * PT + c * 2) = (bf16)f2bf(q * __expf(run)); *(LAS bf16*)(KD + (32 * tq + s) * PT + c * 2) = (bf16)f2bf(k * __expf(-run)); }
      DJ[tq * 128 + c] = __expf(run); }
#pragma unroll
    for (int it = 0; it < 4; ++it) { const int idx = tid + 512 * it, row = idx >> 4, chn = idx & 15; *(LAS v4u*)(VV + row * PT + chn * 16) = *(const v4u*)(p_CI + (m0 + row) * 768 + hh * 128 + chn * 8); }
    f32x16 sacc[4];
    const int kb = wave & 3;
    if (wave >= 4) {
        const float* sp = p_DS + (size_t)(bh * 16 + seg) * 16384 + (size_t)(32 * kb + i) * 128 + 4 * h;
#pragma unroll
        for (int vb = 0; vb < 4; ++vb)
#pragma unroll
            for (int g4 = 0; g4 < 4; ++g4) { const f32x4 t = *(const f32x4*)(sp + 32 * vb + 8 * g4); sacc[vb][4 * g4] = t[0]; sacc[vb][4 * g4 + 1] = t[1]; sacc[vb][4 * g4 + 2] = t[2]; sacc[vb][4 * g4 + 3] = t[3];
                u32x2v w; w.x = cvtpk2(t[0], t[1]); w.y = cvtpk2(t[2], t[3]); *(LAS u32x2v*)(SB + (32 * kb + i) * PT + (32 * vb + 8 * g4 + 4 * h) * 2) = w; }
    }
    __syncthreads();
    const int tro_n = tr_lane_off(PT, lane, false), tro_p = tr_lane_off(PT, lane, true);
#pragma unroll 1
    for (int j = 0; j < 4; ++j) {
        f32x16 oa = zero16();
        if (wave < 4) {
            const int vb = wave;
            bf16x8 qfr[8];
#pragma unroll
            for (int ks = 0; ks < 8; ++ks) qfr[ks] = *(LAS const bf16x8*)(QT + (32 * j + i) * PT + (16 * ks + 8 * h) * 2);
            f32x16 x = zero16();
#pragma unroll
            for (int ks = 0; ks < 8; ++ks) x = MFMA32(*(LAS const bf16x8*)(KD + (32 * j + i) * PT + (16 * ks + 8 * h) * 2), qfr[ks], x);
#pragma unroll
            for (int r = 0; r < 16; ++r) if (crow(r, h) > i) x[r] = 0.f;
            const bf16x8 pb0 = pack8(x, 0), pb1 = pack8(x, 1);
#pragma unroll
            for (int ks = 0; ks < 8; ++ks) oa = MFMA32(trfrag(SB, PT, 16 * ks, 32 * vb, tro_n, false), qfr[ks], oa);
            oa = MFMA32(trfrag(VV, PT, 32 * j, 32 * vb, tro_p, true), pb0, oa);
            oa = MFMA32(trfrag(VV, PT, 32 * j + 16, 32 * vb, tro_p, true), pb1, oa);
            float ss = 0.f;
#pragma unroll
            for (int r = 0; r < 16; ++r) ss += oa[r] * oa[r];
            ss += __shfl_xor(ss, 32);
            if (h == 0) RS[vb * 32 + i] = ss;
        } else if (j < 3) {
#pragma unroll
            for (int s2 = 0; s2 < 2; ++s2) { const bf16x8 kfr = trfrag(KD, PT, 32 * j + 16 * s2, 32 * kb, tro_n, false);
#pragma unroll
                for (int vb = 0; vb < 4; ++vb) sacc[vb] = MFMA32(trfrag(VV, PT, 32 * j + 16 * s2, 32 * vb, tro_n, false), kfr, sacc[vb]); }
            const float d = DJ[j * 128 + 32 * kb + i];
#pragma unroll
            for (int vb = 0; vb < 4; ++vb)
#pragma unroll
                for (int r = 0; r < 16; ++r) sacc[vb][r] *= d;
        }
        __syncthreads();
        if (wave < 4) {
            const int vb = wave; const float tot = RS[i] + RS[32 + i] + RS[64 + i] + RS[96 + i], rstd = __builtin_amdgcn_rsqf(tot * (1.0f / 128.0f) + EPSF);
            const size_t m = m0 + 32 * j + i;
#pragma unroll
            for (int g4 = 0; g4 < 4; ++g4) { const int v0 = hh * 128 + 32 * vb + 8 * g4 + 4 * h; const f32x4 gn = *(const f32x4*)(p_hn_g + l * 768 + v0); const u32x2v z = *(const u32x2v*)(p_ZB + m * 2048 + 1280 + v0); u32x2v w;
                w.x = cvtpk2(oa[4 * g4] * rstd * gn[0] * bflo(z.x), oa[4 * g4 + 1] * rstd * gn[1] * bfhi(z.x)); w.y = cvtpk2(oa[4 * g4 + 2] * rstd * gn[2] * bflo(z.y), oa[4 * g4 + 3] * rstd * gn[3] * bfhi(z.y));
                *(u32x2v*)(p_YB + m * 2048 + 1280 + v0) = w; }
        } else if (j < 3) {
#pragma unroll
            for (int vb = 0; vb < 4; ++vb)
#pragma unroll
                for (int g4 = 0; g4 < 4; ++g4) { u32x2v w; w.x = cvtpk2(sacc[vb][4 * g4], sacc[vb][4 * g4 + 1]); w.y = cvtpk2(sacc[vb][4 * g4 + 2], sacc[vb][4 * g4 + 3]); *(LAS u32x2v*)(SB + (32 * kb + i) * PT + (32 * vb + 8 * g4 + 4 * h) * 2) = w; }
        }
        __syncthreads();
    }
}
DI void samp_attn_item(const Ctx& C, int l, int item) { bf16* const p_KB = ((bf16*)WSP(WS_KB)); bf16* const p_QB = ((bf16*)WSP(WS_QB)); bf16* const p_VB = ((bf16*)WSP(WS_VB)); bf16* const p_YB = ((bf16*)WSP(WS_YB)); bf16* const p_ZB = ((bf16*)WSP(WS_ZB)); const float* const p_cache_k = ((const float*)INP(2)); const float* const p_cache_v = ((const float*)INP(3));
    const int b = item >> 1, wave = C.wave, lane = C.lane; if (wave >= 6) return;
    const int hh = 6 * (item & 1) + wave; const size_t row = MPR + b;
    LAS float* sc = (LAS float*)(C.lds + wave * 2048);
    const float* ck = p_cache_k + ((size_t)(l * 32 + b) * 2048) * 768 + hh * 64; const float* cv = p_cache_v + ((size_t)(l * 32 + b) * 2048) * 768 + hh * 64;
    const int gq = lane >> 4, dl = 4 * (lane & 15);
    const u32x2v qraw = *(const u32x2v*)(p_QB + row * 768 + hh * 64 + dl); const float q0 = bflo(qraw.x), q1 = bfhi(qraw.x), q2 = bflo(qraw.y), q3 = bfhi(qraw.y);
    const u32x2v knraw = *(const u32x2v*)(p_KB + row * 768 + hh * 64 + dl);
    const f32x4 knew = (f32x4){bflo(knraw.x), bfhi(knraw.x), bflo(knraw.y), bfhi(knraw.y)};
#pragma unroll 1
    for (int it = 0; it < 97; ++it) {
        int slot = 4 * it + gq; const bool ok = slot < 387; if (!ok) slot = 386;
        const int pp = slot / 129, jj = slot - 129 * pp, idx = 2048 - (jj << (2 * pp));
        f32x4 kv = knew; if (idx < 2048) kv = *(const f32x4*)(ck + (size_t)idx * 768 + dl);
        float part = (q0 * kv[0] + q1 * kv[1]) + (q2 * kv[2] + q3 * kv[3]);
        part += __shfl_xor(part, 1); part += __shfl_xor(part, 2); part += __shfl_xor(part, 4); part += __shfl_xor(part, 8);
        if ((lane & 15) == 0 && ok) sc[slot] = part;
    }
    float mx = -1e30f;
    for (int t = lane; t < 387; t += 64) mx = fmaxf(mx, sc[t]);
    mx = wave_max(mx);
    float sm = 0.f;
    for (int t = lane; t < 387; t += 64) { const float e = ex2(sc[t] - mx); sc[t] = e; sm += e; }
    sm = wave_sum(sm);
    const float vnew = bf2f(p_VB[row * 768 + hh * 64 + lane]);
    float o = 0.f;
#pragma unroll 1
    for (int pp = 0; pp < 3; ++pp) {
        o += sc[129 * pp] * vnew;
#pragma unroll 4
        for (int jj = 1; jj < 129; ++jj) o += sc[129 * pp + jj] * cv[(size_t)(2048 - (jj << (2 * pp))) * 768 + lane];
    }
    o *= 1.0f / sm;
    p_YB[row * 2048 + hh * 64 + lane] = (bf16)f2bf(o * bf2f(p_ZB[row * 2048 + hh * 64 + lane]));
}
DI void samp_sgu_item(const Ctx& C, int l, int item) { bf16* const p_BU = ((bf16*)WSP(WS_BU)); bf16* const p_BV = ((bf16*)WSP(WS_BV)); bf16* const p_YB = ((bf16*)WSP(WS_YB)); bf16* const p_ZB = ((bf16*)WSP(WS_ZB)); const float* const p_ln_b = ((const float*)INP(10)); const float* const p_ln_g = ((const float*)INP(9)); float* const p_out = OUTP(); const float* const p_sgu_b = ((const float*)INP(12)); const float* const p_sgu_w = ((const float*)INP(11));
    const int b = 8 * item + C.wave, lane = C.lane; const size_t row = MPR + b;
    const v4u raw = *(const v4u*)(p_BV + row * 512 + 8 * lane);
    float x[8] = {bflo(raw.x), bfhi(raw.x), bflo(raw.y), bfhi(raw.y), bflo(raw.z), bfhi(raw.z), bflo(raw.w), bfhi(raw.w)};
    float s = 0.f;
#pragma unroll
    for (int e = 0; e < 8; ++e) s += x[e];
    const float mean = wave_sum(s) * (1.0f / 512.0f); float q = 0.f;
#pragma unroll
    for (int e = 0; e < 8; ++e) { x[e] -= mean; q += x[e] * x[e]; }
    const float rstd = __builtin_amdgcn_rsqf(wave_sum(q) * (1.0f / 512.0f) + EPSF);
    const int g = lane >> 3; const float w00 = p_sgu_w[(size_t)((l * 8 + g) * 128) * 128], bb = p_sgu_b[(l * 8 + g) * 128];
    const v4u ur = *(const v4u*)(p_BU + row * 512 + 8 * lane), zr = *(const v4u*)(p_ZB + row * 2048 + 768 + 8 * lane);
    const float uu[8] = {bflo(ur.x), bfhi(ur.x), bflo(ur.y), bfhi(ur.y), bflo(ur.z), bfhi(ur.z), bflo(ur.w), bfhi(ur.w)};
    const float zz[8] = {bflo(zr.x), bfhi(zr.x), bflo(zr.y), bfhi(zr.y), bflo(zr.z), bfhi(zr.z), bflo(zr.w), bfhi(zr.w)};
    float vn[8], y[8];
#pragma unroll
    for (int e = 0; e < 8; ++e) { vn[e] = x[e] * rstd * p_ln_g[l * 512 + 8 * lane + e] + p_ln_b[l * 512 + 8 * lane + e]; y[e] = uu[e] * (w00 * vn[e] + bb) * zz[e]; }
    float* od = p_out + O_SGU + (size_t)(l * 32 + b) * 512 + 8 * lane;
    *(f32x4*)od = (f32x4){vn[0], vn[1], vn[2], vn[3]}; *(f32x4*)(od + 4) = (f32x4){vn[4], vn[5], vn[6], vn[7]};
    v4u w; w.x = cvtpk2(y[0], y[1]); w.y = cvtpk2(y[2], y[3]); w.z = cvtpk2(y[4], y[5]); w.w = cvtpk2(y[6], y[7]);
    *(v4u*)(p_YB + row * 2048 + 768 + 8 * lane) = w;
}
DI void samp_hgrn_item(const Ctx& C, int l, int item) { float* const p_CG = ((float*)WSP(WS_CG)); bf16* const p_CI = ((bf16*)WSP(WS_CI)); bf16* const p_CK = ((bf16*)WSP(WS_CK)); bf16* const p_CQ = ((bf16*)WSP(WS_CQ)); bf16* const p_YB = ((bf16*)WSP(WS_YB)); bf16* const p_ZB = ((bf16*)WSP(WS_ZB)); const float* const p_hn_g = ((const float*)INP(14)); float* const p_out = OUTP(); const float* const p_state = ((const float*)INP(4));
    const int b = item / 6, hh = item % 6, tid = C.tid; const size_t row = MPR + b;
    LAS float* qs = (LAS float*)C.lds; LAS float* eg = qs + 128; LAS float* kx = eg + 128; LAS float* vv = kx + 128; LAS float* po = vv + 128; LAS float* ov = po + 2048; LAS float* pr = ov + 128;
    if (tid < 128) { const size_t o = row * 768 + hh * 128 + tid; qs[tid] = bf2f(p_CQ[o]); eg[tid] = __expf(p_CG[o]); kx[tid] = bf2f(p_CK[o]); vv[tid] = bf2f(p_CI[o]); }
    __syncthreads();
    const int v4 = (tid & 31) * 4, kq = tid >> 5;
    const f32x4 vloc = *(LAS const f32x4*)(vv + v4); f32x4 acc = (f32x4){0.f, 0.f, 0.f, 0.f};
    const float* S0 = p_state + (size_t)((l * 32 + b) * 6 + hh) * 16384; float* S1 = p_out + O_HS + (size_t)((l * 32 + b) * 6 + hh) * 16384;
#pragma unroll
    for (int kk = 0; kk < 8; ++kk) { const int k = 8 * kq + kk; const f32x4 s = *(const f32x4*)(S0 + k * 128 + v4); const f32x4 sn = s * eg[k] + vloc * kx[k]; *(f32x4*)(S1 + k * 128 + v4) = sn; acc += sn * qs[k]; }
    *(LAS f32x4*)(po + kq * 128 + v4) = acc;
    __syncthreads();
    float o = 0.f;
    if (tid < 128) {
#pragma unroll
        for (int q4 = 0; q4 < 16; ++q4) o += po[q4 * 128 + tid];
        const float ss = wave_sum(o * o); if (C.lane == 0) pr[C.wave] = ss; }
    __syncthreads();
    if (tid < 128) { const float rstd = __builtin_amdgcn_rsqf((pr[0] + pr[1]) * (1.0f / 128.0f) + EPSF);
        p_YB[row * 2048 + 1280 + hh * 128 + tid] = (bf16)f2bf(o * rstd * p_hn_g[l * 768 + hh * 128 + tid] * bf2f(p_ZB[row * 2048 + 1280 + hh * 128 + tid])); }
}
DI void samp_out_item(const Ctx& C, int l, int item) { float* const p_SSQ1 = ((float*)WSP(WS_CTL + CTL_SSQ1)); bf16* const p_WOUT = ((bf16*)WSP(WS_WOUT)); float* const p_X1 = ((float*)WSP(WS_X1)); bf16* const p_XB = ((bf16*)WSP(WS_XB)); bf16* const p_YB = ((bf16*)WSP(WS_YB)); float* const p_out = OUTP(); const float* const p_x_sample = ((const float*)INP(1));
    const int lane = C.lane, i = lane & 31, h = lane >> 5, n0 = 32 * (8 * item + C.wave);
    const bf16* A = p_YB + (size_t)(MPR + i) * 2048 + 8 * h; const bf16* B = p_WOUT + ((size_t)l * DM + n0 + i) * 2048 + 8 * h;
    f32x16 acc = zero16();
#pragma unroll 8
    for (int ks = 0; ks < 128; ++ks) acc = MFMA32(*(const bf16x8*)(A + 16 * ks), *(const bf16x8*)(B + 16 * ks), acc);
#pragma unroll
    for (int r = 0; r < 16; ++r) { const int bb = crow(r, h), n = n0 + i;
        if (l == 0) { const float o = p_x_sample[(size_t)bb * DM + n] + acc[r]; p_X1[(size_t)(MPR + bb) * DM + n] = o; p_XB[(size_t)(MPR + bb) * DM + n] = (bf16)f2bf(o);
            float ss = o * o; ss += __shfl_xor(ss, 1); ss += __shfl_xor(ss, 2); ss += __shfl_xor(ss, 4); ss += __shfl_xor(ss, 8); ss += __shfl_xor(ss, 16);
            if (i == 0) atomicAdd(p_SSQ1 + MPR + bb, ss); }
        else { p_out[O_YS + (size_t)bb * DM + n] = p_X1[(size_t)(MPR + bb) * DM + n] + acc[r]; } }
}
DI int fetch_item(const Ctx& C, int q) { gu32* const p_ctl = ((gu32*)WSP(WS_CTL));
    __syncthreads();
    if (C.tid == 0) C.MISC[0] = __hip_atomic_fetch_add((unsigned*)(p_ctl + CW_Q + 64 * q), 1u, __ATOMIC_RELAXED, __HIP_MEMORY_SCOPE_AGENT);
    __syncthreads();
    return (int)C.MISC[0];
}
#ifndef PH_MASK
#define PH_MASK 2047
#endif
constexpr int N_ATT = 384, N_HG = 768, N_SGU = 128, N_SAT = 64, N_SHG = 192, N_SSG = 4;
constexpr int N_M1 = N_ATT + N_HG + N_SAT + N_SGU + N_SHG + N_SSG;
constexpr int N_M2 = 4 + 384;

__global__ void __launch_bounds__(NWAVES * 64, 2) mega_fwd(Args args) {
    extern __shared__ __attribute__((aligned(16))) unsigned char lds[];
    Ctx C;
    C.lds = (LAS unsigned char*)lds; C.MISC = (volatile LAS unsigned*)(C.lds + MISC_OFF);
    C.tid = threadIdx.x; C.lane = C.tid & 63; C.wave = __builtin_amdgcn_readfirstlane(C.tid >> 6);
    C.G = gridDim.x; { const int bx = blockIdx.x; C.vcu = (C.G % 8 == 0) ? (bx % 8) * (C.G / 8) + bx / 8 : bx; }
    for (int u = C.tid; u < (LDS_BYTES - MISC_OFF) / 4; u += NWAVES * 64) ((LAS unsigned*)(C.lds + MISC_OFF))[u] = 0u;
    __syncthreads();
    XcdBarrier bar; bar.bar = (unsigned*)(((gu32*)WSP(WS_CTL)) + CW_BAR); bar.x = 0; bar.st = nullptr;
    if (N_LAUNCHES == 1) bar = xcd_barrier_post((unsigned*)(((gu32*)WSP(WS_CTL)) + CW_BAR), C.MISC + 8);
    const int lo = args.ph_lo, hi = args.ph_hi;
#pragma unroll 1
    for (int ph = lo; ph < hi; ++ph) {
        { int t_ = threadIdx.x; asm volatile("" : "+v"(t_)); C.tid = t_; C.lane = t_ & 63; C.wave = __builtin_amdgcn_readfirstlane(t_ >> 6); }
        const int l = (ph - 1) / 5, k = (ph - 1) % 5;
        if (ph == 0) { if constexpr (PH_MASK & 1) p0_prologue(C); }
        else if (k == 0) {
            pg8::Gemm g{((bf16*)WSP(WS_XB)), ((bf16*)WSP(WS_WIN)) + (size_t)l * NIN * DM, MPAD, NIN, DM}; pg8::StaticOrder S; S.init(MPAD, NIN, C.G, (int)blockIdx.x);
            pg8::EpiProj E{l == 0 ? ((float*)WSP(WS_CTL + CTL_SSQ0)) : ((float*)WSP(WS_CTL + CTL_SSQ1)), ((float*)WSP(WS_LB)) + l * 3 * 768, WSP(0), OUTP(), l,
                           WS_QB, WS_KB - WS_QB, WS_ZB, WS_BU, WS_BV - WS_BU, WS_CQ, WS_CK - WS_CQ, WS_CG,
                           O_KP + (size_t)l * MPR * 768, O_VP - O_KP, O_KS + (size_t)l * 32 * 768, O_VS - O_KS};
            if constexpr (PH_MASK & 2) pg8::gemm_phase<pg8::EpiProj, pg8::StaticOrder, true, true>(C.lds + RING_OFF, g, S, E);
        } else if (k == 1) {
            for (;;) { int it = fetch_item(C, 3 * l + 0); if (it >= N_M1) break;
                if (it < N_ATT) { if constexpr (PH_MASK & 4) attn_item(C, it); continue; } it -= N_ATT;
                if (it < N_HG) { if constexpr (PH_MASK & 8) hg1_item(C, it); continue; } it -= N_HG;
                if (it < N_SAT) { if constexpr (PH_MASK & 16) samp_attn_item(C, l, it); continue; } it -= N_SAT;
                if (it < N_SGU) { if constexpr (PH_MASK & 32) sgu_item(C, l, it); continue; } it -= N_SGU;
                if (it < N_SHG) { if constexpr (PH_MASK & 64) samp_hgrn_item(C, l, it); continue; } it -= N_SHG;
                if constexpr (PH_MASK & 128) samp_sgu_item(C, l, it); }
        } else if (k == 2) {
            for (;;) { int it = fetch_item(C, 3 * l + 1); if (it >= N_M2) break;
                if (it < 4) { if constexpr (PH_MASK & 256) samp_out_item(C, l, it); continue; } it -= 4;
                if constexpr (PH_MASK & 256) hg2_item(C, l, it); }
        } else if (k == 3) {
            for (;;) { const int it = fetch_item(C, 3 * l + 2); if (it >= N_HG) break; if constexpr (PH_MASK & 512) hg3_item(C, l, it); }
        } else {
            pg8::Gemm g{((bf16*)WSP(WS_YB)), ((bf16*)WSP(WS_WOUT)) + (size_t)l * DM * DMIX, MPR, DM, DMIX}; pg8::StaticOrder S; S.init(MPR, DM, C.G, (int)blockIdx.x);
            pg8::EpiOut E{l == 0 ? ((const float*)INP(0)) : ((float*)WSP(WS_X1)), l == 0 ? ((float*)WSP(WS_X1)) : (OUTP()) + O_YP, l == 0 ? ((bf16*)WSP(WS_XB)) : nullptr, l == 0 ? ((float*)WSP(WS_CTL + CTL_SSQ1)) : nullptr};
            if constexpr (PH_MASK & 1024) pg8::gemm_phase<pg8::EpiOut, pg8::StaticOrder, true, true>(C.lds + RING_OFF, g, S, E);
        }
        if (N_LAUNCHES == 1 && ph + 1 < hi) { XcdBarrier b2; b2.bar = (unsigned*)(((gu32*)WSP(WS_CTL)) + CW_BAR); b2.x = bar.x; b2.st = bar.st; xcd_barrier(b2); }
    }
}

extern "C" void kernel_launch(void* const* d_in, const int* in_sizes, int n_in, void* d_out, int out_size, void* d_ws, size_t ws_size, hipStream_t stream) {
    static int grid = 0;
    if (grid == 0) {
        if (n_in != 16 || (size_t)out_size != O_END || ws_size < WS_END) { fprintf(stderr, "kernel_launch: unexpected shapes: n_in %d out %d ws %zu (need %zu)\n", n_in, out_size, ws_size, (size_t)WS_END); grid = -1; return; }
        int dev = 0, cus = 0, per_cu = 0;
        if (hipGetDevice(&dev) != hipSuccess || hipDeviceGetAttribute(&cus, hipDeviceAttributeMultiprocessorCount, dev) != hipSuccess) { grid = -1; return; }
        if (hipFuncSetAttribute((const void*)mega_fwd, hipFuncAttributeMaxDynamicSharedMemorySize, LDS_BYTES) != hipSuccess) { fprintf(stderr, "kernel_launch: hipFuncSetAttribute failed\n"); grid = -1; return; }
        if (hipOccupancyMaxActiveBlocksPerMultiprocessor(&per_cu, (const void*)mega_fwd, NWAVES * 64, LDS_BYTES) != hipSuccess || per_cu < 1) { fprintf(stderr, "kernel_launch: occupancy query says %d\n", per_cu); (void)hipGetLastError(); per_cu = 1; }
        grid = cus;
    }
    if (grid < 0) return;
    (void)hipMemsetAsync((char*)d_ws + WS_CTL, 0, CTL_ZERO_BYTES, stream);
    Args a{};
    for (int i = 0; i < 16; ++i) a.in[i] = (const float*)d_in[i];
    a.out = (float*)d_out; a.ws = (unsigned char*)d_ws;
    if (N_LAUNCHES == 1) { a.ph_lo = 0; a.ph_hi = N_PHASES; hipLaunchKernelGGL(mega_fwd, dim3(grid), dim3(NWAVES * 64), LDS_BYTES, stream, a); }
    else for (int p = 0; p < N_PHASES; ++p) { a.ph_lo = p; a.ph_hi = p + 1; hipLaunchKernelGGL(mega_fwd, dim3(grid), dim3(NWAVES * 64), LDS_BYTES, stream, a); }
}
```

```cpp
#include <hip/hip_runtime.h>
#include <cstdio>
#include <cstdint>
namespace pg8 {
#define PG8_LAS __attribute__((address_space(3)))
typedef unsigned short bf16_t;
typedef short bf16x8 __attribute__((ext_vector_type(8)));
typedef float f32x4 __attribute__((ext_vector_type(4)));
typedef unsigned u32x4 __attribute__((ext_vector_type(4)));
constexpr int BM = 256, BK = 64, HALF = 128, HTB = HALF * BK * 2  , STAGE_BYTES = 8 * HTB, NXCD = 8, WGM = 8;

__host__ __device__ __forceinline__ int lds_byte(int r, int c) { const int st = (r >> 4) * 2 + (c >> 5), rr = r & 15, cc = c & 31, ob = rr * 64 + cc * 2; return st * 1024 + (ob ^ (((ob >> 9) & 1) << 5)); }
__host__ __device__ __forceinline__ void stage_rc(int b, int& R, int& C) { const int st = b / 1024, sb = b % 1024, swz = sb ^ (((sb >> 9) & 1) << 5); R = (st >> 1) * 16 + swz / 64; C = (st & 1) * 32 + (swz % 64) / 2; }
__host__ __device__ __forceinline__ int perm32(int rho) { const int n = rho >> 4, i = rho & 15; return 8 * (i >> 2) + 4 * n + (i & 3); }

struct Unit { int pm, pn; };
struct Gemm { const bf16_t* A; const bf16_t* Bt; int M, N, K; };

struct StaticOrder {
    int nM, nN, nwg, G, c;
    __host__ __device__ void init(int M, int N, int G_, int c_) { nM = M / BM; nN = N / BM; nwg = nM * nN; G = G_; c = c_; }
    __host__ __device__ bool next(int i, Unit& u) const {
        const long L = (long)i * G + c; if (L >= nwg) return false;
        int wgid = (int)L; { const int q = nwg / NXCD, r = nwg % NXCD, xcd = wgid % NXCD, off = wgid / NXCD; wgid = (xcd < r ? xcd * (q + 1) : r * (q + 1) + (xcd - r) * q) + off; }
        const int nig = WGM * nN, gid = wgid / nig, fm = gid * WGM, gsz = (nM - fm) < WGM ? (nM - fm) : WGM;
        u.pm = fm + ((wgid % nig) % gsz); u.pn = (wgid % nig) / gsz; return true;
    }
    __device__ __forceinline__ void a_ready(const Unit&) const {}
    __device__ __forceinline__ void done(const Unit&) const {}
};


typedef float f32x2 __attribute__((ext_vector_type(2)));
typedef unsigned u32x2 __attribute__((ext_vector_type(2)));
typedef __bf16 bf16x2_t __attribute__((ext_vector_type(2)));
__device__ __forceinline__ unsigned cvtpk(float lo, float hi) { f32x2 v = {lo, hi}; bf16x2_t b = __builtin_convertvector(v, bf16x2_t); return __builtin_bit_cast(unsigned, b); }
__device__ __forceinline__ float fast_sigmoid(float x) { return __builtin_amdgcn_rcpf(1.0f + __expf(-x)); }
__device__ __forceinline__ float silu_f(float x) { return x * fast_sigmoid(x); }

template <int CTRL> __device__ __forceinline__ float dpp_f(float x) { return __builtin_bit_cast(float, __builtin_amdgcn_update_dpp(0, __builtin_bit_cast(int, x), CTRL, 0xf, 0xf, false)); }
__device__ __forceinline__ float row_prefix16(float x) { x += dpp_f<0x111>(x); x += dpp_f<0x112>(x); x += dpp_f<0x114>(x); x += dpp_f<0x118>(x); return x; }
struct EpiProj {
    static constexpr bool PERM = true, AFTER_DRAIN = false, HEADPERM = true;
    const float* ssq;
    const float* gtab;
    unsigned char* ws; float* out; int l; int skip;
    size_t o_qkv, s_qkv, o_zb, o_bu, s_bu, o_cq, s_cq, o_ce, o_dj, o_kh, s_kh;
    size_t o_kp, s_kp, o_ks, s_ks;
    __device__ __forceinline__ void st8(bf16_t* p, const f32x4& a, const f32x4& b) const {
        u32x4 w; w.x = cvtpk(a[0], a[1]); w.y = cvtpk(a[2], a[3]); w.z = cvtpk(b[0], b[1]); w.w = cvtpk(b[2], b[3]); *(u32x4*)p = w; }
    __device__ __forceinline__ void operator()(const f32x4 (&acc)[2][2][4][2], const Unit& u, int wr, int wc, int fr, int fq) const {
        if (skip) return;
        const int pn = u.pn;
        int seg, seg0;
        if (pn < 12) { seg = pn / 3; seg0 = seg * 3; }
        else if (pn < 18) { seg = 4 + (pn - 12) / 2; seg0 = 12 + (seg - 4) * 2; }
        else { seg = 7 + (pn - 18) / 3; seg0 = 18 + (seg - 7) * 3; }
        const int cl = (pn - seg0) * 256 + wc * 64 + 8 * fq;
        const int rowb = u.pm * BM + wr * 64 + fr;
        const bool sample = (u.pm == 64);
        f32x4 gv[2][2];
        { const int gi = (seg == 0) ? 0 : (seg == 1 ? 1 : 2); const float* gp = gtab + gi * 768 + (seg == 0 || seg == 1 || seg == 8 ? cl : 0);
#pragma unroll
          for (int bj = 0; bj < 2; ++bj)
#pragma unroll
              for (int n = 0; n < 2; ++n) gv[bj][n] = *(const f32x4*)(gp + 32 * bj + 4 * n); }
        if (seg == 8) {
            const int lane_hi15 = ((fq << 4) | 15);
            float rsc[2][4];
#pragma unroll
            for (int ai = 0; ai < 2; ++ai)
#pragma unroll
                for (int m = 0; m < 4; ++m) rsc[ai][m] = ssq[rowb + ai * HALF + m * 16];
#pragma unroll
            for (int ai = 0; ai < 2; ++ai)
#pragma unroll
                for (int mp = 0; mp < 2; ++mp) {
                    const int rowA = rowb + ai * HALF + mp * 32, rowB = rowA + 16;
                    const float rsA = __builtin_amdgcn_rsqf(rsc[ai][2 * mp] * (1.0f / 1024.0f) + 1e-6f), rsB = __builtin_amdgcn_rsqf(rsc[ai][2 * mp + 1] * (1.0f / 1024.0f) + 1e-6f);
#pragma unroll
                    for (int bj = 0; bj < 2; ++bj) {
                        f32x4 eA[2], eB[2], kA[2], kB[2], dl[2];
#pragma unroll
                        for (int n = 0; n < 2; ++n)
#pragma unroll
                            for (int e = 0; e < 4; ++e) { const float lbv = gv[bj][n][e];
                                const float sa = fast_sigmoid(acc[ai][bj][2 * mp][n][e] * rsA), sb = fast_sigmoid(acc[ai][bj][2 * mp + 1][n][e] * rsB);
                                kA[n][e] = (1.0f - lbv) * (1.0f - sa); kB[n][e] = (1.0f - lbv) * (1.0f - sb);
                                float ga = __logf(lbv + (1.0f - lbv) * sa), gb = __logf(lbv + (1.0f - lbv) * sb);
                                if (!sample) { ga = row_prefix16(ga); const float t0 = __shfl(ga, lane_hi15); gb = row_prefix16(gb) + t0; dl[n][e] = __expf(__shfl(gb, lane_hi15)); }
                                const float ea = __expf(ga), eb = __expf(gb); eA[n][e] = ea; eB[n][e] = eb;
                                if (!sample) { kA[n][e] *= __builtin_amdgcn_rcpf(ea); kB[n][e] *= __builtin_amdgcn_rcpf(eb); } }
                        bf16_t* dkA = (bf16_t*)(ws + o_cq + s_cq) + (size_t)rowA * 768 + cl + 32 * bj; bf16_t* deA = (bf16_t*)(ws + o_ce) + (size_t)rowA * 768 + cl + 32 * bj;
                        st8(dkA, kA[0], kA[1]); st8(dkA + 16 * 768, kB[0], kB[1]); st8(deA, eA[0], eA[1]); st8(deA + 16 * 768, eB[0], eB[1]);
                        if (!sample && fr == 0) { float* dd = (float*)(ws + o_dj) + (size_t)(rowA >> 5) * 768 + cl + 32 * bj; *(f32x4*)dd = dl[0]; *(f32x4*)(dd + 4) = dl[1]; }
                    }
                    asm volatile("" ::: "memory");
                }
            return;
        }
        float rsv[2][4];
#pragma unroll
        for (int ai = 0; ai < 2; ++ai)
#pragma unroll
            for (int m = 0; m < 4; ++m) rsv[ai][m] = ssq[rowb + ai * HALF + m * 16];
#pragma unroll
        for (int ai = 0; ai < 2; ++ai)
#pragma unroll
            for (int m = 0; m < 4; ++m) {
                const int row = rowb + ai * HALF + m * 16;
                const float rs = __builtin_amdgcn_rsqf(rsv[ai][m] * (1.0f / 1024.0f) + 1e-6f);
                f32x4 v[2][2];
#pragma unroll
                for (int bj = 0; bj < 2; ++bj)
#pragma unroll
                    for (int n = 0; n < 2; ++n) v[bj][n] = acc[ai][bj][m][n] * rs;
                if (seg <= 1) {
                    float ss = 0.f;
#pragma unroll
                    for (int bj = 0; bj < 2; ++bj)
#pragma unroll
                        for (int n = 0; n < 2; ++n) { const f32x4 x = v[bj][n]; ss += (x[0] * x[0] + x[1] * x[1]) + (x[2] * x[2] + x[3] * x[3]); }
                    ss += __shfl_xor(ss, 16); ss += __shfl_xor(ss, 32);
                    float r2 = __builtin_amdgcn_rsqf(ss * (1.0f / 64.0f) + 1e-6f);
                    if (seg == 0) r2 *= 0.125f * 1.4426950408889634f;
#pragma unroll
                    for (int bj = 0; bj < 2; ++bj)
#pragma unroll
                        for (int n = 0; n < 2; ++n) v[bj][n] = v[bj][n] * gv[bj][n] * r2;
                }
                if (seg <= 2) {
                    if (seg == 0 || sample) {
                        bf16_t* dst = (bf16_t*)(ws + o_qkv + (size_t)seg * s_qkv) + (size_t)row * 768 + cl;
#pragma unroll
                        for (int bj = 0; bj < 2; ++bj) st8(dst + 32 * bj, v[bj][0], v[bj][1]);
                    } else {
                        const int t = row & 2047, bb = row >> 11, head = cl >> 6;
                        bf16_t* dst = (bf16_t*)(ws + o_kh + (size_t)(seg - 1) * s_kh) + ((size_t)(((bb * 12 + head) * 16 + (t & 15)) * 128 + (t >> 4))) * 64 + (cl & 63);
#pragma unroll
                        for (int bj = 0; bj < 2; ++bj) st8(dst + 32 * bj, v[bj][0], v[bj][1]);
                    }
                    if (seg >= 1) {
                        const bool okp = !sample, oks = sample && (row - 16384 < 32);
                        float* o = out + (okp ? o_kp + (size_t)(seg - 1) * s_kp + (size_t)row * 768 : o_ks + (size_t)(seg - 1) * s_ks + (size_t)(row - 16384) * 768) + cl;
                        if (okp || oks) {
#pragma unroll
                            for (int bj = 0; bj < 2; ++bj) { *(f32x4*)(o + 32 * bj) = v[bj][0]; *(f32x4*)(o + 32 * bj + 4) = v[bj][1]; }
                        }
                    }
                } else if (seg == 3 || seg == 6 || seg == 10 || seg == 7) {
#pragma unroll
                    for (int bj = 0; bj < 2; ++bj)
#pragma unroll
                        for (int n = 0; n < 2; ++n)
#pragma unroll
                            for (int e = 0; e < 4; ++e) v[bj][n][e] = silu_f(v[bj][n][e]);
                    const size_t zo = (seg == 7) ? o_cq + ((size_t)row * 768 + cl) * 2 : o_zb + ((size_t)row * 2048 + (seg == 3 ? 0 : (seg == 6 ? 768 : 1280)) + cl) * 2;
                    bf16_t* dst = (bf16_t*)(ws + zo);
#pragma unroll
                    for (int bj = 0; bj < 2; ++bj) st8(dst + 32 * bj, v[bj][0], v[bj][1]);
                } else if (seg == 4 || seg == 5) {
                    bf16_t* dst = (bf16_t*)(ws + o_bu + (size_t)(seg - 4) * s_bu) + (size_t)row * 512 + cl;
#pragma unroll
                    for (int bj = 0; bj < 2; ++bj) st8(dst + 32 * bj, v[bj][0], v[bj][1]);
                } else if (seg == 9) {
                    bf16_t* dst = (bf16_t*)(ws + o_cq + 2 * s_cq) + (size_t)row * 768 + cl;
#pragma unroll
                    for (int bj = 0; bj < 2; ++bj) st8(dst + 32 * bj, v[bj][0], v[bj][1]);
                }
                asm volatile("" ::: "memory");
            }
    }
};
struct EpiOut {
    static constexpr bool PERM = false, AFTER_DRAIN = false, HEADPERM = false;
    const float* res; const bf16_t* resb; float* out; bf16_t* xb; float* ssq;
    __device__ __forceinline__ f32x4 ldres(size_t off) const {
        if (res) return *(const f32x4*)(res + off);
        const u32x2 w = *(const u32x2*)(resb + off); return (f32x4){__uint_as_float(w.x << 16), __uint_as_float(w.x & 0xffff0000u), __uint_as_float(w.y << 16), __uint_as_float(w.y & 0xffff0000u)}; }
    __device__ __forceinline__ void operator()(const f32x4 (&acc)[2][2][4][2], const Unit& u, int wr, int wc, int fr, int fq) const {
        const int col0 = u.pn * BM + wc * 32 + 4 * fq;
        const size_t off0 = (size_t)(u.pm * BM + wr * 64 + fr) * 1024 + col0;
        f32x4 rcur[2][2], rnxt[2][2];
#pragma unroll
        for (int bj = 0; bj < 2; ++bj)
#pragma unroll
            for (int n = 0; n < 2; ++n) rcur[bj][n] = ldres(off0 + bj * HALF + n * 16);
#pragma unroll
        for (int it = 0; it < 8; ++it) {
            const int ai = it >> 2, m = it & 3;
            const int row = u.pm * BM + ai * HALF + wr * 64 + m * 16 + fr; const size_t off = (size_t)row * 1024 + col0; float ss = 0.f;
            if (it < 7) { const int ai2 = (it + 1) >> 2, m2 = (it + 1) & 3; const size_t offn = off0 + (size_t)(ai2 * HALF + m2 * 16) * 1024;
#pragma unroll
                for (int bj = 0; bj < 2; ++bj)
#pragma unroll
                    for (int n = 0; n < 2; ++n) rnxt[bj][n] = ldres(offn + bj * HALF + n * 16); }
#pragma unroll
            for (int bj = 0; bj < 2; ++bj)
#pragma unroll
                for (int n = 0; n < 2; ++n) { const f32x4 o = rcur[bj][n] + acc[ai][bj][m][n];
                    if (out) *(f32x4*)(out + off + bj * HALF + n * 16) = o;
                    ss += (o[0] * o[0] + o[1] * o[1]) + (o[2] * o[2] + o[3] * o[3]);
                    if (xb) { u32x2 w; w.x = cvtpk(o[0], o[1]); w.y = cvtpk(o[2], o[3]); *(u32x2*)(xb + off + bj * HALF + n * 16) = w; } }
            if (ssq) { ss += __shfl_xor(ss, 16); ss += __shfl_xor(ss, 32); if (fq == 0) atomicAdd(ssq + row, ss); }
#pragma unroll
            for (int bj = 0; bj < 2; ++bj)
#pragma unroll
                for (int n = 0; n < 2; ++n) rcur[bj][n] = rnxt[bj][n];
        }
    }
};
template <class Epi, class Sched, bool ALIGN_EPI = false, bool SP2 = false>
__device__ __forceinline__ void gemm_phase(PG8_LAS unsigned char* lds, const Gemm g, const Sched& S, const Epi& E) {
    int tid_ = threadIdx.x; asm volatile("" : "+v"(tid_));
    const int tid = tid_, wid = __builtin_amdgcn_readfirstlane(tid >> 6), lane = tid & 63, wr = wid >> 2, wc = wid & 3, fr = lane & 15, fq = lane >> 4;
    const int K = g.K, nt = K / BK;
    unsigned voffA[2], voffB[2];
#pragma unroll
    for (int i = 0; i < 2; ++i) { int R, C; stage_rc(tid * 16 + i * 8192, R, C); const int Rb = Epi::HEADPERM ? (64 * (R >> 5) + perm32(R & 31)) : (Epi::PERM ? ((R & ~31) + perm32(R & 31)) : R);
        voffA[i] = (unsigned)(R * K + C) * 2u; voffB[i] = (unsigned)(Rb * K + C) * 2u; }
    const size_t kstep = (size_t)(BK * 2);
    const size_t hstep = (size_t)HALF * K * 2;
    const size_t tstep = 2 * hstep; const size_t hstepB = Epi::HEADPERM ? (size_t)32 * K * 2 : hstep;
    const unsigned ldsw = (unsigned)wid * 1024u;
    const int aoff = lds_byte(wr * 64 + fr, fq * 8), boff = lds_byte(wc * 32 + fr, fq * 8);
#define PG8_SA(b, h) (((b) * 2 + (h)) * HTB)
#define PG8_SB(b, h) ((4 + (b) * 2 + (h)) * HTB)
#define PG8_STAGE(bufoff, gbase, voff) do { _Pragma("unroll") for (int _i = 0; _i < 2; ++_i) \
        __builtin_amdgcn_global_load_lds((const unsigned*)((const char*)(gbase) + (voff)[_i]), (PG8_LAS unsigned*)(lds + (bufoff) + ldsw + _i * 8192), 16, 0, 0); } while (0)
#define PG8_LDA(dst, b, h) do { _Pragma("unroll") for (int m = 0; m < 4; ++m) _Pragma("unroll") for (int k = 0; k < 2; ++k) dst[m][k] = *(const PG8_LAS bf16x8*)(lds + PG8_SA(b, h) + aoff + m * 2048 + k * 1024); } while (0)
#define PG8_LDB(dst, b, h) do { _Pragma("unroll") for (int n = 0; n < 2; ++n) _Pragma("unroll") for (int k = 0; k < 2; ++k) dst[n][k] = *(const PG8_LAS bf16x8*)(lds + PG8_SB(b, h) + boff + n * 2048 + k * 1024); } while (0)
#define PG8_MMA(ai, bj, At, Bt) do { __builtin_amdgcn_s_setprio(1); _Pragma("unroll") for (int m = 0; m < 4; ++m) _Pragma("unroll") for (int n = 0; n < 2; ++n) _Pragma("unroll") for (int k = 0; k < 2; ++k) \
        acc[ai][bj][m][n] = __builtin_amdgcn_mfma_f32_16x16x32_bf16(Bt[n][k], At[m][k], acc[ai][bj][m][n], 0, 0, 0); __builtin_amdgcn_s_setprio(0); } while (0)
#define PG8_WAIT_V(n) asm volatile("s_waitcnt vmcnt(" #n ")" ::: "memory")
#define PG8_WAIT_L(n) asm volatile("s_waitcnt lgkmcnt(" #n ")" ::: "memory")
#define PG8_BAR __builtin_amdgcn_s_barrier()
#define PG8_SCHED __builtin_amdgcn_sched_barrier(0)
    Unit cur, nxt; int ui = 0;
    if (!S.next(0, cur)) return;
    f32x4 acc[2][2][4][2];
#pragma unroll
    for (int a = 0; a < 2; ++a)
#pragma unroll
        for (int b = 0; b < 2; ++b)
#pragma unroll
            for (int m = 0; m < 4; ++m)
#pragma unroll
                for (int n = 0; n < 2; ++n) acc[a][b][m][n] = (f32x4){0.f, 0.f, 0.f, 0.f};
    bf16x8 At[4][2], B0[2][2], B1[2][2];
    const char* cA = (const char*)g.A + (size_t)cur.pm * tstep; const char* cB = (const char*)g.Bt + (size_t)cur.pn * tstep;
    S.a_ready(cur);
    if constexpr (SP2) {
        PG8_STAGE(PG8_SB(0, 0), cB, voffB); PG8_STAGE(PG8_SB(0, 1), cB + hstepB, voffB); PG8_STAGE(PG8_SA(0, 0), cA, voffA); PG8_STAGE(PG8_SA(0, 1), cA + hstep, voffA);
        if (wr == 1) PG8_BAR;
        PG8_WAIT_V(2); PG8_BAR;
        PG8_STAGE(PG8_SB(1, 0), cB + kstep, voffB); PG8_STAGE(PG8_SA(1, 0), cA + kstep, voffA); PG8_STAGE(PG8_SB(1, 1), cB + hstepB + kstep, voffB);
        PG8_WAIT_V(6); PG8_BAR;
    } else {
        PG8_STAGE(PG8_SB(0, 0), cB, voffB); PG8_STAGE(PG8_SA(0, 0), cA, voffA); PG8_STAGE(PG8_SB(0, 1), cB + hstepB, voffB); PG8_STAGE(PG8_SA(0, 1), cA + hstep, voffA);
        if (wr == 1) PG8_BAR;
        PG8_WAIT_V(4); PG8_BAR;
        PG8_STAGE(PG8_SB(1, 0), cB + kstep, voffB); PG8_STAGE(PG8_SA(1, 0), cA + kstep, voffA); PG8_STAGE(PG8_SB(1, 1), cB + hstepB + kstep, voffB);
        PG8_WAIT_V(6); PG8_BAR;
    }
    for (;;) {
        const bool has_next = S.next(ui + 1, nxt);
        const char* nA = has_next ? (const char*)g.A + (size_t)nxt.pm * tstep : cA; const char* nB = has_next ? (const char*)g.Bt + (size_t)nxt.pn * tstep : cB;
        for (int t = 0; t < nt; t += 2) {
            const bool last = (t == nt - 2);
            const char* a1 = cA + (size_t)(t + 1) * kstep;
            const char* a2 = last ? nA : cA + (size_t)(t + 2) * kstep; const char* b2 = last ? nB : cB + (size_t)(t + 2) * kstep;
            const char* a3 = a2 + kstep; const char* b3 = b2 + kstep;
            if (last && has_next) S.a_ready(nxt);
            if constexpr (SP2) {
            PG8_LDB(B0, 0, 0); PG8_LDB(B1, 0, 1); PG8_SCHED; PG8_LDA(At, 0, 0); PG8_STAGE(PG8_SA(1, 1), a1 + hstep, voffA);
            PG8_WAIT_V(8); PG8_WAIT_L(0); PG8_BAR; PG8_MMA(0, 0, At, B0); PG8_MMA(0, 1, At, B1); PG8_BAR; PG8_SCHED;
            PG8_LDA(At, 0, 1); PG8_STAGE(PG8_SB(0, 0), b2, voffB); PG8_STAGE(PG8_SB(0, 1), b2 + hstepB, voffB); PG8_STAGE(PG8_SA(0, 0), a2, voffA);
            PG8_WAIT_V(8); PG8_WAIT_L(0); PG8_BAR; PG8_MMA(1, 0, At, B0); PG8_MMA(1, 1, At, B1); PG8_BAR; PG8_SCHED;
            PG8_LDB(B0, 1, 0); PG8_LDB(B1, 1, 1); PG8_SCHED; PG8_LDA(At, 1, 0); PG8_STAGE(PG8_SA(0, 1), a2 + hstep, voffA);
            PG8_WAIT_V(8); PG8_WAIT_L(0); PG8_BAR; PG8_MMA(0, 0, At, B0); PG8_MMA(0, 1, At, B1); PG8_BAR; PG8_SCHED;
            PG8_LDA(At, 1, 1); PG8_STAGE(PG8_SB(1, 0), b3, voffB); PG8_STAGE(PG8_SB(1, 1), b3 + hstepB, voffB); PG8_STAGE(PG8_SA(1, 0), a3, voffA);
            PG8_WAIT_V(8); PG8_WAIT_L(0); PG8_BAR; PG8_MMA(1, 0, At, B0); PG8_MMA(1, 1, At, B1); PG8_BAR; PG8_SCHED;
            } else {
            PG8_LDB(B0, 0, 0); PG8_SCHED; PG8_LDA(At, 0, 0); PG8_STAGE(PG8_SA(1, 1), a1 + hstep, voffA);
            PG8_WAIT_L(8); PG8_BAR; PG8_WAIT_L(0); PG8_MMA(0, 0, At, B0); PG8_BAR; PG8_SCHED;
            PG8_LDB(B1, 0, 1); PG8_STAGE(PG8_SB(0, 0), b2, voffB);
            PG8_BAR; PG8_WAIT_L(0); PG8_MMA(0, 1, At, B1); PG8_BAR;
            PG8_LDA(At, 0, 1); PG8_STAGE(PG8_SA(0, 0), a2, voffA);
            PG8_BAR; PG8_WAIT_L(0); PG8_MMA(1, 0, At, B0); PG8_BAR; PG8_SCHED;
            PG8_STAGE(PG8_SB(0, 1), b2 + hstepB, voffB);
            PG8_WAIT_V(6); PG8_BAR; PG8_MMA(1, 1, At, B1); PG8_BAR;
            PG8_LDB(B0, 1, 0); PG8_SCHED; PG8_LDA(At, 1, 0); PG8_STAGE(PG8_SA(0, 1), a2 + hstep, voffA);
            PG8_WAIT_L(8); PG8_BAR; PG8_WAIT_L(0); PG8_MMA(0, 0, At, B0); PG8_BAR; PG8_SCHED;
            PG8_LDB(B1, 1, 1); PG8_STAGE(PG8_SB(1, 0), b3, voffB);
            PG8_BAR; PG8_WAIT_L(0); PG8_MMA(0, 1, At, B1); PG8_BAR;
            PG8_LDA(At, 1, 1); PG8_STAGE(PG8_SA(1, 0), a3, voffA);
            PG8_BAR; PG8_WAIT_L(0); PG8_MMA(1, 0, At, B0); PG8_BAR; PG8_SCHED;
            PG8_STAGE(PG8_SB(1, 1), b3 + hstepB, voffB);
            PG8_WAIT_V(6); PG8_BAR; PG8_MMA(1, 1, At, B1); PG8_BAR;
            }
        }
        if constexpr (ALIGN_EPI) { if (wr == 0) PG8_BAR; }
        if constexpr (!Epi::AFTER_DRAIN) { E(acc, cur, wr, wc, fr, fq); S.done(cur); }
        if (!has_next) break;
#pragma unroll
        for (int a = 0; a < 2; ++a)
#pragma unroll
            for (int b = 0; b < 2; ++b)
#pragma unroll
                for (int m = 0; m < 4; ++m)
#pragma unroll
                    for (int n = 0; n < 2; ++n) acc[a][b][m][n] = (f32x4){0.f, 0.f, 0.f, 0.f};
        cur = nxt; cA = nA; cB = nB; ++ui;
        if constexpr (ALIGN_EPI) { if (wr == 1) PG8_BAR; }
    }
    PG8_WAIT_V(0);
    if constexpr (!ALIGN_EPI) { if (wr == 0) PG8_BAR; }
    PG8_BAR;
    if constexpr (Epi::AFTER_DRAIN) { E.fused(acc, cur, wr, wc, fr, fq, lds, wid, lane); S.done(cur); }
#undef PG8_SA
#undef PG8_SB
#undef PG8_STAGE
#undef PG8_LDA
#undef PG8_LDB
#undef PG8_MMA
#undef PG8_WAIT_V
#undef PG8_WAIT_L
#undef PG8_BAR
#undef PG8_SCHED
}
}
#define GAS __attribute__((address_space(1)))
#define LAS __attribute__((address_space(3)))
typedef unsigned short bf16;
typedef unsigned v4u __attribute__((ext_vector_type(4)));
typedef float f32x4 __attribute__((ext_vector_type(4)));
typedef short bf16x8 __attribute__((ext_vector_type(8)));
typedef GAS unsigned gu32;
typedef GAS unsigned long long gu64;
#define RLX_AGENT __ATOMIC_RELAXED, __HIP_MEMORY_SCOPE_AGENT
#define LDS_WAIT() asm volatile("s_waitcnt lgkmcnt(0)" ::: "memory")
#define VM_WAIT() asm volatile("s_waitcnt vmcnt(0)" ::: "memory")
__device__ __forceinline__ unsigned long long rt() { return __builtin_amdgcn_s_memrealtime(); }
__device__ __forceinline__ unsigned f2bf(float f) { unsigned u = __builtin_bit_cast(unsigned, f); return (u + 0x7fffu + ((u >> 16) & 1u)) >> 16; }
__device__ __forceinline__ unsigned pk2(float lo, float hi) { return f2bf(lo) | (f2bf(hi) << 16); }

#define XB_TMO      128
#define XB_XCNT(j)  (256  + 64 * (j))
#define XB_XSUB(j)  (1280 + 64 * (j))
#define XB_XGEN(j)  (2304 + 64 * (j))
#define XB_TOP      3328
#define XB_TOPGEN   3392
#define XCD_BAR_WORDS 3456
#define XB_SPIN_CAP (1u << 18)

__device__ __forceinline__ unsigned xb_ld(unsigned* p)              { return __hip_atomic_load(p, __ATOMIC_RELAXED, __HIP_MEMORY_SCOPE_AGENT); }
__device__ __forceinline__ unsigned xb_add(unsigned* p, unsigned v) { return __hip_atomic_fetch_add(p, v, __ATOMIC_RELAXED, __HIP_MEMORY_SCOPE_AGENT); }
__device__ __forceinline__ unsigned xb_xcc_id() { return (unsigned)__builtin_amdgcn_s_getreg((3 << 11) | 20) & 0xFu; }
#define XB_SPIN(cond, bar) do { unsigned _sp = 0; while (cond) { __builtin_amdgcn_s_sleep(1); \
    if ((++_sp & 255u) == 0u) { if (xb_ld(&(bar)[XB_TMO])) break; if (_sp > XB_SPIN_CAP) { atomicAdd(&(bar)[XB_TMO], 1u); break; } } } } while (0)

struct XcdBarrier {
    unsigned* bar; unsigned x;
    volatile LAS unsigned* st;
};

__device__ __forceinline__ XcdBarrier xcd_barrier_post(unsigned* bar, volatile LAS unsigned* st) {
    XcdBarrier b; b.bar = bar; b.x = xb_xcc_id(); b.st = st;
    if (threadIdx.x == 0) (void)xb_add(&bar[XB_XCNT(b.x)], 1u);
    return b;
}
__device__ __forceinline__ void xcd_barrier_complete(unsigned* bar, unsigned x, unsigned& nloc, unsigned& nx) {
    const unsigned G = 256u;
    unsigned sum, cnt, mine, sp = 0u;
    for (;;) {
        sum = 0u; cnt = 0u; mine = 0u;
#pragma unroll
        for (unsigned j = 0; j < 16; ++j) { const unsigned c = xb_ld(&bar[XB_XCNT(j)]); sum += c; cnt += (c > 0u) ? 1u : 0u; mine = (j == x) ? c : mine; }
        if (sum == G) break;
        __builtin_amdgcn_s_sleep(1);
        if ((++sp & 255u) == 0u) { if (xb_ld(&bar[XB_TMO])) break; if (sp > XB_SPIN_CAP) { atomicAdd(&bar[XB_TMO], 1u); break; } }
    }
    nloc = mine > 0u ? mine : 1u; nx = cnt > 0u ? cnt : 1u;
}

__device__ __forceinline__ void xcd_barrier(const XcdBarrier& b) {
    asm volatile("s_waitcnt vmcnt(0)" ::: "memory");
    __syncthreads();
    if (threadIdx.x == 0) {
        unsigned* bar = b.bar;
        __builtin_amdgcn_s_waitcnt(0);
        unsigned nloc = b.st[0], nx = b.st[1];
        if (nloc == 0u) { xcd_barrier_complete(bar, b.x, nloc, nx); b.st[0] = nloc; b.st[1] = nx; }
        const unsigned old = xb_add(&bar[XB_XSUB(b.x)], 1u);
        const unsigned gen = old / nloc;
        if (old + 1u == (gen + 1u) * nloc) {
            __builtin_amdgcn_fence(__ATOMIC_RELEASE, "agent");
            asm volatile("s_waitcnt vmcnt(0)" ::: "memory");
            const unsigned og = xb_add(&bar[XB_TOP], 1u);
            const unsigned tg = og / nx;
            if (og + 1u == (tg + 1u) * nx) xb_add(&bar[XB_TOPGEN], 1u);
            else XB_SPIN(xb_ld(&bar[XB_TOPGEN]) == tg, bar);
            __builtin_amdgcn_fence(__ATOMIC_ACQUIRE, "agent");
            xb_add(&bar[XB_XGEN(b.x)], 1u);
            asm volatile("s_waitcnt vmcnt(0)" ::: "memory");
        } else {
            XB_SPIN(xb_ld(&bar[XB_XGEN(b.x)]) == gen, bar);
            __builtin_amdgcn_fence(__ATOMIC_ACQUIRE, "agent");
            asm volatile("s_waitcnt vmcnt(0)" ::: "memory");
        }
    }
    __syncthreads();
}
#ifndef MK_N_LAUNCHES
#define MK_N_LAUNCHES 1
#endif
constexpr int NWAVES = 8, NGRID = 256;
constexpr int N_PHASES = 9;
constexpr int N_LAUNCHES = MK_N_LAUNCHES;
constexpr int DM = 1024, NIN = 7680, DMIX = 2048;
constexpr int MPR = 16384, MSA = 32, MPAD = 16640, SEQL = 2048;
constexpr float EPSF = 1e-6f;
constexpr size_t O_YP = 0, O_YS = 16777216, O_KP = O_YS + 32768, O_VP = O_KP + 25165824, O_KS = O_VP + 25165824, O_VS = O_KS + 49152,
                 O_SGU = O_VS + 49152, O_HP = O_SGU + 32768, O_HS = O_HP + 1572864, O_END = O_HS + 6291456;
constexpr size_t MiB = 1u << 20;
constexpr size_t alup(size_t x) { return (x + MiB - 1) / MiB * MiB; }
constexpr size_t WS_CTL = 0, CTL_ZERO_BYTES = MiB;
constexpr size_t WS_WIN = MiB;
constexpr size_t WS_WOUT = WS_WIN + alup((size_t)2 * NIN * DM * 2);
constexpr size_t WS_SGW = WS_WOUT + alup((size_t)2 * DM * DMIX * 2);
constexpr size_t WS_LB = WS_SGW + alup((size_t)2 * 8 * 128 * 128 * 2);
constexpr size_t WS_XB = WS_LB + MiB;
constexpr size_t WS_QB = WS_XB + alup((size_t)MPAD * DM * 2);
constexpr size_t WS_KB = WS_QB + alup((size_t)MPAD * 768 * 2);
constexpr size_t WS_VB = WS_KB + alup((size_t)MPAD * 768 * 2);
constexpr size_t WS_ZB = WS_VB + alup((size_t)MPAD * 768 * 2);
constexpr size_t WS_BU = WS_ZB + alup((size_t)MPAD * 2048 * 2);
constexpr size_t WS_BV = WS_BU + alup((size_t)MPAD * 512 * 2);
constexpr size_t WS_CQ = WS_BV + alup((size_t)MPAD * 512 * 2);
constexpr size_t WS_CK = WS_CQ + alup((size_t)MPAD * 768 * 2);
constexpr size_t WS_CI = WS_CK + alup((size_t)MPAD * 768 * 2);
constexpr size_t WS_CG = WS_CI + alup((size_t)MPAD * 768 * 2);
constexpr size_t WS_CE = WS_CG;
constexpr size_t WS_DJ = WS_CG + alup((size_t)MPAD * 768 * 2);
constexpr size_t WS_YB = WS_CG + alup((size_t)MPAD * 768 * 4);
constexpr size_t WS_X1 = WS_YB + alup((size_t)MPAD * 2048 * 2);
constexpr size_t WS_DS = WS_X1 + alup((size_t)MPAD * DM * 4);
constexpr size_t WS_DEC = WS_DS + alup((size_t)48 * 16 * 128 * 128 * 4);
constexpr size_t WS_O2 = WS_DEC + alup((size_t)48 * 16 * 128 * 4);
constexpr size_t WS_O3 = WS_O2 + alup((size_t)MPAD * 768 * 2);
constexpr size_t WS_L2 = WS_O3 + alup((size_t)MPAD * 768 * 2);
constexpr size_t WS_L3 = WS_L2 + alup((size_t)MPAD * 16 * 4);
constexpr size_t WS_KH = WS_L3 + alup((size_t)MPAD * 16 * 4);
constexpr size_t WS_VH = WS_KH + alup((size_t)MPR * 768 * 2);
constexpr size_t WS_END = WS_VH + alup((size_t)MPR * 768 * 2);
constexpr int CW_TMO = 0, CW_CODE = 1, CW_BAR = 4096, CW_Q = 8192;
constexpr size_t CTL_SSQ0 = 256 * 1024, CTL_SSQ1 = 512 * 1024;
constexpr int RING_OFF = 0, LDS_BYTES = 163840, MISC_OFF = LDS_BYTES - 1024;
static_assert(WS_VB - WS_KB == WS_KB - WS_QB && WS_CI - WS_CK == WS_CK - WS_CQ, "equally spaced buffer groups (addressed arithmetically in the in-projection epilogue)");
#define DI __device__ __forceinline__
typedef float f32x16 __attribute__((ext_vector_type(16)));
typedef short s16x4 __attribute__((ext_vector_type(4)));
typedef short v4i16_t __attribute__((ext_vector_type(4)));
typedef float f32x2v __attribute__((ext_vector_type(2)));
typedef unsigned u32x2v __attribute__((ext_vector_type(2)));
typedef __bf16 bf16x2v __attribute__((ext_vector_type(2)));
#define MFMA32(a, b, c) __builtin_amdgcn_mfma_f32_32x32x16_bf16((a), (b), (c), 0, 0, 0)
DI unsigned cvtpk2(float lo, float hi) { f32x2v v = {lo, hi}; bf16x2v b = __builtin_convertvector(v, bf16x2v); return __builtin_bit_cast(unsigned, b); }
DI float bf2f(bf16 u) { return __uint_as_float((unsigned)u << 16); }
DI float bflo(unsigned w) { return __uint_as_float(w << 16); }
DI float bfhi(unsigned w) { return __uint_as_float(w & 0xffff0000u); }
DI int crow(int r, int h) { return (r & 3) + 8 * (r >> 2) + 4 * h; }
DI float shx(float v, int mask, int lane) { return __builtin_bit_cast(float, __builtin_amdgcn_ds_bpermute((lane ^ mask) << 2, __builtin_bit_cast(int, v))); }
DI float wave_sum(float v, int lane) {
#pragma unroll
    for (int o = 1; o < 64; o <<= 1) v += shx(v, o, lane);
    return v;
}
DI float wave_max(float v, int lane) {
#pragma unroll
    for (int o = 1; o < 64; o <<= 1) v = fmaxf(v, shx(v, o, lane));
    return v;
}
DI s16x4 trd(LAS const unsigned char* p) { return __builtin_bit_cast(s16x4, __builtin_amdgcn_ds_read_tr16_b64_v4i16((LAS v4i16_t*)p)); }
DI int tr_lane_off(int pitch, int lane, bool perm) { const int i16 = lane & 15, q = i16 >> 2, p = i16 & 3, blk = (lane >> 4) & 1, h = lane >> 5; return ((perm ? 4 * h : 8 * h) + q) * pitch + (16 * blk + 4 * p) * 2; }
DI bf16x8 trfrag(LAS const unsigned char* base, int pitch, int k0, int c0, int laneoff, bool perm) {
    LAS const unsigned char* a = base + k0 * pitch + c0 * 2 + laneoff;
    const s16x4 lo = trd(a), hi = trd(a + (perm ? 8 : 4) * pitch);
    return __builtin_shufflevector(lo, hi, 0, 1, 2, 3, 4, 5, 6, 7);
}
DI bf16x8 pack8(const f32x16& x, int s) { v4u p; p.x = cvtpk2(x[8 * s], x[8 * s + 1]); p.y = cvtpk2(x[8 * s + 2], x[8 * s + 3]); p.z = cvtpk2(x[8 * s + 4], x[8 * s + 5]); p.w = cvtpk2(x[8 * s + 6], x[8 * s + 7]); return __builtin_bit_cast(bf16x8, p); }
DI f32x16 zero16() { f32x16 z;
#pragma unroll
    for (int i = 0; i < 16; ++i) z[i] = 0.f; return z; }

struct Args { const float* in[16]; float* out; unsigned char* ws; int ph_lo, ph_hi, imask, pad; };
struct Ctx {
    LAS unsigned char* lds; volatile LAS unsigned* MISC;
    int tid, lane, wave, vcu, G;
};
typedef __attribute__((address_space(4))) const Args* kaptr_t;
DI kaptr_t kargs() { kaptr_t kp = (kaptr_t)__builtin_amdgcn_kernarg_segment_ptr(); asm volatile("" : "+s"(kp)); return kp; }
#define INP(i) (kargs()->in[i])
#define WSP(off) (kargs()->ws + (off))
#define OUTP() (kargs()->out)
DI void p0_transpose_item(const float* W, int K, int N, bf16* WT, const float* gk, LAS float* scr, int item, int lane) {
    const int nblk = N / 32, kb = item / nblk, nb = item % nblk, k0 = 64 * kb, n0 = 32 * nb;
#pragma unroll 8
    for (int i = 0; i < 32; ++i) { const int kk = 2 * i + (lane >> 5); float w = W[(size_t)(k0 + kk) * N + n0 + (lane & 31)]; if (gk) w *= gk[k0 + kk]; scr[kk * 33 + (lane & 31)] = w; }
    LDS_WAIT(); asm volatile("" ::: "memory");
    const int c = lane & 7;
#pragma unroll
    for (int j = 0; j < 4; ++j) { const int n = (lane >> 3) + 8 * j; const LAS float* s = scr + (8 * c) * 33 + n;
        v4u o; o.x = pk2(s[0 * 33], s[1 * 33]); o.y = pk2(s[2 * 33], s[3 * 33]); o.z = pk2(s[4 * 33], s[5 * 33]); o.w = pk2(s[6 * 33], s[7 * 33]);
        *(GAS v4u*)(WT + (size_t)(n0 + n) * K + k0 + 8 * c) = o; }
    LDS_WAIT(); asm volatile("" ::: "memory");
}
DI void p0_prologue(Ctx& C) { const float* const p_qn_g = ((const float*)INP(7)); const float* const p_kn_g = ((const float*)INP(8)); float* const p_LB = ((float*)WSP(WS_LB)); bf16* const p_SGW = ((bf16*)WSP(WS_SGW)); float* const p_SSQ0 = ((float*)WSP(WS_CTL + CTL_SSQ0)); bf16* const p_WIN = ((bf16*)WSP(WS_WIN)); bf16* const p_WOUT = ((bf16*)WSP(WS_WOUT)); bf16* const p_XB = ((bf16*)WSP(WS_XB)); const float* const p_lb_logits = ((const float*)INP(13)); const float* const p_norm_g = ((const float*)INP(5)); const float* const p_sgu_w = ((const float*)INP(11)); const float* const p_w_in = ((const float*)INP(6)); const float* const p_w_out = ((const float*)INP(15)); const float* const p_x_prompt = ((const float*)INP(0)); const float* const p_x_sample = ((const float*)INP(1));
    LAS float* scr = (LAS float*)(C.lds + RING_OFF + C.wave * 16384);
    const int gw = C.vcu * NWAVES + C.wave, NGW = C.G * NWAVES;
    constexpr int I_IN1 = (DM / 64) * (NIN / 32), I_OUT1 = (DMIX / 64) * (DM / 32);
    for (int it = gw; it < I_IN1; it += NGW) p0_transpose_item(p_w_in, DM, NIN, p_WIN, p_norm_g, scr, it, C.lane);
    for (int m = gw; m < MPAD; m += NGW) {
        GAS unsigned long long* o8 = (GAS unsigned long long*)(p_XB + (size_t)m * DM) + C.lane;
        if (m < MPR + MSA) {
            const float* xrow = (m < MPR) ? p_x_prompt + (size_t)m * DM : p_x_sample + (size_t)(m - MPR) * DM;
            const GAS f32x4* xr = (const GAS f32x4*)xrow + C.lane; f32x4 v[4]; float s = 0.f;
#pragma unroll
            for (int j = 0; j < 4; ++j) { v[j] = xr[64 * j]; s += (v[j].x * v[j].x + v[j].y * v[j].y) + (v[j].z * v[j].z + v[j].w * v[j].w); }
            s = wave_sum(s, C.lane);
#pragma unroll
            for (int j = 0; j < 4; ++j) o8[64 * j] = (unsigned long long)pk2(v[j].x, v[j].y) | ((unsigned long long)pk2(v[j].z, v[j].w) << 32);
            if (C.lane == 0) p_SSQ0[m] = s;
        } else {
#pragma unroll
            for (int j = 0; j < 4; ++j) o8[64 * j] = 0ull;
            if (C.lane == 0) p_SSQ0[m] = 0.f;
        }
    }
    const int gt = C.vcu * 512 + C.tid, NGT = C.G * 512;
    for (int e = gt; e < 2 * 8 * 128 * 128; e += NGT) { const int s = e & 127, t = (e >> 7) & 127; const float w = p_sgu_w[e]; p_SGW[e] = (bf16)f2bf(s <= t ? w : 0.f); }
    for (int e = gt; e < 2 * 768; e += NGT) { const int l = e / 768, c = e - 768 * l; p_LB[(l * 3 + 0) * 768 + c] = p_qn_g[e]; p_LB[(l * 3 + 1) * 768 + c] = p_kn_g[e]; p_LB[(l * 3 + 2) * 768 + c] = (l == 0) ? 0.f : 1.0f / (1.0f + __expf(p_lb_logits[c] - p_lb_logits[768 + c])); }
}

DI void wt_item(const Ctx& C, int item) { const float* const p_w_in = ((const float*)INP(6)); const float* const p_w_out = ((const float*)INP(15)); const float* const p_norm_g = ((const float*)INP(5)); bf16* const p_WIN = ((bf16*)WSP(WS_WIN)); bf16* const p_WOUT = ((bf16*)WSP(WS_WOUT));
    constexpr int I_IN1 = (DM / 64) * (NIN / 32), I_OUT1 = (DMIX / 64) * (DM / 32);
    LAS float* scr = (LAS float*)(C.lds + RING_OFF + C.wave * 16384);
#pragma unroll 1
    for (int rep = 0; rep < 4; ++rep) {
        int it = 32 * item + 8 * rep + C.wave;
        if (it < I_OUT1) { p0_transpose_item(p_w_out, DMIX, DM, p_WOUT, nullptr, scr, it, C.lane); continue; } it -= I_OUT1;
        if (it < I_IN1) p0_transpose_item(p_w_in + (size_t)DM * NIN, DM, NIN, p_WIN + (size_t)NIN * DM, p_norm_g + DM, scr, it, C.lane);
        else if (it < I_IN1 + I_OUT1) p0_transpose_item(p_w_out + (size_t)DMIX * DM, DMIX, DM, p_WOUT + (size_t)DM * DMIX, nullptr, scr, it - I_IN1, C.lane);
    }
}

DI void kvout_item(const Ctx& C, int l, int item) { unsigned char* const ws = WSP(0); const bf16* const p_KH = (const bf16*)(ws + WS_KH); const bf16* const p_VH = (const bf16*)(ws + WS_VH); float* const p_out = OUTP();
    const int b = item >> 5, t0 = (item & 31) * 64, tid = C.tid;
    float* ok = p_out + O_KP + ((size_t)l * MPR + (size_t)b * SEQL + t0) * 768; float* ov = p_out + O_VP + ((size_t)l * MPR + (size_t)b * SEQL + t0) * 768;
#pragma unroll 4
    for (int it = 0; it < 12; ++it) { const int idx = tid + 512 * it, tl = idx / 96, hc = idx - 96 * tl, hh = hc >> 3, ch = hc & 7, t = t0 + tl;
        const size_t so = ((size_t)(((b * 12 + hh) * 16 + (t & 15)) * 128 + (t >> 4))) * 64 + 8 * ch; const size_t dofs = (size_t)tl * 768 + hh * 64 + 8 * ch;
        const v4u k8 = *(const v4u*)(p_KH + so), v8 = *(const v4u*)(p_VH + so);
        *(f32x4*)(ok + dofs) = (f32x4){bflo(k8.x), bfhi(k8.x), bflo(k8.y), bfhi(k8.y)}; *(f32x4*)(ok + dofs + 4) = (f32x4){bflo(k8.z), bfhi(k8.z), bflo(k8.w), bfhi(k8.w)};
        *(f32x4*)(ov + dofs) = (f32x4){bflo(v8.x), bfhi(v8.x), bflo(v8.y), bfhi(v8.y)}; *(f32x4*)(ov + dofs + 4) = (f32x4){bflo(v8.z), bfhi(v8.z), bflo(v8.w), bfhi(v8.w)}; }
}
DI float ex2(float x) { return __builtin_amdgcn_exp2f(x); }
DI float lg2(float x) { return __builtin_amdgcn_logf(x); }

constexpr int AP = 144;
DI void cls_tile(const bf16x8 (&qf)[4], LAS const unsigned char* Kl, LAS const unsigned char* Vl, int kr0, int jstart, int lane, f32x16 (&o)[2], float& lse) {
    const int i = lane & 31, h = lane >> 5;
    o[0] = zero16(); o[1] = zero16();
    constexpr float THR = 6.0f;
    float mrun = 0.f, l = 0.f; bool first = true;
    LAS const unsigned char* kp = Kl + (kr0 + 32 * jstart + i) * AP + 16 * h;
    LAS const unsigned char* vp = Vl + (kr0 + 32 * jstart) * AP + tr_lane_off(AP, lane, true);
#pragma unroll 1
    for (int j = jstart; j < 5; ++j, kp += 32 * AP, vp += 32 * AP) {
        f32x16 st = zero16();
#pragma unroll
        for (int s = 0; s < 4; ++s) st = MFMA32(*(LAS const bf16x8*)(kp + 32 * s), qf[s], st);
        if (j == 0) {
#pragma unroll
            for (int r = 0; r < 16; ++r) if (crow(r, h) < i) st[r] = -1e30f;
        }
        if (j == 4) {
#pragma unroll
            for (int r = 0; r < 16; ++r) if (crow(r, h) > i) st[r] = -1e30f;
        }
        float rm = fmaxf(fmaxf(st[0], st[1]), st[2]);
#pragma unroll
        for (int r = 3; r < 15; r += 2) rm = fmaxf(fmaxf(rm, st[r]), st[r + 1]);
        rm = fmaxf(rm, st[15]);
        rm = fmaxf(rm, shx(rm, 32, lane)) - mrun;
        if (first || __any(rm > THR)) {
            const float delta = first ? rm : fmaxf(rm, 0.f); mrun += delta;
            if (!first) { const float alpha = ex2(-delta); l *= alpha;
#pragma unroll
                for (int r = 0; r < 16; ++r) { o[0][r] *= alpha; o[1][r] *= alpha; } }
            first = false;
        }
        float ps0 = 0.f, ps1 = 0.f;
#pragma unroll
        for (int r = 0; r < 16; r += 2) { st[r] = ex2(st[r] - mrun); st[r + 1] = ex2(st[r + 1] - mrun); ps0 += st[r]; ps1 += st[r + 1]; }
        l += ps0 + ps1;
        const bf16x8 pb0 = pack8(st, 0), pb1 = pack8(st, 1);
#pragma unroll
        for (int db = 0; db < 2; ++db) {
            const s16x4 a0 = trd(vp + 64 * db), a1 = trd(vp + 64 * db + 8 * AP), b0 = trd(vp + 64 * db + 16 * AP), b1 = trd(vp + 64 * db + 24 * AP);
            o[db] = MFMA32(__builtin_shufflevector(a0, a1, 0, 1, 2, 3, 4, 5, 6, 7), pb0, o[db]);
            o[db] = MFMA32(__builtin_shufflevector(b0, b1, 0, 1, 2, 3, 4, 5, 6, 7), pb1, o[db]);
        }
    }
    l += shx(l, 32, lane);
    const float inv = 1.0f / l;
#pragma unroll
    for (int r = 0; r < 16; ++r) { o[0][r] *= inv; o[1][r] *= inv; }
    lse = mrun + lg2(l);
}
DI void cls_store(bf16* Ob, float* Lb, size_t m, int hh, int h, const f32x16 (&o)[2], float lse) {
    bf16* op = Ob + m * 768 + hh * 64 + 4 * h;
#pragma unroll
    for (int db = 0; db < 2; ++db)
#pragma unroll
        for (int g4 = 0; g4 < 4; ++g4) { u32x2v w; w.x = cvtpk2(o[db][4 * g4], o[db][4 * g4 + 1]); w.y = cvtpk2(o[db][4 * g4 + 2], o[db][4 * g4 + 3]); *(u32x2v*)(op + 32 * db + 8 * g4) = w; }
    if (h == 0) Lb[m * 16 + hh] = lse;
}
template <int KIND> DI void att23_item(const Ctx& C, int item) { unsigned char* const ws = WSP(0); const bf16* const p_QB = (const bf16*)(ws + WS_QB); const bf16* const p_KB = (const bf16*)(ws + WS_KH); const bf16* const p_VB = (const bf16*)(ws + WS_VH);
    bf16* const p_O = (bf16*)(ws + (KIND == 2 ? WS_O2 : WS_O3)); float* const p_L = (float*)(ws + (KIND == 2 ? WS_L2 : WS_L3));
    const int up = item & 1, hh = (item >> 1) % 12, b = item / 24, lane = C.lane, wave = C.wave, tid = C.tid, i = lane & 31, h = lane >> 5;
    const size_t rb = (size_t)b * SEQL;
    LAS unsigned char* Kl = C.lds; LAS unsigned char* Vl = C.lds + 512 * AP;
    v4u kr[8], vr[8];
#define A23_TOK(u, row) (KIND == 2 ? (4 * (row) + (u)) : (16 * ((row) & 127) + 4 * (u) + ((row) >> 7)))
#define A23_SRC(u, idx) ((size_t)(((b * 12 + hh) * 16 + (KIND == 2 ? 4 * ((idx) >> 10) + (u) : 4 * (u) + ((idx) >> 10))) * 128 + (((idx) >> 3) & 127)) * 64 + 8 * ((idx) & 7))
#define A23_ROW(idx) (KIND == 2 ? 4 * (((idx) >> 3) & 127) + ((idx) >> 10) : ((idx) >> 3))
#define A23_ISSUE(u) do { _Pragma("unroll") for (int it = 0; it < 8; ++it) { const int idx = tid + 512 * it; const size_t go = A23_SRC(u, idx); \
        kr[it] = *(const v4u*)(p_KB + go); vr[it] = *(const v4u*)(p_VB + go); } } while (0)
    A23_ISSUE(2 * up);
#pragma unroll 1
    for (int u = 2 * up; u < 2 * up + 2; ++u) {
        __syncthreads();
#pragma unroll
        for (int it = 0; it < 8; ++it) { const int idx = tid + 512 * it, row = A23_ROW(idx), ch = idx & 7; *(LAS v4u*)(Kl + row * AP + ch * 16) = kr[it]; *(LAS v4u*)(Vl + row * AP + ch * 16) = vr[it]; }
        __syncthreads();
        int cb0, qa, qb;
        if (KIND == 2) { cb0 = 0; qa = 64 * wave; qb = qa + 32; } else { cb0 = (wave >> 1) * 128; qa = (wave & 1) ? 32 : 0; qb = (wave & 1) ? 64 : 96; }
        const size_t ma = rb + A23_TOK(u, cb0 + qa + i), mb = rb + A23_TOK(u, cb0 + qb + i);
        bf16x8 qfa[4], qfb[4];
#pragma unroll
        for (int s = 0; s < 4; ++s) qfa[s] = *(const bf16x8*)(p_QB + ma * 768 + hh * 64 + 8 * h + 16 * s);
        if (u == 2 * up) A23_ISSUE(u + 1);
        f32x16 o[2]; float lse;
        cls_tile(qfa, Kl + cb0 * AP, Vl + cb0 * AP, qa - 128, qa >= 128 ? 0 : (128 - qa) >> 5, lane, o, lse);
        cls_store(p_O, p_L, ma, hh, h, o, lse);
#pragma unroll
        for (int s = 0; s < 4; ++s) qfb[s] = *(const bf16x8*)(p_QB + mb * 768 + hh * 64 + 8 * h + 16 * s);
        cls_tile(qfb, Kl + cb0 * AP, Vl + cb0 * AP, qb - 128, qb >= 128 ? 0 : (128 - qb) >> 5, lane, o, lse);
        cls_store(p_O, p_L, mb, hh, h, o, lse);
    }
#undef A23_ISSUE
#undef A23_TOK
#undef A23_SRC
#undef A23_ROW
}
DI void att1_item(const Ctx& C, int item) { unsigned char* const ws = WSP(0); const bf16* const p_QB = (const bf16*)(ws + WS_QB); const bf16* const p_KB = (const bf16*)(ws + WS_KH); const bf16* const p_VB = (const bf16*)(ws + WS_VH);
    const bf16* const p_O2 = (const bf16*)(ws + WS_O2); const float* const p_L2 = (const float*)(ws + WS_L2); const bf16* const p_O3 = (const bf16*)(ws + WS_O3); const float* const p_L3 = (const float*)(ws + WS_L3); const bf16* const p_ZB = (const bf16*)(ws + WS_ZB); bf16* const p_YB = (bf16*)(ws + WS_YB);
    const int qtr = item & 3, hh = (item >> 2) % 12, b = item / 48, lane = C.lane, wave = C.wave, tid = C.tid, i = lane & 31, h = lane >> 5;
    const size_t rb = (size_t)b * SEQL;
    LAS unsigned char* Kl = C.lds; LAS unsigned char* Vl = C.lds + 384 * AP;
    v4u kr[6], vr[6];
#define A1_ISSUE(T) do { const int m30_ = 16 * (T) - 8; _Pragma("unroll") for (int it = 0; it < 6; ++it) { const int idx = tid + 512 * it, r16 = idx / 192, rem = idx - 192 * r16; int m3 = m30_ + (rem >> 3); if (m3 < 0) m3 = 0; \
        const size_t go = (size_t)(((b * 12 + hh) * 16 + r16) * 128 + m3) * 64 + 8 * (rem & 7); kr[it] = *(const v4u*)(p_KB + go); vr[it] = *(const v4u*)(p_VB + go); } } while (0)
    A1_ISSUE(2 * qtr);
#pragma unroll 1
    for (int u = 0; u < 2; ++u) {
        const int T = 2 * qtr + u;
        __syncthreads();
#pragma unroll
        for (int it = 0; it < 6; ++it) { const int idx = tid + 512 * it, r16 = idx / 192, rem = idx - 192 * r16, row = 16 * (rem >> 3) + r16, ch = rem & 7; *(LAS v4u*)(Kl + row * AP + ch * 16) = kr[it]; *(LAS v4u*)(Vl + row * AP + ch * 16) = vr[it]; }
        __syncthreads();
        const int tq0 = 256 * T + 32 * wave; const size_t m = rb + tq0 + i;
        bf16x8 qf[4];
#pragma unroll
        for (int s = 0; s < 4; ++s) qf[s] = *(const bf16x8*)(p_QB + m * 768 + hh * 64 + 8 * h + 16 * s);
        const bf16* o2p = p_O2 + m * 768 + hh * 64 + 4 * h; const bf16* o3p = p_O3 + m * 768 + hh * 64 + 4 * h; const bf16* zp = p_ZB + m * 2048 + hh * 64 + 4 * h; bf16* yp = p_YB + m * 2048 + hh * 64 + 4 * h;
        const float l2 = p_L2[m * 16 + hh], l3 = p_L3[m * 16 + hh];
        u32x2v a2[8], a3[8];
#pragma unroll
        for (int c8 = 0; c8 < 8; ++c8) { a2[c8] = *(const u32x2v*)(o2p + 8 * c8); a3[c8] = *(const u32x2v*)(o3p + 8 * c8); }
        if (u < 1) A1_ISSUE(T + 1);
        f32x16 o[2]; float lse;
        cls_tile(qf, Kl, Vl, 32 * wave, tq0 >= 128 ? 0 : (128 - tq0) >> 5, lane, o, lse);
        const float M = fmaxf(lse, fmaxf(l2, l3)), L = M + lg2(ex2(lse - M) + ex2(l2 - M) + ex2(l3 - M));
        const float w1 = ex2(lse - L), w2 = ex2(l2 - L), w3 = ex2(l3 - L);
#pragma unroll
        for (int db = 0; db < 2; ++db)
#pragma unroll
            for (int g4 = 0; g4 < 4; ++g4) { const int c8 = 4 * db + g4; const u32x2v x2 = a2[c8], x3 = a3[c8], z = *(const u32x2v*)(zp + 8 * c8); u32x2v w;
                const float y0 = w1 * o[db][4 * g4] + w2 * bflo(x2.x) + w3 * bflo(x3.x), y1 = w1 * o[db][4 * g4 + 1] + w2 * bfhi(x2.x) + w3 * bfhi(x3.x);
                const float y2 = w1 * o[db][4 * g4 + 2] + w2 * bflo(x2.y) + w3 * bflo(x3.y), y3 = w1 * o[db][4 * g4 + 3] + w2 * bfhi(x2.y) + w3 * bfhi(x3.y);
                w.x = cvtpk2(y0 * bflo(z.x), y1 * bfhi(z.x)); w.y = cvtpk2(y2 * bflo(z.y), y3 * bfhi(z.y)); *(u32x2v*)(yp + 8 * c8) = w; }
    }
#undef A1_ISSUE
}

DI void sgu_item(const Ctx& C, int l, int item) { bf16* const p_BU = ((bf16*)WSP(WS_BU)); bf16* const p_BV = ((bf16*)WSP(WS_BV)); bf16* const p_SGW = ((bf16*)WSP(WS_SGW)); bf16* const p_YB = ((bf16*)WSP(WS_YB)); bf16* const p_ZB = ((bf16*)WSP(WS_ZB)); const float* const p_ln_b = ((const float*)INP(10)); const float* const p_ln_g = ((const float*)INP(9)); const float* const p_sgu_b = ((const float*)INP(12));
    const int b = item >> 4, ch = item & 15, lane = C.lane, wave = C.wave, i = lane & 31, h = lane >> 5; const size_t m0 = (size_t)b * SEQL + ch * 128;
    constexpr int VP = 1040;
    { const f32x4 g0 = *(const f32x4*)(p_ln_g + l * 512 + 8 * lane), g1 = *(const f32x4*)(p_ln_g + l * 512 + 8 * lane + 4), b0 = *(const f32x4*)(p_ln_b + l * 512 + 8 * lane), b1 = *(const f32x4*)(p_ln_b + l * 512 + 8 * lane + 4);
      v4u raw[16]; float s1[16], s2[16];
#pragma unroll
      for (int tt = 0; tt < 16; ++tt) raw[tt] = *(const v4u*)(p_BV + (m0 + 16 * wave + tt) * 512 + 8 * lane);
#pragma unroll
      for (int tt = 0; tt < 16; ++tt) { const v4u r = raw[tt]; const float x0 = bflo(r.x), x1 = bfhi(r.x), x2 = bflo(r.y), x3 = bfhi(r.y), x4 = bflo(r.z), x5 = bfhi(r.z), x6 = bflo(r.w), x7 = bfhi(r.w);
        s1[tt] = ((x0 + x1) + (x2 + x3)) + ((x4 + x5) + (x6 + x7)); s2[tt] = ((x0 * x0 + x1 * x1) + (x2 * x2 + x3 * x3)) + ((x4 * x4 + x5 * x5) + (x6 * x6 + x7 * x7)); }
#pragma unroll
      for (int o = 1; o < 64; o <<= 1) {
#pragma unroll
        for (int tt = 0; tt < 16; ++tt) { s1[tt] += shx(s1[tt], o, lane); s2[tt] += shx(s2[tt], o, lane); } }
#pragma unroll
      for (int tt = 0; tt < 16; ++tt) { const int t = 16 * wave + tt; const v4u r = raw[tt];
        const float mean = s1[tt] * (1.0f / 512.0f), var = fmaxf(s2[tt] * (1.0f / 512.0f) - mean * mean, 0.f), rstd = __builtin_amdgcn_rsqf(var + EPSF);
        float x[8] = {bflo(r.x), bfhi(r.x), bflo(r.y), bfhi(r.y), bflo(r.z), bfhi(r.z), bflo(r.w), bfhi(r.w)};
#pragma unroll
        for (int e = 0; e < 8; ++e) x[e] = (x[e] - mean) * rstd;
        v4u w; w.x = cvtpk2(x[0] * g0[0] + b0[0], x[1] * g0[1] + b0[1]); w.y = cvtpk2(x[2] * g0[2] + b0[2], x[3] * g0[3] + b0[3]);
        w.z = cvtpk2(x[4] * g1[0] + b1[0], x[5] * g1[1] + b1[1]); w.w = cvtpk2(x[6] * g1[2] + b1[2], x[7] * g1[3] + b1[3]);
        *(LAS v4u*)(C.lds + t * VP + lane * 16) = w; } }
    __syncthreads();
    const int g = wave; const bf16* Wg = p_SGW + (size_t)((l * 8 + g) * 128) * 128; const int troff = tr_lane_off(VP, lane, false);
#pragma unroll
    for (int tb = 0; tb < 4; ++tb) {
        f32x16 acc[2]; acc[0] = zero16(); acc[1] = zero16();
#pragma unroll
        for (int ks = 0; ks < 2 * tb + 2; ++ks) {
            const bf16x8 wf = *(const bf16x8*)(Wg + (32 * tb + i) * 128 + 16 * ks + 8 * h);
#pragma unroll
            for (int cb = 0; cb < 2; ++cb) acc[cb] = MFMA32(trfrag(C.lds, VP, 16 * ks, 64 * g + 32 * cb, troff, false), wf, acc[cb]);
        }
        const int t = 32 * tb + i; const float bias = p_sgu_b[(l * 8 + g) * 128 + t]; const size_t m = m0 + t;
#pragma unroll
        for (int cb = 0; cb < 2; ++cb)
#pragma unroll
            for (int g4 = 0; g4 < 4; ++g4) { const int c0 = 64 * g + 32 * cb + 8 * g4 + 4 * h;
                const u32x2v u = *(const u32x2v*)(p_BU + m * 512 + c0), z = *(const u32x2v*)(p_ZB + m * 2048 + 768 + c0); u32x2v w;
                w.x = cvtpk2(bflo(u.x) * (acc[cb][4 * g4] + bias) * bflo(z.x), bfhi(u.x) * (acc[cb][4 * g4 + 1] + bias) * bfhi(z.x));
                w.y = cvtpk2(bflo(u.y) * (acc[cb][4 * g4 + 2] + bias) * bflo(z.y), bfhi(u.y) * (acc[cb][4 * g4 + 3] + bias) * bfhi(z.y));
                *(u32x2v*)(p_YB + m * 2048 + 768 + c0) = w; }
    }
}

DI void hgp_item(const Ctx& C, int l, int item) { unsigned char* const ws = WSP(0); const bf16* const p_CK = (const bf16*)(ws + WS_CK); const bf16* const p_CI = (const bf16*)(ws + WS_CI); const float* const p_DJ = (const float*)(ws + WS_DJ); float* const p_SNAP = (float*)(ws + WS_DS); float* const p_out = OUTP();
    const int bh = item, b = bh / 6, hh = bh % 6, tid = C.tid, lane = C.lane, wave = C.wave, i = lane & 31, h = lane >> 5;
    constexpr int PT = 272, TB = 32 * PT, BUF = 2 * TB;
    LAS unsigned char* L = C.lds;
    const int row = tid >> 4, chn = tid & 15, kb = wave >> 1, vb0 = 2 * (wave & 1), troff = tr_lane_off(PT, lane, false);
    const size_t g0 = ((size_t)b * SEQL + row) * 768 + hh * 128 + chn * 8;
    const float* djp = p_DJ + ((size_t)b * 64) * 768 + hh * 128 + 32 * kb + i;
    v4u kreg = *(const v4u*)(p_CK + g0), vreg = *(const v4u*)(p_CI + g0); float djn = djp[0];
    *(LAS v4u*)(L + row * PT + chn * 16) = kreg; *(LAS v4u*)(L + TB + row * PT + chn * 16) = vreg;
    __syncthreads();
    f32x16 acc[2]; acc[0] = zero16(); acc[1] = zero16();
#pragma unroll 1
    for (int j = 0; j < 64; ++j) {
        LAS const unsigned char* cur = L + (j & 1) * BUF; LAS unsigned char* nxt = L + ((j + 1) & 1) * BUF;
        const float dj = djn;
        if (j < 63) { const size_t g = g0 + (size_t)(32 * (j + 1)) * 768; kreg = *(const v4u*)(p_CK + g); vreg = *(const v4u*)(p_CI + g); djn = djp[(size_t)(j + 1) * 768]; }
#pragma unroll
        for (int s2 = 0; s2 < 2; ++s2) { const bf16x8 kfr = trfrag(cur, PT, 16 * s2, 32 * kb, troff, false);
#pragma unroll
            for (int j2 = 0; j2 < 2; ++j2) acc[j2] = MFMA32(trfrag(cur + TB, PT, 16 * s2, 32 * (vb0 + j2), troff, false), kfr, acc[j2]); }
#pragma unroll
        for (int r = 0; r < 16; ++r) { acc[0][r] *= dj; acc[1][r] *= dj; }
        if ((j & 15) == 15) {
            float* dst = (j == 63) ? p_out + O_HP + (size_t)(l * 48 + bh) * 16384 : p_SNAP + (size_t)(bh * 3 + (j >> 4)) * 16384;
            dst += (size_t)(32 * kb + i) * 128 + 4 * h;
#pragma unroll
            for (int j2 = 0; j2 < 2; ++j2)
#pragma unroll
                for (int g4 = 0; g4 < 4; ++g4) *(f32x4*)(dst + 32 * (vb0 + j2) + 8 * g4) = (f32x4){acc[j2][4 * g4], acc[j2][4 * g4 + 1], acc[j2][4 * g4 + 2], acc[j2][4 * g4 + 3]};
        }
        if (j < 63) { *(LAS v4u*)(nxt + row * PT + chn * 16) = kreg; *(LAS v4u*)(nxt + TB + row * PT + chn * 16) = vreg; }
        __syncthreads();
    }
}
DI void hg3_item(const Ctx& C, int l, int item) { unsigned char* const ws = WSP(0); const bf16* const p_CE = (const bf16*)(ws + WS_CE); const float* const p_DJ = (const float*)(ws + WS_DJ); const bf16* const p_CI = (const bf16*)(ws + WS_CI); const bf16* const p_CK = (const bf16*)(ws + WS_CK); const bf16* const p_CQ = (const bf16*)(ws + WS_CQ); const float* const p_SNAP = (const float*)(ws + WS_DS); bf16* const p_YB = (bf16*)(ws + WS_YB); const bf16* const p_ZB = (const bf16*)(ws + WS_ZB); const float* const p_hn_g = ((const float*)INP(14));
    const int qt = item & 3, bh = item >> 2, b = bh / 6, hh = bh % 6, tid = C.tid, lane = C.lane, wave = C.wave, i = lane & 31, h = lane >> 5;
    constexpr int PT = 272, MB = 128 * PT;
    LAS unsigned char *QT = C.lds, *KD = C.lds + MB, *VV = C.lds + 2 * MB, *SB = C.lds + 3 * MB;
    LAS float* RS = (LAS float*)(C.lds + 4 * MB);
    f32x16 sacc[4];
    const int kb = wave & 3;
    if (wave >= 4) {
        if (qt == 0) {
#pragma unroll
            for (int vb = 0; vb < 4; ++vb) { sacc[vb] = zero16();
#pragma unroll
                for (int g4 = 0; g4 < 4; ++g4) *(LAS u32x2v*)(SB + (32 * kb + i) * PT + (32 * vb + 8 * g4 + 4 * h) * 2) = (u32x2v){0u, 0u}; }
        } else {
            const float* sp = p_SNAP + (size_t)(bh * 3 + qt - 1) * 16384 + (size_t)(32 * kb + i) * 128 + 4 * h;
#pragma unroll
            for (int vb = 0; vb < 4; ++vb)
#pragma unroll
                for (int g4 = 0; g4 < 4; ++g4) { const f32x4 tt = *(const f32x4*)(sp + 32 * vb + 8 * g4); sacc[vb][4 * g4] = tt[0]; sacc[vb][4 * g4 + 1] = tt[1]; sacc[vb][4 * g4 + 2] = tt[2]; sacc[vb][4 * g4 + 3] = tt[3];
                    u32x2v w; w.x = cvtpk2(tt[0], tt[1]); w.y = cvtpk2(tt[2], tt[3]); *(LAS u32x2v*)(SB + (32 * kb + i) * PT + (32 * vb + 8 * g4 + 4 * h) * 2) = w; }
        }
    }
    const int tro_n = tr_lane_off(PT, lane, false), tro_p = tr_lane_off(PT, lane, true);
    v4u rq[4], re[4], rk[4], rv[4];
#define HG3_ISSUE(sgx) do { const size_t mm_ = (size_t)b * SEQL + (4 * qt + (sgx)) * 128; _Pragma("unroll") for (int it = 0; it < 4; ++it) { const int idx = tid + 512 * it, row = idx >> 4, chn = idx & 15; \
        const size_t go = (mm_ + row) * 768 + hh * 128 + chn * 8; rq[it] = *(const v4u*)(p_CQ + go); re[it] = *(const v4u*)(p_CE + go); rk[it] = *(const v4u*)(p_CK + go); rv[it] = *(const v4u*)(p_CI + go); } } while (0)
#define HG3_FILL() do { _Pragma("unroll") for (int it = 0; it < 4; ++it) { const int idx = tid + 512 * it, row = idx >> 4, chn = idx & 15; const v4u q8 = rq[it], e8 = re[it]; v4u w; \
            w.x = cvtpk2(bflo(q8.x) * bflo(e8.x), bfhi(q8.x) * bfhi(e8.x)); w.y = cvtpk2(bflo(q8.y) * bflo(e8.y), bfhi(q8.y) * bfhi(e8.y)); \
            w.z = cvtpk2(bflo(q8.z) * bflo(e8.z), bfhi(q8.z) * bfhi(e8.z)); w.w = cvtpk2(bflo(q8.w) * bflo(e8.w), bfhi(q8.w) * bfhi(e8.w)); \
            *(LAS v4u*)(QT + row * PT + chn * 16) = w; *(LAS v4u*)(KD + row * PT + chn * 16) = rk[it]; *(LAS v4u*)(VV + row * PT + chn * 16) = rv[it]; } } while (0)
    HG3_ISSUE(0);
    if (wave < 4) {
        const int vb = wave;
#pragma unroll 1
        for (int sg = 0; sg < 4; ++sg) {
            const size_t m0 = (size_t)b * SEQL + (4 * qt + sg) * 128;
            HG3_FILL();
            if (sg < 3) HG3_ISSUE(sg + 1);
            __syncthreads();
#pragma unroll 1
            for (int j = 0; j < 4; ++j) {
                u32x2v zr[4]; f32x4 gnv[4];
#pragma unroll
                for (int g4 = 0; g4 < 4; ++g4) { zr[g4] = *(const u32x2v*)(p_ZB + (m0 + 32 * j + i) * 2048 + 1280 + hh * 128 + 32 * vb + 8 * g4 + 4 * h); gnv[g4] = *(const f32x4*)(p_hn_g + l * 768 + hh * 128 + 32 * vb + 8 * g4 + 4 * h); }
                bf16x8 qfr[8];
#pragma unroll
                for (int ks = 0; ks < 8; ++ks) qfr[ks] = *(LAS const bf16x8*)(QT + (32 * j + i) * PT + (16 * ks + 8 * h) * 2);
                f32x16 x = zero16();
#pragma unroll
                for (int ks = 0; ks < 8; ++ks) x = MFMA32(*(LAS const bf16x8*)(KD + (32 * j + i) * PT + (16 * ks + 8 * h) * 2), qfr[ks], x);
#pragma unroll
                for (int r = 0; r < 16; ++r) if (crow(r, h) > i) x[r] = 0.f;
                const bf16x8 pb0 = pack8(x, 0), pb1 = pack8(x, 1);
                f32x16 oa = zero16();
#pragma unroll
                for (int ks = 0; ks < 8; ++ks) oa = MFMA32(trfrag(SB, PT, 16 * ks, 32 * vb, tro_n, false), qfr[ks], oa);
                oa = MFMA32(trfrag(VV, PT, 32 * j, 32 * vb, tro_p, true), pb0, oa);
                oa = MFMA32(trfrag(VV, PT, 32 * j + 16, 32 * vb, tro_p, true), pb1, oa);
                float ss = 0.f;
#pragma unroll
                for (int r = 0; r < 16; ++r) ss += oa[r] * oa[r];
                ss += shx(ss, 32, lane);
                if (h == 0) RS[vb * 32 + i] = ss;
                __syncthreads();
                const float tot = RS[i] + RS[32 + i] + RS[64 + i] + RS[96 + i], rstd = __builtin_amdgcn_rsqf(tot * (1.0f / 128.0f) + EPSF);
                const size_t m = m0 + 32 * j + i;
#pragma unroll
                for (int g4 = 0; g4 < 4; ++g4) { const int v0 = hh * 128 + 32 * vb + 8 * g4 + 4 * h; const f32x4 gn = gnv[g4]; const u32x2v z = zr[g4]; u32x2v w;
                    w.x = cvtpk2(oa[4 * g4] * rstd * gn[0] * bflo(z.x), oa[4 * g4 + 1] * rstd * gn[1] * bfhi(z.x)); w.y = cvtpk2(oa[4 * g4 + 2] * rstd * gn[2] * bflo(z.y), oa[4 * g4 + 3] * rstd * gn[3] * bfhi(z.y));
                    *(u32x2v*)(p_YB + m * 2048 + 1280 + v0) = w; }
                __syncthreads();
            }
        }
    } else {
#pragma unroll 1
        for (int sg = 0; sg < 4; ++sg) {
            const size_t m0 = (size_t)b * SEQL + (4 * qt + sg) * 128;
            HG3_FILL();
            float dv[4];
#pragma unroll
            for (int j = 0; j < 4; ++j) dv[j] = p_DJ[((m0 >> 5) + j) * 768 + hh * 128 + 32 * kb + i];
            if (sg < 3) HG3_ISSUE(sg + 1);
            __syncthreads();
#pragma unroll 1
            for (int j = 0; j < 4; ++j) {
#pragma unroll
                for (int s2 = 0; s2 < 2; ++s2) { const bf16x8 kfr = trfrag(KD, PT, 32 * j + 16 * s2, 32 * kb, tro_n, false);
#pragma unroll
                    for (int vb = 0; vb < 4; ++vb) sacc[vb] = MFMA32(trfrag(VV, PT, 32 * j + 16 * s2, 32 * vb, tro_n, false), kfr, sacc[vb]); }
                const float d = (j == 0) ? dv[0] : (j == 1 ? dv[1] : (j == 2 ? dv[2] : dv[3]));
#pragma unroll
                for (int vb = 0; vb < 4; ++vb)
#pragma unroll
                    for (int r = 0; r < 16; ++r) sacc[vb][r] *= d;
                __syncthreads();
#pragma unroll
                for (int vb = 0; vb < 4; ++vb)
#pragma unroll
                    for (int g4 = 0; g4 < 4; ++g4) { u32x2v w; w.x = cvtpk2(sacc[vb][4 * g4], sacc[vb][4 * g4 + 1]); w.y = cvtpk2(sacc[vb][4 * g4 + 2], sacc[vb][4 * g4 + 3]); *(LAS u32x2v*)(SB + (32 * kb + i) * PT + (32 * vb + 8 * g4 + 4 * h) * 2) = w; }
                __syncthreads();
            }
        }
    }
#undef HG3_ISSUE
#undef HG3_FILL
}
DI void samp_attn_item(const Ctx& C, int l, int item) { const float* const p_cache_k = ((const float*)INP(2)); const float* const p_cache_v = ((const float*)INP(3)); bf16* const p_QB = ((bf16*)WSP(WS_QB)); bf16* const p_KB = ((bf16*)WSP(WS_KB)); bf16* const p_VB = ((bf16*)WSP(WS_VB)); bf16* const p_ZB = ((bf16*)WSP(WS_ZB)); bf16* const p_YB = ((bf16*)WSP(WS_YB));
    const int b = item / 12, hh = item % 12, wave = C.wave, lane = C.lane, tid = C.tid; const size_t row = MPR + b;
    LAS float* sc = (LAS float*)C.lds;
    LAS float* po = sc + 400;
    const float* ck = p_cache_k + ((size_t)(l * 32 + b) * 2048) * 768 + hh * 64; const float* cv = p_cache_v + ((size_t)(l * 32 + b) * 2048) * 768 + hh * 64;
    const int grp = tid >> 4, dl = 4 * (tid & 15);
    const u32x2v qraw = *(const u32x2v*)(p_QB + row * 768 + hh * 64 + dl); const float q0 = bflo(qraw.x), q1 = bfhi(qraw.x), q2 = bflo(qraw.y), q3 = bfhi(qraw.y);
    const u32x2v knraw = *(const u32x2v*)(p_KB + row * 768 + hh * 64 + dl);
    const f32x4 knew = (f32x4){bflo(knraw.x), bfhi(knraw.x), bflo(knraw.y), bfhi(knraw.y)};
    f32x4 kv[13];
#pragma unroll
    for (int it = 0; it < 13; ++it) { int slot = 32 * it + grp; if (slot > 386) slot = 386; const int pp = slot / 129, jj = slot - 129 * pp, idx = 2048 - (jj << (2 * pp));
        kv[it] = knew; if (idx < 2048) kv[it] = *(const f32x4*)(ck + (size_t)idx * 768 + dl); }
#pragma unroll
    for (int it = 0; it < 13; ++it) { const int slot = 32 * it + grp;
        float part = (q0 * kv[it][0] + q1 * kv[it][1]) + (q2 * kv[it][2] + q3 * kv[it][3]);
        part += shx(part, 1, lane); part += shx(part, 2, lane); part += shx(part, 4, lane); part += shx(part, 8, lane);
        if ((tid & 15) == 0 && slot < 387) sc[slot] = part; }
    __syncthreads();
    float mx = -1e30f;
    for (int t = lane; t < 387; t += 64) mx = fmaxf(mx, sc[t]);
    mx = wave_max(mx, lane);
    float sm = 0.f;
    for (int t = lane; t < 387; t += 64) sm += ex2(sc[t] - mx);
    sm = wave_sum(sm, lane);
    const u32x2v vnraw = *(const u32x2v*)(p_VB + row * 768 + hh * 64 + dl);
    const f32x4 vnewv = (f32x4){bflo(vnraw.x), bfhi(vnraw.x), bflo(vnraw.y), bfhi(vnraw.y)};
    f32x4 vv[13];
#pragma unroll
    for (int it = 0; it < 13; ++it) { int slot = 32 * it + grp; if (slot > 386) slot = 386; const int pp = slot / 129, jj = slot - 129 * pp, idx = 2048 - (jj << (2 * pp));
        vv[it] = vnewv; if (idx < 2048) vv[it] = *(const f32x4*)(cv + (size_t)idx * 768 + dl); }
    f32x4 o4 = (f32x4){0.f, 0.f, 0.f, 0.f};
#pragma unroll
    for (int it = 0; it < 13; ++it) { const int slot = 32 * it + grp; if (slot < 387) o4 += vv[it] * ex2(sc[slot] - mx); }
#pragma unroll
    for (int e = 0; e < 4; ++e) { o4[e] += shx(o4[e], 16, lane); o4[e] += shx(o4[e], 32, lane); }
    if (lane < 16) *(LAS f32x4*)(po + wave * 64 + dl) = o4;
    __syncthreads();
    if (wave == 0) { float t = 0.f;
#pragma unroll
        for (int w = 0; w < 8; ++w) t += po[w * 64 + lane];
        t *= 1.0f / sm;
        p_YB[row * 2048 + hh * 64 + lane] = (bf16)f2bf(t * bf2f(p_ZB[row * 2048 + hh * 64 + lane])); }
}
DI void samp_sgu_item(const Ctx& C, int l, int item) { bf16* const p_BU = ((bf16*)WSP(WS_BU)); bf16* const p_BV = ((bf16*)WSP(WS_BV)); bf16* const p_YB = ((bf16*)WSP(WS_YB)); bf16* const p_ZB = ((bf16*)WSP(WS_ZB)); const float* const p_ln_b = ((const float*)INP(10)); const float* const p_ln_g = ((const float*)INP(9)); float* const p_out = OUTP(); const float* const p_sgu_b = ((const float*)INP(12)); const float* const p_sgu_w = ((const float*)INP(11));
    const int b = 8 * item + C.wave, lane = C.lane; const size_t row = MPR + b;
    const v4u raw = *(const v4u*)(p_BV + row * 512 + 8 * lane);
    float x[8] = {bflo(raw.x), bfhi(raw.x), bflo(raw.y), bfhi(raw.y), bflo(raw.z), bfhi(raw.z), bflo(raw.w), bfhi(raw.w)};
    float s = 0.f;
#pragma unroll
    for (int e = 0; e < 8; ++e) s += x[e];
    const float mean = wave_sum(s, lane) * (1.0f / 512.0f); float q = 0.f;
#pragma unroll
    for (int e = 0; e < 8; ++e) { x[e] -= mean; q += x[e] * x[e]; }
    const float rstd = __builtin_amdgcn_rsqf(wave_sum(q, lane) * (1.0f / 512.0f) + EPSF);
    const int g = lane >> 3; const float w00 = p_sgu_w[(size_t)((l * 8 + g) * 128) * 128], bb = p_sgu_b[(l * 8 + g) * 128];
    const v4u ur = *(const v4u*)(p_BU + row * 512 + 8 * lane), zr = *(const v4u*)(p_ZB + row * 2048 + 768 + 8 * lane);
    const float uu[8] = {bflo(ur.x), bfhi(ur.x), bflo(ur.y), bfhi(ur.y), bflo(ur.z), bfhi(ur.z), bflo(ur.w), bfhi(ur.w)};
    const float zz[8] = {bflo(zr.x), bfhi(zr.x), bflo(zr.y), bfhi(zr.y), bflo(zr.z), bfhi(zr.z), bflo(zr.w), bfhi(zr.w)};
    float vn[8], y[8];
#pragma unroll
    for (int e = 0; e < 8; ++e) { vn[e] = x[e] * rstd * p_ln_g[l * 512 + 8 * lane + e] + p_ln_b[l * 512 + 8 * lane + e]; y[e] = uu[e] * (w00 * vn[e] + bb) * zz[e]; }
    float* od = p_out + O_SGU + (size_t)(l * 32 + b) * 512 + 8 * lane;
    *(f32x4*)od = (f32x4){vn[0], vn[1], vn[2], vn[3]}; *(f32x4*)(od + 4) = (f32x4){vn[4], vn[5], vn[6], vn[7]};
    v4u w; w.x = cvtpk2(y[0], y[1]); w.y = cvtpk2(y[2], y[3]); w.z = cvtpk2(y[4], y[5]); w.w = cvtpk2(y[6], y[7]);
    *(v4u*)(p_YB + row * 2048 + 768 + 8 * lane) = w;
}
DI void samp_hgrn_item(const Ctx& C, int l, int item) { bf16* const p_CE = ((bf16*)WSP(WS_CE)); bf16* const p_CI = ((bf16*)WSP(WS_CI)); bf16* const p_CK = ((bf16*)WSP(WS_CK)); bf16* const p_CQ = ((bf16*)WSP(WS_CQ)); bf16* const p_YB = ((bf16*)WSP(WS_YB)); bf16* const p_ZB = ((bf16*)WSP(WS_ZB)); const float* const p_hn_g = ((const float*)INP(14)); float* const p_out = OUTP(); const float* const p_state = ((const float*)INP(4));
    const int b = item / 6, hh = item % 6, tid = C.tid; const size_t row = MPR + b;
    LAS float* qs = (LAS float*)C.lds; LAS float* eg = qs + 128; LAS float* kx = eg + 128; LAS float* vv = kx + 128; LAS float* po = vv + 128; LAS float* ov = po + 2048; LAS float* pr = ov + 128;
    if (tid < 128) { const size_t o = row * 768 + hh * 128 + tid; qs[tid] = bf2f(p_CQ[o]); eg[tid] = bf2f(p_CE[o]); kx[tid] = bf2f(p_CK[o]); vv[tid] = bf2f(p_CI[o]); }
    __syncthreads();
    const int v4 = (tid & 31) * 4, kq = tid >> 5;
    const f32x4 vloc = *(LAS const f32x4*)(vv + v4); f32x4 acc = (f32x4){0.f, 0.f, 0.f, 0.f};
    const float* S0 = p_state + (size_t)((l * 32 + b) * 6 + hh) * 16384; float* S1 = p_out + O_HS + (size_t)((l * 32 + b) * 6 + hh) * 16384;
#pragma unroll
    for (int kk = 0; kk < 8; ++kk) { const int k = 8 * kq + kk; const f32x4 s = *(const f32x4*)(S0 + k * 128 + v4); const f32x4 sn = s * eg[k] + vloc * kx[k]; *(f32x4*)(S1 + k * 128 + v4) = sn; acc += sn * qs[k]; }
    *(LAS f32x4*)(po + kq * 128 + v4) = acc;
    __syncthreads();
    float o = 0.f;
    if (tid < 128) {
#pragma unroll
        for (int q4 = 0; q4 < 16; ++q4) o += po[q4 * 128 + tid];
        const float ss = wave_sum(o * o, C.lane); if (C.lane == 0) pr[C.wave] = ss; }
    __syncthreads();
    if (tid < 128) { const float rstd = __builtin_amdgcn_rsqf((pr[0] + pr[1]) * (1.0f / 128.0f) + EPSF);
        p_YB[row * 2048 + 1280 + hh * 128 + tid] = (bf16)f2bf(o * rstd * p_hn_g[l * 768 + hh * 128 + tid] * bf2f(p_ZB[row * 2048 + 1280 + hh * 128 + tid])); }
}
DI void samp_out_item(const Ctx& C, int l, int item) { const float* const p_x_sample = ((const float*)INP(1)); float* const p_SSQ1 = ((float*)WSP(WS_CTL + CTL_SSQ1)); bf16* const p_WOUT = ((bf16*)WSP(WS_WOUT)); float* const p_X1 = ((float*)WSP(WS_X1)); bf16* const p_XB = ((bf16*)WSP(WS_XB)); bf16* const p_YB = ((bf16*)WSP(WS_YB)); float* const p_out = OUTP();
    const int lane = C.lane, wave = C.wave, i = lane & 31, h = lane >> 5, n0 = 32 * item;
    const bf16* A = p_YB + (size_t)(MPR + i) * 2048 + 256 * wave + 8 * h; const bf16* B = p_WOUT + ((size_t)l * DM + n0 + i) * 2048 + 256 * wave + 8 * h;
    f32x16 acc = zero16();
#pragma unroll
    for (int ks = 0; ks < 16; ++ks) acc = MFMA32(*(const bf16x8*)(A + 16 * ks), *(const bf16x8*)(B + 16 * ks), acc);
    LAS float* red = (LAS float*)C.lds;
#pragma unroll
    for (int r = 0; r < 16; ++r) red[(wave * 16 + r) * 64 + lane] = acc[r];
    __syncthreads();
    const int tl = C.tid & 63, i2 = tl & 31, h2 = tl >> 5;
#pragma unroll
    for (int e = 0; e < 2; ++e) { const int r = (C.tid >> 6) * 2 + e; float s = 0.f;
#pragma unroll
        for (int w = 0; w < 8; ++w) s += red[(w * 16 + r) * 64 + tl];
        const int bb = crow(r, h2), n = n0 + i2;
        if (l == 0) { const float o = p_x_sample[(size_t)bb * DM + n] + s; p_XB[(size_t)(MPR + bb) * DM + n] = (bf16)f2bf(o);
            float ss = o * o; ss += shx(ss, 1, lane); ss += shx(ss, 2, lane); ss += shx(ss, 4, lane); ss += shx(ss, 8, lane); ss += shx(ss, 16, lane);
            if (i2 == 0) atomicAdd(p_SSQ1 + MPR + bb, ss); }
        else { p_out[O_YS + (size_t)bb * DM + n] = bf2f(p_XB[(size_t)(MPR + bb) * DM + n]) + s; } }
}
DI int fetch_item(Ctx& C, int q) { gu32* const p_ctl = ((gu32*)WSP(WS_CTL));
    __syncthreads();
    if (C.tid == 0) C.MISC[0] = __hip_atomic_fetch_add((unsigned*)(p_ctl + CW_Q + 64 * q), 1u, __ATOMIC_RELAXED, __HIP_MEMORY_SCOPE_AGENT);
    __syncthreads();
    const int it = (int)C.MISC[0];
    { int t_ = C.tid; asm volatile("" : "+v"(t_)); C.tid = t_; C.lane = t_ & 63; C.wave = __builtin_amdgcn_readfirstlane(t_ >> 6);
      LAS unsigned char* lp_ = C.lds; asm volatile("" : "+s"(lp_)); C.lds = lp_; C.MISC = (volatile LAS unsigned*)(lp_ + MISC_OFF); }
    return it;
}
#ifndef G1_STAGGER_TICKS
#define G1_STAGGER_TICKS 0
#endif
#ifndef RPT_PHASE
#define RPT_PHASE -1
#define RPT_N 0
#endif
#ifndef RPT_IMASK
#define RPT_IMASK 0xffff
#endif
#ifndef RPT_MASK
#define RPT_MASK 0
#endif
#ifndef PH_MASK
#define PH_MASK 2047
#endif
constexpr int N_ATT = 384, N_HG = 192, N_HGP = 48, N_A1 = 384, N_SGU = 128, N_SAT = 384, N_SHG = 192, N_SSG = 4;
constexpr int N_M1 = N_HGP + N_ATT + N_SAT + N_SGU + N_SHG + N_SSG, N_WT = 184, N_KVO = 0;
constexpr int N_SOUT = 32;

template <int KIND, int L> DI void run_kind(Ctx& C, int im, int bx_) {
    constexpr int l = L;
    if constexpr (KIND == 0) { p0_prologue(C); }
    else if constexpr (KIND == 1) {
        pg8::Gemm g{((bf16*)WSP(WS_XB)), ((bf16*)WSP(WS_WIN)) + (size_t)l * NIN * DM, MPAD, NIN, DM}; pg8::StaticOrder S; S.init(MPAD, NIN, NGRID, bx_);
        pg8::EpiProj E{l == 0 ? ((float*)WSP(WS_CTL + CTL_SSQ0)) : ((float*)WSP(WS_CTL + CTL_SSQ1)), ((float*)WSP(WS_LB)) + l * 3 * 768, WSP(0), OUTP(), l, (im & 2048) ? 0 : 1,
                       WS_QB, WS_KB - WS_QB, WS_ZB, WS_BU, WS_BV - WS_BU, WS_CQ, WS_CK - WS_CQ, WS_CE, WS_DJ, WS_KH, WS_VH - WS_KH,
                       O_KP + (size_t)l * MPR * 768, O_VP - O_KP, O_KS + (size_t)l * 32 * 768, O_VS - O_KS};
#if G1_STAGGER_TICKS > 0
        { const unsigned long long t0 = __builtin_amdgcn_s_memrealtime(), dt = (unsigned long long)((bx_ >> 3) & 3) * G1_STAGGER_TICKS;
          while (__builtin_amdgcn_s_memrealtime() - t0 < dt) __builtin_amdgcn_s_sleep(8); }
#endif
        pg8::gemm_phase<pg8::EpiProj, pg8::StaticOrder, true, true>(C.lds + RING_OFF, g, S, E);
    } else if constexpr (KIND == 2) {
        for (;;) { int it = fetch_item(C, 3 * l + 0); if (it >= N_M1 + N_KVO + (l == 0 ? N_WT : 0)) break;
            if (it < N_HGP) { if (im & 8) hgp_item(C, l, it); continue; } it -= N_HGP;
            if (it < N_ATT) { if (im & 4) { if (it < 192) att23_item<2>(C, it); else att23_item<3>(C, it - 192); } continue; } it -= N_ATT;
            if (it < N_SAT) { if (im & 16) samp_attn_item(C, l, it); continue; } it -= N_SAT;
            if (it < N_SGU) { if (im & 32) sgu_item(C, l, it); continue; } it -= N_SGU;
            if (it < N_SHG) { if (im & 64) samp_hgrn_item(C, l, it); continue; } it -= N_SHG;
            if (it < N_SSG) { if (im & 128) samp_sgu_item(C, l, it); continue; } it -= N_SSG;
            if (it < N_KVO) { if (im & 128) kvout_item(C, l, it); continue; } it -= N_KVO;
            if (im & 128) wt_item(C, it); }
    } else if constexpr (KIND == 4) {
        for (;;) { int it = fetch_item(C, 3 * l + 2); if (it >= N_HG + N_A1 + N_SOUT) break;
            if (it < N_A1) { if (im & 512) att1_item(C, it); continue; } it -= N_A1;
            if (it < N_HG) { if (im & 256) hg3_item(C, l, it); continue; } it -= N_HG;
            if (im & 1024) samp_out_item(C, l, it); }
    } else {
        pg8::Gemm g{((bf16*)WSP(WS_YB)), ((bf16*)WSP(WS_WOUT)) + (size_t)l * DM * DMIX, MPR, DM, DMIX}; pg8::StaticOrder S; S.init(MPR, DM, NGRID, bx_);
        pg8::EpiOut E{l == 0 ? ((const float*)INP(0)) : nullptr, l == 0 ? nullptr : ((bf16*)WSP(WS_XB)), l == 0 ? nullptr : (OUTP()) + O_YP, l == 0 ? ((bf16*)WSP(WS_XB)) : nullptr, l == 0 ? ((float*)WSP(WS_CTL + CTL_SSQ1)) : nullptr};
        pg8::gemm_phase<pg8::EpiOut, pg8::StaticOrder, true, true>(C.lds + RING_OFF, g, S, E);
    }
}

__global__ void __launch_bounds__(NWAVES * 64, 2) mega_fwd(Args args) {
    extern __shared__ __attribute__((aligned(16))) unsigned char lds[];
    Ctx C;
    C.lds = (LAS unsigned char*)lds; C.MISC = (volatile LAS unsigned*)(C.lds + MISC_OFF);
    C.tid = threadIdx.x; C.lane = C.tid & 63; C.wave = __builtin_amdgcn_readfirstlane(C.tid >> 6);
    C.G = NGRID; C.vcu = 0;
    for (int u = C.tid; u < (LDS_BYTES - MISC_OFF) / 4; u += NWAVES * 64) ((LAS unsigned*)(C.lds + MISC_OFF))[u] = 0u;
    __syncthreads();
    XcdBarrier bar; bar.bar = (unsigned*)(((gu32*)WSP(WS_CTL)) + CW_BAR); bar.x = 0; bar.st = nullptr;
    if (N_LAUNCHES == 1) bar = xcd_barrier_post((unsigned*)(((gu32*)WSP(WS_CTL)) + CW_BAR), C.MISC + 8);
    const int lo = args.ph_lo, hi = args.ph_hi, im = args.imask;
    const int wave_s = __builtin_amdgcn_readfirstlane(threadIdx.x >> 6);
#define RELAUNDER() do { int t_ = (wave_s << 6) | (int)__builtin_amdgcn_mbcnt_hi(~0u, __builtin_amdgcn_mbcnt_lo(~0u, 0u)); asm volatile("" : "+v"(t_)); C.tid = t_; C.lane = t_ & 63; C.wave = __builtin_amdgcn_readfirstlane(t_ >> 6); \
        LAS unsigned char* lp_ = (LAS unsigned char*)lds; asm volatile("" : "+s"(lp_)); C.lds = lp_; C.MISC = (volatile LAS unsigned*)(lp_ + MISC_OFF); } while (0)
#define PHASE(p, KIND, L) if (lo <= (p) && (p) < hi) { RELAUNDER(); int bx_ = blockIdx.x; asm volatile("" : "+s"(bx_)); C.vcu = (bx_ & 7) * (NGRID >> 3) + (bx_ >> 3); run_kind<KIND, L>(C, im, bx_); \
        if (N_LAUNCHES == 1 && (p) + 1 < hi) { XcdBarrier b2; b2.bar = (unsigned*)(((gu32*)WSP(WS_CTL)) + CW_BAR); unsigned x2_ = bar.x; asm volatile("" : "+s"(x2_)); b2.x = x2_; b2.st = C.MISC + 8; xcd_barrier(b2); } }
    PHASE(0, 0, 0)
    PHASE(1, 1, 0) PHASE(2, 2, 0) PHASE(3, 4, 0) PHASE(4, 5, 0)
    PHASE(5, 1, 1) PHASE(6, 2, 1) PHASE(7, 4, 1) PHASE(8, 5, 1)
#undef PHASE
#undef RELAUNDER
}

extern "C" void kernel_launch(void* const* d_in, const int* in_sizes, int n_in, void* d_out, int out_size, void* d_ws, size_t ws_size, hipStream_t stream) {
    static int grid = 0;
    if (grid == 0) {
        if (n_in != 16 || (size_t)out_size != O_END || ws_size < WS_END) { fprintf(stderr, "kernel_launch: unexpected shapes: n_in %d out %d ws %zu (need %zu)\n", n_in, out_size, ws_size, (size_t)WS_END); grid = -1; return; }
        int dev = 0, cus = 0, per_cu = 0;
        if (hipGetDevice(&dev) != hipSuccess || hipDeviceGetAttribute(&cus, hipDeviceAttributeMultiprocessorCount, dev) != hipSuccess) { grid = -1; return; }
        if (hipFuncSetAttribute((const void*)mega_fwd, hipFuncAttributeMaxDynamicSharedMemorySize, LDS_BYTES) != hipSuccess) { fprintf(stderr, "kernel_launch: hipFuncSetAttribute failed\n"); grid = -1; return; }
        if (hipOccupancyMaxActiveBlocksPerMultiprocessor(&per_cu, (const void*)mega_fwd, NWAVES * 64, LDS_BYTES) != hipSuccess || per_cu < 1) { fprintf(stderr, "kernel_launch: occupancy query says %d\n", per_cu); (void)hipGetLastError(); per_cu = 1; }
        if (cus < NGRID) { fprintf(stderr, "kernel_launch: %d CUs < %d workgroups: not co-resident\n", cus, NGRID); grid = -1; return; }
        grid = NGRID;
    }
    if (grid < 0) return;
    (void)hipMemsetAsync((char*)d_ws + WS_CTL, 0, CTL_ZERO_BYTES, stream);
    Args a{};
    for (int i = 0; i < 16; ++i) a.in[i] = (const float*)d_in[i];
    a.out = (float*)d_out; a.ws = (unsigned char*)d_ws; a.imask = 0xffff;
    if (N_LAUNCHES == 1) { a.ph_lo = 0; a.ph_hi = N_PHASES; hipLaunchKernelGGL(mega_fwd, dim3(grid), dim3(NWAVES * 64), LDS_BYTES, stream, a); }
    else for (int p = 0; p < N_PHASES; ++p) { a.ph_lo = p; a.ph_hi = p + 1;
        const int nl = 1 + ((p == RPT_PHASE) ? RPT_N : 0);
        for (int r = 0; r < nl; ++r) {
            if (r > 0 && p >= 1) { const int l = (p - 1) / 4, k = (p - 1) % 4; if (k == 1 || k == 2) (void)hipMemsetAsync((char*)d_ws + WS_CTL + (size_t)(CW_Q + 64 * (3 * l + (k == 1 ? 0 : 2))) * 4, 0, 4, stream); }
            a.imask = (r > 0) ? RPT_IMASK : 0xffff;
            hipLaunchKernelGGL(mega_fwd, dim3(grid), dim3(NWAVES * 64), LDS_BYTES, stream, a); } }
}
```

```cpp
#include <hip/hip_runtime.h>
#include <cstdio>
#include <cstdint>
namespace pg8 {
#define PG8_LAS __attribute__((address_space(3)))
typedef unsigned short bf16_t;
typedef short bf16x8 __attribute__((ext_vector_type(8)));
typedef float f32x4 __attribute__((ext_vector_type(4)));
typedef unsigned u32x4 __attribute__((ext_vector_type(4)));
constexpr int BM = 256, BK = 64, HALF = 128, HTB = HALF * BK * 2  , STAGE_BYTES = 8 * HTB, NXCD = 8, WGM = 8;

__host__ __device__ __forceinline__ int lds_byte(int r, int c) { const int st = (r >> 4) * 2 + (c >> 5), rr = r & 15, cc = c & 31, ob = rr * 64 + cc * 2; return st * 1024 + (ob ^ (((ob >> 9) & 1) << 5)); }
__host__ __device__ __forceinline__ void stage_rc(int b, int& R, int& C) { const int st = b / 1024, sb = b % 1024, swz = sb ^ (((sb >> 9) & 1) << 5); R = (st >> 1) * 16 + swz / 64; C = (st & 1) * 32 + (swz % 64) / 2; }
__host__ __device__ __forceinline__ int perm32(int rho) { const int n = rho >> 4, i = rho & 15; return 8 * (i >> 2) + 4 * n + (i & 3); }

struct Unit { int pm, pn; };
struct Gemm { const bf16_t* A; const bf16_t* Bt; int M, N, K; };

struct StaticOrder {
    int nM, nN, nwg, G, c;
    __host__ __device__ void init(int M, int N, int G_, int c_) { nM = M / BM; nN = N / BM; nwg = nM * nN; G = G_; c = c_; }
    __host__ __device__ bool next(int i, Unit& u) const {
        const long L = (long)i * G + c; if (L >= nwg) return false;
        int wgid = (int)L; { const int q = nwg / NXCD, r = nwg % NXCD, xcd = wgid % NXCD, off = wgid / NXCD; wgid = (xcd < r ? xcd * (q + 1) : r * (q + 1) + (xcd - r) * q) + off; }
        const int nig = WGM * nN, gid = wgid / nig, fm = gid * WGM, gsz = (nM - fm) < WGM ? (nM - fm) : WGM;
        u.pm = fm + ((wgid % nig) % gsz); u.pn = (wgid % nig) / gsz; return true;
    }
    __device__ __forceinline__ void a_ready(const Unit&) const {}
    __device__ __forceinline__ void done(const Unit&) const {}
};


typedef float f32x2 __attribute__((ext_vector_type(2)));
typedef unsigned u32x2 __attribute__((ext_vector_type(2)));
typedef __bf16 bf16x2_t __attribute__((ext_vector_type(2)));
__device__ __forceinline__ unsigned cvtpk(float lo, float hi) { f32x2 v = {lo, hi}; bf16x2_t b = __builtin_convertvector(v, bf16x2_t); return __builtin_bit_cast(unsigned, b); }
__device__ __forceinline__ float fast_sigmoid(float x) { return __builtin_amdgcn_rcpf(1.0f + __expf(-x)); }
__device__ __forceinline__ float silu_f(float x) { return x * fast_sigmoid(x); }

template <int CTRL> __device__ __forceinline__ float dpp_f(float x) { return __builtin_bit_cast(float, __builtin_amdgcn_update_dpp(0, __builtin_bit_cast(int, x), CTRL, 0xf, 0xf, false)); }
template <int CTRL> __device__ __forceinline__ float dpp_f1(float x) { return __builtin_bit_cast(float, __builtin_amdgcn_update_dpp(0x3f800000, __builtin_bit_cast(int, x), CTRL, 0xf, 0xf, false)); }
__device__ __forceinline__ float row_prefprod16(float x) { x *= dpp_f1<0x111>(x); x *= dpp_f1<0x112>(x); x *= dpp_f1<0x114>(x); x *= dpp_f1<0x118>(x); return x; }
__device__ __forceinline__ float row_prefix16(float x) { x += dpp_f<0x111>(x); x += dpp_f<0x112>(x); x += dpp_f<0x114>(x); x += dpp_f<0x118>(x); return x; }
struct EpiProj {
    static constexpr bool PERM = true, AFTER_DRAIN = false, HEADPERM = true;
    const float* ssq;
    const float* gtab;
    unsigned char* ws; float* out; int l; int skip;
    size_t o_qkv, s_qkv, o_zb, o_bu, s_bu, o_cq, s_cq, o_ce, o_dj, o_kh, s_kh;
    size_t o_kp, s_kp, o_ks, s_ks;
    __device__ __forceinline__ void st8(bf16_t* p, const f32x4& a, const f32x4& b) const {
        u32x4 w; w.x = cvtpk(a[0], a[1]); w.y = cvtpk(a[2], a[3]); w.z = cvtpk(b[0], b[1]); w.w = cvtpk(b[2], b[3]); *(u32x4*)p = w; }
    __device__ __forceinline__ void operator()(const f32x4 (&acc)[2][2][4][2], const Unit& u, int wr, int wc, int fr, int fq) const {
        if (skip) return;
        const int pn = u.pn;
        int seg, seg0;
        if (pn < 12) { seg = pn / 3; seg0 = seg * 3; }
        else if (pn < 18) { seg = 4 + (pn - 12) / 2; seg0 = 12 + (seg - 4) * 2; }
        else { seg = 7 + (pn - 18) / 3; seg0 = 18 + (seg - 7) * 3; }
        const int cl = (pn - seg0) * 256 + wc * 64 + 8 * fq;
        const int rowb = u.pm * BM + wr * 64 + fr;
        const bool sample = (u.pm == 64);
        f32x4 gv[2][2];
        { const int gi = (seg == 0) ? 0 : (seg == 1 ? 1 : 2); const float* gp = gtab + gi * 768 + (seg == 0 || seg == 1 || seg == 8 ? cl : 0);
#pragma unroll
          for (int bj = 0; bj < 2; ++bj)
#pragma unroll
              for (int n = 0; n < 2; ++n) gv[bj][n] = *(const f32x4*)(gp + 32 * bj + 4 * n); }
        if (seg == 8) {
            const int lane_hi15 = ((fq << 4) | 15);
            float rsc[2][4];
#pragma unroll
            for (int ai = 0; ai < 2; ++ai)
#pragma unroll
                for (int m = 0; m < 4; ++m) rsc[ai][m] = ssq[rowb + ai * HALF + m * 16];
#pragma unroll
            for (int ai = 0; ai < 2; ++ai)
#pragma unroll
                for (int mp = 0; mp < 2; ++mp) {
                    const int rowA = rowb + ai * HALF + mp * 32, rowB = rowA + 16;
                    const float rsA = __builtin_amdgcn_rsqf(rsc[ai][2 * mp] * (1.0f / 1024.0f) + 1e-6f), rsB = __builtin_amdgcn_rsqf(rsc[ai][2 * mp + 1] * (1.0f / 1024.0f) + 1e-6f);
#pragma unroll
                    for (int bj = 0; bj < 2; ++bj) {
                        f32x4 eA[2], eB[2], kA[2], kB[2], dl[2];
#pragma unroll
                        for (int n = 0; n < 2; ++n)
#pragma unroll
                            for (int e = 0; e < 4; ++e) { const float lbv = gv[bj][n][e], omlb = 1.0f - lbv;
                                const float sa = fast_sigmoid(acc[ai][bj][2 * mp][n][e] * rsA), sb = fast_sigmoid(acc[ai][bj][2 * mp + 1][n][e] * rsB);
                                float ka = omlb - omlb * sa, kb = omlb - omlb * sb, pa = lbv + omlb * sa, pb = lbv + omlb * sb;
                                if (!sample) { pa = row_prefprod16(pa); const float t0 = __shfl(pa, lane_hi15); pb = row_prefprod16(pb) * t0; dl[n][e] = __shfl(pb, lane_hi15);
                                    ka *= __builtin_amdgcn_rcpf(pa); kb *= __builtin_amdgcn_rcpf(pb); }
                                eA[n][e] = pa; eB[n][e] = pb; kA[n][e] = ka; kB[n][e] = kb; }
                        bf16_t* dkA = (bf16_t*)(ws + o_cq + s_cq) + (size_t)rowA * 768 + cl + 32 * bj; bf16_t* deA = (bf16_t*)(ws + o_ce) + (size_t)rowA * 768 + cl + 32 * bj;
                        st8(dkA, kA[0], kA[1]); st8(dkA + 16 * 768, kB[0], kB[1]); st8(deA, eA[0], eA[1]); st8(deA + 16 * 768, eB[0], eB[1]);
                        if (!sample && fr == 0) { float* dd = (float*)(ws + o_dj) + (size_t)(rowA >> 5) * 768 + cl + 32 * bj; *(f32x4*)dd = dl[0]; *(f32x4*)(dd + 4) = dl[1]; }
                    }
                    asm volatile("" ::: "memory");
                }
            return;
        }
        float rsv[2][4];
#pragma unroll
        for (int ai = 0; ai < 2; ++ai)
#pragma unroll
            for (int m = 0; m < 4; ++m) rsv[ai][m] = ssq[rowb + ai * HALF + m * 16];
#pragma unroll
        for (int ai = 0; ai < 2; ++ai)
#pragma unroll
            for (int m = 0; m < 4; ++m) {
                const int row = rowb + ai * HALF + m * 16;
                const float rs = __builtin_amdgcn_rsqf(rsv[ai][m] * (1.0f / 1024.0f) + 1e-6f);
                f32x4 v[2][2];
#pragma unroll
                for (int bj = 0; bj < 2; ++bj)
#pragma unroll
                    for (int n = 0; n < 2; ++n) v[bj][n] = acc[ai][bj][m][n] * rs;
                if (seg <= 1) {
                    float ss = 0.f;
#pragma unroll
                    for (int bj = 0; bj < 2; ++bj)
#pragma unroll
                        for (int n = 0; n < 2; ++n) { const f32x4 x = v[bj][n]; ss += (x[0] * x[0] + x[1] * x[1]) + (x[2] * x[2] + x[3] * x[3]); }
                    ss += __shfl_xor(ss, 16); ss += __shfl_xor(ss, 32);
                    float r2 = __builtin_amdgcn_rsqf(ss * (1.0f / 64.0f) + 1e-6f);
                    if (seg == 0) r2 *= 0.125f * 1.4426950408889634f;
#pragma unroll
                    for (int bj = 0; bj < 2; ++bj)
#pragma unroll
                        for (int n = 0; n < 2; ++n) v[bj][n] = v[bj][n] * gv[bj][n] * r2;
                }
                if (seg <= 2) {
                    if (seg == 0 || sample) {
                        bf16_t* dst = (bf16_t*)(ws + o_qkv + (size_t)seg * s_qkv) + (size_t)row * 768 + cl;
#pragma unroll
                        for (int bj = 0; bj < 2; ++bj) st8(dst + 32 * bj, v[bj][0], v[bj][1]);
                    } else {
                        const int t = row & 2047, bb = row >> 11, head = cl >> 6;
                        bf16_t* dst = (bf16_t*)(ws + o_kh + (size_t)(seg - 1) * s_kh) + ((size_t)(((bb * 12 + head) * 16 + (t & 15)) * 128 + (t >> 4))) * 64 + (cl & 63);
#pragma unroll
                        for (int bj = 0; bj < 2; ++bj) st8(dst + 32 * bj, v[bj][0], v[bj][1]);
                    }
                    if (seg >= 1) {
                        const bool okp = !sample, oks = sample && (row - 16384 < 32);
                        float* o = out + (okp ? o_kp + (size_t)(seg - 1) * s_kp + (size_t)row * 768 : o_ks + (size_t)(seg - 1) * s_ks + (size_t)(row - 16384) * 768) + cl;
                        if (okp || oks) {
#pragma unroll
                            for (int bj = 0; bj < 2; ++bj) { *(f32x4*)(o + 32 * bj) = v[bj][0]; *(f32x4*)(o + 32 * bj + 4) = v[bj][1]; }
                        }
                    }
                } else if (seg == 3 || seg == 6 || seg == 10 || seg == 7) {
#pragma unroll
                    for (int bj = 0; bj < 2; ++bj)
#pragma unroll
                        for (int n = 0; n < 2; ++n)
#pragma unroll
                            for (int e = 0; e < 4; ++e) v[bj][n][e] = silu_f(v[bj][n][e]);
                    const size_t zo = (seg == 7) ? o_cq + ((size_t)row * 768 + cl) * 2 : o_zb + ((size_t)row * 2048 + (seg == 3 ? 0 : (seg == 6 ? 768 : 1280)) + cl) * 2;
                    bf16_t* dst = (bf16_t*)(ws + zo);
#pragma unroll
                    for (int bj = 0; bj < 2; ++bj) st8(dst + 32 * bj, v[bj][0], v[bj][1]);
                } else if (seg == 4 || seg == 5) {
                    bf16_t* dst = (bf16_t*)(ws + o_bu + (size_t)(seg - 4) * s_bu) + (size_t)row * 512 + cl;
#pragma unroll
                    for (int bj = 0; bj < 2; ++bj) st8(dst + 32 * bj, v[bj][0], v[bj][1]);
                } else if (seg == 9) {
                    bf16_t* dst = (bf16_t*)(ws + o_cq + 2 * s_cq) + (size_t)row * 768 + cl;
#pragma unroll
                    for (int bj = 0; bj < 2; ++bj) st8(dst + 32 * bj, v[bj][0], v[bj][1]);
                }
                asm volatile("" ::: "memory");
            }
    }
};
struct EpiOut {
    static constexpr bool PERM = false, AFTER_DRAIN = false, HEADPERM = false;
    const float* res; const bf16_t* resb; float* out; bf16_t* xb; float* ssq;
    __device__ __forceinline__ f32x4 ldres(size_t off) const {
        if (res) return *(const f32x4*)(res + off);
        const u32x2 w = *(const u32x2*)(resb + off); return (f32x4){__uint_as_float(w.x << 16), __uint_as_float(w.x & 0xffff0000u), __uint_as_float(w.y << 16), __uint_as_float(w.y & 0xffff0000u)}; }
    __device__ __forceinline__ void operator()(const f32x4 (&acc)[2][2][4][2], const Unit& u, int wr, int wc, int fr, int fq) const {
        const int col0 = u.pn * BM + wc * 32 + 4 * fq;
        const size_t off0 = (size_t)(u.pm * BM + wr * 64 + fr) * 1024 + col0;
        f32x4 rcur[2][2], rnxt[2][2];
#pragma unroll
        for (int bj = 0; bj < 2; ++bj)
#pragma unroll
            for (int n = 0; n < 2; ++n) rcur[bj][n] = ldres(off0 + bj * HALF + n * 16);
#pragma unroll
        for (int it = 0; it < 8; ++it) {
            const int ai = it >> 2, m = it & 3;
            const int row = u.pm * BM + ai * HALF + wr * 64 + m * 16 + fr; const size_t off = (size_t)row * 1024 + col0; float ss = 0.f;
            if (it < 7) { const int ai2 = (it + 1) >> 2, m2 = (it + 1) & 3; const size_t offn = off0 + (size_t)(ai2 * HALF + m2 * 16) * 1024;
#pragma unroll
                for (int bj = 0; bj < 2; ++bj)
#pragma unroll
                    for (int n = 0; n < 2; ++n) rnxt[bj][n] = ldres(offn + bj * HALF + n * 16); }
#pragma unroll
            for (int bj = 0; bj < 2; ++bj)
#pragma unroll
                for (int n = 0; n < 2; ++n) { const f32x4 o = rcur[bj][n] + acc[ai][bj][m][n];
                    if (out) *(f32x4*)(out + off + bj * HALF + n * 16) = o;
                    ss += (o[0] * o[0] + o[1] * o[1]) + (o[2] * o[2] + o[3] * o[3]);
                    if (xb) { u32x2 w; w.x = cvtpk(o[0], o[1]); w.y = cvtpk(o[2], o[3]); *(u32x2*)(xb + off + bj * HALF + n * 16) = w; } }
            if (ssq) { ss += __shfl_xor(ss, 16); ss += __shfl_xor(ss, 32); if (fq == 0) atomicAdd(ssq + row, ss); }
#pragma unroll
            for (int bj = 0; bj < 2; ++bj)
#pragma unroll
                for (int n = 0; n < 2; ++n) rcur[bj][n] = rnxt[bj][n];
        }
    }
};
template <class Epi, class Sched, bool ALIGN_EPI = false, bool SP2 = false>
__device__ __forceinline__ void gemm_phase(PG8_LAS unsigned char* lds, const Gemm g, const Sched& S, const Epi& E) {
    int tid_ = threadIdx.x; asm volatile("" : "+v"(tid_));
    const int tid = tid_, wid = __builtin_amdgcn_readfirstlane(tid >> 6), lane = tid & 63, wr = wid >> 2, wc = wid & 3, fr = lane & 15, fq = lane >> 4;
    const int K = g.K, nt = K / BK;
    unsigned voffA[2], voffB[2];
#pragma unroll
    for (int i = 0; i < 2; ++i) { int R, C; stage_rc(tid * 16 + i * 8192, R, C); const int Rb = Epi::HEADPERM ? (64 * (R >> 5) + perm32(R & 31)) : (Epi::PERM ? ((R & ~31) + perm32(R & 31)) : R);
        voffA[i] = (unsigned)(R * K + C) * 2u; voffB[i] = (unsigned)(Rb * K + C) * 2u; }
    const size_t kstep = (size_t)(BK * 2);
    const size_t hstep = (size_t)HALF * K * 2;
    const size_t tstep = 2 * hstep; const size_t hstepB = Epi::HEADPERM ? (size_t)32 * K * 2 : hstep;
    const unsigned ldsw = (unsigned)wid * 1024u;
    const int aoff = lds_byte(wr * 64 + fr, fq * 8), boff = lds_byte(wc * 32 + fr, fq * 8);
#define PG8_SA(b, h) (((b) * 2 + (h)) * HTB)
#define PG8_SB(b, h) ((4 + (b) * 2 + (h)) * HTB)
#define PG8_STAGE(bufoff, gbase, voff) do { _Pragma("unroll") for (int _i = 0; _i < 2; ++_i) \
        __builtin_amdgcn_global_load_lds((const unsigned*)((const char*)(gbase) + (voff)[_i]), (PG8_LAS unsigned*)(lds + (bufoff) + ldsw + _i * 8192), 16, 0, 0); } while (0)
#define PG8_LDA(dst, b, h) do { _Pragma("unroll") for (int m = 0; m < 4; ++m) _Pragma("unroll") for (int k = 0; k < 2; ++k) dst[m][k] = *(const PG8_LAS bf16x8*)(lds + PG8_SA(b, h) + aoff + m * 2048 + k * 1024); } while (0)
#define PG8_LDB(dst, b, h) do { _Pragma("unroll") for (int n = 0; n < 2; ++n) _Pragma("unroll") for (int k = 0; k < 2; ++k) dst[n][k] = *(const PG8_LAS bf16x8*)(lds + PG8_SB(b, h) + boff + n * 2048 + k * 1024); } while (0)
#define PG8_MMA(ai, bj, At, Bt) do { __builtin_amdgcn_s_setprio(1); _Pragma("unroll") for (int m = 0; m < 4; ++m) _Pragma("unroll") for (int n = 0; n < 2; ++n) _Pragma("unroll") for (int k = 0; k < 2; ++k) \
        acc[ai][bj][m][n] = __builtin_amdgcn_mfma_f32_16x16x32_bf16(Bt[n][k], At[m][k], acc[ai][bj][m][n], 0, 0, 0); __builtin_amdgcn_s_setprio(0); } while (0)
#define PG8_WAIT_V(n) asm volatile("s_waitcnt vmcnt(" #n ")" ::: "memory")
#define PG8_WAIT_L(n) asm volatile("s_waitcnt lgkmcnt(" #n ")" ::: "memory")
#define PG8_BAR __builtin_amdgcn_s_barrier()
#define PG8_SCHED __builtin_amdgcn_sched_barrier(0)
    Unit cur, nxt; int ui = 0;
    if (!S.next(0, cur)) return;
    f32x4 acc[2][2][4][2];
#pragma unroll
    for (int a = 0; a < 2; ++a)
#pragma unroll
        for (int b = 0; b < 2; ++b)
#pragma unroll
            for (int m = 0; m < 4; ++m)
#pragma unroll
                for (int n = 0; n < 2; ++n) acc[a][b][m][n] = (f32x4){0.f, 0.f, 0.f, 0.f};
    bf16x8 At[4][2], B0[2][2], B1[2][2];
    const char* cA = (const char*)g.A + (size_t)cur.pm * tstep; const char* cB = (const char*)g.Bt + (size_t)cur.pn * tstep;
    S.a_ready(cur);
    if constexpr (SP2) {
        PG8_STAGE(PG8_SB(0, 0), cB, voffB); PG8_STAGE(PG8_SB(0, 1), cB + hstepB, voffB); PG8_STAGE(PG8_SA(0, 0), cA, voffA); PG8_STAGE(PG8_SA(0, 1), cA + hstep, voffA);
        if (wr == 1) PG8_BAR;
        PG8_WAIT_V(2); PG8_BAR;
        PG8_STAGE(PG8_SB(1, 0), cB + kstep, voffB); PG8_STAGE(PG8_SA(1, 0), cA + kstep, voffA); PG8_STAGE(PG8_SB(1, 1), cB + hstepB + kstep, voffB);
        PG8_WAIT_V(6); PG8_BAR;
    } else {
        PG8_STAGE(PG8_SB(0, 0), cB, voffB); PG8_STAGE(PG8_SA(0, 0), cA, voffA); PG8_STAGE(PG8_SB(0, 1), cB + hstepB, voffB); PG8_STAGE(PG8_SA(0, 1), cA + hstep, voffA);
        if (wr == 1) PG8_BAR;
        PG8_WAIT_V(4); PG8_BAR;
        PG8_STAGE(PG8_SB(1, 0), cB + kstep, voffB); PG8_STAGE(PG8_SA(1, 0), cA + kstep, voffA); PG8_STAGE(PG8_SB(1, 1), cB + hstepB + kstep, voffB);
        PG8_WAIT_V(6); PG8_BAR;
    }
    for (;;) {
        const bool has_next = S.next(ui + 1, nxt);
        const char* nA = has_next ? (const char*)g.A + (size_t)nxt.pm * tstep : cA; const char* nB = has_next ? (const char*)g.Bt + (size_t)nxt.pn * tstep : cB;
        for (int t = 0; t < nt; t += 2) {
            const bool last = (t == nt - 2);
            const char* a1 = cA + (size_t)(t + 1) * kstep;
            const char* a2 = last ? nA : cA + (size_t)(t + 2) * kstep; const char* b2 = last ? nB : cB + (size_t)(t + 2) * kstep;
            const char* a3 = a2 + kstep; const char* b3 = b2 + kstep;
            if (last && has_next) S.a_ready(nxt);
            if constexpr (SP2) {
            PG8_LDB(B0, 0, 0); PG8_LDB(B1, 0, 1); PG8_SCHED; PG8_LDA(At, 0, 0); PG8_STAGE(PG8_SA(1, 1), a1 + hstep, voffA);
            PG8_WAIT_V(8); PG8_WAIT_L(0); PG8_BAR; PG8_MMA(0, 0, At, B0); PG8_MMA(0, 1, At, B1); PG8_BAR; PG8_SCHED;
            PG8_LDA(At, 0, 1); PG8_STAGE(PG8_SB(0, 0), b2, voffB); PG8_STAGE(PG8_SB(0, 1), b2 + hstepB, voffB); PG8_STAGE(PG8_SA(0, 0), a2, voffA);
            PG8_WAIT_V(8); PG8_WAIT_L(0); PG8_BAR; PG8_MMA(1, 0, At, B0); PG8_MMA(1, 1, At, B1); PG8_BAR; PG8_SCHED;
            PG8_LDB(B0, 1, 0); PG8_LDB(B1, 1, 1); PG8_SCHED; PG8_LDA(At, 1, 0); PG8_STAGE(PG8_SA(0, 1), a2 + hstep, voffA);
            PG8_WAIT_V(8); PG8_WAIT_L(0); PG8_BAR; PG8_MMA(0, 0, At, B0); PG8_MMA(0, 1, At, B1); PG8_BAR; PG8_SCHED;
            PG8_LDA(At, 1, 1); PG8_STAGE(PG8_SB(1, 0), b3, voffB); PG8_STAGE(PG8_SB(1, 1), b3 + hstepB, voffB); PG8_STAGE(PG8_SA(1, 0), a3, voffA);
            PG8_WAIT_V(8); PG8_WAIT_L(0); PG8_BAR; PG8_MMA(1, 0, At, B0); PG8_MMA(1, 1, At, B1); PG8_BAR; PG8_SCHED;
            } else {
            PG8_LDB(B0, 0, 0); PG8_SCHED; PG8_LDA(At, 0, 0); PG8_STAGE(PG8_SA(1, 1), a1 + hstep, voffA);
            PG8_WAIT_L(8); PG8_BAR; PG8_WAIT_L(0); PG8_MMA(0, 0, At, B0); PG8_BAR; PG8_SCHED;
            PG8_LDB(B1, 0, 1); PG8_STAGE(PG8_SB(0, 0), b2, voffB);
            PG8_BAR; PG8_WAIT_L(0); PG8_MMA(0, 1, At, B1); PG8_BAR;
            PG8_LDA(At, 0, 1); PG8_STAGE(PG8_SA(0, 0), a2, voffA);
            PG8_BAR; PG8_WAIT_L(0); PG8_MMA(1, 0, At, B0); PG8_BAR; PG8_SCHED;
            PG8_STAGE(PG8_SB(0, 1), b2 + hstepB, voffB);
            PG8_WAIT_V(6); PG8_BAR; PG8_MMA(1, 1, At, B1); PG8_BAR;
            PG8_LDB(B0, 1, 0); PG8_SCHED; PG8_LDA(At, 1, 0); PG8_STAGE(PG8_SA(0, 1), a2 + hstep, voffA);
            PG8_WAIT_L(8); PG8_BAR; PG8_WAIT_L(0); PG8_MMA(0, 0, At, B0); PG8_BAR; PG8_SCHED;
            PG8_LDB(B1, 1, 1); PG8_STAGE(PG8_SB(1, 0), b3, voffB);
            PG8_BAR; PG8_WAIT_L(0); PG8_MMA(0, 1, At, B1); PG8_BAR;
            PG8_LDA(At, 1, 1); PG8_STAGE(PG8_SA(1, 0), a3, voffA);
            PG8_BAR; PG8_WAIT_L(0); PG8_MMA(1, 0, At, B0); PG8_BAR; PG8_SCHED;
            PG8_STAGE(PG8_SB(1, 1), b3 + hstepB, voffB);
            PG8_WAIT_V(6); PG8_BAR; PG8_MMA(1, 1, At, B1); PG8_BAR;
            }
        }
        if constexpr (ALIGN_EPI) { if (wr == 0) PG8_BAR; }
        if constexpr (!Epi::AFTER_DRAIN) { E(acc, cur, wr, wc, fr, fq); S.done(cur); }
        if (!has_next) break;
#pragma unroll
        for (int a = 0; a < 2; ++a)
#pragma unroll
            for (int b = 0; b < 2; ++b)
#pragma unroll
                for (int m = 0; m < 4; ++m)
#pragma unroll
                    for (int n = 0; n < 2; ++n) acc[a][b][m][n] = (f32x4){0.f, 0.f, 0.f, 0.f};
        cur = nxt; cA = nA; cB = nB; ++ui;
        if constexpr (ALIGN_EPI) { if (wr == 1) PG8_BAR; }
    }
    PG8_WAIT_V(0);
    if constexpr (!ALIGN_EPI) { if (wr == 0) PG8_BAR; }
    PG8_BAR;
    if constexpr (Epi::AFTER_DRAIN) { E.fused(acc, cur, wr, wc, fr, fq, lds, wid, lane); S.done(cur); }
#undef PG8_SA
#undef PG8_SB
#undef PG8_STAGE
#undef PG8_LDA
#undef PG8_LDB
#undef PG8_MMA
#undef PG8_WAIT_V
#undef PG8_WAIT_L
#undef PG8_BAR
#undef PG8_SCHED
}
}
#define GAS __attribute__((address_space(1)))
#define LAS __attribute__((address_space(3)))
typedef unsigned short bf16;
typedef unsigned v4u __attribute__((ext_vector_type(4)));
typedef float f32x4 __attribute__((ext_vector_type(4)));
typedef short bf16x8 __attribute__((ext_vector_type(8)));
typedef GAS unsigned gu32;
typedef GAS unsigned long long gu64;
#define RLX_AGENT __ATOMIC_RELAXED, __HIP_MEMORY_SCOPE_AGENT
#define LDS_WAIT() asm volatile("s_waitcnt lgkmcnt(0)" ::: "memory")
#define VM_WAIT() asm volatile("s_waitcnt vmcnt(0)" ::: "memory")
__device__ __forceinline__ unsigned long long rt() { return __builtin_amdgcn_s_memrealtime(); }
__device__ __forceinline__ unsigned f2bf(float f) { unsigned u = __builtin_bit_cast(unsigned, f); return (u + 0x7fffu + ((u >> 16) & 1u)) >> 16; }
__device__ __forceinline__ unsigned pk2(float lo, float hi) { return f2bf(lo) | (f2bf(hi) << 16); }

#define XB_TMO      128
#define XB_XCNT(j)  (256  + 64 * (j))
#define XB_XSUB(j)  (1280 + 64 * (j))
#define XB_XGEN(j)  (2304 + 64 * (j))
#define XB_TOP      3328
#define XB_TOPGEN   3392
#define XCD_BAR_WORDS 3456
#define XB_SPIN_CAP (1u << 18)

__device__ __forceinline__ unsigned xb_ld(unsigned* p)              { return __hip_atomic_load(p, __ATOMIC_RELAXED, __HIP_MEMORY_SCOPE_AGENT); }
__device__ __forceinline__ unsigned xb_add(unsigned* p, unsigned v) { return __hip_atomic_fetch_add(p, v, __ATOMIC_RELAXED, __HIP_MEMORY_SCOPE_AGENT); }
__device__ __forceinline__ unsigned xb_xcc_id() { return (unsigned)__builtin_amdgcn_s_getreg((3 << 11) | 20) & 0xFu; }
#define XB_SPIN(cond, bar) do { unsigned _sp = 0; while (cond) { __builtin_amdgcn_s_sleep(1); \
    if ((++_sp & 255u) == 0u) { if (xb_ld(&(bar)[XB_TMO])) break; if (_sp > XB_SPIN_CAP) { atomicAdd(&(bar)[XB_TMO], 1u); break; } } } } while (0)

struct XcdBarrier {
    unsigned* bar; unsigned x;
    volatile LAS unsigned* st;
};

__device__ __forceinline__ XcdBarrier xcd_barrier_post(unsigned* bar, volatile LAS unsigned* st) {
    XcdBarrier b; b.bar = bar; b.x = xb_xcc_id(); b.st = st;
    if (threadIdx.x == 0) (void)xb_add(&bar[XB_XCNT(b.x)], 1u);
    return b;
}
__device__ __forceinline__ void xcd_barrier_complete(unsigned* bar, unsigned x, unsigned& nloc, unsigned& nx) {
    const unsigned G = 256u;
    unsigned sum, cnt, mine, sp = 0u;
    for (;;) {
        sum = 0u; cnt = 0u; mine = 0u;
#pragma unroll
        for (unsigned j = 0; j < 16; ++j) { const unsigned c = xb_ld(&bar[XB_XCNT(j)]); sum += c; cnt += (c > 0u) ? 1u : 0u; mine = (j == x) ? c : mine; }
        if (sum == G) break;
        __builtin_amdgcn_s_sleep(1);
        if ((++sp & 255u) == 0u) { if (xb_ld(&bar[XB_TMO])) break; if (sp > XB_SPIN_CAP) { atomicAdd(&bar[XB_TMO], 1u); break; } }
    }
    nloc = mine > 0u ? mine : 1u; nx = cnt > 0u ? cnt : 1u;
}

__device__ __forceinline__ void xcd_barrier(const XcdBarrier& b) {
    asm volatile("s_waitcnt vmcnt(0)" ::: "memory");
    __syncthreads();
    if (threadIdx.x == 0) {
        unsigned* bar = b.bar;
        __builtin_amdgcn_s_waitcnt(0);
        unsigned nloc = b.st[0], nx = b.st[1];
        if (nloc == 0u) { xcd_barrier_complete(bar, b.x, nloc, nx); b.st[0] = nloc; b.st[1] = nx; }
        const unsigned old = xb_add(&bar[XB_XSUB(b.x)], 1u);
        const unsigned gen = old / nloc;
        if (old + 1u == (gen + 1u) * nloc) {
            __builtin_amdgcn_fence(__ATOMIC_RELEASE, "agent");
            asm volatile("s_waitcnt vmcnt(0)" ::: "memory");
            const unsigned og = xb_add(&bar[XB_TOP], 1u);
            const unsigned tg = og / nx;
            if (og + 1u == (tg + 1u) * nx) xb_add(&bar[XB_TOPGEN], 1u);
            else XB_SPIN(xb_ld(&bar[XB_TOPGEN]) == tg, bar);
            __builtin_amdgcn_fence(__ATOMIC_ACQUIRE, "agent");
            xb_add(&bar[XB_XGEN(b.x)], 1u);
            asm volatile("s_waitcnt vmcnt(0)" ::: "memory");
        } else {
            XB_SPIN(xb_ld(&bar[XB_XGEN(b.x)]) == gen, bar);
            __builtin_amdgcn_fence(__ATOMIC_ACQUIRE, "agent");
            asm volatile("s_waitcnt vmcnt(0)" ::: "memory");
        }
    }
    __syncthreads();
}
#ifndef MK_N_LAUNCHES
#define MK_N_LAUNCHES 1
#endif
constexpr int NWAVES = 8, NGRID = 256;
constexpr int N_PHASES = 9;
constexpr int N_LAUNCHES = MK_N_LAUNCHES;
constexpr int DM = 1024, NIN = 7680, DMIX = 2048;
constexpr int MPR = 16384, MSA = 32, MPAD = 16640, SEQL = 2048;
constexpr float EPSF = 1e-6f;
constexpr size_t O_YP = 0, O_YS = 16777216, O_KP = O_YS + 32768, O_VP = O_KP + 25165824, O_KS = O_VP + 25165824, O_VS = O_KS + 49152,
                 O_SGU = O_VS + 49152, O_HP = O_SGU + 32768, O_HS = O_HP + 1572864, O_END = O_HS + 6291456;
constexpr size_t MiB = 1u << 20;
constexpr size_t alup(size_t x) { return (x + MiB - 1) / MiB * MiB; }
constexpr size_t WS_CTL = 0, CTL_ZERO_BYTES = MiB;
constexpr size_t WS_WIN = MiB;
constexpr size_t WS_WOUT = WS_WIN + alup((size_t)2 * NIN * DM * 2);
constexpr size_t WS_SGW = WS_WOUT + alup((size_t)2 * DM * DMIX * 2);
constexpr size_t WS_LB = WS_SGW + alup((size_t)2 * 8 * 128 * 128 * 2);
constexpr size_t WS_XB = WS_LB + MiB;
constexpr size_t WS_QB = WS_XB + alup((size_t)MPAD * DM * 2);
constexpr size_t WS_KB = WS_QB + alup((size_t)MPAD * 768 * 2);
constexpr size_t WS_VB = WS_KB + alup((size_t)MPAD * 768 * 2);
constexpr size_t WS_ZB = WS_VB + alup((size_t)MPAD * 768 * 2);
constexpr size_t WS_BU = WS_ZB + alup((size_t)MPAD * 2048 * 2);
constexpr size_t WS_BV = WS_BU + alup((size_t)MPAD * 512 * 2);
constexpr size_t WS_CQ = WS_BV + alup((size_t)MPAD * 512 * 2);
constexpr size_t WS_CK = WS_CQ + alup((size_t)MPAD * 768 * 2);
constexpr size_t WS_CI = WS_CK + alup((size_t)MPAD * 768 * 2);
constexpr size_t WS_CG = WS_CI + alup((size_t)MPAD * 768 * 2);
constexpr size_t WS_CE = WS_CG;
constexpr size_t WS_DJ = WS_CG + alup((size_t)MPAD * 768 * 2);
constexpr size_t WS_YB = WS_CG + alup((size_t)MPAD * 768 * 4);
constexpr size_t WS_X1 = WS_YB + alup((size_t)MPAD * 2048 * 2);
constexpr size_t WS_DS = WS_X1 + alup((size_t)MPAD * DM * 4);
constexpr size_t WS_DEC = WS_DS + alup((size_t)48 * 16 * 128 * 128 * 4);
constexpr size_t WS_O2 = WS_DEC + alup((size_t)48 * 16 * 128 * 4);
constexpr size_t WS_O3 = WS_O2 + alup((size_t)MPAD * 768 * 2);
constexpr size_t WS_L2 = WS_O3 + alup((size_t)MPAD * 768 * 2);
constexpr size_t WS_L3 = WS_L2 + alup((size_t)MPAD * 16 * 4);
constexpr size_t WS_KH = WS_L3 + alup((size_t)MPAD * 16 * 4);
constexpr size_t WS_VH = WS_KH + alup((size_t)MPR * 768 * 2);
constexpr size_t WS_END = WS_VH + alup((size_t)MPR * 768 * 2);
constexpr int CW_TMO = 0, CW_CODE = 1, CW_BAR = 4096, CW_Q = 8192;
constexpr size_t CTL_SSQ0 = 256 * 1024, CTL_SSQ1 = 512 * 1024;
constexpr int RING_OFF = 0, LDS_BYTES = 163840, MISC_OFF = LDS_BYTES - 1024;
static_assert(WS_VB - WS_KB == WS_KB - WS_QB && WS_CI - WS_CK == WS_CK - WS_CQ, "equally spaced buffer groups (addressed arithmetically in the in-projection epilogue)");
#define DI __device__ __forceinline__
typedef float f32x16 __attribute__((ext_vector_type(16)));
typedef short s16x4 __attribute__((ext_vector_type(4)));
typedef short v4i16_t __attribute__((ext_vector_type(4)));
typedef float f32x2v __attribute__((ext_vector_type(2)));
typedef unsigned u32x2v __attribute__((ext_vector_type(2)));
typedef __bf16 bf16x2v __attribute__((ext_vector_type(2)));
#define MFMA32(a, b, c) __builtin_amdgcn_mfma_f32_32x32x16_bf16((a), (b), (c), 0, 0, 0)
DI unsigned cvtpk2(float lo, float hi) { f32x2v v = {lo, hi}; bf16x2v b = __builtin_convertvector(v, bf16x2v); return __builtin_bit_cast(unsigned, b); }
DI float bf2f(bf16 u) { return __uint_as_float((unsigned)u << 16); }
DI float bflo(unsigned w) { return __uint_as_float(w << 16); }
DI float bfhi(unsigned w) { return __uint_as_float(w & 0xffff0000u); }
DI int crow(int r, int h) { return (r & 3) + 8 * (r >> 2) + 4 * h; }
DI float shx(float v, int mask, int lane) { return __builtin_bit_cast(float, __builtin_amdgcn_ds_bpermute((lane ^ mask) << 2, __builtin_bit_cast(int, v))); }
DI float wave_sum(float v, int lane) {
#pragma unroll
    for (int o = 1; o < 64; o <<= 1) v += shx(v, o, lane);
    return v;
}
DI float wave_max(float v, int lane) {
#pragma unroll
    for (int o = 1; o < 64; o <<= 1) v = fmaxf(v, shx(v, o, lane));
    return v;
}
DI s16x4 trd(LAS const unsigned char* p) { return __builtin_bit_cast(s16x4, __builtin_amdgcn_ds_read_tr16_b64_v4i16((LAS v4i16_t*)p)); }
DI int tr_lane_off(int pitch, int lane, bool perm) { const int i16 = lane & 15, q = i16 >> 2, p = i16 & 3, blk = (lane >> 4) & 1, h = lane >> 5; return ((perm ? 4 * h : 8 * h) + q) * pitch + (16 * blk + 4 * p) * 2; }
DI bf16x8 trfrag(LAS const unsigned char* base, int pitch, int k0, int c0, int laneoff, bool perm) {
    LAS const unsigned char* a = base + k0 * pitch + c0 * 2 + laneoff;
    const s16x4 lo = trd(a), hi = trd(a + (perm ? 8 : 4) * pitch);
    return __builtin_shufflevector(lo, hi, 0, 1, 2, 3, 4, 5, 6, 7);
}
DI bf16x8 pack8(const f32x16& x, int s) { v4u p; p.x = cvtpk2(x[8 * s], x[8 * s + 1]); p.y = cvtpk2(x[8 * s + 2], x[8 * s + 3]); p.z = cvtpk2(x[8 * s + 4], x[8 * s + 5]); p.w = cvtpk2(x[8 * s + 6], x[8 * s + 7]); return __builtin_bit_cast(bf16x8, p); }
DI f32x16 zero16() { f32x16 z;
#pragma unroll
    for (int i = 0; i < 16; ++i) z[i] = 0.f; return z; }

struct Args { const float* in[16]; float* out; unsigned char* ws; int ph_lo, ph_hi, imask, pad; };
struct Ctx {
    LAS unsigned char* lds; volatile LAS unsigned* MISC;
    int tid, lane, wave, vcu, G;
};
typedef __attribute__((address_space(4))) const Args* kaptr_t;
DI kaptr_t kargs() { kaptr_t kp = (kaptr_t)__builtin_amdgcn_kernarg_segment_ptr(); asm volatile("" : "+s"(kp)); return kp; }
#define INP(i) (kargs()->in[i])
#define WSP(off) (kargs()->ws + (off))
#define OUTP() (kargs()->out)
DI void p0_transpose_item(const float* W, int K, int N, bf16* WT, const float* gk, LAS float* scr, int item, int lane) {
    const int nblk = N / 32, kb = item / nblk, nb = item % nblk, k0 = 64 * kb, n0 = 32 * nb;
#pragma unroll 8
    for (int i = 0; i < 32; ++i) { const int kk = 2 * i + (lane >> 5); float w = W[(size_t)(k0 + kk) * N + n0 + (lane & 31)]; if (gk) w *= gk[k0 + kk]; scr[kk * 33 + (lane & 31)] = w; }
    LDS_WAIT(); asm volatile("" ::: "memory");
    const int c = lane & 7;
#pragma unroll
    for (int j = 0; j < 4; ++j) { const int n = (lane >> 3) + 8 * j; const LAS float* s = scr + (8 * c) * 33 + n;
        v4u o; o.x = pk2(s[0 * 33], s[1 * 33]); o.y = pk2(s[2 * 33], s[3 * 33]); o.z = pk2(s[4 * 33], s[5 * 33]); o.w = pk2(s[6 * 33], s[7 * 33]);
        *(GAS v4u*)(WT + (size_t)(n0 + n) * K + k0 + 8 * c) = o; }
    LDS_WAIT(); asm volatile("" ::: "memory");
}
DI void p0_prologue(Ctx& C) { const float* const p_qn_g = ((const float*)INP(7)); const float* const p_kn_g = ((const float*)INP(8)); float* const p_LB = ((float*)WSP(WS_LB)); bf16* const p_SGW = ((bf16*)WSP(WS_SGW)); float* const p_SSQ0 = ((float*)WSP(WS_CTL + CTL_SSQ0)); bf16* const p_WIN = ((bf16*)WSP(WS_WIN)); bf16* const p_WOUT = ((bf16*)WSP(WS_WOUT)); bf16* const p_XB = ((bf16*)WSP(WS_XB)); const float* const p_lb_logits = ((const float*)INP(13)); const float* const p_norm_g = ((const float*)INP(5)); const float* const p_sgu_w = ((const float*)INP(11)); const float* const p_w_in = ((const float*)INP(6)); const float* const p_w_out = ((const float*)INP(15)); const float* const p_x_prompt = ((const float*)INP(0)); const float* const p_x_sample = ((const float*)INP(1));
    LAS float* scr = (LAS float*)(C.lds + RING_OFF + C.wave * 16384);
    const int gw = C.vcu * NWAVES + C.wave, NGW = C.G * NWAVES;
    constexpr int I_IN1 = (DM / 64) * (NIN / 32), I_OUT1 = (DMIX / 64) * (DM / 32);
    for (int it = gw; it < I_IN1; it += NGW) p0_transpose_item(p_w_in, DM, NIN, p_WIN, p_norm_g, scr, it, C.lane);
    for (int m = gw; m < MPAD; m += NGW) {
        GAS unsigned long long* o8 = (GAS unsigned long long*)(p_XB + (size_t)m * DM) + C.lane;
        if (m < MPR + MSA) {
            const float* xrow = (m < MPR) ? p_x_prompt + (size_t)m * DM : p_x_sample + (size_t)(m - MPR) * DM;
            const GAS f32x4* xr = (const GAS f32x4*)xrow + C.lane; f32x4 v[4]; float s = 0.f;
#pragma unroll
            for (int j = 0; j < 4; ++j) { v[j] = xr[64 * j]; s += (v[j].x * v[j].x + v[j].y * v[j].y) + (v[j].z * v[j].z + v[j].w * v[j].w); }
            s = wave_sum(s, C.lane);
#pragma unroll
            for (int j = 0; j < 4; ++j) o8[64 * j] = (unsigned long long)pk2(v[j].x, v[j].y) | ((unsigned long long)pk2(v[j].z, v[j].w) << 32);
            if (C.lane == 0) p_SSQ0[m] = s;
        } else {
#pragma unroll
            for (int j = 0; j < 4; ++j) o8[64 * j] = 0ull;
            if (C.lane == 0) p_SSQ0[m] = 0.f;
        }
    }
    const int gt = C.vcu * 512 + C.tid, NGT = C.G * 512;
    for (int e = gt; e < 2 * 8 * 128 * 128; e += NGT) { const int s = e & 127, t = (e >> 7) & 127; const float w = p_sgu_w[e]; p_SGW[e] = (bf16)f2bf(s <= t ? w : 0.f); }
    for (int e = gt; e < 2 * 768; e += NGT) { const int l = e / 768, c = e - 768 * l; p_LB[(l * 3 + 0) * 768 + c] = p_qn_g[e]; p_LB[(l * 3 + 1) * 768 + c] = p_kn_g[e]; p_LB[(l * 3 + 2) * 768 + c] = (l == 0) ? 0.f : 1.0f / (1.0f + __expf(p_lb_logits[c] - p_lb_logits[768 + c])); }
}

DI void wt_item(const Ctx& C, int item) { const float* const p_w_in = ((const float*)INP(6)); const float* const p_w_out = ((const float*)INP(15)); const float* const p_norm_g = ((const float*)INP(5)); bf16* const p_WIN = ((bf16*)WSP(WS_WIN)); bf16* const p_WOUT = ((bf16*)WSP(WS_WOUT));
    constexpr int I_IN1 = (DM / 64) * (NIN / 32), I_OUT1 = (DMIX / 64) * (DM / 32);
    LAS float* scr = (LAS float*)(C.lds + RING_OFF + C.wave * 16384);
#pragma unroll 1
    for (int rep = 0; rep < 4; ++rep) {
        int it = 32 * item + 8 * rep + C.wave;
        if (it < I_OUT1) { p0_transpose_item(p_w_out, DMIX, DM, p_WOUT, nullptr, scr, it, C.lane); continue; } it -= I_OUT1;
        if (it < I_IN1) p0_transpose_item(p_w_in + (size_t)DM * NIN, DM, NIN, p_WIN + (size_t)NIN * DM, p_norm_g + DM, scr, it, C.lane);
        else if (it < I_IN1 + I_OUT1) p0_transpose_item(p_w_out + (size_t)DMIX * DM, DMIX, DM, p_WOUT + (size_t)DM * DMIX, nullptr, scr, it - I_IN1, C.lane);
    }
}

DI void kvout_item(const Ctx& C, int l, int item) { unsigned char* const ws = WSP(0); const bf16* const p_KH = (const bf16*)(ws + WS_KH); const bf16* const p_VH = (const bf16*)(ws + WS_VH); float* const p_out = OUTP();
    const int b = item >> 5, t0 = (item & 31) * 64, tid = C.tid;
    float* ok = p_out + O_KP + ((size_t)l * MPR + (size_t)b * SEQL + t0) * 768; float* ov = p_out + O_VP + ((size_t)l * MPR + (size_t)b * SEQL + t0) * 768;
#pragma unroll 4
    for (int it = 0; it < 12; ++it) { const int idx = tid + 512 * it, tl = idx / 96, hc = idx - 96 * tl, hh = hc >> 3, ch = hc & 7, t = t0 + tl;
        const size_t so = ((size_t)(((b * 12 + hh) * 16 + (t & 15)) * 128 + (t >> 4))) * 64 + 8 * ch; const size_t dofs = (size_t)tl * 768 + hh * 64 + 8 * ch;
        const v4u k8 = *(const v4u*)(p_KH + so), v8 = *(const v4u*)(p_VH + so);
        *(f32x4*)(ok + dofs) = (f32x4){bflo(k8.x), bfhi(k8.x), bflo(k8.y), bfhi(k8.y)}; *(f32x4*)(ok + dofs + 4) = (f32x4){bflo(k8.z), bfhi(k8.z), bflo(k8.w), bfhi(k8.w)};
        *(f32x4*)(ov + dofs) = (f32x4){bflo(v8.x), bfhi(v8.x), bflo(v8.y), bfhi(v8.y)}; *(f32x4*)(ov + dofs + 4) = (f32x4){bflo(v8.z), bfhi(v8.z), bflo(v8.w), bfhi(v8.w)}; }
}
DI float ex2(float x) { return __builtin_amdgcn_exp2f(x); }
DI float lg2(float x) { return __builtin_amdgcn_logf(x); }

constexpr int AP = 144;
DI void cls_tile(const bf16x8 (&qf)[4], LAS const unsigned char* Kl, LAS const unsigned char* Vl, int kr0, int jstart, int lane, f32x16 (&o)[2], float& lse) {
    const int i = lane & 31, h = lane >> 5;
    o[0] = zero16(); o[1] = zero16();
    constexpr float THR = 6.0f;
    float mrun = 0.f, l = 0.f; bool first = true;
    LAS const unsigned char* kp = Kl + (kr0 + 32 * jstart + i) * AP + 16 * h;
    LAS const unsigned char* vp = Vl + (kr0 + 32 * jstart) * AP + tr_lane_off(AP, lane, true);
#pragma unroll 1
    for (int j = jstart; j < 5; ++j, kp += 32 * AP, vp += 32 * AP) {
        f32x16 st = zero16();
#pragma unroll
        for (int s = 0; s < 4; ++s) st = MFMA32(*(LAS const bf16x8*)(kp + 32 * s), qf[s], st);
        if (j == 0) {
#pragma unroll
            for (int r = 0; r < 16; ++r) if (crow(r, h) < i) st[r] = -1e30f;
        }
        if (j == 4) {
#pragma unroll
            for (int r = 0; r < 16; ++r) if (crow(r, h) > i) st[r] = -1e30f;
        }
        float rm = fmaxf(fmaxf(st[0], st[1]), st[2]);
#pragma unroll
        for (int r = 3; r < 15; r += 2) rm = fmaxf(fmaxf(rm, st[r]), st[r + 1]);
        rm = fmaxf(rm, st[15]);
        rm = fmaxf(rm, shx(rm, 32, lane)) - mrun;
        if (first || __any(rm > THR)) {
            const float delta = first ? rm : fmaxf(rm, 0.f); mrun += delta;
            if (!first) { const float alpha = ex2(-delta); l *= alpha;
#pragma unroll
                for (int r = 0; r < 16; ++r) { o[0][r] *= alpha; o[1][r] *= alpha; } }
            first = false;
        }
        float ps0 = 0.f, ps1 = 0.f;
#pragma unroll
        for (int r = 0; r < 16; r += 2) { st[r] = ex2(st[r] - mrun); st[r + 1] = ex2(st[r + 1] - mrun); ps0 += st[r]; ps1 += st[r + 1]; }
        l += ps0 + ps1;
        const bf16x8 pb0 = pack8(st, 0), pb1 = pack8(st, 1);
#pragma unroll
        for (int db = 0; db < 2; ++db) {
            const s16x4 a0 = trd(vp + 64 * db), a1 = trd(vp + 64 * db + 8 * AP), b0 = trd(vp + 64 * db + 16 * AP), b1 = trd(vp + 64 * db + 24 * AP);
            o[db] = MFMA32(__builtin_shufflevector(a0, a1, 0, 1, 2, 3, 4, 5, 6, 7), pb0, o[db]);
            o[db] = MFMA32(__builtin_shufflevector(b0, b1, 0, 1, 2, 3, 4, 5, 6, 7), pb1, o[db]);
        }
    }
    l += shx(l, 32, lane);
    const float inv = 1.0f / l;
#pragma unroll
    for (int r = 0; r < 16; ++r) { o[0][r] *= inv; o[1][r] *= inv; }
    lse = mrun + lg2(l);
}
DI void cls_store(bf16* Ob, float* Lb, size_t m, int hh, int h, const f32x16 (&o)[2], float lse) {
    bf16* op = Ob + m * 768 + hh * 64 + 4 * h;
#pragma unroll
    for (int db = 0; db < 2; ++db)
#pragma unroll
        for (int g4 = 0; g4 < 4; ++g4) { u32x2v w; w.x = cvtpk2(o[db][4 * g4], o[db][4 * g4 + 1]); w.y = cvtpk2(o[db][4 * g4 + 2], o[db][4 * g4 + 3]); *(u32x2v*)(op + 32 * db + 8 * g4) = w; }
    if (h == 0) Lb[m * 16 + hh] = lse;
}
template <int KIND> DI void att23_item(const Ctx& C, int item) { unsigned char* const ws = WSP(0); const bf16* const p_QB = (const bf16*)(ws + WS_QB); const bf16* const p_KB = (const bf16*)(ws + WS_KH); const bf16* const p_VB = (const bf16*)(ws + WS_VH);
    bf16* const p_O = (bf16*)(ws + (KIND == 2 ? WS_O2 : WS_O3)); float* const p_L = (float*)(ws + (KIND == 2 ? WS_L2 : WS_L3));
    const int up = item & 1, hh = (item >> 1) % 12, b = item / 24, lane = C.lane, wave = C.wave, tid = C.tid, i = lane & 31, h = lane >> 5;
    const size_t rb = (size_t)b * SEQL;
    LAS unsigned char* Kl = C.lds; LAS unsigned char* Vl = C.lds + 512 * AP;
    v4u kr[8], vr[8];
#define A23_TOK(u, row) (KIND == 2 ? (4 * (row) + (u)) : (16 * ((row) & 127) + 4 * (u) + ((row) >> 7)))
#define A23_SRC(u, idx) ((size_t)(((b * 12 + hh) * 16 + (KIND == 2 ? 4 * ((idx) >> 10) + (u) : 4 * (u) + ((idx) >> 10))) * 128 + (((idx) >> 3) & 127)) * 64 + 8 * ((idx) & 7))
#define A23_ROW(idx) (KIND == 2 ? 4 * (((idx) >> 3) & 127) + ((idx) >> 10) : ((idx) >> 3))
#define A23_ISSUE(u) do { _Pragma("unroll") for (int it = 0; it < 8; ++it) { const int idx = tid + 512 * it; const size_t go = A23_SRC(u, idx); \
        kr[it] = *(const v4u*)(p_KB + go); vr[it] = *(const v4u*)(p_VB + go); } } while (0)
    A23_ISSUE(2 * up);
#pragma unroll 1
    for (int u = 2 * up; u < 2 * up + 2; ++u) {
        __syncthreads();
#pragma unroll
        for (int it = 0; it < 8; ++it) { const int idx = tid + 512 * it, row = A23_ROW(idx), ch = idx & 7; *(LAS v4u*)(Kl + row * AP + ch * 16) = kr[it]; *(LAS v4u*)(Vl + row * AP + ch * 16) = vr[it]; }
        __syncthreads();
        int cb0, qa, qb;
        if (KIND == 2) { cb0 = 0; qa = 64 * wave; qb = qa + 32; } else { cb0 = (wave >> 1) * 128; qa = (wave & 1) ? 32 : 0; qb = (wave & 1) ? 64 : 96; }
        const size_t ma = rb + A23_TOK(u, cb0 + qa + i), mb = rb + A23_TOK(u, cb0 + qb + i);
        bf16x8 qfa[4], qfb[4];
#pragma unroll
        for (int s = 0; s < 4; ++s) qfa[s] = *(const bf16x8*)(p_QB + ma * 768 + hh * 64 + 8 * h + 16 * s);
        if (u == 2 * up) A23_ISSUE(u + 1);
        f32x16 o[2]; float lse;
        cls_tile(qfa, Kl + cb0 * AP, Vl + cb0 * AP, qa - 128, qa >= 128 ? 0 : (128 - qa) >> 5, lane, o, lse);
        cls_store(p_O, p_L, ma, hh, h, o, lse);
#pragma unroll
        for (int s = 0; s < 4; ++s) qfb[s] = *(const bf16x8*)(p_QB + mb * 768 + hh * 64 + 8 * h + 16 * s);
        cls_tile(qfb, Kl + cb0 * AP, Vl + cb0 * AP, qb - 128, qb >= 128 ? 0 : (128 - qb) >> 5, lane, o, lse);
        cls_store(p_O, p_L, mb, hh, h, o, lse);
    }
#undef A23_ISSUE
#undef A23_TOK
#undef A23_SRC
#undef A23_ROW
}
DI void att1_item(const Ctx& C, int item) { unsigned char* const ws = WSP(0); const bf16* const p_QB = (const bf16*)(ws + WS_QB); const bf16* const p_KB = (const bf16*)(ws + WS_KH); const bf16* const p_VB = (const bf16*)(ws + WS_VH);
    const bf16* const p_O2 = (const bf16*)(ws + WS_O2); const float* const p_L2 = (const float*)(ws + WS_L2); const bf16* const p_O3 = (const bf16*)(ws + WS_O3); const float* const p_L3 = (const float*)(ws + WS_L3); const bf16* const p_ZB = (const bf16*)(ws + WS_ZB); bf16* const p_YB = (bf16*)(ws + WS_YB);
    const int qtr = item & 3, hh = (item >> 2) % 12, b = item / 48, lane = C.lane, wave = C.wave, tid = C.tid, i = lane & 31, h = lane >> 5;
    const size_t rb = (size_t)b * SEQL;
    LAS unsigned char* Kl = C.lds; LAS unsigned char* Vl = C.lds + 384 * AP;
    v4u kr[6], vr[6];
#define A1_ISSUE(T) do { const int m30_ = 16 * (T) - 8; _Pragma("unroll") for (int it = 0; it < 6; ++it) { const int idx = tid + 512 * it, r16 = idx / 192, rem = idx - 192 * r16; int m3 = m30_ + (rem >> 3); if (m3 < 0) m3 = 0; \
        const size_t go = (size_t)(((b * 12 + hh) * 16 + r16) * 128 + m3) * 64 + 8 * (rem & 7); kr[it] = *(const v4u*)(p_KB + go); vr[it] = *(const v4u*)(p_VB + go); } } while (0)
    A1_ISSUE(2 * qtr);
#pragma unroll 1
    for (int u = 0; u < 2; ++u) {
        const int T = 2 * qtr + u;
        __syncthreads();
#pragma unroll
        for (int it = 0; it < 6; ++it) { const int idx = tid + 512 * it, r16 = idx / 192, rem = idx - 192 * r16, row = 16 * (rem >> 3) + r16, ch = rem & 7; *(LAS v4u*)(Kl + row * AP + ch * 16) = kr[it]; *(LAS v4u*)(Vl + row * AP + ch * 16) = vr[it]; }
        __syncthreads();
        const int tq0 = 256 * T + 32 * wave; const size_t m = rb + tq0 + i;
        bf16x8 qf[4];
#pragma unroll
        for (int s = 0; s < 4; ++s) qf[s] = *(const bf16x8*)(p_QB + m * 768 + hh * 64 + 8 * h + 16 * s);
        const bf16* o2p = p_O2 + m * 768 + hh * 64 + 4 * h; const bf16* o3p = p_O3 + m * 768 + hh * 64 + 4 * h; const bf16* zp = p_ZB + m * 2048 + hh * 64 + 4 * h; bf16* yp = p_YB + m * 2048 + hh * 64 + 4 * h;
        const float l2 = p_L2[m * 16 + hh], l3 = p_L3[m * 16 + hh];
        u32x2v a2[8], a3[8];
#pragma unroll
        for (int c8 = 0; c8 < 8; ++c8) { a2[c8] = *(const u32x2v*)(o2p + 8 * c8); a3[c8] = *(const u32x2v*)(o3p + 8 * c8); }
        if (u < 1) A1_ISSUE(T + 1);
        f32x16 o[2]; float lse;
        cls_tile(qf, Kl, Vl, 32 * wave, tq0 >= 128 ? 0 : (128 - tq0) >> 5, lane, o, lse);
        const float M = fmaxf(lse, fmaxf(l2, l3)), L = M + lg2(ex2(lse - M) + ex2(l2 - M) + ex2(l3 - M));
        const float w1 = ex2(lse - L), w2 = ex2(l2 - L), w3 = ex2(l3 - L);
#pragma unroll
        for (int db = 0; db < 2; ++db)
#pragma unroll
            for (int g4 = 0; g4 < 4; ++g4) { const int c8 = 4 * db + g4; const u32x2v x2 = a2[c8], x3 = a3[c8], z = *(const u32x2v*)(zp + 8 * c8); u32x2v w;
                const float y0 = w1 * o[db][4 * g4] + w2 * bflo(x2.x) + w3 * bflo(x3.x), y1 = w1 * o[db][4 * g4 + 1] + w2 * bfhi(x2.x) + w3 * bfhi(x3.x);
                const float y2 = w1 * o[db][4 * g4 + 2] + w2 * bflo(x2.y) + w3 * bflo(x3.y), y3 = w1 * o[db][4 * g4 + 3] + w2 * bfhi(x2.y) + w3 * bfhi(x3.y);
                w.x = cvtpk2(y0 * bflo(z.x), y1 * bfhi(z.x)); w.y = cvtpk2(y2 * bflo(z.y), y3 * bfhi(z.y)); *(u32x2v*)(yp + 8 * c8) = w; }
    }
#undef A1_ISSUE
}

DI void sgu_item(const Ctx& C, int l, int item) { bf16* const p_BU = ((bf16*)WSP(WS_BU)); bf16* const p_BV = ((bf16*)WSP(WS_BV)); bf16* const p_SGW = ((bf16*)WSP(WS_SGW)); bf16* const p_YB = ((bf16*)WSP(WS_YB)); bf16* const p_ZB = ((bf16*)WSP(WS_ZB)); const float* const p_ln_b = ((const float*)INP(10)); const float* const p_ln_g = ((const float*)INP(9)); const float* const p_sgu_b = ((const float*)INP(12));
    const int b = item >> 4, ch = item & 15, lane = C.lane, wave = C.wave, i = lane & 31, h = lane >> 5; const size_t m0 = (size_t)b * SEQL + ch * 128;
    constexpr int VP = 1040;
    { const f32x4 g0 = *(const f32x4*)(p_ln_g + l * 512 + 8 * lane), g1 = *(const f32x4*)(p_ln_g + l * 512 + 8 * lane + 4), b0 = *(const f32x4*)(p_ln_b + l * 512 + 8 * lane), b1 = *(const f32x4*)(p_ln_b + l * 512 + 8 * lane + 4);
      v4u raw[16]; float s1[16], s2[16];
#pragma unroll
      for (int tt = 0; tt < 16; ++tt) raw[tt] = *(const v4u*)(p_BV + (m0 + 16 * wave + tt) * 512 + 8 * lane);
#pragma unroll
      for (int tt = 0; tt < 16; ++tt) { const v4u r = raw[tt]; const float x0 = bflo(r.x), x1 = bfhi(r.x), x2 = bflo(r.y), x3 = bfhi(r.y), x4 = bflo(r.z), x5 = bfhi(r.z), x6 = bflo(r.w), x7 = bfhi(r.w);
        s1[tt] = ((x0 + x1) + (x2 + x3)) + ((x4 + x5) + (x6 + x7)); s2[tt] = ((x0 * x0 + x1 * x1) + (x2 * x2 + x3 * x3)) + ((x4 * x4 + x5 * x5) + (x6 * x6 + x7 * x7)); }
#pragma unroll
      for (int o = 1; o < 64; o <<= 1) {
#pragma unroll
        for (int tt = 0; tt < 16; ++tt) { s1[tt] += shx(s1[tt], o, lane); s2[tt] += shx(s2[tt], o, lane); } }
#pragma unroll
      for (int tt = 0; tt < 16; ++tt) { const int t = 16 * wave + tt; const v4u r = raw[tt];
        const float mean = s1[tt] * (1.0f / 512.0f), var = fmaxf(s2[tt] * (1.0f / 512.0f) - mean * mean, 0.f), rstd = __builtin_amdgcn_rsqf(var + EPSF);
        float x[8] = {bflo(r.x), bfhi(r.x), bflo(r.y), bfhi(r.y), bflo(r.z), bfhi(r.z), bflo(r.w), bfhi(r.w)};
#pragma unroll
        for (int e = 0; e < 8; ++e) x[e] = (x[e] - mean) * rstd;
        v4u w; w.x = cvtpk2(x[0] * g0[0] + b0[0], x[1] * g0[1] + b0[1]); w.y = cvtpk2(x[2] * g0[2] + b0[2], x[3] * g0[3] + b0[3]);
        w.z = cvtpk2(x[4] * g1[0] + b1[0], x[5] * g1[1] + b1[1]); w.w = cvtpk2(x[6] * g1[2] + b1[2], x[7] * g1[3] + b1[3]);
        *(LAS v4u*)(C.lds + t * VP + lane * 16) = w; } }
    __syncthreads();
    const int g = wave; const bf16* Wg = p_SGW + (size_t)((l * 8 + g) * 128) * 128; const int troff = tr_lane_off(VP, lane, false);
#pragma unroll
    for (int tb = 0; tb < 4; ++tb) {
        f32x16 acc[2]; acc[0] = zero16(); acc[1] = zero16();
#pragma unroll
        for (int ks = 0; ks < 2 * tb + 2; ++ks) {
            const bf16x8 wf = *(const bf16x8*)(Wg + (32 * tb + i) * 128 + 16 * ks + 8 * h);
#pragma unroll
            for (int cb = 0; cb < 2; ++cb) acc[cb] = MFMA32(trfrag(C.lds, VP, 16 * ks, 64 * g + 32 * cb, troff, false), wf, acc[cb]);
        }
        const int t = 32 * tb + i; const float bias = p_sgu_b[(l * 8 + g) * 128 + t]; const size_t m = m0 + t;
#pragma unroll
        for (int cb = 0; cb < 2; ++cb)
#pragma unroll
            for (int g4 = 0; g4 < 4; ++g4) { const int c0 = 64 * g + 32 * cb + 8 * g4 + 4 * h;
                const u32x2v u = *(const u32x2v*)(p_BU + m * 512 + c0), z = *(const u32x2v*)(p_ZB + m * 2048 + 768 + c0); u32x2v w;
                w.x = cvtpk2(bflo(u.x) * (acc[cb][4 * g4] + bias) * bflo(z.x), bfhi(u.x) * (acc[cb][4 * g4 + 1] + bias) * bfhi(z.x));
                w.y = cvtpk2(bflo(u.y) * (acc[cb][4 * g4 + 2] + bias) * bflo(z.y), bfhi(u.y) * (acc[cb][4 * g4 + 3] + bias) * bfhi(z.y));
                *(u32x2v*)(p_YB + m * 2048 + 768 + c0) = w; }
    }
}

DI void hgp_item(const Ctx& C, int l, int item) { unsigned char* const ws = WSP(0); const bf16* const p_CK = (const bf16*)(ws + WS_CK); const bf16* const p_CI = (const bf16*)(ws + WS_CI); const float* const p_DJ = (const float*)(ws + WS_DJ); float* const p_SNAP = (float*)(ws + WS_DS); float* const p_out = OUTP();
    const int bh = item, b = bh / 6, hh = bh % 6, tid = C.tid, lane = C.lane, wave = C.wave, i = lane & 31, h = lane >> 5;
    constexpr int PT = 272, TB = 32 * PT, BUF = 2 * TB;
    LAS unsigned char* L = C.lds;
    const int row = tid >> 4, chn = tid & 15, kb = wave >> 1, vb0 = 2 * (wave & 1), troff = tr_lane_off(PT, lane, false);
    const size_t g0 = ((size_t)b * SEQL + row) * 768 + hh * 128 + chn * 8;
    const float* djp = p_DJ + ((size_t)b * 64) * 768 + hh * 128 + 32 * kb + i;
    v4u kreg = *(const v4u*)(p_CK + g0), vreg = *(const v4u*)(p_CI + g0); float djn = djp[0];
    *(LAS v4u*)(L + row * PT + chn * 16) = kreg; *(LAS v4u*)(L + TB + row * PT + chn * 16) = vreg;
    __syncthreads();
    f32x16 acc[2]; acc[0] = zero16(); acc[1] = zero16();
#pragma unroll 1
    for (int j = 0; j < 64; ++j) {
        LAS const unsigned char* cur = L + (j & 1) * BUF; LAS unsigned char* nxt = L + ((j + 1) & 1) * BUF;
        const float dj = djn;
        if (j < 63) { const size_t g = g0 + (size_t)(32 * (j + 1)) * 768; kreg = *(const v4u*)(p_CK + g); vreg = *(const v4u*)(p_CI + g); djn = djp[(size_t)(j + 1) * 768]; }
#pragma unroll
        for (int s2 = 0; s2 < 2; ++s2) { const bf16x8 kfr = trfrag(cur, PT, 16 * s2, 32 * kb, troff, false);
#pragma unroll
            for (int j2 = 0; j2 < 2; ++j2) acc[j2] = MFMA32(trfrag(cur + TB, PT, 16 * s2, 32 * (vb0 + j2), troff, false), kfr, acc[j2]); }
#pragma unroll
        for (int r = 0; r < 16; ++r) { acc[0][r] *= dj; acc[1][r] *= dj; }
        if ((j & 15) == 15) {
            float* dst = (j == 63) ? p_out + O_HP + (size_t)(l * 48 + bh) * 16384 : p_SNAP + (size_t)(bh * 3 + (j >> 4)) * 16384;
            dst += (size_t)(32 * kb + i) * 128 + 4 * h;
#pragma unroll
            for (int j2 = 0; j2 < 2; ++j2)
#pragma unroll
                for (int g4 = 0; g4 < 4; ++g4) *(f32x4*)(dst + 32 * (vb0 + j2) + 8 * g4) = (f32x4){acc[j2][4 * g4], acc[j2][4 * g4 + 1], acc[j2][4 * g4 + 2], acc[j2][4 * g4 + 3]};
        }
        if (j < 63) { *(LAS v4u*)(nxt + row * PT + chn * 16) = kreg; *(LAS v4u*)(nxt + TB + row * PT + chn * 16) = vreg; }
        __syncthreads();
    }
}
DI void hg3_item(const Ctx& C, int l, int item) { unsigned char* const ws = WSP(0); const bf16* const p_CE = (const bf16*)(ws + WS_CE); const float* const p_DJ = (const float*)(ws + WS_DJ); const bf16* const p_CI = (const bf16*)(ws + WS_CI); const bf16* const p_CK = (const bf16*)(ws + WS_CK); const bf16* const p_CQ = (const bf16*)(ws + WS_CQ); const float* const p_SNAP = (const float*)(ws + WS_DS); bf16* const p_YB = (bf16*)(ws + WS_YB); const bf16* const p_ZB = (const bf16*)(ws + WS_ZB); const float* const p_hn_g = ((const float*)INP(14));
    const int qt = item & 3, bh = item >> 2, b = bh / 6, hh = bh % 6, tid = C.tid, lane = C.lane, wave = C.wave, i = lane & 31, h = lane >> 5;
    constexpr int PT = 272, MB = 128 * PT;
    LAS unsigned char *QT = C.lds, *KD = C.lds + MB, *VV = C.lds + 2 * MB, *SB = C.lds + 3 * MB;
    LAS float* RS = (LAS float*)(C.lds + 4 * MB);
    f32x16 sacc[4];
    const int kb = wave & 3;
    if (wave >= 4) {
        if (qt == 0) {
#pragma unroll
            for (int vb = 0; vb < 4; ++vb) { sacc[vb] = zero16();
#pragma unroll
                for (int g4 = 0; g4 < 4; ++g4) *(LAS u32x2v*)(SB + (32 * kb + i) * PT + (32 * vb + 8 * g4 + 4 * h) * 2) = (u32x2v){0u, 0u}; }
        } else {
            const float* sp = p_SNAP + (size_t)(bh * 3 + qt - 1) * 16384 + (size_t)(32 * kb + i) * 128 + 4 * h;
#pragma unroll
            for (int vb = 0; vb < 4; ++vb)
#pragma unroll
                for (int g4 = 0; g4 < 4; ++g4) { const f32x4 tt = *(const f32x4*)(sp + 32 * vb + 8 * g4); sacc[vb][4 * g4] = tt[0]; sacc[vb][4 * g4 + 1] = tt[1]; sacc[vb][4 * g4 + 2] = tt[2]; sacc[vb][4 * g4 + 3] = tt[3];
                    u32x2v w; w.x = cvtpk2(tt[0], tt[1]); w.y = cvtpk2(tt[2], tt[3]); *(LAS u32x2v*)(SB + (32 * kb + i) * PT + (32 * vb + 8 * g4 + 4 * h) * 2) = w; }
        }
    }
    const int tro_n = tr_lane_off(PT, lane, false), tro_p = tr_lane_off(PT, lane, true);
    v4u rq[4], re[4], rk[4], rv[4];
#define HG3_ISSUE(sgx) do { const size_t mm_ = (size_t)b * SEQL + (4 * qt + (sgx)) * 128; _Pragma("unroll") for (int it = 0; it < 4; ++it) { const int idx = tid + 512 * it, row = idx >> 4, chn = idx & 15; \
        const size_t go = (mm_ + row) * 768 + hh * 128 + chn * 8; rq[it] = *(const v4u*)(p_CQ + go); re[it] = *(const v4u*)(p_CE + go); rk[it] = *(const v4u*)(p_CK + go); rv[it] = *(const v4u*)(p_CI + go); } } while (0)
#define HG3_FILL() do { _Pragma("unroll") for (int it = 0; it < 4; ++it) { const int idx = tid + 512 * it, row = idx >> 4, chn = idx & 15; const v4u q8 = rq[it], e8 = re[it]; v4u w; \
            w.x = cvtpk2(bflo(q8.x) * bflo(e8.x), bfhi(q8.x) * bfhi(e8.x)); w.y = cvtpk2(bflo(q8.y) * bflo(e8.y), bfhi(q8.y) * bfhi(e8.y)); \
            w.z = cvtpk2(bflo(q8.z) * bflo(e8.z), bfhi(q8.z) * bfhi(e8.z)); w.w = cvtpk2(bflo(q8.w) * bflo(e8.w), bfhi(q8.w) * bfhi(e8.w)); \
            *(LAS v4u*)(QT + row * PT + chn * 16) = w; *(LAS v4u*)(KD + row * PT + chn * 16) = rk[it]; *(LAS v4u*)(VV + row * PT + chn * 16) = rv[it]; } } while (0)
    HG3_ISSUE(0);
    if (wave < 4) {
        const int vb = wave;
#pragma unroll 1
        for (int sg = 0; sg < 4; ++sg) {
            const size_t m0 = (size_t)b * SEQL + (4 * qt + sg) * 128;
            HG3_FILL();
            if (sg < 3) HG3_ISSUE(sg + 1);
            __syncthreads();
#pragma unroll 1
            for (int j = 0; j < 4; ++j) {
                u32x2v zr[4]; f32x4 gnv[4];
#pragma unroll
                for (int g4 = 0; g4 < 4; ++g4) { zr[g4] = *(const u32x2v*)(p_ZB + (m0 + 32 * j + i) * 2048 + 1280 + hh * 128 + 32 * vb + 8 * g4 + 4 * h); gnv[g4] = *(const f32x4*)(p_hn_g + l * 768 + hh * 128 + 32 * vb + 8 * g4 + 4 * h); }
                bf16x8 qfr[8];
#pragma unroll
                for (int ks = 0; ks < 8; ++ks) qfr[ks] = *(LAS const bf16x8*)(QT + (32 * j + i) * PT + (16 * ks + 8 * h) * 2);
                f32x16 x = zero16();
#pragma unroll
                for (int ks = 0; ks < 8; ++ks) x = MFMA32(*(LAS const bf16x8*)(KD + (32 * j + i) * PT + (16 * ks + 8 * h) * 2), qfr[ks], x);
#pragma unroll
                for (int r = 0; r < 16; ++r) if (crow(r, h) > i) x[r] = 0.f;
                const bf16x8 pb0 = pack8(x, 0), pb1 = pack8(x, 1);
                f32x16 oa = zero16();
#pragma unroll
                for (int ks = 0; ks < 8; ++ks) oa = MFMA32(trfrag(SB, PT, 16 * ks, 32 * vb, tro_n, false), qfr[ks], oa);
                oa = MFMA32(trfrag(VV, PT, 32 * j, 32 * vb, tro_p, true), pb0, oa);
                oa = MFMA32(trfrag(VV, PT, 32 * j + 16, 32 * vb, tro_p, true), pb1, oa);
                float ss = 0.f;
#pragma unroll
                for (int r = 0; r < 16; ++r) ss += oa[r] * oa[r];
                ss += shx(ss, 32, lane);
                if (h == 0) RS[vb * 32 + i] = ss;
                __syncthreads();
                const float tot = RS[i] + RS[32 + i] + RS[64 + i] + RS[96 + i], rstd = __builtin_amdgcn_rsqf(tot * (1.0f / 128.0f) + EPSF);
                const size_t m = m0 + 32 * j + i;
#pragma unroll
                for (int g4 = 0; g4 < 4; ++g4) { const int v0 = hh * 128 + 32 * vb + 8 * g4 + 4 * h; const f32x4 gn = gnv[g4]; const u32x2v z = zr[g4]; u32x2v w;
                    w.x = cvtpk2(oa[4 * g4] * rstd * gn[0] * bflo(z.x), oa[4 * g4 + 1] * rstd * gn[1] * bfhi(z.x)); w.y = cvtpk2(oa[4 * g4 + 2] * rstd * gn[2] * bflo(z.y), oa[4 * g4 + 3] * rstd * gn[3] * bfhi(z.y));
                    *(u32x2v*)(p_YB + m * 2048 + 1280 + v0) = w; }
                __syncthreads();
            }
        }
    } else {
#pragma unroll 1
        for (int sg = 0; sg < 4; ++sg) {
            const size_t m0 = (size_t)b * SEQL + (4 * qt + sg) * 128;
            HG3_FILL();
            float dv[4];
#pragma unroll
            for (int j = 0; j < 4; ++j) dv[j] = p_DJ[((m0 >> 5) + j) * 768 + hh * 128 + 32 * kb + i];
            if (sg < 3) HG3_ISSUE(sg + 1);
            __syncthreads();
#pragma unroll 1
            for (int j = 0; j < 4; ++j) {
#pragma unroll
                for (int s2 = 0; s2 < 2; ++s2) { const bf16x8 kfr = trfrag(KD, PT, 32 * j + 16 * s2, 32 * kb, tro_n, false);
#pragma unroll
                    for (int vb = 0; vb < 4; ++vb) sacc[vb] = MFMA32(trfrag(VV, PT, 32 * j + 16 * s2, 32 * vb, tro_n, false), kfr, sacc[vb]); }
                const float d = (j == 0) ? dv[0] : (j == 1 ? dv[1] : (j == 2 ? dv[2] : dv[3]));
#pragma unroll
                for (int vb = 0; vb < 4; ++vb)
#pragma unroll
                    for (int r = 0; r < 16; ++r) sacc[vb][r] *= d;
                __syncthreads();
#pragma unroll
                for (int vb = 0; vb < 4; ++vb)
#pragma unroll
                    for (int g4 = 0; g4 < 4; ++g4) { u32x2v w; w.x = cvtpk2(sacc[vb][4 * g4], sacc[vb][4 * g4 + 1]); w.y = cvtpk2(sacc[vb][4 * g4 + 2], sacc[vb][4 * g4 + 3]); *(LAS u32x2v*)(SB + (32 * kb + i) * PT + (32 * vb + 8 * g4 + 4 * h) * 2) = w; }
                __syncthreads();
            }
        }
    }
#undef HG3_ISSUE
#undef HG3_FILL
}
DI void samp_attn_item(const Ctx& C, int l, int item) { const float* const p_cache_k = ((const float*)INP(2)); const float* const p_cache_v = ((const float*)INP(3)); bf16* const p_QB = ((bf16*)WSP(WS_QB)); bf16* const p_KB = ((bf16*)WSP(WS_KB)); bf16* const p_VB = ((bf16*)WSP(WS_VB)); bf16* const p_ZB = ((bf16*)WSP(WS_ZB)); bf16* const p_YB = ((bf16*)WSP(WS_YB));
    const int b = item / 12, hh = item % 12, wave = C.wave, lane = C.lane, tid = C.tid; const size_t row = MPR + b;
    LAS float* sc = (LAS float*)C.lds;
    LAS float* po = sc + 400;
    const float* ck = p_cache_k + ((size_t)(l * 32 + b) * 2048) * 768 + hh * 64; const float* cv = p_cache_v + ((size_t)(l * 32 + b) * 2048) * 768 + hh * 64;
    const int grp = tid >> 4, dl = 4 * (tid & 15);
    const u32x2v qraw = *(const u32x2v*)(p_QB + row * 768 + hh * 64 + dl); const float q0 = bflo(qraw.x), q1 = bfhi(qraw.x), q2 = bflo(qraw.y), q3 = bfhi(qraw.y);
    const u32x2v knraw = *(const u32x2v*)(p_KB + row * 768 + hh * 64 + dl);
    const f32x4 knew = (f32x4){bflo(knraw.x), bfhi(knraw.x), bflo(knraw.y), bfhi(knraw.y)};
    f32x4 kv[13];
#pragma unroll
    for (int it = 0; it < 13; ++it) { int slot = 32 * it + grp; if (slot > 386) slot = 386; const int pp = slot / 129, jj = slot - 129 * pp, idx = 2048 - (jj << (2 * pp));
        kv[it] = knew; if (idx < 2048) kv[it] = *(const f32x4*)(ck + (size_t)idx * 768 + dl); }
#pragma unroll
    for (int it = 0; it < 13; ++it) { const int slot = 32 * it + grp;
        float part = (q0 * kv[it][0] + q1 * kv[it][1]) + (q2 * kv[it][2] + q3 * kv[it][3]);
        part += shx(part, 1, lane); part += shx(part, 2, lane); part += shx(part, 4, lane); part += shx(part, 8, lane);
        if ((tid & 15) == 0 && slot < 387) sc[slot] = part; }
    __syncthreads();
    float mx = -1e30f;
    for (int t = lane; t < 387; t += 64) mx = fmaxf(mx, sc[t]);
    mx = wave_max(mx, lane);
    float sm = 0.f;
    for (int t = lane; t < 387; t += 64) sm += ex2(sc[t] - mx);
    sm = wave_sum(sm, lane);
    const u32x2v vnraw = *(const u32x2v*)(p_VB + row * 768 + hh * 64 + dl);
    const f32x4 vnewv = (f32x4){bflo(vnraw.x), bfhi(vnraw.x), bflo(vnraw.y), bfhi(vnraw.y)};
    f32x4 vv[13];
#pragma unroll
    for (int it = 0; it < 13; ++it) { int slot = 32 * it + grp; if (slot > 386) slot = 386; const int pp = slot / 129, jj = slot - 129 * pp, idx = 2048 - (jj << (2 * pp));
        vv[it] = vnewv; if (idx < 2048) vv[it] = *(const f32x4*)(cv + (size_t)idx * 768 + dl); }
    f32x4 o4 = (f32x4){0.f, 0.f, 0.f, 0.f};
#pragma unroll
    for (int it = 0; it < 13; ++it) { const int slot = 32 * it + grp; if (slot < 387) o4 += vv[it] * ex2(sc[slot] - mx); }
#pragma unroll
    for (int e = 0; e < 4; ++e) { o4[e] += shx(o4[e], 16, lane); o4[e] += shx(o4[e], 32, lane); }
    if (lane < 16) *(LAS f32x4*)(po + wave * 64 + dl) = o4;
    __syncthreads();
    if (wave == 0) { float t = 0.f;
#pragma unroll
        for (int w = 0; w < 8; ++w) t += po[w * 64 + lane];
        t *= 1.0f / sm;
        p_YB[row * 2048 + hh * 64 + lane] = (bf16)f2bf(t * bf2f(p_ZB[row * 2048 + hh * 64 + lane])); }
}
DI void samp_sgu_item(const Ctx& C, int l, int item) { bf16* const p_BU = ((bf16*)WSP(WS_BU)); bf16* const p_BV = ((bf16*)WSP(WS_BV)); bf16* const p_YB = ((bf16*)WSP(WS_YB)); bf16* const p_ZB = ((bf16*)WSP(WS_ZB)); const float* const p_ln_b = ((const float*)INP(10)); const float* const p_ln_g = ((const float*)INP(9)); float* const p_out = OUTP(); const float* const p_sgu_b = ((const float*)INP(12)); const float* const p_sgu_w = ((const float*)INP(11));
    const int b = 8 * item + C.wave, lane = C.lane; const size_t row = MPR + b;
    const v4u raw = *(const v4u*)(p_BV + row * 512 + 8 * lane);
    float x[8] = {bflo(raw.x), bfhi(raw.x), bflo(raw.y), bfhi(raw.y), bflo(raw.z), bfhi(raw.z), bflo(raw.w), bfhi(raw.w)};
    float s = 0.f;
#pragma unroll
    for (int e = 0; e < 8; ++e) s += x[e];
    const float mean = wave_sum(s, lane) * (1.0f / 512.0f); float q = 0.f;
#pragma unroll
    for (int e = 0; e < 8; ++e) { x[e] -= mean; q += x[e] * x[e]; }
    const float rstd = __builtin_amdgcn_rsqf(wave_sum(q, lane) * (1.0f / 512.0f) + EPSF);
    const int g = lane >> 3; const float w00 = p_sgu_w[(size_t)((l * 8 + g) * 128) * 128], bb = p_sgu_b[(l * 8 + g) * 128];
    const v4u ur = *(const v4u*)(p_BU + row * 512 + 8 * lane), zr = *(const v4u*)(p_ZB + row * 2048 + 768 + 8 * lane);
    const float uu[8] = {bflo(ur.x), bfhi(ur.x), bflo(ur.y), bfhi(ur.y), bflo(ur.z), bfhi(ur.z), bflo(ur.w), bfhi(ur.w)};
    const float zz[8] = {bflo(zr.x), bfhi(zr.x), bflo(zr.y), bfhi(zr.y), bflo(zr.z), bfhi(zr.z), bflo(zr.w), bfhi(zr.w)};
    float vn[8], y[8];
#pragma unroll
    for (int e = 0; e < 8; ++e) { vn[e] = x[e] * rstd * p_ln_g[l * 512 + 8 * lane + e] + p_ln_b[l * 512 + 8 * lane + e]; y[e] = uu[e] * (w00 * vn[e] + bb) * zz[e]; }
    float* od = p_out + O_SGU + (size_t)(l * 32 + b) * 512 + 8 * lane;
    *(f32x4*)od = (f32x4){vn[0], vn[1], vn[2], vn[3]}; *(f32x4*)(od + 4) = (f32x4){vn[4], vn[5], vn[6], vn[7]};
    v4u w; w.x = cvtpk2(y[0], y[1]); w.y = cvtpk2(y[2], y[3]); w.z = cvtpk2(y[4], y[5]); w.w = cvtpk2(y[6], y[7]);
    *(v4u*)(p_YB + row * 2048 + 768 + 8 * lane) = w;
}
DI void samp_hgrn_item(const Ctx& C, int l, int item) { bf16* const p_CE = ((bf16*)WSP(WS_CE)); bf16* const p_CI = ((bf16*)WSP(WS_CI)); bf16* const p_CK = ((bf16*)WSP(WS_CK)); bf16* const p_CQ = ((bf16*)WSP(WS_CQ)); bf16* const p_YB = ((bf16*)WSP(WS_YB)); bf16* const p_ZB = ((bf16*)WSP(WS_ZB)); const float* const p_hn_g = ((const float*)INP(14)); float* const p_out = OUTP(); const float* const p_state = ((const float*)INP(4));
    const int b = item / 6, hh = item % 6, tid = C.tid; const size_t row = MPR + b;
    LAS float* qs = (LAS float*)C.lds; LAS float* eg = qs + 128; LAS float* kx = eg + 128; LAS float* vv = kx + 128; LAS float* po = vv + 128; LAS float* ov = po + 2048; LAS float* pr = ov + 128;
    if (tid < 128) { const size_t o = row * 768 + hh * 128 + tid; qs[tid] = bf2f(p_CQ[o]); eg[tid] = bf2f(p_CE[o]); kx[tid] = bf2f(p_CK[o]); vv[tid] = bf2f(p_CI[o]); }
    __syncthreads();
    const int v4 = (tid & 31) * 4, kq = tid >> 5;
    const f32x4 vloc = *(LAS const f32x4*)(vv + v4); f32x4 acc = (f32x4){0.f, 0.f, 0.f, 0.f};
    const float* S0 = p_state + (size_t)((l * 32 + b) * 6 + hh) * 16384; float* S1 = p_out + O_HS + (size_t)((l * 32 + b) * 6 + hh) * 16384;
#pragma unroll
    for (int kk = 0; kk < 8; ++kk) { const int k = 8 * kq + kk; const f32x4 s = *(const f32x4*)(S0 + k * 128 + v4); const f32x4 sn = s * eg[k] + vloc * kx[k]; *(f32x4*)(S1 + k * 128 + v4) = sn; acc += sn * qs[k]; }
    *(LAS f32x4*)(po + kq * 128 + v4) = acc;
    __syncthreads();
    float o = 0.f;
    if (tid < 128) {
#pragma unroll
        for (int q4 = 0; q4 < 16; ++q4) o += po[q4 * 128 + tid];
        const float ss = wave_sum(o * o, C.lane); if (C.lane == 0) pr[C.wave] = ss; }
    __syncthreads();
    if (tid < 128) { const float rstd = __builtin_amdgcn_rsqf((pr[0] + pr[1]) * (1.0f / 128.0f) + EPSF);
        p_YB[row * 2048 + 1280 + hh * 128 + tid] = (bf16)f2bf(o * rstd * p_hn_g[l * 768 + hh * 128 + tid] * bf2f(p_ZB[row * 2048 + 1280 + hh * 128 + tid])); }
}
DI void samp_out_item(const Ctx& C, int l, int item) { const float* const p_x_sample = ((const float*)INP(1)); float* const p_SSQ1 = ((float*)WSP(WS_CTL + CTL_SSQ1)); bf16* const p_WOUT = ((bf16*)WSP(WS_WOUT)); float* const p_X1 = ((float*)WSP(WS_X1)); bf16* const p_XB = ((bf16*)WSP(WS_XB)); bf16* const p_YB = ((bf16*)WSP(WS_YB)); float* const p_out = OUTP();
    const int lane = C.lane, wave = C.wave, i = lane & 31, h = lane >> 5, n0 = 32 * item;
    const bf16* A = p_YB + (size_t)(MPR + i) * 2048 + 256 * wave + 8 * h; const bf16* B = p_WOUT + ((size_t)l * DM + n0 + i) * 2048 + 256 * wave + 8 * h;
    f32x16 acc = zero16();
#pragma unroll
    for (int ks = 0; ks < 16; ++ks) acc = MFMA32(*(const bf16x8*)(A + 16 * ks), *(const bf16x8*)(B + 16 * ks), acc);
    LAS float* red = (LAS float*)C.lds;
#pragma unroll
    for (int r = 0; r < 16; ++r) red[(wave * 16 + r) * 64 + lane] = acc[r];
    __syncthreads();
    const int tl = C.tid & 63, i2 = tl & 31, h2 = tl >> 5;
#pragma unroll
    for (int e = 0; e < 2; ++e) { const int r = (C.tid >> 6) * 2 + e; float s = 0.f;
#pragma unroll
        for (int w = 0; w < 8; ++w) s += red[(w * 16 + r) * 64 + tl];
        const int bb = crow(r, h2), n = n0 + i2;
        if (l == 0) { const float o = p_x_sample[(size_t)bb * DM + n] + s; p_XB[(size_t)(MPR + bb) * DM + n] = (bf16)f2bf(o);
            float ss = o * o; ss += shx(ss, 1, lane); ss += shx(ss, 2, lane); ss += shx(ss, 4, lane); ss += shx(ss, 8, lane); ss += shx(ss, 16, lane);
            if (i2 == 0) atomicAdd(p_SSQ1 + MPR + bb, ss); }
        else { p_out[O_YS + (size_t)bb * DM + n] = bf2f(p_XB[(size_t)(MPR + bb) * DM + n]) + s; } }
}
DI int fetch_item(Ctx& C, int q) { gu32* const p_ctl = ((gu32*)WSP(WS_CTL));
    __syncthreads();
    if (C.tid == 0) C.MISC[0] = __hip_atomic_fetch_add((unsigned*)(p_ctl + CW_Q + 64 * q), 1u, __ATOMIC_RELAXED, __HIP_MEMORY_SCOPE_AGENT);
    __syncthreads();
    const int it = (int)C.MISC[0];
    { int t_ = C.tid; asm volatile("" : "+v"(t_)); C.tid = t_; C.lane = t_ & 63; C.wave = __builtin_amdgcn_readfirstlane(t_ >> 6);
      LAS unsigned char* lp_ = C.lds; asm volatile("" : "+s"(lp_)); C.lds = lp_; C.MISC = (volatile LAS unsigned*)(lp_ + MISC_OFF); }
    return it;
}
#ifndef G1_STAGGER_TICKS
#define G1_STAGGER_TICKS 0
#endif
#ifndef RPT_PHASE
#define RPT_PHASE -1
#define RPT_N 0
#endif
#ifndef RPT_IMASK
#define RPT_IMASK 0xffff
#endif
#ifndef RPT_MASK
#define RPT_MASK 0
#endif
#ifndef PH_MASK
#define PH_MASK 2047
#endif
constexpr int N_ATT = 384, N_HG = 192, N_HGP = 48, N_A1 = 384, N_SGU = 128, N_SAT = 384, N_SHG = 192, N_SSG = 4;
constexpr int N_M1 = N_HGP + N_ATT + N_SAT + N_SGU + N_SHG + N_SSG, N_WT = 184, N_KVO = 0;
constexpr int N_SOUT = 32;

template <int KIND, int L> DI void run_kind(Ctx& C, int im, int bx_) {
    constexpr int l = L;
    if constexpr (KIND == 0) { p0_prologue(C); }
    else if constexpr (KIND == 1) {
        pg8::Gemm g{((bf16*)WSP(WS_XB)), ((bf16*)WSP(WS_WIN)) + (size_t)l * NIN * DM, MPAD, NIN, DM}; pg8::StaticOrder S; S.init(MPAD, NIN, NGRID, bx_);
        pg8::EpiProj E{l == 0 ? ((float*)WSP(WS_CTL + CTL_SSQ0)) : ((float*)WSP(WS_CTL + CTL_SSQ1)), ((float*)WSP(WS_LB)) + l * 3 * 768, WSP(0), OUTP(), l, (im & 2048) ? 0 : 1,
                       WS_QB, WS_KB - WS_QB, WS_ZB, WS_BU, WS_BV - WS_BU, WS_CQ, WS_CK - WS_CQ, WS_CE, WS_DJ, WS_KH, WS_VH - WS_KH,
                       O_KP + (size_t)l * MPR * 768, O_VP - O_KP, O_KS + (size_t)l * 32 * 768, O_VS - O_KS};
#if G1_STAGGER_TICKS > 0
        { const unsigned long long t0 = __builtin_amdgcn_s_memrealtime(), dt = (unsigned long long)((bx_ >> 3) & 3) * G1_STAGGER_TICKS;
          while (__builtin_amdgcn_s_memrealtime() - t0 < dt) __builtin_amdgcn_s_sleep(8); }
#endif
        pg8::gemm_phase<pg8::EpiProj, pg8::StaticOrder, true, true>(C.lds + RING_OFF, g, S, E);
    } else if constexpr (KIND == 2) {
        for (;;) { int it = fetch_item(C, 3 * l + 0); if (it >= N_M1 + N_KVO + (l == 0 ? N_WT : 0)) break;
            if (it < N_HGP) { if (im & 8) hgp_item(C, l, it); continue; } it -= N_HGP;
            if (it < N_ATT) { if (im & 4) { if (it < 192) att23_item<2>(C, it); else att23_item<3>(C, it - 192); } continue; } it -= N_ATT;
            if (it < N_SAT) { if (im & 16) samp_attn_item(C, l, it); continue; } it -= N_SAT;
            if (it < N_SGU) { if (im & 32) sgu_item(C, l, it); continue; } it -= N_SGU;
            if (it < N_SHG) { if (im & 64) samp_hgrn_item(C, l, it); continue; } it -= N_SHG;
            if (it < N_SSG) { if (im & 128) samp_sgu_item(C, l, it); continue; } it -= N_SSG;
            if (it < N_KVO) { if (im & 128) kvout_item(C, l, it); continue; } it -= N_KVO;
            if (im & 128) wt_item(C, it); }
    } else if constexpr (KIND == 4) {
        for (;;) { int it = fetch_item(C, 3 * l + 2); if (it >= N_HG + N_A1 + N_SOUT) break;
            if (it < N_A1) { if (im & 512) att1_item(C, it); continue; } it -= N_A1;
            if (it < N_HG) { if (im & 256) hg3_item(C, l, it); continue; } it -= N_HG;
            if (im & 1024) samp_out_item(C, l, it); }
    } else {
        pg8::Gemm g{((bf16*)WSP(WS_YB)), ((bf16*)WSP(WS_WOUT)) + (size_t)l * DM * DMIX, MPR, DM, DMIX}; pg8::StaticOrder S; S.init(MPR, DM, NGRID, bx_);
        pg8::EpiOut E{l == 0 ? ((const float*)INP(0)) : nullptr, l == 0 ? nullptr : ((bf16*)WSP(WS_XB)), l == 0 ? nullptr : (OUTP()) + O_YP, l == 0 ? ((bf16*)WSP(WS_XB)) : nullptr, l == 0 ? ((float*)WSP(WS_CTL + CTL_SSQ1)) : nullptr};
        pg8::gemm_phase<pg8::EpiOut, pg8::StaticOrder, true, true>(C.lds + RING_OFF, g, S, E);
    }
}

__global__ void __launch_bounds__(NWAVES * 64, 2) mega_fwd(Args args) {
    extern __shared__ __attribute__((aligned(16))) unsigned char lds[];
    Ctx C;
    C.lds = (LAS unsigned char*)lds; C.MISC = (volatile LAS unsigned*)(C.lds + MISC_OFF);
    C.tid = threadIdx.x; C.lane = C.tid & 63; C.wave = __builtin_amdgcn_readfirstlane(C.tid >> 6);
    C.G = NGRID; C.vcu = 0;
    for (int u = C.tid; u < (LDS_BYTES - MISC_OFF) / 4; u += NWAVES * 64) ((LAS unsigned*)(C.lds + MISC_OFF))[u] = 0u;
    __syncthreads();
    XcdBarrier bar; bar.bar = (unsigned*)(((gu32*)WSP(WS_CTL)) + CW_BAR); bar.x = 0; bar.st = nullptr;
    if (N_LAUNCHES == 1) bar = xcd_barrier_post((unsigned*)(((gu32*)WSP(WS_CTL)) + CW_BAR), C.MISC + 8);
    const int lo = args.ph_lo, hi = args.ph_hi, im = args.imask;
    const int wave_s = __builtin_amdgcn_readfirstlane(threadIdx.x >> 6);
#define RELAUNDER() do { int t_ = (wave_s << 6) | (int)__builtin_amdgcn_mbcnt_hi(~0u, __builtin_amdgcn_mbcnt_lo(~0u, 0u)); asm volatile("" : "+v"(t_)); C.tid = t_; C.lane = t_ & 63; C.wave = __builtin_amdgcn_readfirstlane(t_ >> 6); \
        LAS unsigned char* lp_ = (LAS unsigned char*)lds; asm volatile("" : "+s"(lp_)); C.lds = lp_; C.MISC = (volatile LAS unsigned*)(lp_ + MISC_OFF); } while (0)
#define PHASE(p, KIND, L) if (lo <= (p) && (p) < hi) { RELAUNDER(); int bx_ = blockIdx.x; asm volatile("" : "+s"(bx_)); C.vcu = (bx_ & 7) * (NGRID >> 3) + (bx_ >> 3); run_kind<KIND, L>(C, im, bx_); \
        if (N_LAUNCHES == 1 && (p) + 1 < hi) { XcdBarrier b2; b2.bar = (unsigned*)(((gu32*)WSP(WS_CTL)) + CW_BAR); unsigned x2_ = bar.x; asm volatile("" : "+s"(x2_)); b2.x = x2_; b2.st = C.MISC + 8; xcd_barrier(b2); } }
    PHASE(0, 0, 0)
    PHASE(1, 1, 0) PHASE(2, 2, 0) PHASE(3, 4, 0) PHASE(4, 5, 0)
    PHASE(5, 1, 1) PHASE(6, 2, 1) PHASE(7, 4, 1) PHASE(8, 5, 1)
#undef PHASE
#undef RELAUNDER
}

extern "C" void kernel_launch(void* const* d_in, const int* in_sizes, int n_in, void* d_out, int out_size, void* d_ws, size_t ws_size, hipStream_t stream) {
    static int grid = 0;
    if (grid == 0) {
        if (n_in != 16 || (size_t)out_size != O_END || ws_size < WS_END) { fprintf(stderr, "kernel_launch: unexpected shapes: n_in %d out %d ws %zu (need %zu)\n", n_in, out_size, ws_size, (size_t)WS_END); grid = -1; return; }
        int dev = 0, cus = 0, per_cu = 0;
        if (hipGetDevice(&dev) != hipSuccess || hipDeviceGetAttribute(&cus, hipDeviceAttributeMultiprocessorCount, dev) != hipSuccess) { grid = -1; return; }
        if (hipFuncSetAttribute((const void*)mega_fwd, hipFuncAttributeMaxDynamicSharedMemorySize, LDS_BYTES) != hipSuccess) { fprintf(stderr, "kernel_launch: hipFuncSetAttribute failed\n"); grid = -1; return; }
        if (hipOccupancyMaxActiveBlocksPerMultiprocessor(&per_cu, (const void*)mega_fwd, NWAVES * 64, LDS_BYTES) != hipSuccess || per_cu < 1) { fprintf(stderr, "kernel_launch: occupancy query says %d\n", per_cu); (void)hipGetLastError(); per_cu = 1; }
        if (cus < NGRID) { fprintf(stderr, "kernel_launch: %d CUs < %d workgroups: not co-resident\n", cus, NGRID); grid = -1; return; }
        grid = NGRID;
    }
    if (grid < 0) return;
    (void)hipMemsetAsync((char*)d_ws + WS_CTL, 0, CTL_ZERO_BYTES, stream);
    Args a{};
    for (int i = 0; i < 16; ++i) a.in[i] = (const float*)d_in[i];
    a.out = (float*)d_out; a.ws = (unsigned char*)d_ws; a.imask = 0xffff;
    if (N_LAUNCHES == 1) { a.ph_lo = 0; a.ph_hi = N_PHASES; hipLaunchKernelGGL(mega_fwd, dim3(grid), dim3(NWAVES * 64), LDS_BYTES, stream, a); }
    else for (int p = 0; p < N_PHASES; ++p) { a.ph_lo = p; a.ph_hi = p + 1;
        const int nl = 1 + ((p == RPT_PHASE) ? RPT_N : 0);
        for (int r = 0; r < nl; ++r) {
            if (r > 0 && p >= 1) { const int l = (p - 1) / 4, k = (p - 1) % 4; if (k == 1 || k == 2) (void)hipMemsetAsync((char*)d_ws + WS_CTL + (size_t)(CW_Q + 64 * (3 * l + (k == 1 ? 0 : 2))) * 4, 0, 4, stream); }
            a.imask = (r > 0) ? RPT_IMASK : 0xffff;
            hipLaunchKernelGGL(mega_fwd, dim3(grid), dim3(NWAVES * 64), LDS_BYTES, stream, a); } }
}
```

```cpp
#include <hip/hip_runtime.h>
#include <cstdio>
#include <cstdint>
namespace pg8 {
#define PG8_LAS __attribute__((address_space(3)))
typedef unsigned short bf16_t;
typedef short bf16x8 __attribute__((ext_vector_type(8)));
typedef float f32x4 __attribute__((ext_vector_type(4)));
typedef unsigned u32x4 __attribute__((ext_vector_type(4)));
constexpr int BM = 256, BK = 64, HALF = 128, HTB = HALF * BK * 2  , STAGE_BYTES = 8 * HTB, NXCD = 8, WGM = 8;

__host__ __device__ __forceinline__ int lds_byte(int r, int c) { const int st = (r >> 4) * 2 + (c >> 5), rr = r & 15, cc = c & 31, ob = rr * 64 + cc * 2; return st * 1024 + (ob ^ (((ob >> 9) & 1) << 5)); }
__host__ __device__ __forceinline__ void stage_rc(int b, int& R, int& C) { const int st = b / 1024, sb = b % 1024, swz = sb ^ (((sb >> 9) & 1) << 5); R = (st >> 1) * 16 + swz / 64; C = (st & 1) * 32 + (swz % 64) / 2; }
__host__ __device__ __forceinline__ int perm32(int rho) { const int n = rho >> 4, i = rho & 15; return 8 * (i >> 2) + 4 * n + (i & 3); }

struct Unit { int pm, pn; };
struct Gemm { const bf16_t* A; const bf16_t* Bt; int M, N, K; };

struct StaticOrder {
    int nM, nN, nwg, G, c;
    __host__ __device__ void init(int M, int N, int G_, int c_) { nM = M / BM; nN = N / BM; nwg = nM * nN; G = G_; c = c_; }
    __host__ __device__ bool next(int i, Unit& u) const {
        const long L = (long)i * G + c; if (L >= nwg) return false;
        int wgid = (int)L; { const int q = nwg / NXCD, r = nwg % NXCD, xcd = wgid % NXCD, off = wgid / NXCD; wgid = (xcd < r ? xcd * (q + 1) : r * (q + 1) + (xcd - r) * q) + off; }
        const int nig = WGM * nN, gid = wgid / nig, fm = gid * WGM, gsz = (nM - fm) < WGM ? (nM - fm) : WGM;
        u.pm = fm + ((wgid % nig) % gsz); u.pn = (wgid % nig) / gsz; return true;
    }
    __device__ __forceinline__ void a_ready(const Unit&) const {}
    __device__ __forceinline__ void done(const Unit&) const {}
};


typedef float f32x2 __attribute__((ext_vector_type(2)));
typedef unsigned u32x2 __attribute__((ext_vector_type(2)));
typedef __bf16 bf16x2_t __attribute__((ext_vector_type(2)));
__device__ __forceinline__ unsigned cvtpk(float lo, float hi) { f32x2 v = {lo, hi}; bf16x2_t b = __builtin_convertvector(v, bf16x2_t); return __builtin_bit_cast(unsigned, b); }
__device__ __forceinline__ float fast_sigmoid(float x) { return __builtin_amdgcn_rcpf(1.0f + __expf(-x)); }
__device__ __forceinline__ float silu_f(float x) { return x * fast_sigmoid(x); }

template <int CTRL> __device__ __forceinline__ float dpp_f(float x) { return __builtin_bit_cast(float, __builtin_amdgcn_update_dpp(0, __builtin_bit_cast(int, x), CTRL, 0xf, 0xf, false)); }
template <int CTRL> __device__ __forceinline__ float dpp_f1(float x) { return __builtin_bit_cast(float, __builtin_amdgcn_update_dpp(0x3f800000, __builtin_bit_cast(int, x), CTRL, 0xf, 0xf, false)); }
__device__ __forceinline__ float row_prefprod16(float x) { x *= dpp_f1<0x111>(x); x *= dpp_f1<0x112>(x); x *= dpp_f1<0x114>(x); x *= dpp_f1<0x118>(x); return x; }
__device__ __forceinline__ float row_prefix16(float x) { x += dpp_f<0x111>(x); x += dpp_f<0x112>(x); x += dpp_f<0x114>(x); x += dpp_f<0x118>(x); return x; }
struct EpiProj {
    static constexpr bool PERM = true, AFTER_DRAIN = false, HEADPERM = true;
    const float* ssq;
    const float* gtab;
    unsigned char* ws; float* out; int l; int skip;
    size_t o_qkv, s_qkv, o_zb, o_bu, s_bu, o_cq, s_cq, o_ce, o_dj, o_kh, s_kh;
    size_t o_kp, s_kp, o_ks, s_ks;
    __device__ __forceinline__ void st8(bf16_t* p, const f32x4& a, const f32x4& b) const {
        u32x4 w; w.x = cvtpk(a[0], a[1]); w.y = cvtpk(a[2], a[3]); w.z = cvtpk(b[0], b[1]); w.w = cvtpk(b[2], b[3]); *(u32x4*)p = w; }
    __device__ __forceinline__ void operator()(const f32x4 (&acc)[2][2][4][2], const Unit& u, int wr, int wc, int fr, int fq) const {
        if (skip) return;
        const int pn = u.pn;
        int seg, seg0;
        if (pn < 12) { seg = pn / 3; seg0 = seg * 3; }
        else if (pn < 18) { seg = 4 + (pn - 12) / 2; seg0 = 12 + (seg - 4) * 2; }
        else { seg = 7 + (pn - 18) / 3; seg0 = 18 + (seg - 7) * 3; }
        const int cl = (pn - seg0) * 256 + wc * 64 + 8 * fq;
        const int rowb = u.pm * BM + wr * 64 + fr;
        const bool sample = (u.pm == 64);
        f32x4 gv[2][2];
        { const int gi = (seg == 0) ? 0 : (seg == 1 ? 1 : 2); const float* gp = gtab + gi * 768 + (seg == 0 || seg == 1 || seg == 8 ? cl : 0);
#pragma unroll
          for (int bj = 0; bj < 2; ++bj)
#pragma unroll
              for (int n = 0; n < 2; ++n) gv[bj][n] = *(const f32x4*)(gp + 32 * bj + 4 * n); }
        if (seg == 8) {
            const int lane_hi15 = ((fq << 4) | 15);
            float rsc[2][4];
#pragma unroll
            for (int ai = 0; ai < 2; ++ai)
#pragma unroll
                for (int m = 0; m < 4; ++m) rsc[ai][m] = ssq[rowb + ai * HALF + m * 16];
#pragma unroll
            for (int ai = 0; ai < 2; ++ai)
#pragma unroll
                for (int mp = 0; mp < 2; ++mp) {
                    const int rowA = rowb + ai * HALF + mp * 32, rowB = rowA + 16;
                    const float rsA = __builtin_amdgcn_rsqf(rsc[ai][2 * mp] * (1.0f / 1024.0f) + 1e-6f), rsB = __builtin_amdgcn_rsqf(rsc[ai][2 * mp + 1] * (1.0f / 1024.0f) + 1e-6f);
#pragma unroll
                    for (int bj = 0; bj < 2; ++bj) {
                        f32x4 eA[2], eB[2], kA[2], kB[2], dl[2];
#pragma unroll
                        for (int n = 0; n < 2; ++n)
#pragma unroll
                            for (int e = 0; e < 4; ++e) { const float lbv = gv[bj][n][e], omlb = 1.0f - lbv;
                                const float sa = fast_sigmoid(acc[ai][bj][2 * mp][n][e] * rsA), sb = fast_sigmoid(acc[ai][bj][2 * mp + 1][n][e] * rsB);
                                float ka = omlb - omlb * sa, kb = omlb - omlb * sb, pa = lbv + omlb * sa, pb = lbv + omlb * sb;
                                if (!sample) { pa = row_prefprod16(pa); const float t0 = __shfl(pa, lane_hi15); pb = row_prefprod16(pb) * t0; dl[n][e] = __shfl(pb, lane_hi15);
                                    ka *= __builtin_amdgcn_rcpf(pa); kb *= __builtin_amdgcn_rcpf(pb); }
                                eA[n][e] = pa; eB[n][e] = pb; kA[n][e] = ka; kB[n][e] = kb; }
                        bf16_t* dkA = (bf16_t*)(ws + o_cq + s_cq) + (size_t)rowA * 768 + cl + 32 * bj; bf16_t* deA = (bf16_t*)(ws + o_ce) + (size_t)rowA * 768 + cl + 32 * bj;
                        st8(dkA, kA[0], kA[1]); st8(dkA + 16 * 768, kB[0], kB[1]); st8(deA, eA[0], eA[1]); st8(deA + 16 * 768, eB[0], eB[1]);
                        if (!sample && fr == 0) { float* dd = (float*)(ws + o_dj) + (size_t)(rowA >> 5) * 768 + cl + 32 * bj; *(f32x4*)dd = dl[0]; *(f32x4*)(dd + 4) = dl[1]; }
                    }
                    asm volatile("" ::: "memory");
                }
            return;
        }
        float rsv[2][4];
#pragma unroll
        for (int ai = 0; ai < 2; ++ai)
#pragma unroll
            for (int m = 0; m < 4; ++m) rsv[ai][m] = ssq[rowb + ai * HALF + m * 16];
#pragma unroll
        for (int ai = 0; ai < 2; ++ai)
#pragma unroll
            for (int m = 0; m < 4; ++m) {
                const int row = rowb + ai * HALF + m * 16;
                const float rs = __builtin_amdgcn_rsqf(rsv[ai][m] * (1.0f / 1024.0f) + 1e-6f);
                f32x4 v[2][2];
#pragma unroll
                for (int bj = 0; bj < 2; ++bj)
#pragma unroll
                    for (int n = 0; n < 2; ++n) v[bj][n] = acc[ai][bj][m][n] * rs;
                if (seg <= 1) {
                    float ss = 0.f;
#pragma unroll
                    for (int bj = 0; bj < 2; ++bj)
#pragma unroll
                        for (int n = 0; n < 2; ++n) { const f32x4 x = v[bj][n]; ss += (x[0] * x[0] + x[1] * x[1]) + (x[2] * x[2] + x[3] * x[3]); }
                    ss += __shfl_xor(ss, 16); ss += __shfl_xor(ss, 32);
                    float r2 = __builtin_amdgcn_rsqf(ss * (1.0f / 64.0f) + 1e-6f);
                    if (seg == 0) r2 *= 0.125f * 1.4426950408889634f;
#pragma unroll
                    for (int bj = 0; bj < 2; ++bj)
#pragma unroll
                        for (int n = 0; n < 2; ++n) v[bj][n] = v[bj][n] * gv[bj][n] * r2;
                }
                if (seg <= 2) {
                    if (seg == 0 || sample) {
                        bf16_t* dst = (bf16_t*)(ws + o_qkv + (size_t)seg * s_qkv) + (size_t)row * 768 + cl;
#pragma unroll
                        for (int bj = 0; bj < 2; ++bj) st8(dst + 32 * bj, v[bj][0], v[bj][1]);
                    } else {
                        const int t = row & 2047, bb = row >> 11, head = cl >> 6;
                        bf16_t* dst = (bf16_t*)(ws + o_kh + (size_t)(seg - 1) * s_kh) + ((size_t)(((bb * 12 + head) * 16 + (t & 15)) * 128 + (t >> 4))) * 64 + (cl & 63);
#pragma unroll
                        for (int bj = 0; bj < 2; ++bj) st8(dst + 32 * bj, v[bj][0], v[bj][1]);
                    }
                    if (seg >= 1) {
                        const bool okp = !sample, oks = sample && (row - 16384 < 32);
                        float* o = out + (okp ? o_kp + (size_t)(seg - 1) * s_kp + (size_t)row * 768 : o_ks + (size_t)(seg - 1) * s_ks + (size_t)(row - 16384) * 768) + cl;
                        if (okp || oks) {
#pragma unroll
                            for (int bj = 0; bj < 2; ++bj) { __builtin_nontemporal_store(v[bj][0], (f32x4*)(o + 32 * bj)); __builtin_nontemporal_store(v[bj][1], (f32x4*)(o + 32 * bj + 4)); }
                        }
                    }
                } else if (seg == 3 || seg == 6 || seg == 10 || seg == 7) {
#pragma unroll
                    for (int bj = 0; bj < 2; ++bj)
#pragma unroll
                        for (int n = 0; n < 2; ++n)
#pragma unroll
                            for (int e = 0; e < 4; ++e) v[bj][n][e] = silu_f(v[bj][n][e]);
                    const size_t zo = (seg == 7) ? o_cq + ((size_t)row * 768 + cl) * 2 : o_zb + ((size_t)row * 2048 + (seg == 3 ? 0 : (seg == 6 ? 768 : 1280)) + cl) * 2;
                    bf16_t* dst = (bf16_t*)(ws + zo);
#pragma unroll
                    for (int bj = 0; bj < 2; ++bj) st8(dst + 32 * bj, v[bj][0], v[bj][1]);
                } else if (seg == 4 || seg == 5) {
                    bf16_t* dst = (bf16_t*)(ws + o_bu + (size_t)(seg - 4) * s_bu) + (size_t)row * 512 + cl;
#pragma unroll
                    for (int bj = 0; bj < 2; ++bj) st8(dst + 32 * bj, v[bj][0], v[bj][1]);
                } else if (seg == 9) {
                    bf16_t* dst = (bf16_t*)(ws + o_cq + 2 * s_cq) + (size_t)row * 768 + cl;
#pragma unroll
                    for (int bj = 0; bj < 2; ++bj) st8(dst + 32 * bj, v[bj][0], v[bj][1]);
                }
                asm volatile("" ::: "memory");
            }
    }
};
struct EpiOut {
    static constexpr bool PERM = false, AFTER_DRAIN = false, HEADPERM = false;
    const float* res; const bf16_t* resb; float* out; bf16_t* xb; float* ssq;
    __device__ __forceinline__ f32x4 ldres(size_t off) const {
        if (res) return __builtin_nontemporal_load((const f32x4*)(res + off));
        const u32x2 w = *(const u32x2*)(resb + off); return (f32x4){__uint_as_float(w.x << 16), __uint_as_float(w.x & 0xffff0000u), __uint_as_float(w.y << 16), __uint_as_float(w.y & 0xffff0000u)}; }
    __device__ __forceinline__ void operator()(const f32x4 (&acc)[2][2][4][2], const Unit& u, int wr, int wc, int fr, int fq) const {
        const int col0 = u.pn * BM + wc * 32 + 4 * fq;
        const size_t off0 = (size_t)(u.pm * BM + wr * 64 + fr) * 1024 + col0;
        f32x4 rcur[2][2], rnxt[2][2];
#pragma unroll
        for (int bj = 0; bj < 2; ++bj)
#pragma unroll
            for (int n = 0; n < 2; ++n) rcur[bj][n] = ldres(off0 + bj * HALF + n * 16);
#pragma unroll
        for (int it = 0; it < 8; ++it) {
            const int ai = it >> 2, m = it & 3;
            const int row = u.pm * BM + ai * HALF + wr * 64 + m * 16 + fr; const size_t off = (size_t)row * 1024 + col0; float ss = 0.f;
            if (it < 7) { const int ai2 = (it + 1) >> 2, m2 = (it + 1) & 3; const size_t offn = off0 + (size_t)(ai2 * HALF + m2 * 16) * 1024;
#pragma unroll
                for (int bj = 0; bj < 2; ++bj)
#pragma unroll
                    for (int n = 0; n < 2; ++n) rnxt[bj][n] = ldres(offn + bj * HALF + n * 16); }
#pragma unroll
            for (int bj = 0; bj < 2; ++bj)
#pragma unroll
                for (int n = 0; n < 2; ++n) { const f32x4 o = rcur[bj][n] + acc[ai][bj][m][n];
                    if (out) __builtin_nontemporal_store(o, (f32x4*)(out + off + bj * HALF + n * 16));
                    ss += (o[0] * o[0] + o[1] * o[1]) + (o[2] * o[2] + o[3] * o[3]);
                    if (xb) { u32x2 w; w.x = cvtpk(o[0], o[1]); w.y = cvtpk(o[2], o[3]); *(u32x2*)(xb + off + bj * HALF + n * 16) = w; } }
            if (ssq) { ss += __shfl_xor(ss, 16); ss += __shfl_xor(ss, 32); if (fq == 0) atomicAdd(ssq + row, ss); }
#pragma unroll
            for (int bj = 0; bj < 2; ++bj)
#pragma unroll
                for (int n = 0; n < 2; ++n) rcur[bj][n] = rnxt[bj][n];
        }
    }
};
template <class Epi, class Sched, bool ALIGN_EPI = false, bool SP2 = false>
__device__ __forceinline__ void gemm_phase(PG8_LAS unsigned char* lds, const Gemm g, const Sched& S, const Epi& E) {
    int tid_ = threadIdx.x; asm volatile("" : "+v"(tid_));
    const int tid = tid_, wid = __builtin_amdgcn_readfirstlane(tid >> 6), lane = tid & 63, wr = wid >> 2, wc = wid & 3, fr = lane & 15, fq = lane >> 4;
    const int K = g.K, nt = K / BK;
    unsigned voffA[2], voffB[2];
#pragma unroll
    for (int i = 0; i < 2; ++i) { int R, C; stage_rc(tid * 16 + i * 8192, R, C); const int Rb = Epi::HEADPERM ? (64 * (R >> 5) + perm32(R & 31)) : (Epi::PERM ? ((R & ~31) + perm32(R & 31)) : R);
        voffA[i] = (unsigned)(R * K + C) * 2u; voffB[i] = (unsigned)(Rb * K + C) * 2u; }
    const size_t kstep = (size_t)(BK * 2);
    const size_t hstep = (size_t)HALF * K * 2;
    const size_t tstep = 2 * hstep; const size_t hstepB = Epi::HEADPERM ? (size_t)32 * K * 2 : hstep;
    const unsigned ldsw = (unsigned)wid * 1024u;
    const int aoff = lds_byte(wr * 64 + fr, fq * 8), boff = lds_byte(wc * 32 + fr, fq * 8);
#define PG8_SA(b, h) (((b) * 2 + (h)) * HTB)
#define PG8_SB(b, h) ((4 + (b) * 2 + (h)) * HTB)
#define PG8_STAGE(bufoff, gbase, voff) do { _Pragma("unroll") for (int _i = 0; _i < 2; ++_i) \
        __builtin_amdgcn_global_load_lds((const unsigned*)((const char*)(gbase) + (voff)[_i]), (PG8_LAS unsigned*)(lds + (bufoff) + ldsw + _i * 8192), 16, 0, 0); } while (0)
#define PG8_LDA(dst, b, h) do { _Pragma("unroll") for (int m = 0; m < 4; ++m) _Pragma("unroll") for (int k = 0; k < 2; ++k) dst[m][k] = *(const PG8_LAS bf16x8*)(lds + PG8_SA(b, h) + aoff + m * 2048 + k * 1024); } while (0)
#define PG8_LDB(dst, b, h) do { _Pragma("unroll") for (int n = 0; n < 2; ++n) _Pragma("unroll") for (int k = 0; k < 2; ++k) dst[n][k] = *(const PG8_LAS bf16x8*)(lds + PG8_SB(b, h) + boff + n * 2048 + k * 1024); } while (0)
#define PG8_MMA(ai, bj, At, Bt) do { __builtin_amdgcn_s_setprio(1); _Pragma("unroll") for (int m = 0; m < 4; ++m) _Pragma("unroll") for (int n = 0; n < 2; ++n) _Pragma("unroll") for (int k = 0; k < 2; ++k) \
        acc[ai][bj][m][n] = __builtin_amdgcn_mfma_f32_16x16x32_bf16(Bt[n][k], At[m][k], acc[ai][bj][m][n], 0, 0, 0); __builtin_amdgcn_s_setprio(0); } while (0)
#define PG8_WAIT_V(n) asm volatile("s_waitcnt vmcnt(" #n ")" ::: "memory")
#define PG8_WAIT_L(n) asm volatile("s_waitcnt lgkmcnt(" #n ")" ::: "memory")
#define PG8_BAR __builtin_amdgcn_s_barrier()
#define PG8_SCHED __builtin_amdgcn_sched_barrier(0)
    Unit cur, nxt; int ui = 0;
    if (!S.next(0, cur)) return;
    f32x4 acc[2][2][4][2];
#pragma unroll
    for (int a = 0; a < 2; ++a)
#pragma unroll
        for (int b = 0; b < 2; ++b)
#pragma unroll
            for (int m = 0; m < 4; ++m)
#pragma unroll
                for (int n = 0; n < 2; ++n) acc[a][b][m][n] = (f32x4){0.f, 0.f, 0.f, 0.f};
    bf16x8 At[4][2], B0[2][2], B1[2][2];
    const char* cA = (const char*)g.A + (size_t)cur.pm * tstep; const char* cB = (const char*)g.Bt + (size_t)cur.pn * tstep;
    S.a_ready(cur);
    if constexpr (SP2) {
        PG8_STAGE(PG8_SB(0, 0), cB, voffB); PG8_STAGE(PG8_SB(0, 1), cB + hstepB, voffB); PG8_STAGE(PG8_SA(0, 0), cA, voffA); PG8_STAGE(PG8_SA(0, 1), cA + hstep, voffA);
        if (wr == 1) PG8_BAR;
        PG8_WAIT_V(2); PG8_BAR;
        PG8_STAGE(PG8_SB(1, 0), cB + kstep, voffB); PG8_STAGE(PG8_SA(1, 0), cA + kstep, voffA); PG8_STAGE(PG8_SB(1, 1), cB + hstepB + kstep, voffB);
        PG8_WAIT_V(6); PG8_BAR;
    } else {
        PG8_STAGE(PG8_SB(0, 0), cB, voffB); PG8_STAGE(PG8_SA(0, 0), cA, voffA); PG8_STAGE(PG8_SB(0, 1), cB + hstepB, voffB); PG8_STAGE(PG8_SA(0, 1), cA + hstep, voffA);
        if (wr == 1) PG8_BAR;
        PG8_WAIT_V(4); PG8_BAR;
        PG8_STAGE(PG8_SB(1, 0), cB + kstep, voffB); PG8_STAGE(PG8_SA(1, 0), cA + kstep, voffA); PG8_STAGE(PG8_SB(1, 1), cB + hstepB + kstep, voffB);
        PG8_WAIT_V(6); PG8_BAR;
    }
    for (;;) {
        const bool has_next = S.next(ui + 1, nxt);
        const char* nA = has_next ? (const char*)g.A + (size_t)nxt.pm * tstep : cA; const char* nB = has_next ? (const char*)g.Bt + (size_t)nxt.pn * tstep : cB;
        for (int t = 0; t < nt; t += 2) {
            const bool last = (t == nt - 2);
            const char* a1 = cA + (size_t)(t + 1) * kstep;
            const char* a2 = last ? nA : cA + (size_t)(t + 2) * kstep; const char* b2 = last ? nB : cB + (size_t)(t + 2) * kstep;
            const char* a3 = a2 + kstep; const char* b3 = b2 + kstep;
            if (last && has_next) S.a_ready(nxt);
            if constexpr (SP2) {
            PG8_LDB(B0, 0, 0); PG8_LDB(B1, 0, 1); PG8_SCHED; PG8_LDA(At, 0, 0); PG8_STAGE(PG8_SA(1, 1), a1 + hstep, voffA);
            PG8_WAIT_V(8); PG8_WAIT_L(0); PG8_BAR; PG8_MMA(0, 0, At, B0); PG8_MMA(0, 1, At, B1); PG8_BAR; PG8_SCHED;
            PG8_LDA(At, 0, 1); PG8_STAGE(PG8_SB(0, 0), b2, voffB); PG8_STAGE(PG8_SB(0, 1), b2 + hstepB, voffB); PG8_STAGE(PG8_SA(0, 0), a2, voffA);
            PG8_WAIT_V(8); PG8_WAIT_L(0); PG8_BAR; PG8_MMA(1, 0, At, B0); PG8_MMA(1, 1, At, B1); PG8_BAR; PG8_SCHED;
            PG8_LDB(B0, 1, 0); PG8_LDB(B1, 1, 1); PG8_SCHED; PG8_LDA(At, 1, 0); PG8_STAGE(PG8_SA(0, 1), a2 + hstep, voffA);
            PG8_WAIT_V(8); PG8_WAIT_L(0); PG8_BAR; PG8_MMA(0, 0, At, B0); PG8_MMA(0, 1, At, B1); PG8_BAR; PG8_SCHED;
            PG8_LDA(At, 1, 1); PG8_STAGE(PG8_SB(1, 0), b3, voffB); PG8_STAGE(PG8_SB(1, 1), b3 + hstepB, voffB); PG8_STAGE(PG8_SA(1, 0), a3, voffA);
            PG8_WAIT_V(8); PG8_WAIT_L(0); PG8_BAR; PG8_MMA(1, 0, At, B0); PG8_MMA(1, 1, At, B1); PG8_BAR; PG8_SCHED;
            } else {
            PG8_LDB(B0, 0, 0); PG8_SCHED; PG8_LDA(At, 0, 0); PG8_STAGE(PG8_SA(1, 1), a1 + hstep, voffA);
            PG8_WAIT_L(8); PG8_BAR; PG8_WAIT_L(0); PG8_MMA(0, 0, At, B0); PG8_BAR; PG8_SCHED;
            PG8_LDB(B1, 0, 1); PG8_STAGE(PG8_SB(0, 0), b2, voffB);
            PG8_BAR; PG8_WAIT_L(0); PG8_MMA(0, 1, At, B1); PG8_BAR;
            PG8_LDA(At, 0, 1); PG8_STAGE(PG8_SA(0, 0), a2, voffA);
            PG8_BAR; PG8_WAIT_L(0); PG8_MMA(1, 0, At, B0); PG8_BAR; PG8_SCHED;
            PG8_STAGE(PG8_SB(0, 1), b2 + hstepB, voffB);
            PG8_WAIT_V(6); PG8_BAR; PG8_MMA(1, 1, At, B1); PG8_BAR;
            PG8_LDB(B0, 1, 0); PG8_SCHED; PG8_LDA(At, 1, 0); PG8_STAGE(PG8_SA(0, 1), a2 + hstep, voffA);
            PG8_WAIT_L(8); PG8_BAR; PG8_WAIT_L(0); PG8_MMA(0, 0, At, B0); PG8_BAR; PG8_SCHED;
            PG8_LDB(B1, 1, 1); PG8_STAGE(PG8_SB(1, 0), b3, voffB);
            PG8_BAR; PG8_WAIT_L(0); PG8_MMA(0, 1, At, B1); PG8_BAR;
            PG8_LDA(At, 1, 1); PG8_STAGE(PG8_SA(1, 0), a3, voffA);
            PG8_BAR; PG8_WAIT_L(0); PG8_MMA(1, 0, At, B0); PG8_BAR; PG8_SCHED;
            PG8_STAGE(PG8_SB(1, 1), b3 + hstepB, voffB);
            PG8_WAIT_V(6); PG8_BAR; PG8_MMA(1, 1, At, B1); PG8_BAR;
            }
        }
        if constexpr (ALIGN_EPI) { if (wr == 0) PG8_BAR; }
        if constexpr (!Epi::AFTER_DRAIN) { E(acc, cur, wr, wc, fr, fq); S.done(cur); }
        if (!has_next) break;
#pragma unroll
        for (int a = 0; a < 2; ++a)
#pragma unroll
            for (int b = 0; b < 2; ++b)
#pragma unroll
                for (int m = 0; m < 4; ++m)
#pragma unroll
                    for (int n = 0; n < 2; ++n) acc[a][b][m][n] = (f32x4){0.f, 0.f, 0.f, 0.f};
        cur = nxt; cA = nA; cB = nB; ++ui;
        if constexpr (ALIGN_EPI) { if (wr == 1) PG8_BAR; }
    }
    PG8_WAIT_V(0);
    if constexpr (!ALIGN_EPI) { if (wr == 0) PG8_BAR; }
    PG8_BAR;
    if constexpr (Epi::AFTER_DRAIN) { E.fused(acc, cur, wr, wc, fr, fq, lds, wid, lane); S.done(cur); }
#undef PG8_SA
#undef PG8_SB
#undef PG8_STAGE
#undef PG8_LDA
#undef PG8_LDB
#undef PG8_MMA
#undef PG8_WAIT_V
#undef PG8_WAIT_L
#undef PG8_BAR
#undef PG8_SCHED
}
}
#define GAS __attribute__((address_space(1)))
#define LAS __attribute__((address_space(3)))
typedef unsigned short bf16;
typedef unsigned v4u __attribute__((ext_vector_type(4)));
typedef float f32x4 __attribute__((ext_vector_type(4)));
typedef short bf16x8 __attribute__((ext_vector_type(8)));
typedef GAS unsigned gu32;
typedef GAS unsigned long long gu64;
#define RLX_AGENT __ATOMIC_RELAXED, __HIP_MEMORY_SCOPE_AGENT
#define LDS_WAIT() asm volatile("s_waitcnt lgkmcnt(0)" ::: "memory")
#define VM_WAIT() asm volatile("s_waitcnt vmcnt(0)" ::: "memory")
__device__ __forceinline__ unsigned long long rt() { return __builtin_amdgcn_s_memrealtime(); }
__device__ __forceinline__ unsigned f2bf(float f) { unsigned u = __builtin_bit_cast(unsigned, f); return (u + 0x7fffu + ((u >> 16) & 1u)) >> 16; }
__device__ __forceinline__ unsigned pk2(float lo, float hi) { return f2bf(lo) | (f2bf(hi) << 16); }

#define XB_TMO      128
#define XB_XCNT(j)  (256  + 64 * (j))
#define XB_XSUB(j)  (1280 + 64 * (j))
#define XB_XGEN(j)  (2304 + 64 * (j))
#define XB_TOP      3328
#define XB_TOPGEN   3392
#define XCD_BAR_WORDS 3456
#define XB_SPIN_CAP (1u << 18)

__device__ __forceinline__ unsigned xb_ld(unsigned* p)              { return __hip_atomic_load(p, __ATOMIC_RELAXED, __HIP_MEMORY_SCOPE_AGENT); }
__device__ __forceinline__ unsigned xb_add(unsigned* p, unsigned v) { return __hip_atomic_fetch_add(p, v, __ATOMIC_RELAXED, __HIP_MEMORY_SCOPE_AGENT); }
__device__ __forceinline__ unsigned xb_xcc_id() { return (unsigned)__builtin_amdgcn_s_getreg((3 << 11) | 20) & 0xFu; }
#define XB_SPIN(cond, bar) do { unsigned _sp = 0; while (cond) { __builtin_amdgcn_s_sleep(1); \
    if ((++_sp & 255u) == 0u) { if (xb_ld(&(bar)[XB_TMO])) break; if (_sp > XB_SPIN_CAP) { atomicAdd(&(bar)[XB_TMO], 1u); break; } } } } while (0)

struct XcdBarrier {
    unsigned* bar; unsigned x;
    volatile LAS unsigned* st;
};

__device__ __forceinline__ XcdBarrier xcd_barrier_post(unsigned* bar, volatile LAS unsigned* st) {
    XcdBarrier b; b.bar = bar; b.x = xb_xcc_id(); b.st = st;
    if (threadIdx.x == 0) (void)xb_add(&bar[XB_XCNT(b.x)], 1u);
    return b;
}
__device__ __forceinline__ void xcd_barrier_complete(unsigned* bar, unsigned x, unsigned& nloc, unsigned& nx) {
    const unsigned G = 256u;
    unsigned sum, cnt, mine, sp = 0u;
    for (;;) {
        sum = 0u; cnt = 0u; mine = 0u;
#pragma unroll
        for (unsigned j = 0; j < 16; ++j) { const unsigned c = xb_ld(&bar[XB_XCNT(j)]); sum += c; cnt += (c > 0u) ? 1u : 0u; mine = (j == x) ? c : mine; }
        if (sum == G) break;
        __builtin_amdgcn_s_sleep(1);
        if ((++sp & 255u) == 0u) { if (xb_ld(&bar[XB_TMO])) break; if (sp > XB_SPIN_CAP) { atomicAdd(&bar[XB_TMO], 1u); break; } }
    }
    nloc = mine > 0u ? mine : 1u; nx = cnt > 0u ? cnt : 1u;
}

__device__ __forceinline__ void xcd_barrier(const XcdBarrier& b) {
    asm volatile("s_waitcnt vmcnt(0)" ::: "memory");
    __syncthreads();
    if (threadIdx.x == 0) {
        unsigned* bar = b.bar;
        __builtin_amdgcn_s_waitcnt(0);
        unsigned nloc = b.st[0], nx = b.st[1];
        if (nloc == 0u) { xcd_barrier_complete(bar, b.x, nloc, nx); b.st[0] = nloc; b.st[1] = nx; }
        const unsigned old = xb_add(&bar[XB_XSUB(b.x)], 1u);
        const unsigned gen = old / nloc;
        if (old + 1u == (gen + 1u) * nloc) {
            __builtin_amdgcn_fence(__ATOMIC_RELEASE, "agent");
            asm volatile("s_waitcnt vmcnt(0)" ::: "memory");
            const unsigned og = xb_add(&bar[XB_TOP], 1u);
            const unsigned tg = og / nx;
            if (og + 1u == (tg + 1u) * nx) xb_add(&bar[XB_TOPGEN], 1u);
            else XB_SPIN(xb_ld(&bar[XB_TOPGEN]) == tg, bar);
            __builtin_amdgcn_fence(__ATOMIC_ACQUIRE, "agent");
            xb_add(&bar[XB_XGEN(b.x)], 1u);
            asm volatile("s_waitcnt vmcnt(0)" ::: "memory");
        } else {
            XB_SPIN(xb_ld(&bar[XB_XGEN(b.x)]) == gen, bar);
            __builtin_amdgcn_fence(__ATOMIC_ACQUIRE, "agent");
            asm volatile("s_waitcnt vmcnt(0)" ::: "memory");
        }
    }
    __syncthreads();
}
#ifndef MK_N_LAUNCHES
#define MK_N_LAUNCHES 1
#endif
constexpr int NWAVES = 8, NGRID = 256;
constexpr int N_PHASES = 9;
constexpr int N_LAUNCHES = MK_N_LAUNCHES;
constexpr int DM = 1024, NIN = 7680, DMIX = 2048;
constexpr int MPR = 16384, MSA = 32, MPAD = 16640, SEQL = 2048;
constexpr float EPSF = 1e-6f;
constexpr size_t O_YP = 0, O_YS = 16777216, O_KP = O_YS + 32768, O_VP = O_KP + 25165824, O_KS = O_VP + 25165824, O_VS = O_KS + 49152,
                 O_SGU = O_VS + 49152, O_HP = O_SGU + 32768, O_HS = O_HP + 1572864, O_END = O_HS + 6291456;
constexpr size_t MiB = 1u << 20;
constexpr size_t alup(size_t x) { return (x + MiB - 1) / MiB * MiB; }
constexpr size_t WS_CTL = 0, CTL_ZERO_BYTES = MiB;
constexpr size_t WS_WIN = MiB;
constexpr size_t WS_WOUT = WS_WIN + alup((size_t)2 * NIN * DM * 2);
constexpr size_t WS_SGW = WS_WOUT + alup((size_t)2 * DM * DMIX * 2);
constexpr size_t WS_LB = WS_SGW + alup((size_t)2 * 8 * 128 * 128 * 2);
constexpr size_t WS_XB = WS_LB + MiB;
constexpr size_t WS_QB = WS_XB + alup((size_t)MPAD * DM * 2);
constexpr size_t WS_KB = WS_QB + alup((size_t)MPAD * 768 * 2);
constexpr size_t WS_VB = WS_KB + alup((size_t)MPAD * 768 * 2);
constexpr size_t WS_ZB = WS_VB + alup((size_t)MPAD * 768 * 2);
constexpr size_t WS_BU = WS_ZB + alup((size_t)MPAD * 2048 * 2);
constexpr size_t WS_BV = WS_BU + alup((size_t)MPAD * 512 * 2);
constexpr size_t WS_CQ = WS_BV + alup((size_t)MPAD * 512 * 2);
constexpr size_t WS_CK = WS_CQ + alup((size_t)MPAD * 768 * 2);
constexpr size_t WS_CI = WS_CK + alup((size_t)MPAD * 768 * 2);
constexpr size_t WS_CG = WS_CI + alup((size_t)MPAD * 768 * 2);
constexpr size_t WS_CE = WS_CG;
constexpr size_t WS_DJ = WS_CG + alup((size_t)MPAD * 768 * 2);
constexpr size_t WS_YB = WS_CG + alup((size_t)MPAD * 768 * 4);
constexpr size_t WS_X1 = WS_YB + alup((size_t)MPAD * 2048 * 2);
constexpr size_t WS_DS = WS_X1 + alup((size_t)MPAD * DM * 4);
constexpr size_t WS_DEC = WS_DS + alup((size_t)48 * 16 * 128 * 128 * 4);
constexpr size_t WS_O2 = WS_DEC + alup((size_t)48 * 16 * 128 * 4);
constexpr size_t WS_O3 = WS_O2 + alup((size_t)MPAD * 768 * 2);
constexpr size_t WS_L2 = WS_O3 + alup((size_t)MPAD * 768 * 2);
constexpr size_t WS_L3 = WS_L2 + alup((size_t)MPAD * 16 * 4);
constexpr size_t WS_KH = WS_L3 + alup((size_t)MPAD * 16 * 4);
constexpr size_t WS_VH = WS_KH + alup((size_t)MPR * 768 * 2);
constexpr size_t WS_END = WS_VH + alup((size_t)MPR * 768 * 2);
constexpr int CW_TMO = 0, CW_CODE = 1, CW_BAR = 4096, CW_Q = 8192;
constexpr size_t CTL_SSQ0 = 256 * 1024, CTL_SSQ1 = 512 * 1024;
constexpr int RING_OFF = 0, LDS_BYTES = 163840, MISC_OFF = LDS_BYTES - 1024;
static_assert(WS_VB - WS_KB == WS_KB - WS_QB && WS_CI - WS_CK == WS_CK - WS_CQ, "equally spaced buffer groups (addressed arithmetically in the in-projection epilogue)");
#define DI __device__ __forceinline__
typedef float f32x16 __attribute__((ext_vector_type(16)));
typedef short s16x4 __attribute__((ext_vector_type(4)));
typedef short v4i16_t __attribute__((ext_vector_type(4)));
typedef float f32x2v __attribute__((ext_vector_type(2)));
typedef unsigned u32x2v __attribute__((ext_vector_type(2)));
typedef __bf16 bf16x2v __attribute__((ext_vector_type(2)));
#define MFMA32(a, b, c) __builtin_amdgcn_mfma_f32_32x32x16_bf16((a), (b), (c), 0, 0, 0)
DI unsigned cvtpk2(float lo, float hi) { f32x2v v = {lo, hi}; bf16x2v b = __builtin_convertvector(v, bf16x2v); return __builtin_bit_cast(unsigned, b); }
DI float bf2f(bf16 u) { return __uint_as_float((unsigned)u << 16); }
DI float bflo(unsigned w) { return __uint_as_float(w << 16); }
DI float bfhi(unsigned w) { return __uint_as_float(w & 0xffff0000u); }
DI int crow(int r, int h) { return (r & 3) + 8 * (r >> 2) + 4 * h; }
DI float shx(float v, int mask, int lane) { return __builtin_bit_cast(float, __builtin_amdgcn_ds_bpermute((lane ^ mask) << 2, __builtin_bit_cast(int, v))); }
DI float wave_sum(float v, int lane) {
#pragma unroll
    for (int o = 1; o < 64; o <<= 1) v += shx(v, o, lane);
    return v;
}
DI float wave_max(float v, int lane) {
#pragma unroll
    for (int o = 1; o < 64; o <<= 1) v = fmaxf(v, shx(v, o, lane));
    return v;
}
DI s16x4 trd(LAS const unsigned char* p) { return __builtin_bit_cast(s16x4, __builtin_amdgcn_ds_read_tr16_b64_v4i16((LAS v4i16_t*)p)); }
DI int tr_lane_off(int pitch, int lane, bool perm) { const int i16 = lane & 15, q = i16 >> 2, p = i16 & 3, blk = (lane >> 4) & 1, h = lane >> 5; return ((perm ? 4 * h : 8 * h) + q) * pitch + (16 * blk + 4 * p) * 2; }
DI bf16x8 trfrag(LAS const unsigned char* base, int pitch, int k0, int c0, int laneoff, bool perm) {
    LAS const unsigned char* a = base + k0 * pitch + c0 * 2 + laneoff;
    const s16x4 lo = trd(a), hi = trd(a + (perm ? 8 : 4) * pitch);
    return __builtin_shufflevector(lo, hi, 0, 1, 2, 3, 4, 5, 6, 7);
}
DI bf16x8 pack8(const f32x16& x, int s) { v4u p; p.x = cvtpk2(x[8 * s], x[8 * s + 1]); p.y = cvtpk2(x[8 * s + 2], x[8 * s + 3]); p.z = cvtpk2(x[8 * s + 4], x[8 * s + 5]); p.w = cvtpk2(x[8 * s + 6], x[8 * s + 7]); return __builtin_bit_cast(bf16x8, p); }
DI f32x16 zero16() { f32x16 z;
#pragma unroll
    for (int i = 0; i < 16; ++i) z[i] = 0.f; return z; }

struct Args { const float* in[16]; float* out; unsigned char* ws; int ph_lo, ph_hi, imask, pad; };
struct Ctx {
    LAS unsigned char* lds; volatile LAS unsigned* MISC;
    int tid, lane, wave, vcu, G;
};
typedef __attribute__((address_space(4))) const Args* kaptr_t;
DI kaptr_t kargs() { kaptr_t kp = (kaptr_t)__builtin_amdgcn_kernarg_segment_ptr(); asm volatile("" : "+s"(kp)); return kp; }
#define INP(i) (kargs()->in[i])
#define WSP(off) (kargs()->ws + (off))
#define OUTP() (kargs()->out)
DI void p0_transpose_item(const float* W, int K, int N, bf16* WT, const float* gk, LAS float* scr, int item, int lane) {
    const int nblk = N / 32, kb = item / nblk, nb = item % nblk, k0 = 64 * kb, n0 = 32 * nb;
#pragma unroll 8
    for (int i = 0; i < 32; ++i) { const int kk = 2 * i + (lane >> 5); float w = __builtin_nontemporal_load(W + (size_t)(k0 + kk) * N + n0 + (lane & 31)); if (gk) w *= gk[k0 + kk]; scr[kk * 33 + (lane & 31)] = w; }
    LDS_WAIT(); asm volatile("" ::: "memory");
    const int c = lane & 7;
#pragma unroll
    for (int j = 0; j < 4; ++j) { const int n = (lane >> 3) + 8 * j; const LAS float* s = scr + (8 * c) * 33 + n;
        v4u o; o.x = pk2(s[0 * 33], s[1 * 33]); o.y = pk2(s[2 * 33], s[3 * 33]); o.z = pk2(s[4 * 33], s[5 * 33]); o.w = pk2(s[6 * 33], s[7 * 33]);
        *(GAS v4u*)(WT + (size_t)(n0 + n) * K + k0 + 8 * c) = o; }
    LDS_WAIT(); asm volatile("" ::: "memory");
}
DI void p0_prologue(Ctx& C) { const float* const p_qn_g = ((const float*)INP(7)); const float* const p_kn_g = ((const float*)INP(8)); float* const p_LB = ((float*)WSP(WS_LB)); bf16* const p_SGW = ((bf16*)WSP(WS_SGW)); float* const p_SSQ0 = ((float*)WSP(WS_CTL + CTL_SSQ0)); bf16* const p_WIN = ((bf16*)WSP(WS_WIN)); bf16* const p_WOUT = ((bf16*)WSP(WS_WOUT)); bf16* const p_XB = ((bf16*)WSP(WS_XB)); const float* const p_lb_logits = ((const float*)INP(13)); const float* const p_norm_g = ((const float*)INP(5)); const float* const p_sgu_w = ((const float*)INP(11)); const float* const p_w_in = ((const float*)INP(6)); const float* const p_w_out = ((const float*)INP(15)); const float* const p_x_prompt = ((const float*)INP(0)); const float* const p_x_sample = ((const float*)INP(1));
    LAS float* scr = (LAS float*)(C.lds + RING_OFF + C.wave * 16384);
    const int gw = C.vcu * NWAVES + C.wave, NGW = C.G * NWAVES;
    constexpr int I_IN1 = (DM / 64) * (NIN / 32), I_OUT1 = (DMIX / 64) * (DM / 32);
    for (int it = gw; it < I_IN1; it += NGW) p0_transpose_item(p_w_in, DM, NIN, p_WIN, p_norm_g, scr, it, C.lane);
    for (int m = gw; m < MPAD; m += NGW) {
        GAS unsigned long long* o8 = (GAS unsigned long long*)(p_XB + (size_t)m * DM) + C.lane;
        if (m < MPR + MSA) {
            const float* xrow = (m < MPR) ? p_x_prompt + (size_t)m * DM : p_x_sample + (size_t)(m - MPR) * DM;
            const GAS f32x4* xr = (const GAS f32x4*)xrow + C.lane; f32x4 v[4]; float s = 0.f;
#pragma unroll
            for (int j = 0; j < 4; ++j) { v[j] = __builtin_nontemporal_load(xr + 64 * j); s += (v[j].x * v[j].x + v[j].y * v[j].y) + (v[j].z * v[j].z + v[j].w * v[j].w); }
            s = wave_sum(s, C.lane);
#pragma unroll
            for (int j = 0; j < 4; ++j) o8[64 * j] = (unsigned long long)pk2(v[j].x, v[j].y) | ((unsigned long long)pk2(v[j].z, v[j].w) << 32);
            if (C.lane == 0) p_SSQ0[m] = s;
        } else {
#pragma unroll
            for (int j = 0; j < 4; ++j) o8[64 * j] = 0ull;
            if (C.lane == 0) p_SSQ0[m] = 0.f;
        }
    }
    const int gt = C.vcu * 512 + C.tid, NGT = C.G * 512;
    for (int e = gt; e < 2 * 8 * 128 * 128; e += NGT) { const int s = e & 127, t = (e >> 7) & 127; const float w = p_sgu_w[e]; p_SGW[e] = (bf16)f2bf(s <= t ? w : 0.f); }
    for (int e = gt; e < 2 * 768; e += NGT) { const int l = e / 768, c = e - 768 * l; p_LB[(l * 3 + 0) * 768 + c] = p_qn_g[e]; p_LB[(l * 3 + 1) * 768 + c] = p_kn_g[e]; p_LB[(l * 3 + 2) * 768 + c] = (l == 0) ? 0.f : 1.0f / (1.0f + __expf(p_lb_logits[c] - p_lb_logits[768 + c])); }
}

DI void wt_item(const Ctx& C, int item) { const float* const p_w_in = ((const float*)INP(6)); const float* const p_w_out = ((const float*)INP(15)); const float* const p_norm_g = ((const float*)INP(5)); bf16* const p_WIN = ((bf16*)WSP(WS_WIN)); bf16* const p_WOUT = ((bf16*)WSP(WS_WOUT));
    constexpr int I_IN1 = (DM / 64) * (NIN / 32), I_OUT1 = (DMIX / 64) * (DM / 32);
    LAS float* scr = (LAS float*)(C.lds + RING_OFF + C.wave * 16384);
#pragma unroll 1
    for (int rep = 0; rep < 4; ++rep) {
        int it = 32 * item + 8 * rep + C.wave;
        if (it < I_OUT1) { p0_transpose_item(p_w_out, DMIX, DM, p_WOUT, nullptr, scr, it, C.lane); continue; } it -= I_OUT1;
        if (it < I_IN1) p0_transpose_item(p_w_in + (size_t)DM * NIN, DM, NIN, p_WIN + (size_t)NIN * DM, p_norm_g + DM, scr, it, C.lane);
        else if (it < I_IN1 + I_OUT1) p0_transpose_item(p_w_out + (size_t)DMIX * DM, DMIX, DM, p_WOUT + (size_t)DM * DMIX, nullptr, scr, it - I_IN1, C.lane);
    }
}

DI void kvout_item(const Ctx& C, int l, int item) { unsigned char* const ws = WSP(0); const bf16* const p_KH = (const bf16*)(ws + WS_KH); const bf16* const p_VH = (const bf16*)(ws + WS_VH); float* const p_out = OUTP();
    const int b = item >> 5, t0 = (item & 31) * 64, tid = C.tid;
    float* ok = p_out + O_KP + ((size_t)l * MPR + (size_t)b * SEQL + t0) * 768; float* ov = p_out + O_VP + ((size_t)l * MPR + (size_t)b * SEQL + t0) * 768;
#pragma unroll 4
    for (int it = 0; it < 12; ++it) { const int idx = tid + 512 * it, tl = idx / 96, hc = idx - 96 * tl, hh = hc >> 3, ch = hc & 7, t = t0 + tl;
        const size_t so = ((size_t)(((b * 12 + hh) * 16 + (t & 15)) * 128 + (t >> 4))) * 64 + 8 * ch; const size_t dofs = (size_t)tl * 768 + hh * 64 + 8 * ch;
        const v4u k8 = *(const v4u*)(p_KH + so), v8 = *(const v4u*)(p_VH + so);
        *(f32x4*)(ok + dofs) = (f32x4){bflo(k8.x), bfhi(k8.x), bflo(k8.y), bfhi(k8.y)}; *(f32x4*)(ok + dofs + 4) = (f32x4){bflo(k8.z), bfhi(k8.z), bflo(k8.w), bfhi(k8.w)};
        *(f32x4*)(ov + dofs) = (f32x4){bflo(v8.x), bfhi(v8.x), bflo(v8.y), bfhi(v8.y)}; *(f32x4*)(ov + dofs + 4) = (f32x4){bflo(v8.z), bfhi(v8.z), bflo(v8.w), bfhi(v8.w)}; }
}
DI float ex2(float x) { return __builtin_amdgcn_exp2f(x); }
DI float lg2(float x) { return __builtin_amdgcn_logf(x); }

constexpr int AP = 144;
DI void cls_tile(const bf16x8 (&qf)[4], LAS const unsigned char* Kl, LAS const unsigned char* Vl, int kr0, int jstart, int lane, f32x16 (&o)[2], float& lse) {
    const int i = lane & 31, h = lane >> 5;
    o[0] = zero16(); o[1] = zero16();
    constexpr float THR = 6.0f;
    float mrun = 0.f, l = 0.f; bool first = true;
    LAS const unsigned char* kp = Kl + (kr0 + 32 * jstart + i) * AP + 16 * h;
    LAS const unsigned char* vp = Vl + (kr0 + 32 * jstart) * AP + tr_lane_off(AP, lane, true);
#pragma unroll 1
    for (int j = jstart; j < 5; ++j, kp += 32 * AP, vp += 32 * AP) {
        f32x16 st = zero16();
#pragma unroll
        for (int s = 0; s < 4; ++s) st = MFMA32(*(LAS const bf16x8*)(kp + 32 * s), qf[s], st);
        if (j == 0) {
#pragma unroll
            for (int r = 0; r < 16; ++r) if (crow(r, h) < i) st[r] = -1e30f;
        }
        if (j == 4) {
#pragma unroll
            for (int r = 0; r < 16; ++r) if (crow(r, h) > i) st[r] = -1e30f;
        }
        float rm = fmaxf(fmaxf(st[0], st[1]), st[2]);
#pragma unroll
        for (int r = 3; r < 15; r += 2) rm = fmaxf(fmaxf(rm, st[r]), st[r + 1]);
        rm = fmaxf(rm, st[15]);
        rm = fmaxf(rm, shx(rm, 32, lane)) - mrun;
        if (first || __any(rm > THR)) {
            const float delta = first ? rm : fmaxf(rm, 0.f); mrun += delta;
            if (!first) { const float alpha = ex2(-delta); l *= alpha;
#pragma unroll
                for (int r = 0; r < 16; ++r) { o[0][r] *= alpha; o[1][r] *= alpha; } }
            first = false;
        }
        float ps0 = 0.f, ps1 = 0.f;
#pragma unroll
        for (int r = 0; r < 16; r += 2) { st[r] = ex2(st[r] - mrun); st[r + 1] = ex2(st[r + 1] - mrun); ps0 += st[r]; ps1 += st[r + 1]; }
        l += ps0 + ps1;
        const bf16x8 pb0 = pack8(st, 0), pb1 = pack8(st, 1);
#pragma unroll
        for (int db = 0; db < 2; ++db) {
            const s16x4 a0 = trd(vp + 64 * db), a1 = trd(vp + 64 * db + 8 * AP), b0 = trd(vp + 64 * db + 16 * AP), b1 = trd(vp + 64 * db + 24 * AP);
            o[db] = MFMA32(__builtin_shufflevector(a0, a1, 0, 1, 2, 3, 4, 5, 6, 7), pb0, o[db]);
            o[db] = MFMA32(__builtin_shufflevector(b0, b1, 0, 1, 2, 3, 4, 5, 6, 7), pb1, o[db]);
        }
    }
    l += shx(l, 32, lane);
    const float inv = 1.0f / l;
#pragma unroll
    for (int r = 0; r < 16; ++r) { o[0][r] *= inv; o[1][r] *= inv; }
    lse = mrun + lg2(l);
}
DI void cls_store(bf16* Ob, float* Lb, size_t m, int hh, int h, const f32x16 (&o)[2], float lse) {
    bf16* op = Ob + m * 768 + hh * 64 + 4 * h;
#pragma unroll
    for (int db = 0; db < 2; ++db)
#pragma unroll
        for (int g4 = 0; g4 < 4; ++g4) { u32x2v w; w.x = cvtpk2(o[db][4 * g4], o[db][4 * g4 + 1]); w.y = cvtpk2(o[db][4 * g4 + 2], o[db][4 * g4 + 3]); *(u32x2v*)(op + 32 * db + 8 * g4) = w; }
    if (h == 0) Lb[m * 16 + hh] = lse;
}
template <int KIND> DI void att23_item(const Ctx& C, int item) { unsigned char* const ws = WSP(0); const bf16* const p_QB = (const bf16*)(ws + WS_QB); const bf16* const p_KB = (const bf16*)(ws + WS_KH); const bf16* const p_VB = (const bf16*)(ws + WS_VH);
    bf16* const p_O = (bf16*)(ws + (KIND == 2 ? WS_O2 : WS_O3)); float* const p_L = (float*)(ws + (KIND == 2 ? WS_L2 : WS_L3));
    const int up = item & 1, hh = (item >> 1) % 12, b = item / 24, lane = C.lane, wave = C.wave, tid = C.tid, i = lane & 31, h = lane >> 5;
    const size_t rb = (size_t)b * SEQL;
    LAS unsigned char* Kl = C.lds; LAS unsigned char* Vl = C.lds + 512 * AP;
    v4u kr[8], vr[8];
#define A23_TOK(u, row) (KIND == 2 ? (4 * (row) + (u)) : (16 * ((row) & 127) + 4 * (u) + ((row) >> 7)))
#define A23_SRC(u, idx) ((size_t)(((b * 12 + hh) * 16 + (KIND == 2 ? 4 * ((idx) >> 10) + (u) : 4 * (u) + ((idx) >> 10))) * 128 + (((idx) >> 3) & 127)) * 64 + 8 * ((idx) & 7))
#define A23_ROW(idx) (KIND == 2 ? 4 * (((idx) >> 3) & 127) + ((idx) >> 10) : ((idx) >> 3))
#define A23_ISSUE(u) do { _Pragma("unroll") for (int it = 0; it < 8; ++it) { const int idx = tid + 512 * it; const size_t go = A23_SRC(u, idx); \
        kr[it] = *(const v4u*)(p_KB + go); vr[it] = *(const v4u*)(p_VB + go); } } while (0)
    A23_ISSUE(2 * up);
#pragma unroll 1
    for (int u = 2 * up; u < 2 * up + 2; ++u) {
        __syncthreads();
#pragma unroll
        for (int it = 0; it < 8; ++it) { const int idx = tid + 512 * it, row = A23_ROW(idx), ch = idx & 7; *(LAS v4u*)(Kl + row * AP + ch * 16) = kr[it]; *(LAS v4u*)(Vl + row * AP + ch * 16) = vr[it]; }
        __syncthreads();
        int cb0, qa, qb;
        if (KIND == 2) { cb0 = 0; qa = 64 * wave; qb = qa + 32; } else { cb0 = (wave >> 1) * 128; qa = (wave & 1) ? 32 : 0; qb = (wave & 1) ? 64 : 96; }
        const size_t ma = rb + A23_TOK(u, cb0 + qa + i), mb = rb + A23_TOK(u, cb0 + qb + i);
        bf16x8 qfa[4], qfb[4];
#pragma unroll
        for (int s = 0; s < 4; ++s) qfa[s] = *(const bf16x8*)(p_QB + ma * 768 + hh * 64 + 8 * h + 16 * s);
        if (u == 2 * up) A23_ISSUE(u + 1);
        f32x16 o[2]; float lse;
        cls_tile(qfa, Kl + cb0 * AP, Vl + cb0 * AP, qa - 128, qa >= 128 ? 0 : (128 - qa) >> 5, lane, o, lse);
        cls_store(p_O, p_L, ma, hh, h, o, lse);
#pragma unroll
        for (int s = 0; s < 4; ++s) qfb[s] = *(const bf16x8*)(p_QB + mb * 768 + hh * 64 + 8 * h + 16 * s);
        cls_tile(qfb, Kl + cb0 * AP, Vl + cb0 * AP, qb - 128, qb >= 128 ? 0 : (128 - qb) >> 5, lane, o, lse);
        cls_store(p_O, p_L, mb, hh, h, o, lse);
    }
#undef A23_ISSUE
#undef A23_TOK
#undef A23_SRC
#undef A23_ROW
}
DI void att1_item(const Ctx& C, int item) { unsigned char* const ws = WSP(0); const bf16* const p_QB = (const bf16*)(ws + WS_QB); const bf16* const p_KB = (const bf16*)(ws + WS_KH); const bf16* const p_VB = (const bf16*)(ws + WS_VH);
    const bf16* const p_O2 = (const bf16*)(ws + WS_O2); const float* const p_L2 = (const float*)(ws + WS_L2); const bf16* const p_O3 = (const bf16*)(ws + WS_O3); const float* const p_L3 = (const float*)(ws + WS_L3); const bf16* const p_ZB = (const bf16*)(ws + WS_ZB); bf16* const p_YB = (bf16*)(ws + WS_YB);
    const int qtr = item & 3, hh = (item >> 2) % 12, b = item / 48, lane = C.lane, wave = C.wave, tid = C.tid, i = lane & 31, h = lane >> 5;
    const size_t rb = (size_t)b * SEQL;
    LAS unsigned char* Kl = C.lds; LAS unsigned char* Vl = C.lds + 384 * AP;
    v4u kr[6], vr[6];
#define A1_ISSUE(T) do { const int m30_ = 16 * (T) - 8; _Pragma("unroll") for (int it = 0; it < 6; ++it) { const int idx = tid + 512 * it, r16 = idx / 192, rem = idx - 192 * r16; int m3 = m30_ + (rem >> 3); if (m3 < 0) m3 = 0; \
        const size_t go = (size_t)(((b * 12 + hh) * 16 + r16) * 128 + m3) * 64 + 8 * (rem & 7); kr[it] = *(const v4u*)(p_KB + go); vr[it] = *(const v4u*)(p_VB + go); } } while (0)
    A1_ISSUE(2 * qtr);
#pragma unroll 1
    for (int u = 0; u < 2; ++u) {
        const int T = 2 * qtr + u;
        __syncthreads();
#pragma unroll
        for (int it = 0; it < 6; ++it) { const int idx = tid + 512 * it, r16 = idx / 192, rem = idx - 192 * r16, row = 16 * (rem >> 3) + r16, ch = rem & 7; *(LAS v4u*)(Kl + row * AP + ch * 16) = kr[it]; *(LAS v4u*)(Vl + row * AP + ch * 16) = vr[it]; }
        __syncthreads();
        const int tq0 = 256 * T + 32 * wave; const size_t m = rb + tq0 + i;
        bf16x8 qf[4];
#pragma unroll
        for (int s = 0; s < 4; ++s) qf[s] = *(const bf16x8*)(p_QB + m * 768 + hh * 64 + 8 * h + 16 * s);
        const bf16* o2p = p_O2 + m * 768 + hh * 64 + 4 * h; const bf16* o3p = p_O3 + m * 768 + hh * 64 + 4 * h; const bf16* zp = p_ZB + m * 2048 + hh * 64 + 4 * h; bf16* yp = p_YB + m * 2048 + hh * 64 + 4 * h;
        const float l2 = p_L2[m * 16 + hh], l3 = p_L3[m * 16 + hh];
        u32x2v a2[8], a3[8];
#pragma unroll
        for (int c8 = 0; c8 < 8; ++c8) { a2[c8] = *(const u32x2v*)(o2p + 8 * c8); a3[c8] = *(const u32x2v*)(o3p + 8 * c8); }
        if (u < 1) A1_ISSUE(T + 1);
        f32x16 o[2]; float lse;
        cls_tile(qf, Kl, Vl, 32 * wave, tq0 >= 128 ? 0 : (128 - tq0) >> 5, lane, o, lse);
        const float M = fmaxf(lse, fmaxf(l2, l3)), L = M + lg2(ex2(lse - M) + ex2(l2 - M) + ex2(l3 - M));
        const float w1 = ex2(lse - L), w2 = ex2(l2 - L), w3 = ex2(l3 - L);
#pragma unroll
        for (int db = 0; db < 2; ++db)
#pragma unroll
            for (int g4 = 0; g4 < 4; ++g4) { const int c8 = 4 * db + g4; const u32x2v x2 = a2[c8], x3 = a3[c8], z = *(const u32x2v*)(zp + 8 * c8); u32x2v w;
                const float y0 = w1 * o[db][4 * g4] + w2 * bflo(x2.x) + w3 * bflo(x3.x), y1 = w1 * o[db][4 * g4 + 1] + w2 * bfhi(x2.x) + w3 * bfhi(x3.x);
                const float y2 = w1 * o[db][4 * g4 + 2] + w2 * bflo(x2.y) + w3 * bflo(x3.y), y3 = w1 * o[db][4 * g4 + 3] + w2 * bfhi(x2.y) + w3 * bfhi(x3.y);
                w.x = cvtpk2(y0 * bflo(z.x), y1 * bfhi(z.x)); w.y = cvtpk2(y2 * bflo(z.y), y3 * bfhi(z.y)); *(u32x2v*)(yp + 8 * c8) = w; }
    }
#undef A1_ISSUE
}

DI void sgu_item(const Ctx& C, int l, int item) { bf16* const p_BU = ((bf16*)WSP(WS_BU)); bf16* const p_BV = ((bf16*)WSP(WS_BV)); bf16* const p_SGW = ((bf16*)WSP(WS_SGW)); bf16* const p_YB = ((bf16*)WSP(WS_YB)); bf16* const p_ZB = ((bf16*)WSP(WS_ZB)); const float* const p_ln_b = ((const float*)INP(10)); const float* const p_ln_g = ((const float*)INP(9)); const float* const p_sgu_b = ((const float*)INP(12));
    const int b = item >> 4, ch = item & 15, lane = C.lane, wave = C.wave, i = lane & 31, h = lane >> 5; const size_t m0 = (size_t)b * SEQL + ch * 128;
    constexpr int VP = 1040;
    { const f32x4 g0 = *(const f32x4*)(p_ln_g + l * 512 + 8 * lane), g1 = *(const f32x4*)(p_ln_g + l * 512 + 8 * lane + 4), b0 = *(const f32x4*)(p_ln_b + l * 512 + 8 * lane), b1 = *(const f32x4*)(p_ln_b + l * 512 + 8 * lane + 4);
      v4u raw[16]; float s1[16], s2[16];
#pragma unroll
      for (int tt = 0; tt < 16; ++tt) raw[tt] = *(const v4u*)(p_BV + (m0 + 16 * wave + tt) * 512 + 8 * lane);
#pragma unroll
      for (int tt = 0; tt < 16; ++tt) { const v4u r = raw[tt]; const float x0 = bflo(r.x), x1 = bfhi(r.x), x2 = bflo(r.y), x3 = bfhi(r.y), x4 = bflo(r.z), x5 = bfhi(r.z), x6 = bflo(r.w), x7 = bfhi(r.w);
        s1[tt] = ((x0 + x1) + (x2 + x3)) + ((x4 + x5) + (x6 + x7)); s2[tt] = ((x0 * x0 + x1 * x1) + (x2 * x2 + x3 * x3)) + ((x4 * x4 + x5 * x5) + (x6 * x6 + x7 * x7)); }
#pragma unroll
      for (int o = 1; o < 64; o <<= 1) {
#pragma unroll
        for (int tt = 0; tt < 16; ++tt) { s1[tt] += shx(s1[tt], o, lane); s2[tt] += shx(s2[tt], o, lane); } }
#pragma unroll
      for (int tt = 0; tt < 16; ++tt) { const int t = 16 * wave + tt; const v4u r = raw[tt];
        const float mean = s1[tt] * (1.0f / 512.0f), var = fmaxf(s2[tt] * (1.0f / 512.0f) - mean * mean, 0.f), rstd = __builtin_amdgcn_rsqf(var + EPSF);
        float x[8] = {bflo(r.x), bfhi(r.x), bflo(r.y), bfhi(r.y), bflo(r.z), bfhi(r.z), bflo(r.w), bfhi(r.w)};
#pragma unroll
        for (int e = 0; e < 8; ++e) x[e] = (x[e] - mean) * rstd;
        v4u w; w.x = cvtpk2(x[0] * g0[0] + b0[0], x[1] * g0[1] + b0[1]); w.y = cvtpk2(x[2] * g0[2] + b0[2], x[3] * g0[3] + b0[3]);
        w.z = cvtpk2(x[4] * g1[0] + b1[0], x[5] * g1[1] + b1[1]); w.w = cvtpk2(x[6] * g1[2] + b1[2], x[7] * g1[3] + b1[3]);
        *(LAS v4u*)(C.lds + t * VP + lane * 16) = w; } }
    __syncthreads();
    const int g = wave; const bf16* Wg = p_SGW + (size_t)((l * 8 + g) * 128) * 128; const int troff = tr_lane_off(VP, lane, false);
#pragma unroll
    for (int tb = 0; tb < 4; ++tb) {
        f32x16 acc[2]; acc[0] = zero16(); acc[1] = zero16();
#pragma unroll
        for (int ks = 0; ks < 2 * tb + 2; ++ks) {
            const bf16x8 wf = *(const bf16x8*)(Wg + (32 * tb + i) * 128 + 16 * ks + 8 * h);
#pragma unroll
            for (int cb = 0; cb < 2; ++cb) acc[cb] = MFMA32(trfrag(C.lds, VP, 16 * ks, 64 * g + 32 * cb, troff, false), wf, acc[cb]);
        }
        const int t = 32 * tb + i; const float bias = p_sgu_b[(l * 8 + g) * 128 + t]; const size_t m = m0 + t;
#pragma unroll
        for (int cb = 0; cb < 2; ++cb)
#pragma unroll
            for (int g4 = 0; g4 < 4; ++g4) { const int c0 = 64 * g + 32 * cb + 8 * g4 + 4 * h;
                const u32x2v u = *(const u32x2v*)(p_BU + m * 512 + c0), z = *(const u32x2v*)(p_ZB + m * 2048 + 768 + c0); u32x2v w;
                w.x = cvtpk2(bflo(u.x) * (acc[cb][4 * g4] + bias) * bflo(z.x), bfhi(u.x) * (acc[cb][4 * g4 + 1] + bias) * bfhi(z.x));
                w.y = cvtpk2(bflo(u.y) * (acc[cb][4 * g4 + 2] + bias) * bflo(z.y), bfhi(u.y) * (acc[cb][4 * g4 + 3] + bias) * bfhi(z.y));
                *(u32x2v*)(p_YB + m * 2048 + 768 + c0) = w; }
    }
}

DI void hgp_item(const Ctx& C, int l, int item) { unsigned char* const ws = WSP(0); const bf16* const p_CK = (const bf16*)(ws + WS_CK); const bf16* const p_CI = (const bf16*)(ws + WS_CI); const float* const p_DJ = (const float*)(ws + WS_DJ); float* const p_SNAP = (float*)(ws + WS_DS); float* const p_out = OUTP();
    const int bh = item, b = bh / 6, hh = bh % 6, tid = C.tid, lane = C.lane, wave = C.wave, i = lane & 31, h = lane >> 5;
    constexpr int PT = 272, TB = 32 * PT, BUF = 2 * TB;
    LAS unsigned char* L = C.lds;
    const int row = tid >> 4, chn = tid & 15, kb = wave >> 1, vb0 = 2 * (wave & 1), troff = tr_lane_off(PT, lane, false);
    const size_t g0 = ((size_t)b * SEQL + row) * 768 + hh * 128 + chn * 8;
    const float* djp = p_DJ + ((size_t)b * 64) * 768 + hh * 128 + 32 * kb + i;
    v4u kreg = *(const v4u*)(p_CK + g0), vreg = *(const v4u*)(p_CI + g0); float djn = djp[0];
    *(LAS v4u*)(L + row * PT + chn * 16) = kreg; *(LAS v4u*)(L + TB + row * PT + chn * 16) = vreg;
    __syncthreads();
    f32x16 acc[2]; acc[0] = zero16(); acc[1] = zero16();
#pragma unroll 1
    for (int j = 0; j < 64; ++j) {
        LAS const unsigned char* cur = L + (j & 1) * BUF; LAS unsigned char* nxt = L + ((j + 1) & 1) * BUF;
        const float dj = djn;
        if (j < 63) { const size_t g = g0 + (size_t)(32 * (j + 1)) * 768; kreg = *(const v4u*)(p_CK + g); vreg = *(const v4u*)(p_CI + g); djn = djp[(size_t)(j + 1) * 768]; }
#pragma unroll
        for (int s2 = 0; s2 < 2; ++s2) { const bf16x8 kfr = trfrag(cur, PT, 16 * s2, 32 * kb, troff, false);
#pragma unroll
            for (int j2 = 0; j2 < 2; ++j2) acc[j2] = MFMA32(trfrag(cur + TB, PT, 16 * s2, 32 * (vb0 + j2), troff, false), kfr, acc[j2]); }
#pragma unroll
        for (int r = 0; r < 16; ++r) { acc[0][r] *= dj; acc[1][r] *= dj; }
        if ((j & 15) == 15) {
            float* dst = (j == 63) ? p_out + O_HP + (size_t)(l * 48 + bh) * 16384 : p_SNAP + (size_t)(bh * 3 + (j >> 4)) * 16384;
            dst += (size_t)(32 * kb + i) * 128 + 4 * h;
#pragma unroll
            for (int j2 = 0; j2 < 2; ++j2)
#pragma unroll
                for (int g4 = 0; g4 < 4; ++g4) *(f32x4*)(dst + 32 * (vb0 + j2) + 8 * g4) = (f32x4){acc[j2][4 * g4], acc[j2][4 * g4 + 1], acc[j2][4 * g4 + 2], acc[j2][4 * g4 + 3]};
        }
        if (j < 63) { *(LAS v4u*)(nxt + row * PT + chn * 16) = kreg; *(LAS v4u*)(nxt + TB + row * PT + chn * 16) = vreg; }
        __syncthreads();
    }
}
DI void hg3_item(const Ctx& C, int l, int item) { unsigned char* const ws = WSP(0); const bf16* const p_CE = (const bf16*)(ws + WS_CE); const float* const p_DJ = (const float*)(ws + WS_DJ); const bf16* const p_CI = (const bf16*)(ws + WS_CI); const bf16* const p_CK = (const bf16*)(ws + WS_CK); const bf16* const p_CQ = (const bf16*)(ws + WS_CQ); const float* const p_SNAP = (const float*)(ws + WS_DS); bf16* const p_YB = (bf16*)(ws + WS_YB); const bf16* const p_ZB = (const bf16*)(ws + WS_ZB); const float* const p_hn_g = ((const float*)INP(14));
    const int qt = item & 3, bh = item >> 2, b = bh / 6, hh = bh % 6, tid = C.tid, lane = C.lane, wave = C.wave, i = lane & 31, h = lane >> 5;
    constexpr int PT = 272, MB = 128 * PT;
    LAS unsigned char *QT = C.lds, *KD = C.lds + MB, *VV = C.lds + 2 * MB, *SB = C.lds + 3 * MB;
    LAS float* RS = (LAS float*)(C.lds + 4 * MB);
    f32x16 sacc[4];
    const int kb = wave & 3;
    if (wave >= 4) {
        if (qt == 0) {
#pragma unroll
            for (int vb = 0; vb < 4; ++vb) { sacc[vb] = zero16();
#pragma unroll
                for (int g4 = 0; g4 < 4; ++g4) *(LAS u32x2v*)(SB + (32 * kb + i) * PT + (32 * vb + 8 * g4 + 4 * h) * 2) = (u32x2v){0u, 0u}; }
        } else {
            const float* sp = p_SNAP + (size_t)(bh * 3 + qt - 1) * 16384 + (size_t)(32 * kb + i) * 128 + 4 * h;
#pragma unroll
            for (int vb = 0; vb < 4; ++vb)
#pragma unroll
                for (int g4 = 0; g4 < 4; ++g4) { const f32x4 tt = *(const f32x4*)(sp + 32 * vb + 8 * g4); sacc[vb][4 * g4] = tt[0]; sacc[vb][4 * g4 + 1] = tt[1]; sacc[vb][4 * g4 + 2] = tt[2]; sacc[vb][4 * g4 + 3] = tt[3];
                    u32x2v w; w.x = cvtpk2(tt[0], tt[1]); w.y = cvtpk2(tt[2], tt[3]); *(LAS u32x2v*)(SB + (32 * kb + i) * PT + (32 * vb + 8 * g4 + 4 * h) * 2) = w; }
        }
    }
    const int tro_n = tr_lane_off(PT, lane, false), tro_p = tr_lane_off(PT, lane, true);
    v4u rq[4], re[4], rk[4], rv[4];
#define HG3_ISSUE(sgx) do { const size_t mm_ = (size_t)b * SEQL + (4 * qt + (sgx)) * 128; _Pragma("unroll") for (int it = 0; it < 4; ++it) { const int idx = tid + 512 * it, row = idx >> 4, chn = idx & 15; \
        const size_t go = (mm_ + row) * 768 + hh * 128 + chn * 8; rq[it] = *(const v4u*)(p_CQ + go); re[it] = *(const v4u*)(p_CE + go); rk[it] = *(const v4u*)(p_CK + go); rv[it] = *(const v4u*)(p_CI + go); } } while (0)
#define HG3_FILL() do { _Pragma("unroll") for (int it = 0; it < 4; ++it) { const int idx = tid + 512 * it, row = idx >> 4, chn = idx & 15; const v4u q8 = rq[it], e8 = re[it]; v4u w; \
            w.x = cvtpk2(bflo(q8.x) * bflo(e8.x), bfhi(q8.x) * bfhi(e8.x)); w.y = cvtpk2(bflo(q8.y) * bflo(e8.y), bfhi(q8.y) * bfhi(e8.y)); \
            w.z = cvtpk2(bflo(q8.z) * bflo(e8.z), bfhi(q8.z) * bfhi(e8.z)); w.w = cvtpk2(bflo(q8.w) * bflo(e8.w), bfhi(q8.w) * bfhi(e8.w)); \
            *(LAS v4u*)(QT + row * PT + chn * 16) = w; *(LAS v4u*)(KD + row * PT + chn * 16) = rk[it]; *(LAS v4u*)(VV + row * PT + chn * 16) = rv[it]; } } while (0)
    HG3_ISSUE(0);
    if (wave < 4) {
        const int vb = wave;
#pragma unroll 1
        for (int sg = 0; sg < 4; ++sg) {
            const size_t m0 = (size_t)b * SEQL + (4 * qt + sg) * 128;
            HG3_FILL();
            if (sg < 3) HG3_ISSUE(sg + 1);
            __syncthreads();
#pragma unroll 1
            for (int j = 0; j < 4; ++j) {
                u32x2v zr[4]; f32x4 gnv[4];
#pragma unroll
                for (int g4 = 0; g4 < 4; ++g4) { zr[g4] = *(const u32x2v*)(p_ZB + (m0 + 32 * j + i) * 2048 + 1280 + hh * 128 + 32 * vb + 8 * g4 + 4 * h); gnv[g4] = *(const f32x4*)(p_hn_g + l * 768 + hh * 128 + 32 * vb + 8 * g4 + 4 * h); }
                bf16x8 qfr[8];
#pragma unroll
                for (int ks = 0; ks < 8; ++ks) qfr[ks] = *(LAS const bf16x8*)(QT + (32 * j + i) * PT + (16 * ks + 8 * h) * 2);
                f32x16 x = zero16();
#pragma unroll
                for (int ks = 0; ks < 8; ++ks) x = MFMA32(*(LAS const bf16x8*)(KD + (32 * j + i) * PT + (16 * ks + 8 * h) * 2), qfr[ks], x);
#pragma unroll
                for (int r = 0; r < 16; ++r) if (crow(r, h) > i) x[r] = 0.f;
                const bf16x8 pb0 = pack8(x, 0), pb1 = pack8(x, 1);
                f32x16 oa = zero16();
#pragma unroll
                for (int ks = 0; ks < 8; ++ks) oa = MFMA32(trfrag(SB, PT, 16 * ks, 32 * vb, tro_n, false), qfr[ks], oa);
                oa = MFMA32(trfrag(VV, PT, 32 * j, 32 * vb, tro_p, true), pb0, oa);
                oa = MFMA32(trfrag(VV, PT, 32 * j + 16, 32 * vb, tro_p, true), pb1, oa);
                float ss = 0.f;
#pragma unroll
                for (int r = 0; r < 16; ++r) ss += oa[r] * oa[r];
                ss += shx(ss, 32, lane);
                if (h == 0) RS[vb * 32 + i] = ss;
                __syncthreads();
                const float tot = RS[i] + RS[32 + i] + RS[64 + i] + RS[96 + i], rstd = __builtin_amdgcn_rsqf(tot * (1.0f / 128.0f) + EPSF);
                const size_t m = m0 + 32 * j + i;
#pragma unroll
                for (int g4 = 0; g4 < 4; ++g4) { const int v0 = hh * 128 + 32 * vb + 8 * g4 + 4 * h; const f32x4 gn = gnv[g4]; const u32x2v z = zr[g4]; u32x2v w;
                    w.x = cvtpk2(oa[4 * g4] * rstd * gn[0] * bflo(z.x), oa[4 * g4 + 1] * rstd * gn[1] * bfhi(z.x)); w.y = cvtpk2(oa[4 * g4 + 2] * rstd * gn[2] * bflo(z.y), oa[4 * g4 + 3] * rstd * gn[3] * bfhi(z.y));
                    *(u32x2v*)(p_YB + m * 2048 + 1280 + v0) = w; }
                __syncthreads();
            }
        }
    } else {
#pragma unroll 1
        for (int sg = 0; sg < 4; ++sg) {
            const size_t m0 = (size_t)b * SEQL + (4 * qt + sg) * 128;
            HG3_FILL();
            float dv[4];
#pragma unroll
            for (int j = 0; j < 4; ++j) dv[j] = p_DJ[((m0 >> 5) + j) * 768 + hh * 128 + 32 * kb + i];
            if (sg < 3) HG3_ISSUE(sg + 1);
            __syncthreads();
#pragma unroll 1
            for (int j = 0; j < 4; ++j) {
#pragma unroll
                for (int s2 = 0; s2 < 2; ++s2) { const bf16x8 kfr = trfrag(KD, PT, 32 * j + 16 * s2, 32 * kb, tro_n, false);
#pragma unroll
                    for (int vb = 0; vb < 4; ++vb) sacc[vb] = MFMA32(trfrag(VV, PT, 32 * j + 16 * s2, 32 * vb, tro_n, false), kfr, sacc[vb]); }
                const float d = (j == 0) ? dv[0] : (j == 1 ? dv[1] : (j == 2 ? dv[2] : dv[3]));
#pragma unroll
                for (int vb = 0; vb < 4; ++vb)
#pragma unroll
                    for (int r = 0; r < 16; ++r) sacc[vb][r] *= d;
                __syncthreads();
#pragma unroll
                for (int vb = 0; vb < 4; ++vb)
#pragma unroll
                    for (int g4 = 0; g4 < 4; ++g4) { u32x2v w; w.x = cvtpk2(sacc[vb][4 * g4], sacc[vb][4 * g4 + 1]); w.y = cvtpk2(sacc[vb][4 * g4 + 2], sacc[vb][4 * g4 + 3]); *(LAS u32x2v*)(SB + (32 * kb + i) * PT + (32 * vb + 8 * g4 + 4 * h) * 2) = w; }
                __syncthreads();
            }
        }
    }
#undef HG3_ISSUE
#undef HG3_FILL
}
DI void samp_attn_item(const Ctx& C, int l, int item) { const float* const p_cache_k = ((const float*)INP(2)); const float* const p_cache_v = ((const float*)INP(3)); bf16* const p_QB = ((bf16*)WSP(WS_QB)); bf16* const p_KB = ((bf16*)WSP(WS_KB)); bf16* const p_VB = ((bf16*)WSP(WS_VB)); bf16* const p_ZB = ((bf16*)WSP(WS_ZB)); bf16* const p_YB = ((bf16*)WSP(WS_YB));
    const int b = item / 12, hh = item % 12, wave = C.wave, lane = C.lane, tid = C.tid; const size_t row = MPR + b;
    LAS float* sc = (LAS float*)C.lds;
    LAS float* po = sc + 400;
    const float* ck = p_cache_k + ((size_t)(l * 32 + b) * 2048) * 768 + hh * 64; const float* cv = p_cache_v + ((size_t)(l * 32 + b) * 2048) * 768 + hh * 64;
    const int grp = tid >> 4, dl = 4 * (tid & 15);
    const u32x2v qraw = *(const u32x2v*)(p_QB + row * 768 + hh * 64 + dl); const float q0 = bflo(qraw.x), q1 = bfhi(qraw.x), q2 = bflo(qraw.y), q3 = bfhi(qraw.y);
    const u32x2v knraw = *(const u32x2v*)(p_KB + row * 768 + hh * 64 + dl);
    const f32x4 knew = (f32x4){bflo(knraw.x), bfhi(knraw.x), bflo(knraw.y), bfhi(knraw.y)};
    f32x4 kv[13];
#pragma unroll
    for (int it = 0; it < 13; ++it) { int slot = 32 * it + grp; if (slot > 386) slot = 386; const int pp = slot / 129, jj = slot - 129 * pp, idx = 2048 - (jj << (2 * pp));
        kv[it] = knew; if (idx < 2048) kv[it] = __builtin_nontemporal_load((const f32x4*)(ck + (size_t)idx * 768 + dl)); }
#pragma unroll
    for (int it = 0; it < 13; ++it) { const int slot = 32 * it + grp;
        float part = (q0 * kv[it][0] + q1 * kv[it][1]) + (q2 * kv[it][2] + q3 * kv[it][3]);
        part += shx(part, 1, lane); part += shx(part, 2, lane); part += shx(part, 4, lane); part += shx(part, 8, lane);
        if ((tid & 15) == 0 && slot < 387) sc[slot] = part; }
    __syncthreads();
    float mx = -1e30f;
    for (int t = lane; t < 387; t += 64) mx = fmaxf(mx, sc[t]);
    mx = wave_max(mx, lane);
    float sm = 0.f;
    for (int t = lane; t < 387; t += 64) sm += ex2(sc[t] - mx);
    sm = wave_sum(sm, lane);
    const u32x2v vnraw = *(const u32x2v*)(p_VB + row * 768 + hh * 64 + dl);
    const f32x4 vnewv = (f32x4){bflo(vnraw.x), bfhi(vnraw.x), bflo(vnraw.y), bfhi(vnraw.y)};
    f32x4 vv[13];
#pragma unroll
    for (int it = 0; it < 13; ++it) { int slot = 32 * it + grp; if (slot > 386) slot = 386; const int pp = slot / 129, jj = slot - 129 * pp, idx = 2048 - (jj << (2 * pp));
        vv[it] = vnewv; if (idx < 2048) vv[it] = __builtin_nontemporal_load((const f32x4*)(cv + (size_t)idx * 768 + dl)); }
    f32x4 o4 = (f32x4){0.f, 0.f, 0.f, 0.f};
#pragma unroll
    for (int it = 0; it < 13; ++it) { const int slot = 32 * it + grp; if (slot < 387) o4 += vv[it] * ex2(sc[slot] - mx); }
#pragma unroll
    for (int e = 0; e < 4; ++e) { o4[e] += shx(o4[e], 16, lane); o4[e] += shx(o4[e], 32, lane); }
    if (lane < 16) *(LAS f32x4*)(po + wave * 64 + dl) = o4;
    __syncthreads();
    if (wave == 0) { float t = 0.f;
#pragma unroll
        for (int w = 0; w < 8; ++w) t += po[w * 64 + lane];
        t *= 1.0f / sm;
        p_YB[row * 2048 + hh * 64 + lane] = (bf16)f2bf(t * bf2f(p_ZB[row * 2048 + hh * 64 + lane])); }
}
DI void samp_sgu_item(const Ctx& C, int l, int item) { bf16* const p_BU = ((bf16*)WSP(WS_BU)); bf16* const p_BV = ((bf16*)WSP(WS_BV)); bf16* const p_YB = ((bf16*)WSP(WS_YB)); bf16* const p_ZB = ((bf16*)WSP(WS_ZB)); const float* const p_ln_b = ((const float*)INP(10)); const float* const p_ln_g = ((const float*)INP(9)); float* const p_out = OUTP(); const float* const p_sgu_b = ((const float*)INP(12)); const float* const p_sgu_w = ((const float*)INP(11));
    const int b = 8 * item + C.wave, lane = C.lane; const size_t row = MPR + b;
    const v4u raw = *(const v4u*)(p_BV + row * 512 + 8 * lane);
    float x[8] = {bflo(raw.x), bfhi(raw.x), bflo(raw.y), bfhi(raw.y), bflo(raw.z), bfhi(raw.z), bflo(raw.w), bfhi(raw.w)};
    float s = 0.f;
#pragma unroll
    for (int e = 0; e < 8; ++e) s += x[e];
    const float mean = wave_sum(s, lane) * (1.0f / 512.0f); float q = 0.f;
#pragma unroll
    for (int e = 0; e < 8; ++e) { x[e] -= mean; q += x[e] * x[e]; }
    const float rstd = __builtin_amdgcn_rsqf(wave_sum(q, lane) * (1.0f / 512.0f) + EPSF);
    const int g = lane >> 3; const float w00 = p_sgu_w[(size_t)((l * 8 + g) * 128) * 128], bb = p_sgu_b[(l * 8 + g) * 128];
    const v4u ur = *(const v4u*)(p_BU + row * 512 + 8 * lane), zr = *(const v4u*)(p_ZB + row * 2048 + 768 + 8 * lane);
    const float uu[8] = {bflo(ur.x), bfhi(ur.x), bflo(ur.y), bfhi(ur.y), bflo(ur.z), bfhi(ur.z), bflo(ur.w), bfhi(ur.w)};
    const float zz[8] = {bflo(zr.x), bfhi(zr.x), bflo(zr.y), bfhi(zr.y), bflo(zr.z), bfhi(zr.z), bflo(zr.w), bfhi(zr.w)};
    float vn[8], y[8];
#pragma unroll
    for (int e = 0; e < 8; ++e) { vn[e] = x[e] * rstd * p_ln_g[l * 512 + 8 * lane + e] + p_ln_b[l * 512 + 8 * lane + e]; y[e] = uu[e] * (w00 * vn[e] + bb) * zz[e]; }
    float* od = p_out + O_SGU + (size_t)(l * 32 + b) * 512 + 8 * lane;
    *(f32x4*)od = (f32x4){vn[0], vn[1], vn[2], vn[3]}; *(f32x4*)(od + 4) = (f32x4){vn[4], vn[5], vn[6], vn[7]};
    v4u w; w.x = cvtpk2(y[0], y[1]); w.y = cvtpk2(y[2], y[3]); w.z = cvtpk2(y[4], y[5]); w.w = cvtpk2(y[6], y[7]);
    *(v4u*)(p_YB + row * 2048 + 768 + 8 * lane) = w;
}
DI void samp_hgrn_item(const Ctx& C, int l, int item) { bf16* const p_CE = ((bf16*)WSP(WS_CE)); bf16* const p_CI = ((bf16*)WSP(WS_CI)); bf16* const p_CK = ((bf16*)WSP(WS_CK)); bf16* const p_CQ = ((bf16*)WSP(WS_CQ)); bf16* const p_YB = ((bf16*)WSP(WS_YB)); bf16* const p_ZB = ((bf16*)WSP(WS_ZB)); const float* const p_hn_g = ((const float*)INP(14)); float* const p_out = OUTP(); const float* const p_state = ((const float*)INP(4));
    const int b = item / 6, hh = item % 6, tid = C.tid; const size_t row = MPR + b;
    LAS float* qs = (LAS float*)C.lds; LAS float* eg = qs + 128; LAS float* kx = eg + 128; LAS float* vv = kx + 128; LAS float* po = vv + 128; LAS float* ov = po + 2048; LAS float* pr = ov + 128;
    if (tid < 128) { const size_t o = row * 768 + hh * 128 + tid; qs[tid] = bf2f(p_CQ[o]); eg[tid] = bf2f(p_CE[o]); kx[tid] = bf2f(p_CK[o]); vv[tid] = bf2f(p_CI[o]); }
    __syncthreads();
    const int v4 = (tid & 31) * 4, kq = tid >> 5;
    const f32x4 vloc = *(LAS const f32x4*)(vv + v4); f32x4 acc = (f32x4){0.f, 0.f, 0.f, 0.f};
    const float* S0 = p_state + (size_t)((l * 32 + b) * 6 + hh) * 16384; float* S1 = p_out + O_HS + (size_t)((l * 32 + b) * 6 + hh) * 16384;
#pragma unroll
    for (int kk = 0; kk < 8; ++kk) { const int k = 8 * kq + kk; const f32x4 s = __builtin_nontemporal_load((const f32x4*)(S0 + k * 128 + v4)); const f32x4 sn = s * eg[k] + vloc * kx[k]; __builtin_nontemporal_store(sn, (f32x4*)(S1 + k * 128 + v4)); acc += sn * qs[k]; }
    *(LAS f32x4*)(po + kq * 128 + v4) = acc;
    __syncthreads();
    float o = 0.f;
    if (tid < 128) {
#pragma unroll
        for (int q4 = 0; q4 < 16; ++q4) o += po[q4 * 128 + tid];
        const float ss = wave_sum(o * o, C.lane); if (C.lane == 0) pr[C.wave] = ss; }
    __syncthreads();
    if (tid < 128) { const float rstd = __builtin_amdgcn_rsqf((pr[0] + pr[1]) * (1.0f / 128.0f) + EPSF);
        p_YB[row * 2048 + 1280 + hh * 128 + tid] = (bf16)f2bf(o * rstd * p_hn_g[l * 768 + hh * 128 + tid] * bf2f(p_ZB[row * 2048 + 1280 + hh * 128 + tid])); }
}
DI void samp_out_item(const Ctx& C, int l, int item) { const float* const p_x_sample = ((const float*)INP(1)); float* const p_SSQ1 = ((float*)WSP(WS_CTL + CTL_SSQ1)); bf16* const p_WOUT = ((bf16*)WSP(WS_WOUT)); float* const p_X1 = ((float*)WSP(WS_X1)); bf16* const p_XB = ((bf16*)WSP(WS_XB)); bf16* const p_YB = ((bf16*)WSP(WS_YB)); float* const p_out = OUTP();
    const int lane = C.lane, wave = C.wave, i = lane & 31, h = lane >> 5, n0 = 32 * item;
    const bf16* A = p_YB + (size_t)(MPR + i) * 2048 + 256 * wave + 8 * h; const bf16* B = p_WOUT + ((size_t)l * DM + n0 + i) * 2048 + 256 * wave + 8 * h;
    f32x16 acc = zero16();
#pragma unroll
    for (int ks = 0; ks < 16; ++ks) acc = MFMA32(*(const bf16x8*)(A + 16 * ks), *(const bf16x8*)(B + 16 * ks), acc);
    LAS float* red = (LAS float*)C.lds;
#pragma unroll
    for (int r = 0; r < 16; ++r) red[(wave * 16 + r) * 64 + lane] = acc[r];
    __syncthreads();
    const int tl = C.tid & 63, i2 = tl & 31, h2 = tl >> 5;
#pragma unroll
    for (int e = 0; e < 2; ++e) { const int r = (C.tid >> 6) * 2 + e; float s = 0.f;
#pragma unroll
        for (int w = 0; w < 8; ++w) s += red[(w * 16 + r) * 64 + tl];
        const int bb = crow(r, h2), n = n0 + i2;
        if (l == 0) { const float o = p_x_sample[(size_t)bb * DM + n] + s; p_XB[(size_t)(MPR + bb) * DM + n] = (bf16)f2bf(o);
            float ss = o * o; ss += shx(ss, 1, lane); ss += shx(ss, 2, lane); ss += shx(ss, 4, lane); ss += shx(ss, 8, lane); ss += shx(ss, 16, lane);
            if (i2 == 0) atomicAdd(p_SSQ1 + MPR + bb, ss); }
        else { p_out[O_YS + (size_t)bb * DM + n] = bf2f(p_XB[(size_t)(MPR + bb) * DM + n]) + s; } }
}
DI int fetch_item(Ctx& C, int q) { gu32* const p_ctl = ((gu32*)WSP(WS_CTL));
    __syncthreads();
    if (C.tid == 0) C.MISC[0] = __hip_atomic_fetch_add((unsigned*)(p_ctl + CW_Q + 64 * q), 1u, __ATOMIC_RELAXED, __HIP_MEMORY_SCOPE_AGENT);
    __syncthreads();
    const int it = (int)C.MISC[0];
    { int t_ = C.tid; asm volatile("" : "+v"(t_)); C.tid = t_; C.lane = t_ & 63; C.wave = __builtin_amdgcn_readfirstlane(t_ >> 6);
      LAS unsigned char* lp_ = C.lds; asm volatile("" : "+s"(lp_)); C.lds = lp_; C.MISC = (volatile LAS unsigned*)(lp_ + MISC_OFF); }
    return it;
}
#ifndef G1_STAGGER_TICKS
#define G1_STAGGER_TICKS 0
#endif
#ifndef RPT_PHASE
#define RPT_PHASE -1
#define RPT_N 0
#endif
#ifndef RPT_IMASK
#define RPT_IMASK 0xffff
#endif
#ifndef RPT_MASK
#define RPT_MASK 0
#endif
#ifndef PH_MASK
#define PH_MASK 2047
#endif
constexpr int N_ATT = 384, N_HG = 192, N_HGP = 48, N_A1 = 384, N_SGU = 128, N_SAT = 384, N_SHG = 192, N_SSG = 4;
constexpr int N_M1 = N_HGP + N_ATT + N_SAT + N_SGU + N_SHG + N_SSG, N_WT = 184, N_KVO = 0;
constexpr int N_SOUT = 32;

template <int KIND, int L> DI void run_kind(Ctx& C, int im, int bx_) {
    constexpr int l = L;
    if constexpr (KIND == 0) { p0_prologue(C); }
    else if constexpr (KIND == 1) {
        pg8::Gemm g{((bf16*)WSP(WS_XB)), ((bf16*)WSP(WS_WIN)) + (size_t)l * NIN * DM, MPAD, NIN, DM}; pg8::StaticOrder S; S.init(MPAD, NIN, NGRID, bx_);
        pg8::EpiProj E{l == 0 ? ((float*)WSP(WS_CTL + CTL_SSQ0)) : ((float*)WSP(WS_CTL + CTL_SSQ1)), ((float*)WSP(WS_LB)) + l * 3 * 768, WSP(0), OUTP(), l, (im & 2048) ? 0 : 1,
                       WS_QB, WS_KB - WS_QB, WS_ZB, WS_BU, WS_BV - WS_BU, WS_CQ, WS_CK - WS_CQ, WS_CE, WS_DJ, WS_KH, WS_VH - WS_KH,
                       O_KP + (size_t)l * MPR * 768, O_VP - O_KP, O_KS + (size_t)l * 32 * 768, O_VS - O_KS};
#if G1_STAGGER_TICKS > 0
        { const unsigned long long t0 = __builtin_amdgcn_s_memrealtime(), dt = (unsigned long long)((bx_ >> 3) & 3) * G1_STAGGER_TICKS;
          while (__builtin_amdgcn_s_memrealtime() - t0 < dt) __builtin_amdgcn_s_sleep(8); }
#endif
        pg8::gemm_phase<pg8::EpiProj, pg8::StaticOrder, true, true>(C.lds + RING_OFF, g, S, E);
    } else if constexpr (KIND == 2) {
        for (;;) { int it = fetch_item(C, 3 * l + 0); if (it >= N_M1 + N_KVO + (l == 0 ? N_WT : 0)) break;
            if (it < N_HGP) { if (im & 8) hgp_item(C, l, it); continue; } it -= N_HGP;
            if (it < N_ATT) { if (im & 4) { if (it < 192) att23_item<2>(C, it); else att23_item<3>(C, it - 192); } continue; } it -= N_ATT;
            if (it < N_SAT) { if (im & 16) samp_attn_item(C, l, it); continue; } it -= N_SAT;
            if (it < N_SGU) { if (im & 32) sgu_item(C, l, it); continue; } it -= N_SGU;
            if (it < N_SHG) { if (im & 64) samp_hgrn_item(C, l, it); continue; } it -= N_SHG;
            if (it < N_SSG) { if (im & 128) samp_sgu_item(C, l, it); continue; } it -= N_SSG;
            if (it < N_KVO) { if (im & 128) kvout_item(C, l, it); continue; } it -= N_KVO;
            if (im & 128) wt_item(C, it); }
    } else if constexpr (KIND == 4) {
        for (;;) { int it = fetch_item(C, 3 * l + 2); if (it >= N_HG + N_A1 + N_SOUT) break;
            if (it < N_A1) { if (im & 512) att1_item(C, it); continue; } it -= N_A1;
            if (it < N_HG) { if (im & 256) hg3_item(C, l, it); continue; } it -= N_HG;
            if (im & 1024) samp_out_item(C, l, it); }
    } else {
        pg8::Gemm g{((bf16*)WSP(WS_YB)), ((bf16*)WSP(WS_WOUT)) + (size_t)l * DM * DMIX, MPR, DM, DMIX}; pg8::StaticOrder S; S.init(MPR, DM, NGRID, bx_);
        pg8::EpiOut E{l == 0 ? ((const float*)INP(0)) : nullptr, l == 0 ? nullptr : ((bf16*)WSP(WS_XB)), l == 0 ? nullptr : (OUTP()) + O_YP, l == 0 ? ((bf16*)WSP(WS_XB)) : nullptr, l == 0 ? ((float*)WSP(WS_CTL + CTL_SSQ1)) : nullptr};
        pg8::gemm_phase<pg8::EpiOut, pg8::StaticOrder, true, true>(C.lds + RING_OFF, g, S, E);
    }
}

__global__ void __launch_bounds__(NWAVES * 64, 2) mega_fwd(Args args) {
    extern __shared__ __attribute__((aligned(16))) unsigned char lds[];
    Ctx C;
    C.lds = (LAS unsigned char*)lds; C.MISC = (volatile LAS unsigned*)(C.lds + MISC_OFF);
    C.tid = threadIdx.x; C.lane = C.tid & 63; C.wave = __builtin_amdgcn_readfirstlane(C.tid >> 6);
    C.G = NGRID; C.vcu = 0;
    for (int u = C.tid; u < (LDS_BYTES - MISC_OFF) / 4; u += NWAVES * 64) ((LAS unsigned*)(C.lds + MISC_OFF))[u] = 0u;
    __syncthreads();
    XcdBarrier bar; bar.bar = (unsigned*)(((gu32*)WSP(WS_CTL)) + CW_BAR); bar.x = 0; bar.st = nullptr;
    if (N_LAUNCHES == 1) bar = xcd_barrier_post((unsigned*)(((gu32*)WSP(WS_CTL)) + CW_BAR), C.MISC + 8);
    const int lo = args.ph_lo, hi = args.ph_hi, im = args.imask;
    const int wave_s = __builtin_amdgcn_readfirstlane(threadIdx.x >> 6);
#define RELAUNDER() do { int t_ = (wave_s << 6) | (int)__builtin_amdgcn_mbcnt_hi(~0u, __builtin_amdgcn_mbcnt_lo(~0u, 0u)); asm volatile("" : "+v"(t_)); C.tid = t_; C.lane = t_ & 63; C.wave = __builtin_amdgcn_readfirstlane(t_ >> 6); \
        LAS unsigned char* lp_ = (LAS unsigned char*)lds; asm volatile("" : "+s"(lp_)); C.lds = lp_; C.MISC = (volatile LAS unsigned*)(lp_ + MISC_OFF); } while (0)
#define PHASE(p, KIND, L) if (lo <= (p) && (p) < hi) { RELAUNDER(); int bx_ = blockIdx.x; asm volatile("" : "+s"(bx_)); C.vcu = (bx_ & 7) * (NGRID >> 3) + (bx_ >> 3); run_kind<KIND, L>(C, im, bx_); \
        if (N_LAUNCHES == 1 && (p) + 1 < hi) { XcdBarrier b2; b2.bar = (unsigned*)(((gu32*)WSP(WS_CTL)) + CW_BAR); unsigned x2_ = bar.x; asm volatile("" : "+s"(x2_)); b2.x = x2_; b2.st = C.MISC + 8; xcd_barrier(b2); } }
    PHASE(0, 0, 0)
    PHASE(1, 1, 0) PHASE(2, 2, 0) PHASE(3, 4, 0) PHASE(4, 5, 0)
    PHASE(5, 1, 1) PHASE(6, 2, 1) PHASE(7, 4, 1) PHASE(8, 5, 1)
#undef PHASE
#undef RELAUNDER
}

extern "C" void kernel_launch(void* const* d_in, const int* in_sizes, int n_in, void* d_out, int out_size, void* d_ws, size_t ws_size, hipStream_t stream) {
    static int grid = 0;
    if (grid == 0) {
        if (n_in != 16 || (size_t)out_size != O_END || ws_size < WS_END) { fprintf(stderr, "kernel_launch: unexpected shapes: n_in %d out %d ws %zu (need %zu)\n", n_in, out_size, ws_size, (size_t)WS_END); grid = -1; return; }
        int dev = 0, cus = 0, per_cu = 0;
        if (hipGetDevice(&dev) != hipSuccess || hipDeviceGetAttribute(&cus, hipDeviceAttributeMultiprocessorCount, dev) != hipSuccess) { grid = -1; return; }
        if (hipFuncSetAttribute((const void*)mega_fwd, hipFuncAttributeMaxDynamicSharedMemorySize, LDS_BYTES) != hipSuccess) { fprintf(stderr, "kernel_launch: hipFuncSetAttribute failed\n"); grid = -1; return; }
        if (hipOccupancyMaxActiveBlocksPerMultiprocessor(&per_cu, (const void*)mega_fwd, NWAVES * 64, LDS_BYTES) != hipSuccess || per_cu < 1) { fprintf(stderr, "kernel_launch: occupancy query says %d\n", per_cu); (void)hipGetLastError(); per_cu = 1; }
        if (cus < NGRID) { fprintf(stderr, "kernel_launch: %d CUs < %d workgroups: not co-resident\n", cus, NGRID); grid = -1; return; }
        grid = NGRID;
    }
    if (grid < 0) return;
    (void)hipMemsetAsync((char*)d_ws + WS_CTL, 0, CTL_ZERO_BYTES, stream);
    Args a{};
    for (int i = 0; i < 16; ++i) a.in[i] = (const float*)d_in[i];
    a.out = (float*)d_out; a.ws = (unsigned char*)d_ws; a.imask = 0xffff;
    if (N_LAUNCHES == 1) { a.ph_lo = 0; a.ph_hi = N_PHASES; hipLaunchKernelGGL(mega_fwd, dim3(grid), dim3(NWAVES * 64), LDS_BYTES, stream, a); }
    else for (int p = 0; p < N_PHASES; ++p) { a.ph_lo = p; a.ph_hi = p + 1;
        const int nl = 1 + ((p == RPT_PHASE) ? RPT_N : 0);
        for (int r = 0; r < nl; ++r) {
            if (r > 0 && p >= 1) { const int l = (p - 1) / 4, k = (p - 1) % 4; if (k == 1 || k == 2) (void)hipMemsetAsync((char*)d_ws + WS_CTL + (size_t)(CW_Q + 64 * (3 * l + (k == 1 ? 0 : 2))) * 4, 0, 4, stream); }
            a.imask = (r > 0) ? RPT_IMASK : 0xffff;
            hipLaunchKernelGGL(mega_fwd, dim3(grid), dim3(NWAVES * 64), LDS_BYTES, stream, a); } }
}
```

```cpp
#include <hip/hip_runtime.h>
#include <cstdio>
#include <cstdint>
namespace pg8 {
#define PG8_LAS __attribute__((address_space(3)))
typedef unsigned short bf16_t;
typedef short bf16x8 __attribute__((ext_vector_type(8)));
typedef float f32x4 __attribute__((ext_vector_type(4)));
typedef unsigned u32x4 __attribute__((ext_vector_type(4)));
constexpr int BM = 256, BK = 64, HALF = 128, HTB = HALF * BK * 2  , STAGE_BYTES = 8 * HTB, NXCD = 8, WGM = 8;

__host__ __device__ __forceinline__ int lds_byte(int r, int c) { const int st = (r >> 4) * 2 + (c >> 5), rr = r & 15, cc = c & 31, ob = rr * 64 + cc * 2; return st * 1024 + (ob ^ (((ob >> 9) & 1) << 5)); }
__host__ __device__ __forceinline__ void stage_rc(int b, int& R, int& C) { const int st = b / 1024, sb = b % 1024, swz = sb ^ (((sb >> 9) & 1) << 5); R = (st >> 1) * 16 + swz / 64; C = (st & 1) * 32 + (swz % 64) / 2; }
__host__ __device__ __forceinline__ int perm32(int rho) { const int n = rho >> 4, i = rho & 15; return 8 * (i >> 2) + 4 * n + (i & 3); }

struct Unit { int pm, pn; };
struct Gemm { const bf16_t* A; const bf16_t* Bt; int M, N, K; };

struct StaticOrder {
    int nM, nN, nwg, G, c;
    __host__ __device__ void init(int M, int N, int G_, int c_) { nM = M / BM; nN = N / BM; nwg = nM * nN; G = G_; c = c_; }
    __host__ __device__ bool next(int i, Unit& u) const {
        const long L = (long)i * G + c; if (L >= nwg) return false;
        int wgid = (int)L; { const int q = nwg / NXCD, r = nwg % NXCD, xcd = wgid % NXCD, off = wgid / NXCD; wgid = (xcd < r ? xcd * (q + 1) : r * (q + 1) + (xcd - r) * q) + off; }
        const int nig = WGM * nN, gid = wgid / nig, fm = gid * WGM, gsz = (nM - fm) < WGM ? (nM - fm) : WGM;
        u.pm = fm + ((wgid % nig) % gsz); u.pn = (wgid % nig) / gsz; return true;
    }
    __device__ __forceinline__ void a_ready(const Unit&) const {}
    __device__ __forceinline__ void done(const Unit&) const {}
};


typedef float f32x2 __attribute__((ext_vector_type(2)));
typedef unsigned u32x2 __attribute__((ext_vector_type(2)));
typedef __bf16 bf16x2_t __attribute__((ext_vector_type(2)));
__device__ __forceinline__ unsigned cvtpk(float lo, float hi) { f32x2 v = {lo, hi}; bf16x2_t b = __builtin_convertvector(v, bf16x2_t); return __builtin_bit_cast(unsigned, b); }
__device__ __forceinline__ float fast_sigmoid(float x) { return __builtin_amdgcn_rcpf(1.0f + __expf(-x)); }
__device__ __forceinline__ float silu_f(float x) { return x * fast_sigmoid(x); }

template <int CTRL> __device__ __forceinline__ float dpp_f(float x) { return __builtin_bit_cast(float, __builtin_amdgcn_update_dpp(0, __builtin_bit_cast(int, x), CTRL, 0xf, 0xf, false)); }
template <int CTRL> __device__ __forceinline__ float dpp_f1(float x) { return __builtin_bit_cast(float, __builtin_amdgcn_update_dpp(0x3f800000, __builtin_bit_cast(int, x), CTRL, 0xf, 0xf, false)); }
__device__ __forceinline__ float row_prefprod16(float x) { x *= dpp_f1<0x111>(x); x *= dpp_f1<0x112>(x); x *= dpp_f1<0x114>(x); x *= dpp_f1<0x118>(x); return x; }
__device__ __forceinline__ float row_prefix16(float x) { x += dpp_f<0x111>(x); x += dpp_f<0x112>(x); x += dpp_f<0x114>(x); x += dpp_f<0x118>(x); return x; }
struct EpiProj {
    static constexpr bool PERM = true, AFTER_DRAIN = false, HEADPERM = true;
    const float* ssq;
    const float* gtab;
    unsigned char* ws; float* out; int l; int skip;
    size_t o_qkv, s_qkv, o_zb, o_bu, s_bu, o_cq, s_cq, o_ce, o_dj, o_kh, s_kh;
    size_t o_kp, s_kp, o_ks, s_ks;
    __device__ __forceinline__ void st8(bf16_t* p, const f32x4& a, const f32x4& b) const {
        u32x4 w; w.x = cvtpk(a[0], a[1]); w.y = cvtpk(a[2], a[3]); w.z = cvtpk(b[0], b[1]); w.w = cvtpk(b[2], b[3]); *(u32x4*)p = w; }
    __device__ __forceinline__ void operator()(const f32x4 (&acc)[2][2][4][2], const Unit& u, int wr, int wc, int fr, int fq) const {
        if (skip) return;
        const int pn = u.pn;
        int seg, seg0;
        if (pn < 12) { seg = pn / 3; seg0 = seg * 3; }
        else if (pn < 18) { seg = 4 + (pn - 12) / 2; seg0 = 12 + (seg - 4) * 2; }
        else { seg = 7 + (pn - 18) / 3; seg0 = 18 + (seg - 7) * 3; }
        const int cl = (pn - seg0) * 256 + wc * 64 + 8 * fq;
        const int rowb = u.pm * BM + wr * 64 + fr;
        const bool sample = (u.pm == 64);
        f32x4 gv[2][2];
        { const int gi = (seg == 0) ? 0 : (seg == 1 ? 1 : 2); const float* gp = gtab + gi * 768 + (seg == 0 || seg == 1 || seg == 8 ? cl : 0);
#pragma unroll
          for (int bj = 0; bj < 2; ++bj)
#pragma unroll
              for (int n = 0; n < 2; ++n) gv[bj][n] = *(const f32x4*)(gp + 32 * bj + 4 * n); }
        if (seg == 8) {
            const int lane_hi15 = ((fq << 4) | 15);
            float rsc[2][4];
#pragma unroll
            for (int ai = 0; ai < 2; ++ai)
#pragma unroll
                for (int m = 0; m < 4; ++m) rsc[ai][m] = ssq[rowb + ai * HALF + m * 16];
#pragma unroll
            for (int ai = 0; ai < 2; ++ai)
#pragma unroll
                for (int mp = 0; mp < 2; ++mp) {
                    const int rowA = rowb + ai * HALF + mp * 32, rowB = rowA + 16;
                    const float rsA = __builtin_amdgcn_rsqf(rsc[ai][2 * mp] * (1.0f / 1024.0f) + 1e-6f), rsB = __builtin_amdgcn_rsqf(rsc[ai][2 * mp + 1] * (1.0f / 1024.0f) + 1e-6f);
#pragma unroll
                    for (int bj = 0; bj < 2; ++bj) {
                        f32x4 eA[2], eB[2], kA[2], kB[2], dl[2];
#pragma unroll
                        for (int n = 0; n < 2; ++n)
#pragma unroll
                            for (int e = 0; e < 4; ++e) { const float lbv = gv[bj][n][e], omlb = 1.0f - lbv;
                                const float sa = fast_sigmoid(acc[ai][bj][2 * mp][n][e] * rsA), sb = fast_sigmoid(acc[ai][bj][2 * mp + 1][n][e] * rsB);
                                float ka = omlb - omlb * sa, kb = omlb - omlb * sb, pa = lbv + omlb * sa, pb = lbv + omlb * sb;
                                if (!sample) { pa = row_prefprod16(pa); const float t0 = __shfl(pa, lane_hi15); pb = row_prefprod16(pb) * t0; dl[n][e] = __shfl(pb, lane_hi15);
                                    ka *= __builtin_amdgcn_rcpf(pa); kb *= __builtin_amdgcn_rcpf(pb); }
                                eA[n][e] = pa; eB[n][e] = pb; kA[n][e] = ka; kB[n][e] = kb; }
                        bf16_t* dkA = (bf16_t*)(ws + o_cq + s_cq) + (size_t)rowA * 768 + cl + 32 * bj; bf16_t* deA = (bf16_t*)(ws + o_ce) + (size_t)rowA * 768 + cl + 32 * bj;
                        st8(dkA, kA[0], kA[1]); st8(dkA + 16 * 768, kB[0], kB[1]); st8(deA, eA[0], eA[1]); st8(deA + 16 * 768, eB[0], eB[1]);
                        if (!sample && fr == 0) { float* dd = (float*)(ws + o_dj) + (size_t)(rowA >> 5) * 768 + cl + 32 * bj; *(f32x4*)dd = dl[0]; *(f32x4*)(dd + 4) = dl[1]; }
                    }
                    asm volatile("" ::: "memory");
                }
            return;
        }
        float rsv[2][4];
#pragma unroll
        for (int ai = 0; ai < 2; ++ai)
#pragma unroll
            for (int m = 0; m < 4; ++m) rsv[ai][m] = ssq[rowb + ai * HALF + m * 16];
#pragma unroll
        for (int ai = 0; ai < 2; ++ai)
#pragma unroll
            for (int m = 0; m < 4; ++m) {
                const int row = rowb + ai * HALF + m * 16;
                const float rs = __builtin_amdgcn_rsqf(rsv[ai][m] * (1.0f / 1024.0f) + 1e-6f);
                f32x4 v[2][2];
#pragma unroll
                for (int bj = 0; bj < 2; ++bj)
#pragma unroll
                    for (int n = 0; n < 2; ++n) v[bj][n] = acc[ai][bj][m][n] * rs;
                if (seg <= 1) {
                    float ss = 0.f;
#pragma unroll
                    for (int bj = 0; bj < 2; ++bj)
#pragma unroll
                        for (int n = 0; n < 2; ++n) { const f32x4 x = v[bj][n]; ss += (x[0] * x[0] + x[1] * x[1]) + (x[2] * x[2] + x[3] * x[3]); }
                    ss += __shfl_xor(ss, 16); ss += __shfl_xor(ss, 32);
                    float r2 = __builtin_amdgcn_rsqf(ss * (1.0f / 64.0f) + 1e-6f);
                    if (seg == 0) r2 *= 0.125f * 1.4426950408889634f;
#pragma unroll
                    for (int bj = 0; bj < 2; ++bj)
#pragma unroll
                        for (int n = 0; n < 2; ++n) v[bj][n] = v[bj][n] * gv[bj][n] * r2;
                }
                if (seg <= 2) {
                    if (seg == 0 || sample) {
                        bf16_t* dst = (bf16_t*)(ws + o_qkv + (size_t)seg * s_qkv) + (size_t)row * 768 + cl;
#pragma unroll
                        for (int bj = 0; bj < 2; ++bj) st8(dst + 32 * bj, v[bj][0], v[bj][1]);
                    } else {
                        const int t = row & 2047, bb = row >> 11, head = cl >> 6;
                        bf16_t* dst = (bf16_t*)(ws + o_kh + (size_t)(seg - 1) * s_kh) + ((size_t)(((bb * 12 + head) * 16 + (t & 15)) * 128 + (t >> 4))) * 64 + (cl & 63);
#pragma unroll
                        for (int bj = 0; bj < 2; ++bj) st8(dst + 32 * bj, v[bj][0], v[bj][1]);
                    }
                    if (seg >= 1) {
                        const bool okp = !sample, oks = sample && (row - 16384 < 32);
                        float* o = out + (okp ? o_kp + (size_t)(seg - 1) * s_kp + (size_t)row * 768 : o_ks + (size_t)(seg - 1) * s_ks + (size_t)(row - 16384) * 768) + cl;
                        if (okp || oks) {
#pragma unroll
                            for (int bj = 0; bj < 2; ++bj) { __builtin_nontemporal_store(v[bj][0], (f32x4*)(o + 32 * bj)); __builtin_nontemporal_store(v[bj][1], (f32x4*)(o + 32 * bj + 4)); }
                        }
                    }
                } else if (seg == 3 || seg == 6 || seg == 10 || seg == 7) {
#pragma unroll
                    for (int bj = 0; bj < 2; ++bj)
#pragma unroll
                        for (int n = 0; n < 2; ++n)
#pragma unroll
                            for (int e = 0; e < 4; ++e) v[bj][n][e] = silu_f(v[bj][n][e]);
                    const size_t zo = (seg == 7) ? o_cq + ((size_t)row * 768 + cl) * 2 : o_zb + ((size_t)row * 2048 + (seg == 3 ? 0 : (seg == 6 ? 768 : 1280)) + cl) * 2;
                    bf16_t* dst = (bf16_t*)(ws + zo);
#pragma unroll
                    for (int bj = 0; bj < 2; ++bj) st8(dst + 32 * bj, v[bj][0], v[bj][1]);
                } else if (seg == 4 || seg == 5) {
                    bf16_t* dst = (bf16_t*)(ws + o_bu + (size_t)(seg - 4) * s_bu) + (size_t)row * 512 + cl;
#pragma unroll
                    for (int bj = 0; bj < 2; ++bj) st8(dst + 32 * bj, v[bj][0], v[bj][1]);
                } else if (seg == 9) {
                    bf16_t* dst = (bf16_t*)(ws + o_cq + 2 * s_cq) + (size_t)row * 768 + cl;
#pragma unroll
                    for (int bj = 0; bj < 2; ++bj) st8(dst + 32 * bj, v[bj][0], v[bj][1]);
                }
                asm volatile("" ::: "memory");
            }
    }
};
struct EpiOut {
    static constexpr bool PERM = false, AFTER_DRAIN = false, HEADPERM = false;
    const float* res; const bf16_t* resb; float* out; bf16_t* xb; float* ssq;
    __device__ __forceinline__ f32x4 ldres(size_t off) const {
        if (res) return __builtin_nontemporal_load((const f32x4*)(res + off));
        const u32x2 w = *(const u32x2*)(resb + off); return (f32x4){__uint_as_float(w.x << 16), __uint_as_float(w.x & 0xffff0000u), __uint_as_float(w.y << 16), __uint_as_float(w.y & 0xffff0000u)}; }
    __device__ __forceinline__ void operator()(const f32x4 (&acc)[2][2][4][2], const Unit& u, int wr, int wc, int fr, int fq) const {
        const int col0 = u.pn * BM + wc * 32 + 4 * fq;
        const size_t off0 = (size_t)(u.pm * BM + wr * 64 + fr) * 1024 + col0;
        f32x4 rcur[2][2], rnxt[2][2];
#pragma unroll
        for (int bj = 0; bj < 2; ++bj)
#pragma unroll
            for (int n = 0; n < 2; ++n) rcur[bj][n] = ldres(off0 + bj * HALF + n * 16);
#pragma unroll
        for (int it = 0; it < 8; ++it) {
            const int ai = it >> 2, m = it & 3;
            const int row = u.pm * BM + ai * HALF + wr * 64 + m * 16 + fr; const size_t off = (size_t)row * 1024 + col0; float ss = 0.f;
            if (it < 7) { const int ai2 = (it + 1) >> 2, m2 = (it + 1) & 3; const size_t offn = off0 + (size_t)(ai2 * HALF + m2 * 16) * 1024;
#pragma unroll
                for (int bj = 0; bj < 2; ++bj)
#pragma unroll
                    for (int n = 0; n < 2; ++n) rnxt[bj][n] = ldres(offn + bj * HALF + n * 16); }
#pragma unroll
            for (int bj = 0; bj < 2; ++bj)
#pragma unroll
                for (int n = 0; n < 2; ++n) { const f32x4 o = rcur[bj][n] + acc[ai][bj][m][n];
                    if (out) __builtin_nontemporal_store(o, (f32x4*)(out + off + bj * HALF + n * 16));
                    ss += (o[0] * o[0] + o[1] * o[1]) + (o[2] * o[2] + o[3] * o[3]);
                    if (xb) { u32x2 w; w.x = cvtpk(o[0], o[1]); w.y = cvtpk(o[2], o[3]); *(u32x2*)(xb + off + bj * HALF + n * 16) = w; } }
            if (ssq) { ss += __shfl_xor(ss, 16); ss += __shfl_xor(ss, 32); if (fq == 0) atomicAdd(ssq + row, ss); }
#pragma unroll
            for (int bj = 0; bj < 2; ++bj)
#pragma unroll
                for (int n = 0; n < 2; ++n) rcur[bj][n] = rnxt[bj][n];
        }
    }
};
template <class Epi, class Sched, bool ALIGN_EPI = false, bool SP2 = false>
__device__ __forceinline__ void gemm_phase(PG8_LAS unsigned char* lds, const Gemm g, const Sched& S, const Epi& E) {
    int tid_ = threadIdx.x; asm volatile("" : "+v"(tid_));
    const int tid = tid_, wid = __builtin_amdgcn_readfirstlane(tid >> 6), lane = tid & 63, wr = wid >> 2, wc = wid & 3, fr = lane & 15, fq = lane >> 4;
    const int K = g.K, nt = K / BK;
    unsigned voffA[2], voffB[2];
#pragma unroll
    for (int i = 0; i < 2; ++i) { int R, C; stage_rc(tid * 16 + i * 8192, R, C); const int Rb = Epi::HEADPERM ? (64 * (R >> 5) + perm32(R & 31)) : (Epi::PERM ? ((R & ~31) + perm32(R & 31)) : R);
        voffA[i] = (unsigned)(R * K + C) * 2u; voffB[i] = (unsigned)(Rb * K + C) * 2u; }
    const size_t kstep = (size_t)(BK * 2);
    const size_t hstep = (size_t)HALF * K * 2;
    const size_t tstep = 2 * hstep; const size_t hstepB = Epi::HEADPERM ? (size_t)32 * K * 2 : hstep;
    const unsigned ldsw = (unsigned)wid * 1024u;
    const int aoff = lds_byte(wr * 64 + fr, fq * 8), boff = lds_byte(wc * 32 + fr, fq * 8);
#define PG8_SA(b, h) (((b) * 2 + (h)) * HTB)
#define PG8_SB(b, h) ((4 + (b) * 2 + (h)) * HTB)
#define PG8_STAGE(bufoff, gbase, voff) do { _Pragma("unroll") for (int _i = 0; _i < 2; ++_i) \
        __builtin_amdgcn_global_load_lds((const unsigned*)((const char*)(gbase) + (voff)[_i]), (PG8_LAS unsigned*)(lds + (bufoff) + ldsw + _i * 8192), 16, 0, 0); } while (0)
#define PG8_LDA(dst, b, h) do { _Pragma("unroll") for (int m = 0; m < 4; ++m) _Pragma("unroll") for (int k = 0; k < 2; ++k) dst[m][k] = *(const PG8_LAS bf16x8*)(lds + PG8_SA(b, h) + aoff + m * 2048 + k * 1024); } while (0)
#define PG8_LDB(dst, b, h) do { _Pragma("unroll") for (int n = 0; n < 2; ++n) _Pragma("unroll") for (int k = 0; k < 2; ++k) dst[n][k] = *(const PG8_LAS bf16x8*)(lds + PG8_SB(b, h) + boff + n * 2048 + k * 1024); } while (0)
#define PG8_MMA(ai, bj, At, Bt) do { __builtin_amdgcn_s_setprio(1); _Pragma("unroll") for (int m = 0; m < 4; ++m) _Pragma("unroll") for (int n = 0; n < 2; ++n) _Pragma("unroll") for (int k = 0; k < 2; ++k) \
        acc[ai][bj][m][n] = __builtin_amdgcn_mfma_f32_16x16x32_bf16(Bt[n][k], At[m][k], acc[ai][bj][m][n], 0, 0, 0); __builtin_amdgcn_s_setprio(0); } while (0)
#define PG8_WAIT_V(n) asm volatile("s_waitcnt vmcnt(" #n ")" ::: "memory")
#define PG8_WAIT_L(n) asm volatile("s_waitcnt lgkmcnt(" #n ")" ::: "memory")
#define PG8_BAR __builtin_amdgcn_s_barrier()
#define PG8_SCHED __builtin_amdgcn_sched_barrier(0)
    Unit cur, nxt; int ui = 0;
    if (!S.next(0, cur)) return;
    f32x4 acc[2][2][4][2];
#pragma unroll
    for (int a = 0; a < 2; ++a)
#pragma unroll
        for (int b = 0; b < 2; ++b)
#pragma unroll
            for (int m = 0; m < 4; ++m)
#pragma unroll
                for (int n = 0; n < 2; ++n) acc[a][b][m][n] = (f32x4){0.f, 0.f, 0.f, 0.f};
    bf16x8 At[4][2], B0[2][2], B1[2][2];
    const char* cA = (const char*)g.A + (size_t)cur.pm * tstep; const char* cB = (const char*)g.Bt + (size_t)cur.pn * tstep;
    S.a_ready(cur);
    if constexpr (SP2) {
        PG8_STAGE(PG8_SB(0, 0), cB, voffB); PG8_STAGE(PG8_SB(0, 1), cB + hstepB, voffB); PG8_STAGE(PG8_SA(0, 0), cA, voffA); PG8_STAGE(PG8_SA(0, 1), cA + hstep, voffA);
        if (wr == 1) PG8_BAR;
        PG8_WAIT_V(2); PG8_BAR;
        PG8_STAGE(PG8_SB(1, 0), cB + kstep, voffB); PG8_STAGE(PG8_SA(1, 0), cA + kstep, voffA); PG8_STAGE(PG8_SB(1, 1), cB + hstepB + kstep, voffB);
        PG8_WAIT_V(6); PG8_BAR;
    } else {
        PG8_STAGE(PG8_SB(0, 0), cB, voffB); PG8_STAGE(PG8_SA(0, 0), cA, voffA); PG8_STAGE(PG8_SB(0, 1), cB + hstepB, voffB); PG8_STAGE(PG8_SA(0, 1), cA + hstep, voffA);
        if (wr == 1) PG8_BAR;
        PG8_WAIT_V(4); PG8_BAR;
        PG8_STAGE(PG8_SB(1, 0), cB + kstep, voffB); PG8_STAGE(PG8_SA(1, 0), cA + kstep, voffA); PG8_STAGE(PG8_SB(1, 1), cB + hstepB + kstep, voffB);
        PG8_WAIT_V(6); PG8_BAR;
    }
    for (;;) {
        const bool has_next = S.next(ui + 1, nxt);
        const char* nA = has_next ? (const char*)g.A + (size_t)nxt.pm * tstep : cA; const char* nB = has_next ? (const char*)g.Bt + (size_t)nxt.pn * tstep : cB;
        for (int t = 0; t < nt; t += 2) {
            const bool last = (t == nt - 2);
            const char* a1 = cA + (size_t)(t + 1) * kstep;
            const char* a2 = last ? nA : cA + (size_t)(t + 2) * kstep; const char* b2 = last ? nB : cB + (size_t)(t + 2) * kstep;
            const char* a3 = a2 + kstep; const char* b3 = b2 + kstep;
            if (last && has_next) S.a_ready(nxt);
            if constexpr (SP2) {
            PG8_LDB(B0, 0, 0); PG8_LDB(B1, 0, 1); PG8_SCHED; PG8_LDA(At, 0, 0); PG8_STAGE(PG8_SA(1, 1), a1 + hstep, voffA);
            PG8_WAIT_V(8); PG8_WAIT_L(0); PG8_BAR; PG8_MMA(0, 0, At, B0); PG8_MMA(0, 1, At, B1); PG8_BAR; PG8_SCHED;
            PG8_LDA(At, 0, 1); PG8_STAGE(PG8_SB(0, 0), b2, voffB); PG8_STAGE(PG8_SB(0, 1), b2 + hstepB, voffB); PG8_STAGE(PG8_SA(0, 0), a2, voffA);
            PG8_WAIT_V(8); PG8_WAIT_L(0); PG8_BAR; PG8_MMA(1, 0, At, B0); PG8_MMA(1, 1, At, B1); PG8_BAR; PG8_SCHED;
            PG8_LDB(B0, 1, 0); PG8_LDB(B1, 1, 1); PG8_SCHED; PG8_LDA(At, 1, 0); PG8_STAGE(PG8_SA(0, 1), a2 + hstep, voffA);
            PG8_WAIT_V(8); PG8_WAIT_L(0); PG8_BAR; PG8_MMA(0, 0, At, B0); PG8_MMA(0, 1, At, B1); PG8_BAR; PG8_SCHED;
            PG8_LDA(At, 1, 1); PG8_STAGE(PG8_SB(1, 0), b3, voffB); PG8_STAGE(PG8_SB(1, 1), b3 + hstepB, voffB); PG8_STAGE(PG8_SA(1, 0), a3, voffA);
            PG8_WAIT_V(8); PG8_WAIT_L(0); PG8_BAR; PG8_MMA(1, 0, At, B0); PG8_MMA(1, 1, At, B1); PG8_BAR; PG8_SCHED;
            } else {
            PG8_LDB(B0, 0, 0); PG8_SCHED; PG8_LDA(At, 0, 0); PG8_STAGE(PG8_SA(1, 1), a1 + hstep, voffA);
            PG8_WAIT_L(8); PG8_BAR; PG8_WAIT_L(0); PG8_MMA(0, 0, At, B0); PG8_BAR; PG8_SCHED;
            PG8_LDB(B1, 0, 1); PG8_STAGE(PG8_SB(0, 0), b2, voffB);
            PG8_BAR; PG8_WAIT_L(0); PG8_MMA(0, 1, At, B1); PG8_BAR;
            PG8_LDA(At, 0, 1); PG8_STAGE(PG8_SA(0, 0), a2, voffA);
            PG8_BAR; PG8_WAIT_L(0); PG8_MMA(1, 0, At, B0); PG8_BAR; PG8_SCHED;
            PG8_STAGE(PG8_SB(0, 1), b2 + hstepB, voffB);
            PG8_WAIT_V(6); PG8_BAR; PG8_MMA(1, 1, At, B1); PG8_BAR;
            PG8_LDB(B0, 1, 0); PG8_SCHED; PG8_LDA(At, 1, 0); PG8_STAGE(PG8_SA(0, 1), a2 + hstep, voffA);
            PG8_WAIT_L(8); PG8_BAR; PG8_WAIT_L(0); PG8_MMA(0, 0, At, B0); PG8_BAR; PG8_SCHED;
            PG8_LDB(B1, 1, 1); PG8_STAGE(PG8_SB(1, 0), b3, voffB);
            PG8_BAR; PG8_WAIT_L(0); PG8_MMA(0, 1, At, B1); PG8_BAR;
            PG8_LDA(At, 1, 1); PG8_STAGE(PG8_SA(1, 0), a3, voffA);
            PG8_BAR; PG8_WAIT_L(0); PG8_MMA(1, 0, At, B0); PG8_BAR; PG8_SCHED;
            PG8_STAGE(PG8_SB(1, 1), b3 + hstepB, voffB);
            PG8_WAIT_V(6); PG8_BAR; PG8_MMA(1, 1, At, B1); PG8_BAR;
            }
        }
        if constexpr (ALIGN_EPI) { if (wr == 0) PG8_BAR; }
        if constexpr (!Epi::AFTER_DRAIN) { E(acc, cur, wr, wc, fr, fq); S.done(cur); }
        if (!has_next) break;
#pragma unroll
        for (int a = 0; a < 2; ++a)
#pragma unroll
            for (int b = 0; b < 2; ++b)
#pragma unroll
                for (int m = 0; m < 4; ++m)
#pragma unroll
                    for (int n = 0; n < 2; ++n) acc[a][b][m][n] = (f32x4){0.f, 0.f, 0.f, 0.f};
        cur = nxt; cA = nA; cB = nB; ++ui;
        if constexpr (ALIGN_EPI) { if (wr == 1) PG8_BAR; }
    }
    PG8_WAIT_V(0);
    if constexpr (!ALIGN_EPI) { if (wr == 0) PG8_BAR; }
    PG8_BAR;
    if constexpr (Epi::AFTER_DRAIN) { E.fused(acc, cur, wr, wc, fr, fq, lds, wid, lane); S.done(cur); }
#undef PG8_SA
#undef PG8_SB
#undef PG8_STAGE
#undef PG8_LDA
#undef PG8_LDB
#undef PG8_MMA
#undef PG8_WAIT_V
#undef PG8_WAIT_L
#undef PG8_BAR
#undef PG8_SCHED
}
}
#define GAS __attribute__((address_space(1)))
#define LAS __attribute__((address_space(3)))
typedef unsigned short bf16;
typedef unsigned v4u __attribute__((ext_vector_type(4)));
typedef float f32x4 __attribute__((ext_vector_type(4)));
typedef short bf16x8 __attribute__((ext_vector_type(8)));
typedef GAS unsigned gu32;
typedef GAS unsigned long long gu64;
#define RLX_AGENT __ATOMIC_RELAXED, __HIP_MEMORY_SCOPE_AGENT
#define LDS_WAIT() asm volatile("s_waitcnt lgkmcnt(0)" ::: "memory")
#define VM_WAIT() asm volatile("s_waitcnt vmcnt(0)" ::: "memory")
__device__ __forceinline__ unsigned long long rt() { return __builtin_amdgcn_s_memrealtime(); }
__device__ __forceinline__ unsigned f2bf(float f) { unsigned u = __builtin_bit_cast(unsigned, f); return (u + 0x7fffu + ((u >> 16) & 1u)) >> 16; }
__device__ __forceinline__ unsigned pk2(float lo, float hi) { return f2bf(lo) | (f2bf(hi) << 16); }

#define XB_TMO      128
#define XB_XCNT(j)  (256  + 64 * (j))
#define XB_XSUB(j)  (1280 + 64 * (j))
#define XB_XGEN(j)  (2304 + 64 * (j))
#define XB_TOP      3328
#define XB_TOPGEN   3392
#define XCD_BAR_WORDS 3456
#define XB_SPIN_CAP (1u << 18)

__device__ __forceinline__ unsigned xb_ld(unsigned* p)              { return __hip_atomic_load(p, __ATOMIC_RELAXED, __HIP_MEMORY_SCOPE_AGENT); }
__device__ __forceinline__ unsigned xb_add(unsigned* p, unsigned v) { return __hip_atomic_fetch_add(p, v, __ATOMIC_RELAXED, __HIP_MEMORY_SCOPE_AGENT); }
__device__ __forceinline__ unsigned xb_xcc_id() { return (unsigned)__builtin_amdgcn_s_getreg((3 << 11) | 20) & 0xFu; }
#define XB_SPIN(cond, bar) do { unsigned _sp = 0; while (cond) { __builtin_amdgcn_s_sleep(1); \
    if ((++_sp & 255u) == 0u) { if (xb_ld(&(bar)[XB_TMO])) break; if (_sp > XB_SPIN_CAP) { atomicAdd(&(bar)[XB_TMO], 1u); break; } } } } while (0)

struct XcdBarrier {
    unsigned* bar; unsigned x;
    volatile LAS unsigned* st;
};

__device__ __forceinline__ XcdBarrier xcd_barrier_post(unsigned* bar, volatile LAS unsigned* st) {
    XcdBarrier b; b.bar = bar; b.x = xb_xcc_id(); b.st = st;
    if (threadIdx.x == 0) (void)xb_add(&bar[XB_XCNT(b.x)], 1u);
    return b;
}
__device__ __forceinline__ void xcd_barrier_complete(unsigned* bar, unsigned x, unsigned& nloc, unsigned& nx) {
    const unsigned G = 256u;
    unsigned sum, cnt, mine, sp = 0u;
    for (;;) {
        sum = 0u; cnt = 0u; mine = 0u;
#pragma unroll
        for (unsigned j = 0; j < 16; ++j) { const unsigned c = xb_ld(&bar[XB_XCNT(j)]); sum += c; cnt += (c > 0u) ? 1u : 0u; mine = (j == x) ? c : mine; }
        if (sum == G) break;
        __builtin_amdgcn_s_sleep(1);
        if ((++sp & 255u) == 0u) { if (xb_ld(&bar[XB_TMO])) break; if (sp > XB_SPIN_CAP) { atomicAdd(&bar[XB_TMO], 1u); break; } }
    }
    nloc = mine > 0u ? mine : 1u; nx = cnt > 0u ? cnt : 1u;
}

__device__ __forceinline__ void xcd_barrier(const XcdBarrier& b) {
    asm volatile("s_waitcnt vmcnt(0)" ::: "memory");
    __syncthreads();
    if (threadIdx.x == 0) {
        unsigned* bar = b.bar;
        __builtin_amdgcn_s_waitcnt(0);
        unsigned nloc = b.st[0], nx = b.st[1];
        if (nloc == 0u) { xcd_barrier_complete(bar, b.x, nloc, nx); b.st[0] = nloc; b.st[1] = nx; }
        const unsigned old = xb_add(&bar[XB_XSUB(b.x)], 1u);
        const unsigned gen = old / nloc;
        if (old + 1u == (gen + 1u) * nloc) {
            __builtin_amdgcn_fence(__ATOMIC_RELEASE, "agent");
            asm volatile("s_waitcnt vmcnt(0)" ::: "memory");
            const unsigned og = xb_add(&bar[XB_TOP], 1u);
            const unsigned tg = og / nx;
            if (og + 1u == (tg + 1u) * nx) xb_add(&bar[XB_TOPGEN], 1u);
            else XB_SPIN(xb_ld(&bar[XB_TOPGEN]) == tg, bar);
            __builtin_amdgcn_fence(__ATOMIC_ACQUIRE, "agent");
            xb_add(&bar[XB_XGEN(b.x)], 1u);
            asm volatile("s_waitcnt vmcnt(0)" ::: "memory");
        } else {
            XB_SPIN(xb_ld(&bar[XB_XGEN(b.x)]) == gen, bar);
            __builtin_amdgcn_fence(__ATOMIC_ACQUIRE, "agent");
            asm volatile("s_waitcnt vmcnt(0)" ::: "memory");
        }
    }
    __syncthreads();
}
#ifndef MK_N_LAUNCHES
#define MK_N_LAUNCHES 1
#endif
constexpr int NWAVES = 8, NGRID = 256;
constexpr int N_PHASES = 9;
constexpr int N_LAUNCHES = MK_N_LAUNCHES;
constexpr int DM = 1024, NIN = 7680, DMIX = 2048;
constexpr int MPR = 16384, MSA = 32, MPAD = 16640, SEQL = 2048;
constexpr float EPSF = 1e-6f;
constexpr size_t O_YP = 0, O_YS = 16777216, O_KP = O_YS + 32768, O_VP = O_KP + 25165824, O_KS = O_VP + 25165824, O_VS = O_KS + 49152,
                 O_SGU = O_VS + 49152, O_HP = O_SGU + 32768, O_HS = O_HP + 1572864, O_END = O_HS + 6291456;
constexpr size_t MiB = 1u << 20;
constexpr size_t alup(size_t x) { return (x + MiB - 1) / MiB * MiB; }
constexpr size_t WS_CTL = 0, CTL_ZERO_BYTES = MiB;
constexpr size_t WS_WIN = MiB;
constexpr size_t WS_WOUT = WS_WIN + alup((size_t)2 * NIN * DM * 2);
constexpr size_t WS_SGW = WS_WOUT + alup((size_t)2 * DM * DMIX * 2);
constexpr size_t WS_LB = WS_SGW + alup((size_t)2 * 8 * 128 * 128 * 2);
constexpr size_t WS_XB = WS_LB + MiB;
constexpr size_t WS_QB = WS_XB + alup((size_t)MPAD * DM * 2);
constexpr size_t WS_KB = WS_QB + alup((size_t)MPAD * 768 * 2);
constexpr size_t WS_VB = WS_KB + alup((size_t)MPAD * 768 * 2);
constexpr size_t WS_ZB = WS_VB + alup((size_t)MPAD * 768 * 2);
constexpr size_t WS_BU = WS_ZB + alup((size_t)MPAD * 2048 * 2);
constexpr size_t WS_BV = WS_BU + alup((size_t)MPAD * 512 * 2);
constexpr size_t WS_CQ = WS_BV + alup((size_t)MPAD * 512 * 2);
constexpr size_t WS_CK = WS_CQ + alup((size_t)MPAD * 768 * 2);
constexpr size_t WS_CI = WS_CK + alup((size_t)MPAD * 768 * 2);
constexpr size_t WS_CG = WS_CI + alup((size_t)MPAD * 768 * 2);
constexpr size_t WS_CE = WS_CG;
constexpr size_t WS_DJ = WS_CG + alup((size_t)MPAD * 768 * 2);
constexpr size_t WS_YB = WS_CG + alup((size_t)MPAD * 768 * 4);
constexpr size_t WS_X1 = WS_YB + alup((size_t)MPAD * 2048 * 2);
constexpr size_t WS_DS = WS_X1 + alup((size_t)MPAD * DM * 4);
constexpr size_t WS_DEC = WS_DS + alup((size_t)48 * 16 * 128 * 128 * 4);
constexpr size_t WS_O2 = WS_DEC + alup((size_t)48 * 16 * 128 * 4);
constexpr size_t WS_O3 = WS_O2 + alup((size_t)MPAD * 768 * 2);
constexpr size_t WS_L2 = WS_O3 + alup((size_t)MPAD * 768 * 2);
constexpr size_t WS_L3 = WS_L2 + alup((size_t)MPAD * 16 * 4);
constexpr size_t WS_KH = WS_L3 + alup((size_t)MPAD * 16 * 4);
constexpr size_t WS_VH = WS_KH + alup((size_t)MPR * 768 * 2);
constexpr size_t WS_END = WS_VH + alup((size_t)MPR * 768 * 2);
constexpr int CW_TMO = 0, CW_CODE = 1, CW_BAR = 4096, CW_Q = 8192;
constexpr size_t CTL_SSQ0 = 256 * 1024, CTL_SSQ1 = 512 * 1024;
constexpr int RING_OFF = 0, LDS_BYTES = 163840, MISC_OFF = LDS_BYTES - 1024;
static_assert(WS_VB - WS_KB == WS_KB - WS_QB && WS_CI - WS_CK == WS_CK - WS_CQ, "equally spaced buffer groups (addressed arithmetically in the in-projection epilogue)");
#define DI __device__ __forceinline__
typedef float f32x16 __attribute__((ext_vector_type(16)));
typedef short s16x4 __attribute__((ext_vector_type(4)));
typedef short v4i16_t __attribute__((ext_vector_type(4)));
typedef float f32x2v __attribute__((ext_vector_type(2)));
typedef unsigned u32x2v __attribute__((ext_vector_type(2)));
typedef __bf16 bf16x2v __attribute__((ext_vector_type(2)));
#define MFMA32(a, b, c) __builtin_amdgcn_mfma_f32_32x32x16_bf16((a), (b), (c), 0, 0, 0)
DI unsigned cvtpk2(float lo, float hi) { f32x2v v = {lo, hi}; bf16x2v b = __builtin_convertvector(v, bf16x2v); return __builtin_bit_cast(unsigned, b); }
DI float bf2f(bf16 u) { return __uint_as_float((unsigned)u << 16); }
DI float bflo(unsigned w) { return __uint_as_float(w << 16); }
DI float bfhi(unsigned w) { return __uint_as_float(w & 0xffff0000u); }
DI int crow(int r, int h) { return (r & 3) + 8 * (r >> 2) + 4 * h; }
DI float shx(float v, int mask, int lane) { return __builtin_bit_cast(float, __builtin_amdgcn_ds_bpermute((lane ^ mask) << 2, __builtin_bit_cast(int, v))); }
DI float wave_sum(float v, int lane) {
#pragma unroll
    for (int o = 1; o < 64; o <<= 1) v += shx(v, o, lane);
    return v;
}
DI float wave_max(float v, int lane) {
#pragma unroll
    for (int o = 1; o < 64; o <<= 1) v = fmaxf(v, shx(v, o, lane));
    return v;
}
DI s16x4 trd(LAS const unsigned char* p) { return __builtin_bit_cast(s16x4, __builtin_amdgcn_ds_read_tr16_b64_v4i16((LAS v4i16_t*)p)); }
DI int tr_lane_off(int pitch, int lane, bool perm) { const int i16 = lane & 15, q = i16 >> 2, p = i16 & 3, blk = (lane >> 4) & 1, h = lane >> 5; return ((perm ? 4 * h : 8 * h) + q) * pitch + (16 * blk + 4 * p) * 2; }
DI bf16x8 trfrag(LAS const unsigned char* base, int pitch, int k0, int c0, int laneoff, bool perm) {
    LAS const unsigned char* a = base + k0 * pitch + c0 * 2 + laneoff;
    const s16x4 lo = trd(a), hi = trd(a + (perm ? 8 : 4) * pitch);
    return __builtin_shufflevector(lo, hi, 0, 1, 2, 3, 4, 5, 6, 7);
}
DI bf16x8 pack8(const f32x16& x, int s) { v4u p; p.x = cvtpk2(x[8 * s], x[8 * s + 1]); p.y = cvtpk2(x[8 * s + 2], x[8 * s + 3]); p.z = cvtpk2(x[8 * s + 4], x[8 * s + 5]); p.w = cvtpk2(x[8 * s + 6], x[8 * s + 7]); return __builtin_bit_cast(bf16x8, p); }
DI f32x16 zero16() { f32x16 z;
#pragma unroll
    for (int i = 0; i < 16; ++i) z[i] = 0.f; return z; }

struct Args { const float* in[16]; float* out; unsigned char* ws; int ph_lo, ph_hi, imask, pad; };
struct Ctx {
    LAS unsigned char* lds; volatile LAS unsigned* MISC;
    int tid, lane, wave, vcu, G;
};
typedef __attribute__((address_space(4))) const Args* kaptr_t;
DI kaptr_t kargs() { kaptr_t kp = (kaptr_t)__builtin_amdgcn_kernarg_segment_ptr(); asm volatile("" : "+s"(kp)); return kp; }
#define INP(i) (kargs()->in[i])
#define WSP(off) (kargs()->ws + (off))
#define OUTP() (kargs()->out)
DI void p0_transpose_item(const float* W, int K, int N, bf16* WT, const float* gk, LAS float* scr, int item, int lane, bool nts = false) {
    const int nblk = N / 32, kb = item / nblk, nb = item % nblk, k0 = 64 * kb, n0 = 32 * nb;
#pragma unroll 8
    for (int i = 0; i < 32; ++i) { const int kk = 2 * i + (lane >> 5); float w = __builtin_nontemporal_load(W + (size_t)(k0 + kk) * N + n0 + (lane & 31)); if (gk) w *= gk[k0 + kk]; scr[kk * 33 + (lane & 31)] = w; }
    LDS_WAIT(); asm volatile("" ::: "memory");
    const int c = lane & 7;
#pragma unroll
    for (int j = 0; j < 4; ++j) { const int n = (lane >> 3) + 8 * j; const LAS float* s = scr + (8 * c) * 33 + n;
        v4u o; o.x = pk2(s[0 * 33], s[1 * 33]); o.y = pk2(s[2 * 33], s[3 * 33]); o.z = pk2(s[4 * 33], s[5 * 33]); o.w = pk2(s[6 * 33], s[7 * 33]);
        if (nts) __builtin_nontemporal_store(o, (v4u*)(WT + (size_t)(n0 + n) * K + k0 + 8 * c)); else *(GAS v4u*)(WT + (size_t)(n0 + n) * K + k0 + 8 * c) = o; }
    LDS_WAIT(); asm volatile("" ::: "memory");
}
DI void p0_prologue(Ctx& C) { const float* const p_qn_g = ((const float*)INP(7)); const float* const p_kn_g = ((const float*)INP(8)); float* const p_LB = ((float*)WSP(WS_LB)); bf16* const p_SGW = ((bf16*)WSP(WS_SGW)); float* const p_SSQ0 = ((float*)WSP(WS_CTL + CTL_SSQ0)); bf16* const p_WIN = ((bf16*)WSP(WS_WIN)); bf16* const p_WOUT = ((bf16*)WSP(WS_WOUT)); bf16* const p_XB = ((bf16*)WSP(WS_XB)); const float* const p_lb_logits = ((const float*)INP(13)); const float* const p_norm_g = ((const float*)INP(5)); const float* const p_sgu_w = ((const float*)INP(11)); const float* const p_w_in = ((const float*)INP(6)); const float* const p_w_out = ((const float*)INP(15)); const float* const p_x_prompt = ((const float*)INP(0)); const float* const p_x_sample = ((const float*)INP(1));
    LAS float* scr = (LAS float*)(C.lds + RING_OFF + C.wave * 16384);
    const int gw = C.vcu * NWAVES + C.wave, NGW = C.G * NWAVES;
    constexpr int I_IN1 = (DM / 64) * (NIN / 32), I_OUT1 = (DMIX / 64) * (DM / 32);
    for (int it = gw; it < I_IN1; it += NGW) p0_transpose_item(p_w_in, DM, NIN, p_WIN, p_norm_g, scr, it, C.lane);
    for (int m = gw; m < MPAD; m += NGW) {
        GAS unsigned long long* o8 = (GAS unsigned long long*)(p_XB + (size_t)m * DM) + C.lane;
        if (m < MPR + MSA) {
            const float* xrow = (m < MPR) ? p_x_prompt + (size_t)m * DM : p_x_sample + (size_t)(m - MPR) * DM;
            const GAS f32x4* xr = (const GAS f32x4*)xrow + C.lane; f32x4 v[4]; float s = 0.f;
#pragma unroll
            for (int j = 0; j < 4; ++j) { v[j] = __builtin_nontemporal_load(xr + 64 * j); s += (v[j].x * v[j].x + v[j].y * v[j].y) + (v[j].z * v[j].z + v[j].w * v[j].w); }
            s = wave_sum(s, C.lane);
#pragma unroll
            for (int j = 0; j < 4; ++j) o8[64 * j] = (unsigned long long)pk2(v[j].x, v[j].y) | ((unsigned long long)pk2(v[j].z, v[j].w) << 32);
            if (C.lane == 0) p_SSQ0[m] = s;
        } else {
#pragma unroll
            for (int j = 0; j < 4; ++j) o8[64 * j] = 0ull;
            if (C.lane == 0) p_SSQ0[m] = 0.f;
        }
    }
    const int gt = C.vcu * 512 + C.tid, NGT = C.G * 512;
    for (int e = gt; e < 2 * 8 * 128 * 128; e += NGT) { const int s = e & 127, t = (e >> 7) & 127; const float w = p_sgu_w[e]; p_SGW[e] = (bf16)f2bf(s <= t ? w : 0.f); }
    for (int e = gt; e < 2 * 768; e += NGT) { const int l = e / 768, c = e - 768 * l; p_LB[(l * 3 + 0) * 768 + c] = p_qn_g[e]; p_LB[(l * 3 + 1) * 768 + c] = p_kn_g[e]; p_LB[(l * 3 + 2) * 768 + c] = (l == 0) ? 0.f : 1.0f / (1.0f + __expf(p_lb_logits[c] - p_lb_logits[768 + c])); }
}

DI void wt_item(const Ctx& C, int item) { const float* const p_w_in = ((const float*)INP(6)); const float* const p_w_out = ((const float*)INP(15)); const float* const p_norm_g = ((const float*)INP(5)); bf16* const p_WIN = ((bf16*)WSP(WS_WIN)); bf16* const p_WOUT = ((bf16*)WSP(WS_WOUT));
    constexpr int I_IN1 = (DM / 64) * (NIN / 32), I_OUT1 = (DMIX / 64) * (DM / 32);
    LAS float* scr = (LAS float*)(C.lds + RING_OFF + C.wave * 16384);
#pragma unroll 1
    for (int rep = 0; rep < 4; ++rep) {
        int it = 32 * item + 8 * rep + C.wave;
        if (it < I_OUT1) { p0_transpose_item(p_w_out, DMIX, DM, p_WOUT, nullptr, scr, it, C.lane, true); continue; } it -= I_OUT1;
        if (it < I_IN1) p0_transpose_item(p_w_in + (size_t)DM * NIN, DM, NIN, p_WIN + (size_t)NIN * DM, p_norm_g + DM, scr, it, C.lane, true);
        else if (it < I_IN1 + I_OUT1) p0_transpose_item(p_w_out + (size_t)DMIX * DM, DMIX, DM, p_WOUT + (size_t)DM * DMIX, nullptr, scr, it - I_IN1, C.lane, true);
    }
}

DI void kvout_item(const Ctx& C, int l, int item) { unsigned char* const ws = WSP(0); const bf16* const p_KH = (const bf16*)(ws + WS_KH); const bf16* const p_VH = (const bf16*)(ws + WS_VH); float* const p_out = OUTP();
    const int b = item >> 5, t0 = (item & 31) * 64, tid = C.tid;
    float* ok = p_out + O_KP + ((size_t)l * MPR + (size_t)b * SEQL + t0) * 768; float* ov = p_out + O_VP + ((size_t)l * MPR + (size_t)b * SEQL + t0) * 768;
#pragma unroll 4
    for (int it = 0; it < 12; ++it) { const int idx = tid + 512 * it, tl = idx / 96, hc = idx - 96 * tl, hh = hc >> 3, ch = hc & 7, t = t0 + tl;
        const size_t so = ((size_t)(((b * 12 + hh) * 16 + (t & 15)) * 128 + (t >> 4))) * 64 + 8 * ch; const size_t dofs = (size_t)tl * 768 + hh * 64 + 8 * ch;
        const v4u k8 = *(const v4u*)(p_KH + so), v8 = *(const v4u*)(p_VH + so);
        *(f32x4*)(ok + dofs) = (f32x4){bflo(k8.x), bfhi(k8.x), bflo(k8.y), bfhi(k8.y)}; *(f32x4*)(ok + dofs + 4) = (f32x4){bflo(k8.z), bfhi(k8.z), bflo(k8.w), bfhi(k8.w)};
        *(f32x4*)(ov + dofs) = (f32x4){bflo(v8.x), bfhi(v8.x), bflo(v8.y), bfhi(v8.y)}; *(f32x4*)(ov + dofs + 4) = (f32x4){bflo(v8.z), bfhi(v8.z), bflo(v8.w), bfhi(v8.w)}; }
}
DI float ex2(float x) { return __builtin_amdgcn_exp2f(x); }
DI float lg2(float x) { return __builtin_amdgcn_logf(x); }

constexpr int AP = 144;
DI void cls_tile(const bf16x8 (&qf)[4], LAS const unsigned char* Kl, LAS const unsigned char* Vl, int kr0, int jstart, int lane, f32x16 (&o)[2], float& lse) {
    const int i = lane & 31, h = lane >> 5;
    o[0] = zero16(); o[1] = zero16();
    constexpr float THR = 6.0f;
    float mrun = 0.f, l = 0.f; bool first = true;
    LAS const unsigned char* kp = Kl + (kr0 + 32 * jstart + i) * AP + 16 * h;
    LAS const unsigned char* vp = Vl + (kr0 + 32 * jstart) * AP + tr_lane_off(AP, lane, true);
#pragma unroll 1
    for (int j = jstart; j < 5; ++j, kp += 32 * AP, vp += 32 * AP) {
        f32x16 st = zero16();
#pragma unroll
        for (int s = 0; s < 4; ++s) st = MFMA32(*(LAS const bf16x8*)(kp + 32 * s), qf[s], st);
        if (j == 0) {
#pragma unroll
            for (int r = 0; r < 16; ++r) if (crow(r, h) < i) st[r] = -1e30f;
        }
        if (j == 4) {
#pragma unroll
            for (int r = 0; r < 16; ++r) if (crow(r, h) > i) st[r] = -1e30f;
        }
        float rm = fmaxf(fmaxf(st[0], st[1]), st[2]);
#pragma unroll
        for (int r = 3; r < 15; r += 2) rm = fmaxf(fmaxf(rm, st[r]), st[r + 1]);
        rm = fmaxf(rm, st[15]);
        rm = fmaxf(rm, shx(rm, 32, lane)) - mrun;
        if (first || __any(rm > THR)) {
            const float delta = first ? rm : fmaxf(rm, 0.f); mrun += delta;
            if (!first) { const float alpha = ex2(-delta); l *= alpha;
#pragma unroll
                for (int r = 0; r < 16; ++r) { o[0][r] *= alpha; o[1][r] *= alpha; } }
            first = false;
        }
        float ps0 = 0.f, ps1 = 0.f;
#pragma unroll
        for (int r = 0; r < 16; r += 2) { st[r] = ex2(st[r] - mrun); st[r + 1] = ex2(st[r + 1] - mrun); ps0 += st[r]; ps1 += st[r + 1]; }
        l += ps0 + ps1;
        const bf16x8 pb0 = pack8(st, 0), pb1 = pack8(st, 1);
#pragma unroll
        for (int db = 0; db < 2; ++db) {
            const s16x4 a0 = trd(vp + 64 * db), a1 = trd(vp + 64 * db + 8 * AP), b0 = trd(vp + 64 * db + 16 * AP), b1 = trd(vp + 64 * db + 24 * AP);
            o[db] = MFMA32(__builtin_shufflevector(a0, a1, 0, 1, 2, 3, 4, 5, 6, 7), pb0, o[db]);
            o[db] = MFMA32(__builtin_shufflevector(b0, b1, 0, 1, 2, 3, 4, 5, 6, 7), pb1, o[db]);
        }
    }
    l += shx(l, 32, lane);
    const float inv = 1.0f / l;
#pragma unroll
    for (int r = 0; r < 16; ++r) { o[0][r] *= inv; o[1][r] *= inv; }
    lse = mrun + lg2(l);
}
DI void cls_store(bf16* Ob, float* Lb, size_t m, int hh, int h, const f32x16 (&o)[2], float lse) {
    bf16* op = Ob + m * 768 + hh * 64 + 4 * h;
#pragma unroll
    for (int db = 0; db < 2; ++db)
#pragma unroll
        for (int g4 = 0; g4 < 4; ++g4) { u32x2v w; w.x = cvtpk2(o[db][4 * g4], o[db][4 * g4 + 1]); w.y = cvtpk2(o[db][4 * g4 + 2], o[db][4 * g4 + 3]); *(u32x2v*)(op + 32 * db + 8 * g4) = w; }
    if (h == 0) Lb[m * 16 + hh] = lse;
}
template <int KIND> DI void att23_item(const Ctx& C, int item) { unsigned char* const ws = WSP(0); const bf16* const p_QB = (const bf16*)(ws + WS_QB); const bf16* const p_KB = (const bf16*)(ws + WS_KH); const bf16* const p_VB = (const bf16*)(ws + WS_VH);
    bf16* const p_O = (bf16*)(ws + (KIND == 2 ? WS_O2 : WS_O3)); float* const p_L = (float*)(ws + (KIND == 2 ? WS_L2 : WS_L3));
    const int up = item & 1, hh = (item >> 1) % 12, b = item / 24, lane = C.lane, wave = C.wave, tid = C.tid, i = lane & 31, h = lane >> 5;
    const size_t rb = (size_t)b * SEQL;
    LAS unsigned char* Kl = C.lds; LAS unsigned char* Vl = C.lds + 512 * AP;
    v4u kr[8], vr[8];
#define A23_TOK(u, row) (KIND == 2 ? (4 * (row) + (u)) : (16 * ((row) & 127) + 4 * (u) + ((row) >> 7)))
#define A23_SRC(u, idx) ((size_t)(((b * 12 + hh) * 16 + (KIND == 2 ? 4 * ((idx) >> 10) + (u) : 4 * (u) + ((idx) >> 10))) * 128 + (((idx) >> 3) & 127)) * 64 + 8 * ((idx) & 7))
#define A23_ROW(idx) (KIND == 2 ? 4 * (((idx) >> 3) & 127) + ((idx) >> 10) : ((idx) >> 3))
#define A23_ISSUE(u) do { _Pragma("unroll") for (int it = 0; it < 8; ++it) { const int idx = tid + 512 * it; const size_t go = A23_SRC(u, idx); \
        kr[it] = *(const v4u*)(p_KB + go); vr[it] = *(const v4u*)(p_VB + go); } } while (0)
    A23_ISSUE(2 * up);
#pragma unroll 1
    for (int u = 2 * up; u < 2 * up + 2; ++u) {
        __syncthreads();
#pragma unroll
        for (int it = 0; it < 8; ++it) { const int idx = tid + 512 * it, row = A23_ROW(idx), ch = idx & 7; *(LAS v4u*)(Kl + row * AP + ch * 16) = kr[it]; *(LAS v4u*)(Vl + row * AP + ch * 16) = vr[it]; }
        __syncthreads();
        int cb0, qa, qb;
        if (KIND == 2) { cb0 = 0; qa = 64 * wave; qb = qa + 32; } else { cb0 = (wave >> 1) * 128; qa = (wave & 1) ? 32 : 0; qb = (wave & 1) ? 64 : 96; }
        const size_t ma = rb + A23_TOK(u, cb0 + qa + i), mb = rb + A23_TOK(u, cb0 + qb + i);
        bf16x8 qfa[4], qfb[4];
#pragma unroll
        for (int s = 0; s < 4; ++s) qfa[s] = *(const bf16x8*)(p_QB + ma * 768 + hh * 64 + 8 * h + 16 * s);
        if (u == 2 * up) A23_ISSUE(u + 1);
        f32x16 o[2]; float lse;
        cls_tile(qfa, Kl + cb0 * AP, Vl + cb0 * AP, qa - 128, qa >= 128 ? 0 : (128 - qa) >> 5, lane, o, lse);
        cls_store(p_O, p_L, ma, hh, h, o, lse);
#pragma unroll
        for (int s = 0; s < 4; ++s) qfb[s] = *(const bf16x8*)(p_QB + mb * 768 + hh * 64 + 8 * h + 16 * s);
        cls_tile(qfb, Kl + cb0 * AP, Vl + cb0 * AP, qb - 128, qb >= 128 ? 0 : (128 - qb) >> 5, lane, o, lse);
        cls_store(p_O, p_L, mb, hh, h, o, lse);
    }
#undef A23_ISSUE
#undef A23_TOK
#undef A23_SRC
#undef A23_ROW
}
DI void att1_item(const Ctx& C, int item) { unsigned char* const ws = WSP(0); const bf16* const p_QB = (const bf16*)(ws + WS_QB); const bf16* const p_KB = (const bf16*)(ws + WS_KH); const bf16* const p_VB = (const bf16*)(ws + WS_VH);
    const bf16* const p_O2 = (const bf16*)(ws + WS_O2); const float* const p_L2 = (const float*)(ws + WS_L2); const bf16* const p_O3 = (const bf16*)(ws + WS_O3); const float* const p_L3 = (const float*)(ws + WS_L3); const bf16* const p_ZB = (const bf16*)(ws + WS_ZB); bf16* const p_YB = (bf16*)(ws + WS_YB);
    const int qtr = item & 3, hh = (item >> 2) % 12, b = item / 48, lane = C.lane, wave = C.wave, tid = C.tid, i = lane & 31, h = lane >> 5;
    const size_t rb = (size_t)b * SEQL;
    LAS unsigned char* Kl = C.lds; LAS unsigned char* Vl = C.lds + 384 * AP;
    v4u kr[6], vr[6];
#define A1_ISSUE(T) do { const int m30_ = 16 * (T) - 8; _Pragma("unroll") for (int it = 0; it < 6; ++it) { const int idx = tid + 512 * it, r16 = idx / 192, rem = idx - 192 * r16; int m3 = m30_ + (rem >> 3); if (m3 < 0) m3 = 0; \
        const size_t go = (size_t)(((b * 12 + hh) * 16 + r16) * 128 + m3) * 64 + 8 * (rem & 7); kr[it] = *(const v4u*)(p_KB + go); vr[it] = *(const v4u*)(p_VB + go); } } while (0)
    A1_ISSUE(2 * qtr);
#pragma unroll 1
    for (int u = 0; u < 2; ++u) {
        const int T = 2 * qtr + u;
        __syncthreads();
#pragma unroll
        for (int it = 0; it < 6; ++it) { const int idx = tid + 512 * it, r16 = idx / 192, rem = idx - 192 * r16, row = 16 * (rem >> 3) + r16, ch = rem & 7; *(LAS v4u*)(Kl + row * AP + ch * 16) = kr[it]; *(LAS v4u*)(Vl + row * AP + ch * 16) = vr[it]; }
        __syncthreads();
        const int tq0 = 256 * T + 32 * wave; const size_t m = rb + tq0 + i;
        bf16x8 qf[4];
#pragma unroll
        for (int s = 0; s < 4; ++s) qf[s] = *(const bf16x8*)(p_QB + m * 768 + hh * 64 + 8 * h + 16 * s);
        const bf16* o2p = p_O2 + m * 768 + hh * 64 + 4 * h; const bf16* o3p = p_O3 + m * 768 + hh * 64 + 4 * h; const bf16* zp = p_ZB + m * 2048 + hh * 64 + 4 * h; bf16* yp = p_YB + m * 2048 + hh * 64 + 4 * h;
        const float l2 = p_L2[m * 16 + hh], l3 = p_L3[m * 16 + hh];
        u32x2v a2[8], a3[8];
#pragma unroll
        for (int c8 = 0; c8 < 8; ++c8) { a2[c8] = *(const u32x2v*)(o2p + 8 * c8); a3[c8] = *(const u32x2v*)(o3p + 8 * c8); }
        if (u < 1) A1_ISSUE(T + 1);
        f32x16 o[2]; float lse;
        cls_tile(qf, Kl, Vl, 32 * wave, tq0 >= 128 ? 0 : (128 - tq0) >> 5, lane, o, lse);
        const float M = fmaxf(lse, fmaxf(l2, l3)), L = M + lg2(ex2(lse - M) + ex2(l2 - M) + ex2(l3 - M));
        const float w1 = ex2(lse - L), w2 = ex2(l2 - L), w3 = ex2(l3 - L);
#pragma unroll
        for (int db = 0; db < 2; ++db)
#pragma unroll
            for (int g4 = 0; g4 < 4; ++g4) { const int c8 = 4 * db + g4; const u32x2v x2 = a2[c8], x3 = a3[c8], z = *(const u32x2v*)(zp + 8 * c8); u32x2v w;
                const float y0 = w1 * o[db][4 * g4] + w2 * bflo(x2.x) + w3 * bflo(x3.x), y1 = w1 * o[db][4 * g4 + 1] + w2 * bfhi(x2.x) + w3 * bfhi(x3.x);
                const float y2 = w1 * o[db][4 * g4 + 2] + w2 * bflo(x2.y) + w3 * bflo(x3.y), y3 = w1 * o[db][4 * g4 + 3] + w2 * bfhi(x2.y) + w3 * bfhi(x3.y);
                w.x = cvtpk2(y0 * bflo(z.x), y1 * bfhi(z.x)); w.y = cvtpk2(y2 * bflo(z.y), y3 * bfhi(z.y)); *(u32x2v*)(yp + 8 * c8) = w; }
    }
#undef A1_ISSUE
}

DI void sgu_item(const Ctx& C, int l, int item) { bf16* const p_BU = ((bf16*)WSP(WS_BU)); bf16* const p_BV = ((bf16*)WSP(WS_BV)); bf16* const p_SGW = ((bf16*)WSP(WS_SGW)); bf16* const p_YB = ((bf16*)WSP(WS_YB)); bf16* const p_ZB = ((bf16*)WSP(WS_ZB)); const float* const p_ln_b = ((const float*)INP(10)); const float* const p_ln_g = ((const float*)INP(9)); const float* const p_sgu_b = ((const float*)INP(12));
    const int b = item >> 4, ch = item & 15, lane = C.lane, wave = C.wave, i = lane & 31, h = lane >> 5; const size_t m0 = (size_t)b * SEQL + ch * 128;
    constexpr int VP = 1040;
    { const f32x4 g0 = *(const f32x4*)(p_ln_g + l * 512 + 8 * lane), g1 = *(const f32x4*)(p_ln_g + l * 512 + 8 * lane + 4), b0 = *(const f32x4*)(p_ln_b + l * 512 + 8 * lane), b1 = *(const f32x4*)(p_ln_b + l * 512 + 8 * lane + 4);
      v4u raw[16]; float s1[16], s2[16];
#pragma unroll
      for (int tt = 0; tt < 16; ++tt) raw[tt] = *(const v4u*)(p_BV + (m0 + 16 * wave + tt) * 512 + 8 * lane);
#pragma unroll
      for (int tt = 0; tt < 16; ++tt) { const v4u r = raw[tt]; const float x0 = bflo(r.x), x1 = bfhi(r.x), x2 = bflo(r.y), x3 = bfhi(r.y), x4 = bflo(r.z), x5 = bfhi(r.z), x6 = bflo(r.w), x7 = bfhi(r.w);
        s1[tt] = ((x0 + x1) + (x2 + x3)) + ((x4 + x5) + (x6 + x7)); s2[tt] = ((x0 * x0 + x1 * x1) + (x2 * x2 + x3 * x3)) + ((x4 * x4 + x5 * x5) + (x6 * x6 + x7 * x7)); }
#pragma unroll
      for (int o = 1; o < 64; o <<= 1) {
#pragma unroll
        for (int tt = 0; tt < 16; ++tt) { s1[tt] += shx(s1[tt], o, lane); s2[tt] += shx(s2[tt], o, lane); } }
#pragma unroll
      for (int tt = 0; tt < 16; ++tt) { const int t = 16 * wave + tt; const v4u r = raw[tt];
        const float mean = s1[tt] * (1.0f / 512.0f), var = fmaxf(s2[tt] * (1.0f / 512.0f) - mean * mean, 0.f), rstd = __builtin_amdgcn_rsqf(var + EPSF);
        float x[8] = {bflo(r.x), bfhi(r.x), bflo(r.y), bfhi(r.y), bflo(r.z), bfhi(r.z), bflo(r.w), bfhi(r.w)};
#pragma unroll
        for (int e = 0; e < 8; ++e) x[e] = (x[e] - mean) * rstd;
        v4u w; w.x = cvtpk2(x[0] * g0[0] + b0[0], x[1] * g0[1] + b0[1]); w.y = cvtpk2(x[2] * g0[2] + b0[2], x[3] * g0[3] + b0[3]);
        w.z = cvtpk2(x[4] * g1[0] + b1[0], x[5] * g1[1] + b1[1]); w.w = cvtpk2(x[6] * g1[2] + b1[2], x[7] * g1[3] + b1[3]);
        *(LAS v4u*)(C.lds + t * VP + lane * 16) = w; } }
    __syncthreads();
    const int g = wave; const bf16* Wg = p_SGW + (size_t)((l * 8 + g) * 128) * 128; const int troff = tr_lane_off(VP, lane, false);
#pragma unroll
    for (int tb = 0; tb < 4; ++tb) {
        f32x16 acc[2]; acc[0] = zero16(); acc[1] = zero16();
#pragma unroll
        for (int ks = 0; ks < 2 * tb + 2; ++ks) {
            const bf16x8 wf = *(const bf16x8*)(Wg + (32 * tb + i) * 128 + 16 * ks + 8 * h);
#pragma unroll
            for (int cb = 0; cb < 2; ++cb) acc[cb] = MFMA32(trfrag(C.lds, VP, 16 * ks, 64 * g + 32 * cb, troff, false), wf, acc[cb]);
        }
        const int t = 32 * tb + i; const float bias = p_sgu_b[(l * 8 + g) * 128 + t]; const size_t m = m0 + t;
#pragma unroll
        for (int cb = 0; cb < 2; ++cb)
#pragma unroll
            for (int g4 = 0; g4 < 4; ++g4) { const int c0 = 64 * g + 32 * cb + 8 * g4 + 4 * h;
                const u32x2v u = *(const u32x2v*)(p_BU + m * 512 + c0), z = *(const u32x2v*)(p_ZB + m * 2048 + 768 + c0); u32x2v w;
                w.x = cvtpk2(bflo(u.x) * (acc[cb][4 * g4] + bias) * bflo(z.x), bfhi(u.x) * (acc[cb][4 * g4 + 1] + bias) * bfhi(z.x));
                w.y = cvtpk2(bflo(u.y) * (acc[cb][4 * g4 + 2] + bias) * bflo(z.y), bfhi(u.y) * (acc[cb][4 * g4 + 3] + bias) * bfhi(z.y));
                *(u32x2v*)(p_YB + m * 2048 + 768 + c0) = w; }
    }
}

DI void hgp_item(const Ctx& C, int l, int item) { unsigned char* const ws = WSP(0); const bf16* const p_CK = (const bf16*)(ws + WS_CK); const bf16* const p_CI = (const bf16*)(ws + WS_CI); const float* const p_DJ = (const float*)(ws + WS_DJ); float* const p_SNAP = (float*)(ws + WS_DS); float* const p_out = OUTP();
    const int bh = item, b = bh / 6, hh = bh % 6, tid = C.tid, lane = C.lane, wave = C.wave, i = lane & 31, h = lane >> 5;
    constexpr int PT = 272, TB = 32 * PT, BUF = 2 * TB;
    LAS unsigned char* L = C.lds;
    const int row = tid >> 4, chn = tid & 15, kb = wave >> 1, vb0 = 2 * (wave & 1), troff = tr_lane_off(PT, lane, false);
    const size_t g0 = ((size_t)b * SEQL + row) * 768 + hh * 128 + chn * 8;
    const float* djp = p_DJ + ((size_t)b * 64) * 768 + hh * 128 + 32 * kb + i;
    v4u kreg = *(const v4u*)(p_CK + g0), vreg = *(const v4u*)(p_CI + g0); float djn = djp[0];
    *(LAS v4u*)(L + row * PT + chn * 16) = kreg; *(LAS v4u*)(L + TB + row * PT + chn * 16) = vreg;
    __syncthreads();
    f32x16 acc[2]; acc[0] = zero16(); acc[1] = zero16();
#pragma unroll 1
    for (int j = 0; j < 64; ++j) {
        LAS const unsigned char* cur = L + (j & 1) * BUF; LAS unsigned char* nxt = L + ((j + 1) & 1) * BUF;
        const float dj = djn;
        if (j < 63) { const size_t g = g0 + (size_t)(32 * (j + 1)) * 768; kreg = *(const v4u*)(p_CK + g); vreg = *(const v4u*)(p_CI + g); djn = djp[(size_t)(j + 1) * 768]; }
#pragma unroll
        for (int s2 = 0; s2 < 2; ++s2) { const bf16x8 kfr = trfrag(cur, PT, 16 * s2, 32 * kb, troff, false);
#pragma unroll
            for (int j2 = 0; j2 < 2; ++j2) acc[j2] = MFMA32(trfrag(cur + TB, PT, 16 * s2, 32 * (vb0 + j2), troff, false), kfr, acc[j2]); }
#pragma unroll
        for (int r = 0; r < 16; ++r) { acc[0][r] *= dj; acc[1][r] *= dj; }
        if ((j & 15) == 15) {
            float* dst = (j == 63) ? p_out + O_HP + (size_t)(l * 48 + bh) * 16384 : p_SNAP + (size_t)(bh * 3 + (j >> 4)) * 16384;
            dst += (size_t)(32 * kb + i) * 128 + 4 * h;
#pragma unroll
            for (int j2 = 0; j2 < 2; ++j2)
#pragma unroll
                for (int g4 = 0; g4 < 4; ++g4) *(f32x4*)(dst + 32 * (vb0 + j2) + 8 * g4) = (f32x4){acc[j2][4 * g4], acc[j2][4 * g4 + 1], acc[j2][4 * g4 + 2], acc[j2][4 * g4 + 3]};
        }
        if (j < 63) { *(LAS v4u*)(nxt + row * PT + chn * 16) = kreg; *(LAS v4u*)(nxt + TB + row * PT + chn * 16) = vreg; }
        __syncthreads();
    }
}
DI void hg3_item(const Ctx& C, int l, int item) { unsigned char* const ws = WSP(0); const bf16* const p_CE = (const bf16*)(ws + WS_CE); const float* const p_DJ = (const float*)(ws + WS_DJ); const bf16* const p_CI = (const bf16*)(ws + WS_CI); const bf16* const p_CK = (const bf16*)(ws + WS_CK); const bf16* const p_CQ = (const bf16*)(ws + WS_CQ); const float* const p_SNAP = (const float*)(ws + WS_DS); bf16* const p_YB = (bf16*)(ws + WS_YB); const bf16* const p_ZB = (const bf16*)(ws + WS_ZB); const float* const p_hn_g = ((const float*)INP(14));
    const int qt = item & 3, bh = item >> 2, b = bh / 6, hh = bh % 6, tid = C.tid, lane = C.lane, wave = C.wave, i = lane & 31, h = lane >> 5;
    constexpr int PT = 272, IMG = 64 * PT, SBB = 128 * PT;
    LAS unsigned char *QT = C.lds, *KD = C.lds + IMG, *VV = C.lds + 2 * IMG, *SB = C.lds + 3 * IMG;
    LAS float* RS = (LAS float*)(C.lds + 3 * IMG + 2 * SBB);
    f32x16 sacc[4];
    const int kb = wave & 3;
    if (wave >= 4) {
        if (qt == 0) {
#pragma unroll
            for (int vb = 0; vb < 4; ++vb) { sacc[vb] = zero16();
#pragma unroll
                for (int g4 = 0; g4 < 4; ++g4) *(LAS u32x2v*)(SB + (32 * kb + i) * PT + (32 * vb + 8 * g4 + 4 * h) * 2) = (u32x2v){0u, 0u}; }
        } else {
            const float* sp = p_SNAP + (size_t)(bh * 3 + qt - 1) * 16384 + (size_t)(32 * kb + i) * 128 + 4 * h;
#pragma unroll
            for (int vb = 0; vb < 4; ++vb)
#pragma unroll
                for (int g4 = 0; g4 < 4; ++g4) { const f32x4 tt = *(const f32x4*)(sp + 32 * vb + 8 * g4); sacc[vb][4 * g4] = tt[0]; sacc[vb][4 * g4 + 1] = tt[1]; sacc[vb][4 * g4 + 2] = tt[2]; sacc[vb][4 * g4 + 3] = tt[3];
                    u32x2v w; w.x = cvtpk2(tt[0], tt[1]); w.y = cvtpk2(tt[2], tt[3]); *(LAS u32x2v*)(SB + (32 * kb + i) * PT + (32 * vb + 8 * g4 + 4 * h) * 2) = w; }
        }
    }
    const int tro_n = tr_lane_off(PT, lane, false), tro_p = tr_lane_off(PT, lane, true);
    v4u rq[2], re[2], rk[2], rv[2];
#define HG3_ISSUE(sgx) do { const size_t mm_ = (size_t)b * SEQL + (8 * qt + (sgx)) * 64; _Pragma("unroll") for (int it = 0; it < 2; ++it) { const int idx = tid + 512 * it, row = idx >> 4, chn = idx & 15; \
        const size_t go = (mm_ + row) * 768 + hh * 128 + chn * 8; rq[it] = *(const v4u*)(p_CQ + go); re[it] = *(const v4u*)(p_CE + go); rk[it] = *(const v4u*)(p_CK + go); rv[it] = *(const v4u*)(p_CI + go); } } while (0)
#define HG3_FILL() do { _Pragma("unroll") for (int it = 0; it < 2; ++it) { const int idx = tid + 512 * it, row = idx >> 4, chn = idx & 15; const v4u q8 = rq[it], e8 = re[it]; v4u w; \
            w.x = cvtpk2(bflo(q8.x) * bflo(e8.x), bfhi(q8.x) * bfhi(e8.x)); w.y = cvtpk2(bflo(q8.y) * bflo(e8.y), bfhi(q8.y) * bfhi(e8.y)); \
            w.z = cvtpk2(bflo(q8.z) * bflo(e8.z), bfhi(q8.z) * bfhi(e8.z)); w.w = cvtpk2(bflo(q8.w) * bflo(e8.w), bfhi(q8.w) * bfhi(e8.w)); \
            *(LAS v4u*)(QT + row * PT + chn * 16) = w; *(LAS v4u*)(KD + row * PT + chn * 16) = rk[it]; *(LAS v4u*)(VV + row * PT + chn * 16) = rv[it]; } } while (0)
    HG3_ISSUE(0);
    if (wave < 4) {
        const int vb = wave;
#pragma unroll 1
        for (int sg = 0; sg < 8; ++sg) {
            const size_t m0 = (size_t)b * SEQL + (8 * qt + sg) * 64;
            HG3_FILL();
            if (sg < 7) HG3_ISSUE(sg + 1);
            __syncthreads();
#pragma unroll 1
            for (int j = 0; j < 2; ++j) {
                const int g = 2 * sg + j; LAS const unsigned char* SBr = SB + (g & 1) * SBB; LAS float* RSg = RS + (g & 1) * 128;
                u32x2v zr[4]; f32x4 gnv[4];
#pragma unroll
                for (int g4 = 0; g4 < 4; ++g4) { zr[g4] = *(const u32x2v*)(p_ZB + (m0 + 32 * j + i) * 2048 + 1280 + hh * 128 + 32 * vb + 8 * g4 + 4 * h); gnv[g4] = *(const f32x4*)(p_hn_g + l * 768 + hh * 128 + 32 * vb + 8 * g4 + 4 * h); }
                bf16x8 qfr[8];
#pragma unroll
                for (int ks = 0; ks < 8; ++ks) qfr[ks] = *(LAS const bf16x8*)(QT + (32 * j + i) * PT + (16 * ks + 8 * h) * 2);
                f32x16 x0 = zero16(), x1 = zero16();
#pragma unroll
                for (int ks = 0; ks < 8; ks += 2) { x0 = MFMA32(*(LAS const bf16x8*)(KD + (32 * j + i) * PT + (16 * ks + 8 * h) * 2), qfr[ks], x0);
                                                    x1 = MFMA32(*(LAS const bf16x8*)(KD + (32 * j + i) * PT + (16 * ks + 16 + 8 * h) * 2), qfr[ks + 1], x1); }
#pragma unroll
                for (int r = 0; r < 16; ++r) { const float xs = x0[r] + x1[r]; x0[r] = (crow(r, h) > i) ? 0.f : xs; }
                const bf16x8 pb0 = pack8(x0, 0), pb1 = pack8(x0, 1);
                f32x16 oa = zero16(), ob = zero16();
#pragma unroll
                for (int ks = 0; ks < 8; ks += 2) { oa = MFMA32(trfrag(SBr, PT, 16 * ks, 32 * vb, tro_n, false), qfr[ks], oa); ob = MFMA32(trfrag(SBr, PT, 16 * ks + 16, 32 * vb, tro_n, false), qfr[ks + 1], ob); }
                oa = MFMA32(trfrag(VV, PT, 32 * j, 32 * vb, tro_p, true), pb0, oa);
                ob = MFMA32(trfrag(VV, PT, 32 * j + 16, 32 * vb, tro_p, true), pb1, ob);
                float ss = 0.f;
#pragma unroll
                for (int r = 0; r < 16; ++r) { oa[r] += ob[r]; ss += oa[r] * oa[r]; }
                ss += shx(ss, 32, lane);
                if (h == 0) RSg[vb * 32 + i] = ss;
                __syncthreads();
                const float tot = RSg[i] + RSg[32 + i] + RSg[64 + i] + RSg[96 + i], rstd = __builtin_amdgcn_rsqf(tot * (1.0f / 128.0f) + EPSF);
                const size_t m = m0 + 32 * j + i;
#pragma unroll
                for (int g4 = 0; g4 < 4; ++g4) { const int v0 = hh * 128 + 32 * vb + 8 * g4 + 4 * h; const f32x4 gn = gnv[g4]; const u32x2v z = zr[g4]; u32x2v w;
                    w.x = cvtpk2(oa[4 * g4] * rstd * gn[0] * bflo(z.x), oa[4 * g4 + 1] * rstd * gn[1] * bfhi(z.x)); w.y = cvtpk2(oa[4 * g4 + 2] * rstd * gn[2] * bflo(z.y), oa[4 * g4 + 3] * rstd * gn[3] * bfhi(z.y));
                    *(u32x2v*)(p_YB + m * 2048 + 1280 + v0) = w; }
            }
        }
    } else {
#pragma unroll 1
        for (int sg = 0; sg < 8; ++sg) {
            const size_t m0 = (size_t)b * SEQL + (8 * qt + sg) * 64;
            HG3_FILL();
            float dv[2];
#pragma unroll
            for (int j = 0; j < 2; ++j) dv[j] = p_DJ[((m0 >> 5) + j) * 768 + hh * 128 + 32 * kb + i];
            if (sg < 7) HG3_ISSUE(sg + 1);
            __syncthreads();
#pragma unroll 1
            for (int j = 0; j < 2; ++j) {
                const int g = 2 * sg + j; LAS unsigned char* SBw = SB + ((g + 1) & 1) * SBB;
#pragma unroll
                for (int s2 = 0; s2 < 2; ++s2) { const bf16x8 kfr = trfrag(KD, PT, 32 * j + 16 * s2, 32 * kb, tro_n, false);
#pragma unroll
                    for (int vb = 0; vb < 4; ++vb) sacc[vb] = MFMA32(trfrag(VV, PT, 32 * j + 16 * s2, 32 * vb, tro_n, false), kfr, sacc[vb]); }
                const float d = (j == 0) ? dv[0] : dv[1];
#pragma unroll
                for (int vb = 0; vb < 4; ++vb)
#pragma unroll
                    for (int r = 0; r < 16; ++r) sacc[vb][r] *= d;
#pragma unroll
                for (int vb = 0; vb < 4; ++vb)
#pragma unroll
                    for (int g4 = 0; g4 < 4; ++g4) { u32x2v w; w.x = cvtpk2(sacc[vb][4 * g4], sacc[vb][4 * g4 + 1]); w.y = cvtpk2(sacc[vb][4 * g4 + 2], sacc[vb][4 * g4 + 3]); *(LAS u32x2v*)(SBw + (32 * kb + i) * PT + (32 * vb + 8 * g4 + 4 * h) * 2) = w; }
                __syncthreads();
            }
        }
    }
#undef HG3_ISSUE
#undef HG3_FILL
}
DI void samp_attn_item(const Ctx& C, int l, int item) { const float* const p_cache_k = ((const float*)INP(2)); const float* const p_cache_v = ((const float*)INP(3)); bf16* const p_QB = ((bf16*)WSP(WS_QB)); bf16* const p_KB = ((bf16*)WSP(WS_KB)); bf16* const p_VB = ((bf16*)WSP(WS_VB)); bf16* const p_ZB = ((bf16*)WSP(WS_ZB)); bf16* const p_YB = ((bf16*)WSP(WS_YB));
    const int b = item / 12, hh = item % 12, wave = C.wave, lane = C.lane, tid = C.tid; const size_t row = MPR + b;
    LAS float* sc = (LAS float*)C.lds;
    LAS float* po = sc + 400;
    const float* ck = p_cache_k + ((size_t)(l * 32 + b) * 2048) * 768 + hh * 64; const float* cv = p_cache_v + ((size_t)(l * 32 + b) * 2048) * 768 + hh * 64;
    const int grp = tid >> 4, dl = 4 * (tid & 15);
    const u32x2v qraw = *(const u32x2v*)(p_QB + row * 768 + hh * 64 + dl); const float q0 = bflo(qraw.x), q1 = bfhi(qraw.x), q2 = bflo(qraw.y), q3 = bfhi(qraw.y);
    const u32x2v knraw = *(const u32x2v*)(p_KB + row * 768 + hh * 64 + dl);
    const f32x4 knew = (f32x4){bflo(knraw.x), bfhi(knraw.x), bflo(knraw.y), bfhi(knraw.y)};
    f32x4 kv[13];
#pragma unroll
    for (int it = 0; it < 13; ++it) { int slot = 32 * it + grp; if (slot > 386) slot = 386; const int pp = slot / 129, jj = slot - 129 * pp, idx = 2048 - (jj << (2 * pp));
        kv[it] = knew; if (idx < 2048) kv[it] = __builtin_nontemporal_load((const f32x4*)(ck + (size_t)idx * 768 + dl)); }
#pragma unroll
    for (int it = 0; it < 13; ++it) { const int slot = 32 * it + grp;
        float part = (q0 * kv[it][0] + q1 * kv[it][1]) + (q2 * kv[it][2] + q3 * kv[it][3]);
        part += shx(part, 1, lane); part += shx(part, 2, lane); part += shx(part, 4, lane); part += shx(part, 8, lane);
        if ((tid & 15) == 0 && slot < 387) sc[slot] = part; }
    __syncthreads();
    float mx = -1e30f;
    for (int t = lane; t < 387; t += 64) mx = fmaxf(mx, sc[t]);
    mx = wave_max(mx, lane);
    float sm = 0.f;
    for (int t = lane; t < 387; t += 64) sm += ex2(sc[t] - mx);
    sm = wave_sum(sm, lane);
    const u32x2v vnraw = *(const u32x2v*)(p_VB + row * 768 + hh * 64 + dl);
    const f32x4 vnewv = (f32x4){bflo(vnraw.x), bfhi(vnraw.x), bflo(vnraw.y), bfhi(vnraw.y)};
    f32x4 vv[13];
#pragma unroll
    for (int it = 0; it < 13; ++it) { int slot = 32 * it + grp; if (slot > 386) slot = 386; const int pp = slot / 129, jj = slot - 129 * pp, idx = 2048 - (jj << (2 * pp));
        vv[it] = vnewv; if (idx < 2048) vv[it] = __builtin_nontemporal_load((const f32x4*)(cv + (size_t)idx * 768 + dl)); }
    f32x4 o4 = (f32x4){0.f, 0.f, 0.f, 0.f};
#pragma unroll
    for (int it = 0; it < 13; ++it) { const int slot = 32 * it + grp; if (slot < 387) o4 += vv[it] * ex2(sc[slot] - mx); }
#pragma unroll
    for (int e = 0; e < 4; ++e) { o4[e] += shx(o4[e], 16, lane); o4[e] += shx(o4[e], 32, lane); }
    if (lane < 16) *(LAS f32x4*)(po + wave * 64 + dl) = o4;
    __syncthreads();
    if (wave == 0) { float t = 0.f;
#pragma unroll
        for (int w = 0; w < 8; ++w) t += po[w * 64 + lane];
        t *= 1.0f / sm;
        p_YB[row * 2048 + hh * 64 + lane] = (bf16)f2bf(t * bf2f(p_ZB[row * 2048 + hh * 64 + lane])); }
}
DI void samp_sgu_item(const Ctx& C, int l, int item) { bf16* const p_BU = ((bf16*)WSP(WS_BU)); bf16* const p_BV = ((bf16*)WSP(WS_BV)); bf16* const p_YB = ((bf16*)WSP(WS_YB)); bf16* const p_ZB = ((bf16*)WSP(WS_ZB)); const float* const p_ln_b = ((const float*)INP(10)); const float* const p_ln_g = ((const float*)INP(9)); float* const p_out = OUTP(); const float* const p_sgu_b = ((const float*)INP(12)); const float* const p_sgu_w = ((const float*)INP(11));
    const int b = 8 * item + C.wave, lane = C.lane; const size_t row = MPR + b;
    const v4u raw = *(const v4u*)(p_BV + row * 512 + 8 * lane);
    float x[8] = {bflo(raw.x), bfhi(raw.x), bflo(raw.y), bfhi(raw.y), bflo(raw.z), bfhi(raw.z), bflo(raw.w), bfhi(raw.w)};
    float s = 0.f;
#pragma unroll
    for (int e = 0; e < 8; ++e) s += x[e];
    const float mean = wave_sum(s, lane) * (1.0f / 512.0f); float q = 0.f;
#pragma unroll
    for (int e = 0; e < 8; ++e) { x[e] -= mean; q += x[e] * x[e]; }
    const float rstd = __builtin_amdgcn_rsqf(wave_sum(q, lane) * (1.0f / 512.0f) + EPSF);
    const int g = lane >> 3; const float w00 = p_sgu_w[(size_t)((l * 8 + g) * 128) * 128], bb = p_sgu_b[(l * 8 + g) * 128];
    const v4u ur = *(const v4u*)(p_BU + row * 512 + 8 * lane), zr = *(const v4u*)(p_ZB + row * 2048 + 768 + 8 * lane);
    const float uu[8] = {bflo(ur.x), bfhi(ur.x), bflo(ur.y), bfhi(ur.y), bflo(ur.z), bfhi(ur.z), bflo(ur.w), bfhi(ur.w)};
    const float zz[8] = {bflo(zr.x), bfhi(zr.x), bflo(zr.y), bfhi(zr.y), bflo(zr.z), bfhi(zr.z), bflo(zr.w), bfhi(zr.w)};
    float vn[8], y[8];
#pragma unroll
    for (int e = 0; e < 8; ++e) { vn[e] = x[e] * rstd * p_ln_g[l * 512 + 8 * lane + e] + p_ln_b[l * 512 + 8 * lane + e]; y[e] = uu[e] * (w00 * vn[e] + bb) * zz[e]; }
    float* od = p_out + O_SGU + (size_t)(l * 32 + b) * 512 + 8 * lane;
    *(f32x4*)od = (f32x4){vn[0], vn[1], vn[2], vn[3]}; *(f32x4*)(od + 4) = (f32x4){vn[4], vn[5], vn[6], vn[7]};
    v4u w; w.x = cvtpk2(y[0], y[1]); w.y = cvtpk2(y[2], y[3]); w.z = cvtpk2(y[4], y[5]); w.w = cvtpk2(y[6], y[7]);
    *(v4u*)(p_YB + row * 2048 + 768 + 8 * lane) = w;
}
DI void samp_hgrn_item(const Ctx& C, int l, int item) { bf16* const p_CE = ((bf16*)WSP(WS_CE)); bf16* const p_CI = ((bf16*)WSP(WS_CI)); bf16* const p_CK = ((bf16*)WSP(WS_CK)); bf16* const p_CQ = ((bf16*)WSP(WS_CQ)); bf16* const p_YB = ((bf16*)WSP(WS_YB)); bf16* const p_ZB = ((bf16*)WSP(WS_ZB)); const float* const p_hn_g = ((const float*)INP(14)); float* const p_out = OUTP(); const float* const p_state = ((const float*)INP(4));
    const int b = item / 6, hh = item % 6, tid = C.tid; const size_t row = MPR + b;
    LAS float* qs = (LAS float*)C.lds; LAS float* eg = qs + 128; LAS float* kx = eg + 128; LAS float* vv = kx + 128; LAS float* po = vv + 128; LAS float* ov = po + 2048; LAS float* pr = ov + 128;
    if (tid < 128) { const size_t o = row * 768 + hh * 128 + tid; qs[tid] = bf2f(p_CQ[o]); eg[tid] = bf2f(p_CE[o]); kx[tid] = bf2f(p_CK[o]); vv[tid] = bf2f(p_CI[o]); }
    __syncthreads();
    const int v4 = (tid & 31) * 4, kq = tid >> 5;
    const f32x4 vloc = *(LAS const f32x4*)(vv + v4); f32x4 acc = (f32x4){0.f, 0.f, 0.f, 0.f};
    const float* S0 = p_state + (size_t)((l * 32 + b) * 6 + hh) * 16384; float* S1 = p_out + O_HS + (size_t)((l * 32 + b) * 6 + hh) * 16384;
#pragma unroll
    for (int kk = 0; kk < 8; ++kk) { const int k = 8 * kq + kk; const f32x4 s = __builtin_nontemporal_load((const f32x4*)(S0 + k * 128 + v4)); const f32x4 sn = s * eg[k] + vloc * kx[k]; __builtin_nontemporal_store(sn, (f32x4*)(S1 + k * 128 + v4)); acc += sn * qs[k]; }
    *(LAS f32x4*)(po + kq * 128 + v4) = acc;
    __syncthreads();
    float o = 0.f;
    if (tid < 128) {
#pragma unroll
        for (int q4 = 0; q4 < 16; ++q4) o += po[q4 * 128 + tid];
        const float ss = wave_sum(o * o, C.lane); if (C.lane == 0) pr[C.wave] = ss; }
    __syncthreads();
    if (tid < 128) { const float rstd = __builtin_amdgcn_rsqf((pr[0] + pr[1]) * (1.0f / 128.0f) + EPSF);
        p_YB[row * 2048 + 1280 + hh * 128 + tid] = (bf16)f2bf(o * rstd * p_hn_g[l * 768 + hh * 128 + tid] * bf2f(p_ZB[row * 2048 + 1280 + hh * 128 + tid])); }
}
DI void samp_out_item(const Ctx& C, int l, int item) { const float* const p_x_sample = ((const float*)INP(1)); float* const p_SSQ1 = ((float*)WSP(WS_CTL + CTL_SSQ1)); bf16* const p_WOUT = ((bf16*)WSP(WS_WOUT)); float* const p_X1 = ((float*)WSP(WS_X1)); bf16* const p_XB = ((bf16*)WSP(WS_XB)); bf16* const p_YB = ((bf16*)WSP(WS_YB)); float* const p_out = OUTP();
    const int lane = C.lane, wave = C.wave, i = lane & 31, h = lane >> 5, n0 = 32 * item;
    const bf16* A = p_YB + (size_t)(MPR + i) * 2048 + 256 * wave + 8 * h; const bf16* B = p_WOUT + ((size_t)l * DM + n0 + i) * 2048 + 256 * wave + 8 * h;
    f32x16 acc = zero16();
#pragma unroll
    for (int ks = 0; ks < 16; ++ks) acc = MFMA32(*(const bf16x8*)(A + 16 * ks), *(const bf16x8*)(B + 16 * ks), acc);
    LAS float* red = (LAS float*)C.lds;
#pragma unroll
    for (int r = 0; r < 16; ++r) red[(wave * 16 + r) * 64 + lane] = acc[r];
    __syncthreads();
    const int tl = C.tid & 63, i2 = tl & 31, h2 = tl >> 5;
#pragma unroll
    for (int e = 0; e < 2; ++e) { const int r = (C.tid >> 6) * 2 + e; float s = 0.f;
#pragma unroll
        for (int w = 0; w < 8; ++w) s += red[(w * 16 + r) * 64 + tl];
        const int bb = crow(r, h2), n = n0 + i2;
        if (l == 0) { const float o = p_x_sample[(size_t)bb * DM + n] + s; p_XB[(size_t)(MPR + bb) * DM + n] = (bf16)f2bf(o);
            float ss = o * o; ss += shx(ss, 1, lane); ss += shx(ss, 2, lane); ss += shx(ss, 4, lane); ss += shx(ss, 8, lane); ss += shx(ss, 16, lane);
            if (i2 == 0) atomicAdd(p_SSQ1 + MPR + bb, ss); }
        else { p_out[O_YS + (size_t)bb * DM + n] = bf2f(p_XB[(size_t)(MPR + bb) * DM + n]) + s; } }
}
DI int fetch_item(Ctx& C, int q) { gu32* const p_ctl = ((gu32*)WSP(WS_CTL));
    __syncthreads();
    if (C.tid == 0) C.MISC[0] = __hip_atomic_fetch_add((unsigned*)(p_ctl + CW_Q + 64 * q), 1u, __ATOMIC_RELAXED, __HIP_MEMORY_SCOPE_AGENT);
    __syncthreads();
    const int it = (int)C.MISC[0];
    { int t_ = C.tid; asm volatile("" : "+v"(t_)); C.tid = t_; C.lane = t_ & 63; C.wave = __builtin_amdgcn_readfirstlane(t_ >> 6);
      LAS unsigned char* lp_ = C.lds; asm volatile("" : "+s"(lp_)); C.lds = lp_; C.MISC = (volatile LAS unsigned*)(lp_ + MISC_OFF); }
    return it;
}
#ifndef G1_STAGGER_TICKS
#define G1_STAGGER_TICKS 0
#endif
#ifndef RPT_PHASE
#define RPT_PHASE -1
#define RPT_N 0
#endif
#ifndef RPT_IMASK
#define RPT_IMASK 0xffff
#endif
#ifndef RPT_MASK
#define RPT_MASK 0
#endif
#ifndef PH_MASK
#define PH_MASK 2047
#endif
constexpr int N_ATT = 384, N_HG = 192, N_HGP = 48, N_A1 = 384, N_SGU = 128, N_SAT = 384, N_SHG = 192, N_SSG = 4;
constexpr int N_M1 = N_HGP + N_ATT + N_SAT + N_SGU + N_SHG + N_SSG, N_WT = 184, N_KVO = 0;
constexpr int N_SOUT = 32;

template <int KIND, int L> DI void run_kind(Ctx& C, int im, int bx_) {
    constexpr int l = L;
    if constexpr (KIND == 0) { p0_prologue(C); }
    else if constexpr (KIND == 1) {
        pg8::Gemm g{((bf16*)WSP(WS_XB)), ((bf16*)WSP(WS_WIN)) + (size_t)l * NIN * DM, MPAD, NIN, DM}; pg8::StaticOrder S; S.init(MPAD, NIN, NGRID, bx_);
        pg8::EpiProj E{l == 0 ? ((float*)WSP(WS_CTL + CTL_SSQ0)) : ((float*)WSP(WS_CTL + CTL_SSQ1)), ((float*)WSP(WS_LB)) + l * 3 * 768, WSP(0), OUTP(), l, (im & 2048) ? 0 : 1,
                       WS_QB, WS_KB - WS_QB, WS_ZB, WS_BU, WS_BV - WS_BU, WS_CQ, WS_CK - WS_CQ, WS_CE, WS_DJ, WS_KH, WS_VH - WS_KH,
                       O_KP + (size_t)l * MPR * 768, O_VP - O_KP, O_KS + (size_t)l * 32 * 768, O_VS - O_KS};
#if G1_STAGGER_TICKS > 0
        { const unsigned long long t0 = __builtin_amdgcn_s_memrealtime(), dt = (unsigned long long)((bx_ >> 3) & 3) * G1_STAGGER_TICKS;
          while (__builtin_amdgcn_s_memrealtime() - t0 < dt) __builtin_amdgcn_s_sleep(8); }
#endif
        pg8::gemm_phase<pg8::EpiProj, pg8::StaticOrder, true, true>(C.lds + RING_OFF, g, S, E);
    } else if constexpr (KIND == 2) {
        for (;;) { int it = fetch_item(C, 3 * l + 0); if (it >= N_M1 + N_KVO + (l == 0 ? N_WT : 0)) break;
            if (it < N_HGP) { if (im & 8) hgp_item(C, l, it); continue; } it -= N_HGP;
            if (it < N_ATT) { if (im & 4) { if (it < 192) att23_item<2>(C, it); else att23_item<3>(C, it - 192); } continue; } it -= N_ATT;
            if (it < N_SAT) { if (im & 16) samp_attn_item(C, l, it); continue; } it -= N_SAT;
            if (it < N_SGU) { if (im & 32) sgu_item(C, l, it); continue; } it -= N_SGU;
            if (it < N_SHG) { if (im & 64) samp_hgrn_item(C, l, it); continue; } it -= N_SHG;
            if (it < N_SSG) { if (im & 128) samp_sgu_item(C, l, it); continue; } it -= N_SSG;
            if (it < N_KVO) { if (im & 128) kvout_item(C, l, it); continue; } it -= N_KVO;
            if (im & 128) wt_item(C, it); }
    } else if constexpr (KIND == 4) {
        for (;;) { int it = fetch_item(C, 3 * l + 2); if (it >= N_HG + N_A1 + N_SOUT) break;
            if (it < N_A1) { if (im & 512) att1_item(C, it); continue; } it -= N_A1;
            if (it < N_HG) { if (im & 256) hg3_item(C, l, it); continue; } it -= N_HG;
            if (im & 1024) samp_out_item(C, l, it); }
    } else {
        pg8::Gemm g{((bf16*)WSP(WS_YB)), ((bf16*)WSP(WS_WOUT)) + (size_t)l * DM * DMIX, MPR, DM, DMIX}; pg8::StaticOrder S; S.init(MPR, DM, NGRID, bx_);
        pg8::EpiOut E{l == 0 ? ((const float*)INP(0)) : nullptr, l == 0 ? nullptr : ((bf16*)WSP(WS_XB)), l == 0 ? nullptr : (OUTP()) + O_YP, l == 0 ? ((bf16*)WSP(WS_XB)) : nullptr, l == 0 ? ((float*)WSP(WS_CTL + CTL_SSQ1)) : nullptr};
        pg8::gemm_phase<pg8::EpiOut, pg8::StaticOrder, true, true>(C.lds + RING_OFF, g, S, E);
    }
}

__global__ void __launch_bounds__(NWAVES * 64, 2) mega_fwd(Args args) {
    extern __shared__ __attribute__((aligned(16))) unsigned char lds[];
    Ctx C;
    C.lds = (LAS unsigned char*)lds; C.MISC = (volatile LAS unsigned*)(C.lds + MISC_OFF);
    C.tid = threadIdx.x; C.lane = C.tid & 63; C.wave = __builtin_amdgcn_readfirstlane(C.tid >> 6);
    C.G = NGRID; C.vcu = 0;
    for (int u = C.tid; u < (LDS_BYTES - MISC_OFF) / 4; u += NWAVES * 64) ((LAS unsigned*)(C.lds + MISC_OFF))[u] = 0u;
    __syncthreads();
    XcdBarrier bar; bar.bar = (unsigned*)(((gu32*)WSP(WS_CTL)) + CW_BAR); bar.x = 0; bar.st = nullptr;
    if (N_LAUNCHES == 1) bar = xcd_barrier_post((unsigned*)(((gu32*)WSP(WS_CTL)) + CW_BAR), C.MISC + 8);
    const int lo = args.ph_lo, hi = args.ph_hi, im = args.imask;
    const int wave_s = __builtin_amdgcn_readfirstlane(threadIdx.x >> 6);
#define RELAUNDER() do { int t_ = (wave_s << 6) | (int)__builtin_amdgcn_mbcnt_hi(~0u, __builtin_amdgcn_mbcnt_lo(~0u, 0u)); asm volatile("" : "+v"(t_)); C.tid = t_; C.lane = t_ & 63; C.wave = __builtin_amdgcn_readfirstlane(t_ >> 6); \
        LAS unsigned char* lp_ = (LAS unsigned char*)lds; asm volatile("" : "+s"(lp_)); C.lds = lp_; C.MISC = (volatile LAS unsigned*)(lp_ + MISC_OFF); } while (0)
#define PHASE(p, KIND, L) if (lo <= (p) && (p) < hi) { RELAUNDER(); int bx_ = blockIdx.x; asm volatile("" : "+s"(bx_)); C.vcu = (bx_ & 7) * (NGRID >> 3) + (bx_ >> 3); run_kind<KIND, L>(C, im, bx_); \
        if (N_LAUNCHES == 1 && (p) + 1 < hi) { XcdBarrier b2; b2.bar = (unsigned*)(((gu32*)WSP(WS_CTL)) + CW_BAR); unsigned x2_ = bar.x; asm volatile("" : "+s"(x2_)); b2.x = x2_; b2.st = C.MISC + 8; xcd_barrier(b2); } }
    PHASE(0, 0, 0)
    PHASE(1, 1, 0) PHASE(2, 2, 0) PHASE(3, 4, 0) PHASE(4, 5, 0)
    PHASE(5, 1, 1) PHASE(6, 2, 1) PHASE(7, 4, 1) PHASE(8, 5, 1)
#undef PHASE
#undef RELAUNDER
}

extern "C" void kernel_launch(void* const* d_in, const int* in_sizes, int n_in, void* d_out, int out_size, void* d_ws, size_t ws_size, hipStream_t stream) {
    static int grid = 0;
    if (grid == 0) {
        if (n_in != 16 || (size_t)out_size != O_END || ws_size < WS_END) { fprintf(stderr, "kernel_launch: unexpected shapes: n_in %d out %d ws %zu (need %zu)\n", n_in, out_size, ws_size, (size_t)WS_END); grid = -1; return; }
        int dev = 0, cus = 0, per_cu = 0;
        if (hipGetDevice(&dev) != hipSuccess || hipDeviceGetAttribute(&cus, hipDeviceAttributeMultiprocessorCount, dev) != hipSuccess) { grid = -1; return; }
        if (hipFuncSetAttribute((const void*)mega_fwd, hipFuncAttributeMaxDynamicSharedMemorySize, LDS_BYTES) != hipSuccess) { fprintf(stderr, "kernel_launch: hipFuncSetAttribute failed\n"); grid = -1; return; }
        if (hipOccupancyMaxActiveBlocksPerMultiprocessor(&per_cu, (const void*)mega_fwd, NWAVES * 64, LDS_BYTES) != hipSuccess || per_cu < 1) { fprintf(stderr, "kernel_launch: occupancy query says %d\n", per_cu); (void)hipGetLastError(); per_cu = 1; }
        if (cus < NGRID) { fprintf(stderr, "kernel_launch: %d CUs < %d workgroups: not co-resident\n", cus, NGRID); grid = -1; return; }
        grid = NGRID;
    }
    if (grid < 0) return;
    (void)hipMemsetAsync((char*)d_ws + WS_CTL, 0, CTL_ZERO_BYTES, stream);
    Args a{};
    for (int i = 0; i < 16; ++i) a.in[i] = (const float*)d_in[i];
    a.out = (float*)d_out; a.ws = (unsigned char*)d_ws; a.imask = 0xffff;
    if (N_LAUNCHES == 1) { a.ph_lo = 0; a.ph_hi = N_PHASES; hipLaunchKernelGGL(mega_fwd, dim3(grid), dim3(NWAVES * 64), LDS_BYTES, stream, a); }
    else for (int p = 0; p < N_PHASES; ++p) { a.ph_lo = p; a.ph_hi = p + 1;
        const int nl = 1 + ((p == RPT_PHASE) ? RPT_N : 0);
        for (int r = 0; r < nl; ++r) {
            if (r > 0 && p >= 1) { const int l = (p - 1) / 4, k = (p - 1) % 4; if (k == 1 || k == 2) (void)hipMemsetAsync((char*)d_ws + WS_CTL + (size_t)(CW_Q + 64 * (3 * l + (k == 1 ? 0 : 2))) * 4, 0, 4, stream); }
            a.imask = (r > 0) ? RPT_IMASK : 0xffff;
            hipLaunchKernelGGL(mega_fwd, dim3(grid), dim3(NWAVES * 64), LDS_BYTES, stream, a); } }
}
```

```cpp
#include <hip/hip_runtime.h>
#include <cstdio>
#include <cstdint>
namespace pg8 {
#define PG8_LAS __attribute__((address_space(3)))
typedef unsigned short bf16_t;
typedef short bf16x8 __attribute__((ext_vector_type(8)));
typedef float f32x4 __attribute__((ext_vector_type(4)));
typedef unsigned u32x4 __attribute__((ext_vector_type(4)));
constexpr int BM = 256, BK = 64, HALF = 128, HTB = HALF * BK * 2  , STAGE_BYTES = 8 * HTB, NXCD = 8, WGM = 8;

__host__ __device__ __forceinline__ int lds_byte(int r, int c) { const int st = (r >> 4) * 2 + (c >> 5), rr = r & 15, cc = c & 31, ob = rr * 64 + cc * 2; return st * 1024 + (ob ^ (((ob >> 9) & 1) << 5)); }
__host__ __device__ __forceinline__ void stage_rc(int b, int& R, int& C) { const int st = b / 1024, sb = b % 1024, swz = sb ^ (((sb >> 9) & 1) << 5); R = (st >> 1) * 16 + swz / 64; C = (st & 1) * 32 + (swz % 64) / 2; }
__host__ __device__ __forceinline__ int perm32(int rho) { const int n = rho >> 4, i = rho & 15; return 8 * (i >> 2) + 4 * n + (i & 3); }

struct Unit { int pm, pn; };
struct Gemm { const bf16_t* A; const bf16_t* Bt; int M, N, K; };

struct StaticOrder {
    int nM, nN, nwg, G, c;
    __host__ __device__ void init(int M, int N, int G_, int c_) { nM = M / BM; nN = N / BM; nwg = nM * nN; G = G_; c = c_; }
    __host__ __device__ bool next(int i, Unit& u) const {
        const long L = (long)i * G + c; if (L >= nwg) return false;
        int wgid = (int)L; { const int q = nwg / NXCD, r = nwg % NXCD, xcd = wgid % NXCD, off = wgid / NXCD; wgid = (xcd < r ? xcd * (q + 1) : r * (q + 1) + (xcd - r) * q) + off; }
        const int nig = WGM * nN, gid = wgid / nig, fm = gid * WGM, gsz = (nM - fm) < WGM ? (nM - fm) : WGM;
        u.pm = fm + ((wgid % nig) % gsz); u.pn = (wgid % nig) / gsz; return true;
    }
    __device__ __forceinline__ void a_ready(const Unit&) const {}
    __device__ __forceinline__ void done(const Unit&) const {}
};


typedef float f32x2 __attribute__((ext_vector_type(2)));
typedef unsigned u32x2 __attribute__((ext_vector_type(2)));
typedef __bf16 bf16x2_t __attribute__((ext_vector_type(2)));
__device__ __forceinline__ unsigned cvtpk(float lo, float hi) { f32x2 v = {lo, hi}; bf16x2_t b = __builtin_convertvector(v, bf16x2_t); return __builtin_bit_cast(unsigned, b); }
__device__ __forceinline__ float fast_sigmoid(float x) { return __builtin_amdgcn_rcpf(1.0f + __expf(-x)); }
__device__ __forceinline__ float silu_f(float x) { return x * fast_sigmoid(x); }

template <int CTRL> __device__ __forceinline__ float dpp_f(float x) { return __builtin_bit_cast(float, __builtin_amdgcn_update_dpp(0, __builtin_bit_cast(int, x), CTRL, 0xf, 0xf, false)); }
template <int CTRL> __device__ __forceinline__ float dpp_f1(float x) { return __builtin_bit_cast(float, __builtin_amdgcn_update_dpp(0x3f800000, __builtin_bit_cast(int, x), CTRL, 0xf, 0xf, false)); }
__device__ __forceinline__ float row_prefprod16(float x) { x *= dpp_f1<0x111>(x); x *= dpp_f1<0x112>(x); x *= dpp_f1<0x114>(x); x *= dpp_f1<0x118>(x); return x; }
__device__ __forceinline__ float row_bcast15(float x) { return __builtin_bit_cast(float, __builtin_amdgcn_update_dpp(0, __builtin_bit_cast(int, x), 0x15F, 0xf, 0xf, false)); }
__device__ __forceinline__ float row_prefix16(float x) { x += dpp_f<0x111>(x); x += dpp_f<0x112>(x); x += dpp_f<0x114>(x); x += dpp_f<0x118>(x); return x; }
struct EpiProj {
    static constexpr bool PERM = true, AFTER_DRAIN = false, HEADPERM = true;
    const float* ssq;
    const float* gtab;
    unsigned char* ws; float* out; int l; int skip;
    size_t o_qkv, s_qkv, o_zb, o_bu, s_bu, o_cq, s_cq, o_ce, o_dj, o_kh, s_kh;
    size_t o_kp, s_kp, o_ks, s_ks;
    __device__ __forceinline__ void st8(bf16_t* p, const f32x4& a, const f32x4& b) const {
        u32x4 w; w.x = cvtpk(a[0], a[1]); w.y = cvtpk(a[2], a[3]); w.z = cvtpk(b[0], b[1]); w.w = cvtpk(b[2], b[3]); *(u32x4*)p = w; }
    __device__ __forceinline__ void operator()(const f32x4 (&acc)[2][2][4][2], const Unit& u, int wr, int wc, int fr, int fq) const {
        if (skip) return;
        const int pn = u.pn;
        int seg, seg0;
        if (pn < 12) { seg = pn / 3; seg0 = seg * 3; }
        else if (pn < 18) { seg = 4 + (pn - 12) / 2; seg0 = 12 + (seg - 4) * 2; }
        else { seg = 7 + (pn - 18) / 3; seg0 = 18 + (seg - 7) * 3; }
        const int cl = (pn - seg0) * 256 + wc * 64 + 8 * fq;
        const int rowb = u.pm * BM + wr * 64 + fr;
        const bool sample = (u.pm == 64);
        f32x4 gv[2][2];
        { const int gi = (seg == 0) ? 0 : (seg == 1 ? 1 : 2); const float* gp = gtab + gi * 768 + (seg == 0 || seg == 1 || seg == 8 ? cl : 0);
#pragma unroll
          for (int bj = 0; bj < 2; ++bj)
#pragma unroll
              for (int n = 0; n < 2; ++n) gv[bj][n] = *(const f32x4*)(gp + 32 * bj + 4 * n); }
        if (seg == 8) {
            const int lane_hi15 = ((fq << 4) | 15);
            float rsc[2][4];
#pragma unroll
            for (int ai = 0; ai < 2; ++ai)
#pragma unroll
                for (int m = 0; m < 4; ++m) rsc[ai][m] = ssq[rowb + ai * HALF + m * 16];
#pragma unroll
            for (int ai = 0; ai < 2; ++ai)
#pragma unroll
                for (int mp = 0; mp < 2; ++mp) {
                    const int rowA = rowb + ai * HALF + mp * 32, rowB = rowA + 16;
                    const float rsA = __builtin_amdgcn_rsqf(rsc[ai][2 * mp] * (1.0f / 1024.0f) + 1e-6f), rsB = __builtin_amdgcn_rsqf(rsc[ai][2 * mp + 1] * (1.0f / 1024.0f) + 1e-6f);
#pragma unroll
                    for (int bj = 0; bj < 2; ++bj) {
                        f32x4 eA[2], eB[2], kA[2], kB[2], dl[2];
#pragma unroll
                        for (int n = 0; n < 2; ++n)
#pragma unroll
                            for (int e = 0; e < 4; ++e) { const float lbv = gv[bj][n][e], omlb = 1.0f - lbv;
                                const float sa = fast_sigmoid(acc[ai][bj][2 * mp][n][e] * rsA), sb = fast_sigmoid(acc[ai][bj][2 * mp + 1][n][e] * rsB);
                                float ka = omlb - omlb * sa, kb = omlb - omlb * sb, pa = lbv + omlb * sa, pb = lbv + omlb * sb;
                                if (!sample) { pa = row_prefprod16(pa); const float t0 = row_bcast15(pa); pb = row_prefprod16(pb) * t0; dl[n][e] = row_bcast15(pb);
                                    ka *= __builtin_amdgcn_rcpf(pa); kb *= __builtin_amdgcn_rcpf(pb); }
                                eA[n][e] = pa; eB[n][e] = pb; kA[n][e] = ka; kB[n][e] = kb; }
                        bf16_t* dkA = (bf16_t*)(ws + o_cq + s_cq) + (size_t)rowA * 768 + cl + 32 * bj; bf16_t* deA = (bf16_t*)(ws + o_ce) + (size_t)rowA * 768 + cl + 32 * bj;
                        st8(dkA, kA[0], kA[1]); st8(dkA + 16 * 768, kB[0], kB[1]); st8(deA, eA[0], eA[1]); st8(deA + 16 * 768, eB[0], eB[1]);
                        if (!sample && fr == 0) { float* dd = (float*)(ws + o_dj) + (size_t)(rowA >> 5) * 768 + cl + 32 * bj; *(f32x4*)dd = dl[0]; *(f32x4*)(dd + 4) = dl[1]; }
                    }
                    asm volatile("" ::: "memory");
                }
            return;
        }
        float rsv[2][4];
#pragma unroll
        for (int ai = 0; ai < 2; ++ai)
#pragma unroll
            for (int m = 0; m < 4; ++m) rsv[ai][m] = ssq[rowb + ai * HALF + m * 16];
#pragma unroll
        for (int ai = 0; ai < 2; ++ai)
#pragma unroll
            for (int m = 0; m < 4; ++m) {
                const int row = rowb + ai * HALF + m * 16;
                const float rs = __builtin_amdgcn_rsqf(rsv[ai][m] * (1.0f / 1024.0f) + 1e-6f);
                f32x4 v[2][2];
#pragma unroll
                for (int bj = 0; bj < 2; ++bj)
#pragma unroll
                    for (int n = 0; n < 2; ++n) v[bj][n] = acc[ai][bj][m][n] * rs;
                if (seg <= 1) {
                    float ss = 0.f;
#pragma unroll
                    for (int bj = 0; bj < 2; ++bj)
#pragma unroll
                        for (int n = 0; n < 2; ++n) { const f32x4 x = v[bj][n]; ss += (x[0] * x[0] + x[1] * x[1]) + (x[2] * x[2] + x[3] * x[3]); }
                    ss += __shfl_xor(ss, 16); ss += __shfl_xor(ss, 32);
                    float r2 = __builtin_amdgcn_rsqf(ss * (1.0f / 64.0f) + 1e-6f);
                    if (seg == 0) r2 *= 0.125f * 1.4426950408889634f;
#pragma unroll
                    for (int bj = 0; bj < 2; ++bj)
#pragma unroll
                        for (int n = 0; n < 2; ++n) v[bj][n] = v[bj][n] * gv[bj][n] * r2;
                }
                if (seg <= 2) {
                    if (seg == 0 || sample) {
                        bf16_t* dst = (bf16_t*)(ws + o_qkv + (size_t)seg * s_qkv) + (size_t)row * 768 + cl;
#pragma unroll
                        for (int bj = 0; bj < 2; ++bj) st8(dst + 32 * bj, v[bj][0], v[bj][1]);
                    } else {
                        const int t = row & 2047, bb = row >> 11, head = cl >> 6;
                        bf16_t* dst = (bf16_t*)(ws + o_kh + (size_t)(seg - 1) * s_kh) + ((size_t)(((bb * 12 + head) * 16 + (t & 15)) * 128 + (t >> 4))) * 64 + (cl & 63);
#pragma unroll
                        for (int bj = 0; bj < 2; ++bj) st8(dst + 32 * bj, v[bj][0], v[bj][1]);
                    }
                    if (seg >= 1) {
                        const bool okp = !sample, oks = sample && (row - 16384 < 32);
                        float* o = out + (okp ? o_kp + (size_t)(seg - 1) * s_kp + (size_t)row * 768 : o_ks + (size_t)(seg - 1) * s_ks + (size_t)(row - 16384) * 768) + cl;
                        if (okp || oks) {
#pragma unroll
                            for (int bj = 0; bj < 2; ++bj) { __builtin_nontemporal_store(v[bj][0], (f32x4*)(o + 32 * bj)); __builtin_nontemporal_store(v[bj][1], (f32x4*)(o + 32 * bj + 4)); }
                        }
                    }
                } else if (seg == 3 || seg == 6 || seg == 10 || seg == 7) {
#pragma unroll
                    for (int bj = 0; bj < 2; ++bj)
#pragma unroll
                        for (int n = 0; n < 2; ++n)
#pragma unroll
                            for (int e = 0; e < 4; ++e) v[bj][n][e] = silu_f(v[bj][n][e]);
                    const size_t zo = (seg == 7) ? o_cq + ((size_t)row * 768 + cl) * 2 : o_zb + ((size_t)row * 2048 + (seg == 3 ? 0 : (seg == 6 ? 768 : 1280)) + cl) * 2;
                    bf16_t* dst = (bf16_t*)(ws + zo);
#pragma unroll
                    for (int bj = 0; bj < 2; ++bj) st8(dst + 32 * bj, v[bj][0], v[bj][1]);
                } else if (seg == 4 || seg == 5) {
                    bf16_t* dst = (bf16_t*)(ws + o_bu + (size_t)(seg - 4) * s_bu) + (size_t)row * 512 + cl;
#pragma unroll
                    for (int bj = 0; bj < 2; ++bj) st8(dst + 32 * bj, v[bj][0], v[bj][1]);
                } else if (seg == 9) {
                    bf16_t* dst = (bf16_t*)(ws + o_cq + 2 * s_cq) + (size_t)row * 768 + cl;
#pragma unroll
                    for (int bj = 0; bj < 2; ++bj) st8(dst + 32 * bj, v[bj][0], v[bj][1]);
                }
                asm volatile("" ::: "memory");
            }
    }
};
struct EpiOut {
    static constexpr bool PERM = false, AFTER_DRAIN = false, HEADPERM = false;
    const float* res; const bf16_t* resb; float* out; bf16_t* xb; float* ssq;
    __device__ __forceinline__ f32x4 ldres(size_t off) const {
        if (res) return __builtin_nontemporal_load((const f32x4*)(res + off));
        const u32x2 w = *(const u32x2*)(resb + off); return (f32x4){__uint_as_float(w.x << 16), __uint_as_float(w.x & 0xffff0000u), __uint_as_float(w.y << 16), __uint_as_float(w.y & 0xffff0000u)}; }
    __device__ __forceinline__ void operator()(const f32x4 (&acc)[2][2][4][2], const Unit& u, int wr, int wc, int fr, int fq) const {
        const int col0 = u.pn * BM + wc * 32 + 4 * fq;
        const size_t off0 = (size_t)(u.pm * BM + wr * 64 + fr) * 1024 + col0;
        f32x4 rcur[2][2], rnxt[2][2];
#pragma unroll
        for (int bj = 0; bj < 2; ++bj)
#pragma unroll
            for (int n = 0; n < 2; ++n) rcur[bj][n] = ldres(off0 + bj * HALF + n * 16);
#pragma unroll
        for (int it = 0; it < 8; ++it) {
            const int ai = it >> 2, m = it & 3;
            const int row = u.pm * BM + ai * HALF + wr * 64 + m * 16 + fr; const size_t off = (size_t)row * 1024 + col0; float ss = 0.f;
            if (it < 7) { const int ai2 = (it + 1) >> 2, m2 = (it + 1) & 3; const size_t offn = off0 + (size_t)(ai2 * HALF + m2 * 16) * 1024;
#pragma unroll
                for (int bj = 0; bj < 2; ++bj)
#pragma unroll
                    for (int n = 0; n < 2; ++n) rnxt[bj][n] = ldres(offn + bj * HALF + n * 16); }
#pragma unroll
            for (int bj = 0; bj < 2; ++bj)
#pragma unroll
                for (int n = 0; n < 2; ++n) { const f32x4 o = rcur[bj][n] + acc[ai][bj][m][n];
                    if (out) __builtin_nontemporal_store(o, (f32x4*)(out + off + bj * HALF + n * 16));
                    ss += (o[0] * o[0] + o[1] * o[1]) + (o[2] * o[2] + o[3] * o[3]);
                    if (xb) { u32x2 w; w.x = cvtpk(o[0], o[1]); w.y = cvtpk(o[2], o[3]); *(u32x2*)(xb + off + bj * HALF + n * 16) = w; } }
            if (ssq) { ss += __shfl_xor(ss, 16); ss += __shfl_xor(ss, 32); if (fq == 0) atomicAdd(ssq + row, ss); }
#pragma unroll
            for (int bj = 0; bj < 2; ++bj)
#pragma unroll
                for (int n = 0; n < 2; ++n) rcur[bj][n] = rnxt[bj][n];
        }
    }
};
template <class Epi, class Sched, bool ALIGN_EPI = false, bool SP2 = false>
__device__ __forceinline__ void gemm_phase(PG8_LAS unsigned char* lds, const Gemm g, const Sched& S, const Epi& E) {
    int tid_ = threadIdx.x; asm volatile("" : "+v"(tid_));
    const int tid = tid_, wid = __builtin_amdgcn_readfirstlane(tid >> 6), lane = tid & 63, wr = wid >> 2, wc = wid & 3, fr = lane & 15, fq = lane >> 4;
    const int K = g.K, nt = K / BK;
    unsigned voffA[2], voffB[2];
#pragma unroll
    for (int i = 0; i < 2; ++i) { int R, C; stage_rc(tid * 16 + i * 8192, R, C); const int Rb = Epi::HEADPERM ? (64 * (R >> 5) + perm32(R & 31)) : (Epi::PERM ? ((R & ~31) + perm32(R & 31)) : R);
        voffA[i] = (unsigned)(R * K + C) * 2u; voffB[i] = (unsigned)(Rb * K + C) * 2u; }
    const size_t kstep = (size_t)(BK * 2);
    const size_t hstep = (size_t)HALF * K * 2;
    const size_t tstep = 2 * hstep; const size_t hstepB = Epi::HEADPERM ? (size_t)32 * K * 2 : hstep;
    const unsigned ldsw = (unsigned)wid * 1024u;
    const int aoff = lds_byte(wr * 64 + fr, fq * 8), boff = lds_byte(wc * 32 + fr, fq * 8);
#define PG8_SA(b, h) (((b) * 2 + (h)) * HTB)
#define PG8_SB(b, h) ((4 + (b) * 2 + (h)) * HTB)
#define PG8_STAGE(bufoff, gbase, voff) do { _Pragma("unroll") for (int _i = 0; _i < 2; ++_i) \
        __builtin_amdgcn_global_load_lds((const unsigned*)((const char*)(gbase) + (voff)[_i]), (PG8_LAS unsigned*)(lds + (bufoff) + ldsw + _i * 8192), 16, 0, 0); } while (0)
#define PG8_LDA(dst, b, h) do { _Pragma("unroll") for (int m = 0; m < 4; ++m) _Pragma("unroll") for (int k = 0; k < 2; ++k) dst[m][k] = *(const PG8_LAS bf16x8*)(lds + PG8_SA(b, h) + aoff + m * 2048 + k * 1024); } while (0)
#define PG8_LDB(dst, b, h) do { _Pragma("unroll") for (int n = 0; n < 2; ++n) _Pragma("unroll") for (int k = 0; k < 2; ++k) dst[n][k] = *(const PG8_LAS bf16x8*)(lds + PG8_SB(b, h) + boff + n * 2048 + k * 1024); } while (0)
#define PG8_MMA(ai, bj, At, Bt) do { __builtin_amdgcn_s_setprio(1); _Pragma("unroll") for (int m = 0; m < 4; ++m) _Pragma("unroll") for (int n = 0; n < 2; ++n) _Pragma("unroll") for (int k = 0; k < 2; ++k) \
        acc[ai][bj][m][n] = __builtin_amdgcn_mfma_f32_16x16x32_bf16(Bt[n][k], At[m][k], acc[ai][bj][m][n], 0, 0, 0); __builtin_amdgcn_s_setprio(0); } while (0)
#define PG8_WAIT_V(n) asm volatile("s_waitcnt vmcnt(" #n ")" ::: "memory")
#define PG8_WAIT_L(n) asm volatile("s_waitcnt lgkmcnt(" #n ")" ::: "memory")
#define PG8_BAR __builtin_amdgcn_s_barrier()
#define PG8_SCHED __builtin_amdgcn_sched_barrier(0)
    Unit cur, nxt; int ui = 0;
    if (!S.next(0, cur)) return;
    f32x4 acc[2][2][4][2];
#pragma unroll
    for (int a = 0; a < 2; ++a)
#pragma unroll
        for (int b = 0; b < 2; ++b)
#pragma unroll
            for (int m = 0; m < 4; ++m)
#pragma unroll
                for (int n = 0; n < 2; ++n) acc[a][b][m][n] = (f32x4){0.f, 0.f, 0.f, 0.f};
    bf16x8 At[4][2], B0[2][2], B1[2][2];
    const char* cA = (const char*)g.A + (size_t)cur.pm * tstep; const char* cB = (const char*)g.Bt + (size_t)cur.pn * tstep;
    S.a_ready(cur);
    if constexpr (SP2) {
        PG8_STAGE(PG8_SB(0, 0), cB, voffB); PG8_STAGE(PG8_SB(0, 1), cB + hstepB, voffB); PG8_STAGE(PG8_SA(0, 0), cA, voffA); PG8_STAGE(PG8_SA(0, 1), cA + hstep, voffA);
        if (wr == 1) PG8_BAR;
        PG8_WAIT_V(2); PG8_BAR;
        PG8_STAGE(PG8_SB(1, 0), cB + kstep, voffB); PG8_STAGE(PG8_SA(1, 0), cA + kstep, voffA); PG8_STAGE(PG8_SB(1, 1), cB + hstepB + kstep, voffB);
        PG8_WAIT_V(6); PG8_BAR;
    } else {
        PG8_STAGE(PG8_SB(0, 0), cB, voffB); PG8_STAGE(PG8_SA(0, 0), cA, voffA); PG8_STAGE(PG8_SB(0, 1), cB + hstepB, voffB); PG8_STAGE(PG8_SA(0, 1), cA + hstep, voffA);
        if (wr == 1) PG8_BAR;
        PG8_WAIT_V(4); PG8_BAR;
        PG8_STAGE(PG8_SB(1, 0), cB + kstep, voffB); PG8_STAGE(PG8_SA(1, 0), cA + kstep, voffA); PG8_STAGE(PG8_SB(1, 1), cB + hstepB + kstep, voffB);
        PG8_WAIT_V(6); PG8_BAR;
    }
    for (;;) {
        const bool has_next = S.next(ui + 1, nxt);
        const char* nA = has_next ? (const char*)g.A + (size_t)nxt.pm * tstep : cA; const char* nB = has_next ? (const char*)g.Bt + (size_t)nxt.pn * tstep : cB;
        for (int t = 0; t < nt; t += 2) {
            const bool last = (t == nt - 2);
            const char* a1 = cA + (size_t)(t + 1) * kstep;
            const char* a2 = last ? nA : cA + (size_t)(t + 2) * kstep; const char* b2 = last ? nB : cB + (size_t)(t + 2) * kstep;
            const char* a3 = a2 + kstep; const char* b3 = b2 + kstep;
            if (last && has_next) S.a_ready(nxt);
            if constexpr (SP2) {
            PG8_LDB(B0, 0, 0); PG8_LDB(B1, 0, 1); PG8_SCHED; PG8_LDA(At, 0, 0); PG8_STAGE(PG8_SA(1, 1), a1 + hstep, voffA);
            PG8_WAIT_V(8); PG8_WAIT_L(0); PG8_BAR; PG8_MMA(0, 0, At, B0); PG8_MMA(0, 1, At, B1); PG8_BAR; PG8_SCHED;
            PG8_LDA(At, 0, 1); PG8_STAGE(PG8_SB(0, 0), b2, voffB); PG8_STAGE(PG8_SB(0, 1), b2 + hstepB, voffB); PG8_STAGE(PG8_SA(0, 0), a2, voffA);
            PG8_WAIT_V(8); PG8_WAIT_L(0); PG8_BAR; PG8_MMA(1, 0, At, B0); PG8_MMA(1, 1, At, B1); PG8_BAR; PG8_SCHED;
            PG8_LDB(B0, 1, 0); PG8_LDB(B1, 1, 1); PG8_SCHED; PG8_LDA(At, 1, 0); PG8_STAGE(PG8_SA(0, 1), a2 + hstep, voffA);
            PG8_WAIT_V(8); PG8_WAIT_L(0); PG8_BAR; PG8_MMA(0, 0, At, B0); PG8_MMA(0, 1, At, B1); PG8_BAR; PG8_SCHED;
            PG8_LDA(At, 1, 1); PG8_STAGE(PG8_SB(1, 0), b3, voffB); PG8_STAGE(PG8_SB(1, 1), b3 + hstepB, voffB); PG8_STAGE(PG8_SA(1, 0), a3, voffA);
            PG8_WAIT_V(8); PG8_WAIT_L(0); PG8_BAR; PG8_MMA(1, 0, At, B0); PG8_MMA(1, 1, At, B1); PG8_BAR; PG8_SCHED;
            } else {
            PG8_LDB(B0, 0, 0); PG8_SCHED; PG8_LDA(At, 0, 0); PG8_STAGE(PG8_SA(1, 1), a1 + hstep, voffA);
            PG8_WAIT_L(8); PG8_BAR; PG8_WAIT_L(0); PG8_MMA(0, 0, At, B0); PG8_BAR; PG8_SCHED;
            PG8_LDB(B1, 0, 1); PG8_STAGE(PG8_SB(0, 0), b2, voffB);
            PG8_BAR; PG8_WAIT_L(0); PG8_MMA(0, 1, At, B1); PG8_BAR;
            PG8_LDA(At, 0, 1); PG8_STAGE(PG8_SA(0, 0), a2, voffA);
            PG8_BAR; PG8_WAIT_L(0); PG8_MMA(1, 0, At, B0); PG8_BAR; PG8_SCHED;
            PG8_STAGE(PG8_SB(0, 1), b2 + hstepB, voffB);
            PG8_WAIT_V(6); PG8_BAR; PG8_MMA(1, 1, At, B1); PG8_BAR;
            PG8_LDB(B0, 1, 0); PG8_SCHED; PG8_LDA(At, 1, 0); PG8_STAGE(PG8_SA(0, 1), a2 + hstep, voffA);
            PG8_WAIT_L(8); PG8_BAR; PG8_WAIT_L(0); PG8_MMA(0, 0, At, B0); PG8_BAR; PG8_SCHED;
            PG8_LDB(B1, 1, 1); PG8_STAGE(PG8_SB(1, 0), b3, voffB);
            PG8_BAR; PG8_WAIT_L(0); PG8_MMA(0, 1, At, B1); PG8_BAR;
            PG8_LDA(At, 1, 1); PG8_STAGE(PG8_SA(1, 0), a3, voffA);
            PG8_BAR; PG8_WAIT_L(0); PG8_MMA(1, 0, At, B0); PG8_BAR; PG8_SCHED;
            PG8_STAGE(PG8_SB(1, 1), b3 + hstepB, voffB);
            PG8_WAIT_V(6); PG8_BAR; PG8_MMA(1, 1, At, B1); PG8_BAR;
            }
        }
        if constexpr (ALIGN_EPI) { if (wr == 0) PG8_BAR; }
        if constexpr (!Epi::AFTER_DRAIN) { E(acc, cur, wr, wc, fr, fq); S.done(cur); }
        if (!has_next) break;
#pragma unroll
        for (int a = 0; a < 2; ++a)
#pragma unroll
            for (int b = 0; b < 2; ++b)
#pragma unroll
                for (int m = 0; m < 4; ++m)
#pragma unroll
                    for (int n = 0; n < 2; ++n) acc[a][b][m][n] = (f32x4){0.f, 0.f, 0.f, 0.f};
        cur = nxt; cA = nA; cB = nB; ++ui;
        if constexpr (ALIGN_EPI) { if (wr == 1) PG8_BAR; }
    }
    PG8_WAIT_V(0);
    if constexpr (!ALIGN_EPI) { if (wr == 0) PG8_BAR; }
    PG8_BAR;
    if constexpr (Epi::AFTER_DRAIN) { E.fused(acc, cur, wr, wc, fr, fq, lds, wid, lane); S.done(cur); }
#undef PG8_SA
#undef PG8_SB
#undef PG8_STAGE
#undef PG8_LDA
#undef PG8_LDB
#undef PG8_MMA
#undef PG8_WAIT_V
#undef PG8_WAIT_L
#undef PG8_BAR
#undef PG8_SCHED
}
}
#define GAS __attribute__((address_space(1)))
#define LAS __attribute__((address_space(3)))
typedef unsigned short bf16;
typedef unsigned v4u __attribute__((ext_vector_type(4)));
typedef float f32x4 __attribute__((ext_vector_type(4)));
typedef short bf16x8 __attribute__((ext_vector_type(8)));
typedef GAS unsigned gu32;
typedef GAS unsigned long long gu64;
#define RLX_AGENT __ATOMIC_RELAXED, __HIP_MEMORY_SCOPE_AGENT
#define LDS_WAIT() asm volatile("s_waitcnt lgkmcnt(0)" ::: "memory")
#define VM_WAIT() asm volatile("s_waitcnt vmcnt(0)" ::: "memory")
__device__ __forceinline__ unsigned long long rt() { return __builtin_amdgcn_s_memrealtime(); }
__device__ __forceinline__ unsigned f2bf(float f) { unsigned u = __builtin_bit_cast(unsigned, f); return (u + 0x7fffu + ((u >> 16) & 1u)) >> 16; }
__device__ __forceinline__ unsigned pk2(float lo, float hi) { return f2bf(lo) | (f2bf(hi) << 16); }

#define XB_TMO      128
#define XB_XCNT(j)  (256  + 64 * (j))
#define XB_XSUB(j)  (1280 + 64 * (j))
#define XB_XGEN(j)  (2304 + 64 * (j))
#define XB_TOP      3328
#define XB_TOPGEN   3392
#define XCD_BAR_WORDS 3456
#define XB_SPIN_CAP (1u << 18)

__device__ __forceinline__ unsigned xb_ld(unsigned* p)              { return __hip_atomic_load(p, __ATOMIC_RELAXED, __HIP_MEMORY_SCOPE_AGENT); }
__device__ __forceinline__ unsigned xb_add(unsigned* p, unsigned v) { return __hip_atomic_fetch_add(p, v, __ATOMIC_RELAXED, __HIP_MEMORY_SCOPE_AGENT); }
__device__ __forceinline__ unsigned xb_xcc_id() { return (unsigned)__builtin_amdgcn_s_getreg((3 << 11) | 20) & 0xFu; }
#define XB_SPIN(cond, bar) do { unsigned _sp = 0; while (cond) { __builtin_amdgcn_s_sleep(1); \
    if ((++_sp & 255u) == 0u) { if (xb_ld(&(bar)[XB_TMO])) break; if (_sp > XB_SPIN_CAP) { atomicAdd(&(bar)[XB_TMO], 1u); break; } } } } while (0)

struct XcdBarrier {
    unsigned* bar; unsigned x;
    volatile LAS unsigned* st;
};

__device__ __forceinline__ XcdBarrier xcd_barrier_post(unsigned* bar, volatile LAS unsigned* st) {
    XcdBarrier b; b.bar = bar; b.x = xb_xcc_id(); b.st = st;
    if (threadIdx.x == 0) (void)xb_add(&bar[XB_XCNT(b.x)], 1u);
    return b;
}
__device__ __forceinline__ void xcd_barrier_complete(unsigned* bar, unsigned x, unsigned& nloc, unsigned& nx) {
    const unsigned G = 256u;
    unsigned sum, cnt, mine, sp = 0u;
    for (;;) {
        sum = 0u; cnt = 0u; mine = 0u;
#pragma unroll
        for (unsigned j = 0; j < 16; ++j) { const unsigned c = xb_ld(&bar[XB_XCNT(j)]); sum += c; cnt += (c > 0u) ? 1u : 0u; mine = (j == x) ? c : mine; }
        if (sum == G) break;
        __builtin_amdgcn_s_sleep(1);
        if ((++sp & 255u) == 0u) { if (xb_ld(&bar[XB_TMO])) break; if (sp > XB_SPIN_CAP) { atomicAdd(&bar[XB_TMO], 1u); break; } }
    }
    nloc = mine > 0u ? mine : 1u; nx = cnt > 0u ? cnt : 1u;
}

__device__ __forceinline__ void xcd_barrier(const XcdBarrier& b) {
    asm volatile("s_waitcnt vmcnt(0)" ::: "memory");
    __syncthreads();
    if (threadIdx.x == 0) {
        unsigned* bar = b.bar;
        __builtin_amdgcn_s_waitcnt(0);
        unsigned nloc = b.st[0], nx = b.st[1];
        if (nloc == 0u) { xcd_barrier_complete(bar, b.x, nloc, nx); b.st[0] = nloc; b.st[1] = nx; }
        const unsigned old = xb_add(&bar[XB_XSUB(b.x)], 1u);
        const unsigned gen = old / nloc;
        if (old + 1u == (gen + 1u) * nloc) {
            __builtin_amdgcn_fence(__ATOMIC_RELEASE, "agent");
            asm volatile("s_waitcnt vmcnt(0)" ::: "memory");
            const unsigned og = xb_add(&bar[XB_TOP], 1u);
            const unsigned tg = og / nx;
            if (og + 1u == (tg + 1u) * nx) xb_add(&bar[XB_TOPGEN], 1u);
            else XB_SPIN(xb_ld(&bar[XB_TOPGEN]) == tg, bar);
            __builtin_amdgcn_fence(__ATOMIC_ACQUIRE, "agent");
            xb_add(&bar[XB_XGEN(b.x)], 1u);
            asm volatile("s_waitcnt vmcnt(0)" ::: "memory");
        } else {
            XB_SPIN(xb_ld(&bar[XB_XGEN(b.x)]) == gen, bar);
            __builtin_amdgcn_fence(__ATOMIC_ACQUIRE, "agent");
            asm volatile("s_waitcnt vmcnt(0)" ::: "memory");
        }
    }
    __syncthreads();
}
#ifndef MK_N_LAUNCHES
#define MK_N_LAUNCHES 1
#endif
constexpr int NWAVES = 8, NGRID = 256;
constexpr int N_PHASES = 9;
constexpr int N_LAUNCHES = MK_N_LAUNCHES;
constexpr int DM = 1024, NIN = 7680, DMIX = 2048;
constexpr int MPR = 16384, MSA = 32, MPAD = 16640, SEQL = 2048;
constexpr float EPSF = 1e-6f;
constexpr size_t O_YP = 0, O_YS = 16777216, O_KP = O_YS + 32768, O_VP = O_KP + 25165824, O_KS = O_VP + 25165824, O_VS = O_KS + 49152,
                 O_SGU = O_VS + 49152, O_HP = O_SGU + 32768, O_HS = O_HP + 1572864, O_END = O_HS + 6291456;
constexpr size_t MiB = 1u << 20;
constexpr size_t alup(size_t x) { return (x + MiB - 1) / MiB * MiB; }
constexpr size_t WS_CTL = 0, CTL_ZERO_BYTES = MiB;
constexpr size_t WS_WIN = MiB;
constexpr size_t WS_WOUT = WS_WIN + alup((size_t)2 * NIN * DM * 2);
constexpr size_t WS_SGW = WS_WOUT + alup((size_t)2 * DM * DMIX * 2);
constexpr size_t WS_LB = WS_SGW + alup((size_t)2 * 8 * 128 * 128 * 2);
constexpr size_t WS_XB = WS_LB + MiB;
constexpr size_t WS_QB = WS_XB + alup((size_t)MPAD * DM * 2);
constexpr size_t WS_KB = WS_QB + alup((size_t)MPAD * 768 * 2);
constexpr size_t WS_VB = WS_KB + alup((size_t)MPAD * 768 * 2);
constexpr size_t WS_ZB = WS_VB + alup((size_t)MPAD * 768 * 2);
constexpr size_t WS_BU = WS_ZB + alup((size_t)MPAD * 2048 * 2);
constexpr size_t WS_BV = WS_BU + alup((size_t)MPAD * 512 * 2);
constexpr size_t WS_CQ = WS_BV + alup((size_t)MPAD * 512 * 2);
constexpr size_t WS_CK = WS_CQ + alup((size_t)MPAD * 768 * 2);
constexpr size_t WS_CI = WS_CK + alup((size_t)MPAD * 768 * 2);
constexpr size_t WS_CG = WS_CI + alup((size_t)MPAD * 768 * 2);
constexpr size_t WS_CE = WS_CG;
constexpr size_t WS_DJ = WS_CG + alup((size_t)MPAD * 768 * 2);
constexpr size_t WS_YB = WS_CG + alup((size_t)MPAD * 768 * 4);
constexpr size_t WS_X1 = WS_YB + alup((size_t)MPAD * 2048 * 2);
constexpr size_t WS_DS = WS_X1 + alup((size_t)MPAD * DM * 4);
constexpr size_t WS_DEC = WS_DS + alup((size_t)48 * 16 * 128 * 128 * 4);
constexpr size_t WS_O2 = WS_DEC + alup((size_t)48 * 16 * 128 * 4);
constexpr size_t WS_O3 = WS_O2 + alup((size_t)MPAD * 768 * 2);
constexpr size_t WS_L2 = WS_O3 + alup((size_t)MPAD * 768 * 2);
constexpr size_t WS_L3 = WS_L2 + alup((size_t)MPAD * 16 * 4);
constexpr size_t WS_KH = WS_L3 + alup((size_t)MPAD * 16 * 4);
constexpr size_t WS_VH = WS_KH + alup((size_t)MPR * 768 * 2);
constexpr size_t WS_END = WS_VH + alup((size_t)MPR * 768 * 2);
constexpr int CW_TMO = 0, CW_CODE = 1, CW_BAR = 4096, CW_Q = 8192;
constexpr size_t CTL_SSQ0 = 256 * 1024, CTL_SSQ1 = 512 * 1024;
constexpr int RING_OFF = 0, LDS_BYTES = 163840, MISC_OFF = LDS_BYTES - 1024;
static_assert(WS_VB - WS_KB == WS_KB - WS_QB && WS_CI - WS_CK == WS_CK - WS_CQ, "equally spaced buffer groups (addressed arithmetically in the in-projection epilogue)");
#define DI __device__ __forceinline__
typedef float f32x16 __attribute__((ext_vector_type(16)));
typedef short s16x4 __attribute__((ext_vector_type(4)));
typedef short v4i16_t __attribute__((ext_vector_type(4)));
typedef float f32x2v __attribute__((ext_vector_type(2)));
typedef unsigned u32x2v __attribute__((ext_vector_type(2)));
typedef __bf16 bf16x2v __attribute__((ext_vector_type(2)));
#define MFMA32(a, b, c) __builtin_amdgcn_mfma_f32_32x32x16_bf16((a), (b), (c), 0, 0, 0)
DI unsigned cvtpk2(float lo, float hi) { f32x2v v = {lo, hi}; bf16x2v b = __builtin_convertvector(v, bf16x2v); return __builtin_bit_cast(unsigned, b); }
DI float bf2f(bf16 u) { return __uint_as_float((unsigned)u << 16); }
DI float bflo(unsigned w) { return __uint_as_float(w << 16); }
DI float bfhi(unsigned w) { return __uint_as_float(w & 0xffff0000u); }
DI int crow(int r, int h) { return (r & 3) + 8 * (r >> 2) + 4 * h; }
DI float shx(float v, int mask, int lane) { return __builtin_bit_cast(float, __builtin_amdgcn_ds_bpermute((lane ^ mask) << 2, __builtin_bit_cast(int, v))); }
DI float wave_sum(float v, int lane) {
#pragma unroll
    for (int o = 1; o < 64; o <<= 1) v += shx(v, o, lane);
    return v;
}
DI float wave_max(float v, int lane) {
#pragma unroll
    for (int o = 1; o < 64; o <<= 1) v = fmaxf(v, shx(v, o, lane));
    return v;
}
DI s16x4 trd(LAS const unsigned char* p) { return __builtin_bit_cast(s16x4, __builtin_amdgcn_ds_read_tr16_b64_v4i16((LAS v4i16_t*)p)); }
DI int tr_lane_off(int pitch, int lane, bool perm) { const int i16 = lane & 15, q = i16 >> 2, p = i16 & 3, blk = (lane >> 4) & 1, h = lane >> 5; return ((perm ? 4 * h : 8 * h) + q) * pitch + (16 * blk + 4 * p) * 2; }
DI bf16x8 trfrag(LAS const unsigned char* base, int pitch, int k0, int c0, int laneoff, bool perm) {
    LAS const unsigned char* a = base + k0 * pitch + c0 * 2 + laneoff;
    const s16x4 lo = trd(a), hi = trd(a + (perm ? 8 : 4) * pitch);
    return __builtin_shufflevector(lo, hi, 0, 1, 2, 3, 4, 5, 6, 7);
}
DI bf16x8 pack8(const f32x16& x, int s) { v4u p; p.x = cvtpk2(x[8 * s], x[8 * s + 1]); p.y = cvtpk2(x[8 * s + 2], x[8 * s + 3]); p.z = cvtpk2(x[8 * s + 4], x[8 * s + 5]); p.w = cvtpk2(x[8 * s + 6], x[8 * s + 7]); return __builtin_bit_cast(bf16x8, p); }
DI f32x16 zero16() { f32x16 z;
#pragma unroll
    for (int i = 0; i < 16; ++i) z[i] = 0.f; return z; }

struct Args { const float* in[16]; float* out; unsigned char* ws; int ph_lo, ph_hi, imask, pad; };
struct Ctx {
    LAS unsigned char* lds; volatile LAS unsigned* MISC;
    int tid, lane, wave, vcu, G;
};
typedef __attribute__((address_space(4))) const Args* kaptr_t;
DI kaptr_t kargs() { kaptr_t kp = (kaptr_t)__builtin_amdgcn_kernarg_segment_ptr(); asm volatile("" : "+s"(kp)); return kp; }
#define INP(i) (kargs()->in[i])
#define WSP(off) (kargs()->ws + (off))
#define OUTP() (kargs()->out)
DI void p0_transpose_item(const float* W, int K, int N, bf16* WT, const float* gk, LAS float* scr, int item, int lane, bool nts = false) {
    const int nblk = N / 32, kb = item / nblk, nb = item % nblk, k0 = 64 * kb, n0 = 32 * nb;
#pragma unroll 8
    for (int i = 0; i < 32; ++i) { const int kk = 2 * i + (lane >> 5); float w = __builtin_nontemporal_load(W + (size_t)(k0 + kk) * N + n0 + (lane & 31)); if (gk) w *= gk[k0 + kk]; scr[kk * 33 + (lane & 31)] = w; }
    LDS_WAIT(); asm volatile("" ::: "memory");
    const int c = lane & 7;
#pragma unroll
    for (int j = 0; j < 4; ++j) { const int n = (lane >> 3) + 8 * j; const LAS float* s = scr + (8 * c) * 33 + n;
        v4u o; o.x = pk2(s[0 * 33], s[1 * 33]); o.y = pk2(s[2 * 33], s[3 * 33]); o.z = pk2(s[4 * 33], s[5 * 33]); o.w = pk2(s[6 * 33], s[7 * 33]);
        if (nts) __builtin_nontemporal_store(o, (v4u*)(WT + (size_t)(n0 + n) * K + k0 + 8 * c)); else *(GAS v4u*)(WT + (size_t)(n0 + n) * K + k0 + 8 * c) = o; }
    LDS_WAIT(); asm volatile("" ::: "memory");
}
DI void p0_prologue(Ctx& C) { const float* const p_qn_g = ((const float*)INP(7)); const float* const p_kn_g = ((const float*)INP(8)); float* const p_LB = ((float*)WSP(WS_LB)); bf16* const p_SGW = ((bf16*)WSP(WS_SGW)); float* const p_SSQ0 = ((float*)WSP(WS_CTL + CTL_SSQ0)); bf16* const p_WIN = ((bf16*)WSP(WS_WIN)); bf16* const p_WOUT = ((bf16*)WSP(WS_WOUT)); bf16* const p_XB = ((bf16*)WSP(WS_XB)); const float* const p_lb_logits = ((const float*)INP(13)); const float* const p_norm_g = ((const float*)INP(5)); const float* const p_sgu_w = ((const float*)INP(11)); const float* const p_w_in = ((const float*)INP(6)); const float* const p_w_out = ((const float*)INP(15)); const float* const p_x_prompt = ((const float*)INP(0)); const float* const p_x_sample = ((const float*)INP(1));
    LAS float* scr = (LAS float*)(C.lds + RING_OFF + C.wave * 16384);
    const int gw = C.vcu * NWAVES + C.wave, NGW = C.G * NWAVES;
    constexpr int I_IN1 = (DM / 64) * (NIN / 32), I_OUT1 = (DMIX / 64) * (DM / 32);
    for (int it = gw; it < I_IN1; it += NGW) p0_transpose_item(p_w_in, DM, NIN, p_WIN, p_norm_g, scr, it, C.lane);
    for (int m = gw; m < MPAD; m += NGW) {
        GAS unsigned long long* o8 = (GAS unsigned long long*)(p_XB + (size_t)m * DM) + C.lane;
        if (m < MPR + MSA) {
            const float* xrow = (m < MPR) ? p_x_prompt + (size_t)m * DM : p_x_sample + (size_t)(m - MPR) * DM;
            const GAS f32x4* xr = (const GAS f32x4*)xrow + C.lane; f32x4 v[4]; float s = 0.f;
#pragma unroll
            for (int j = 0; j < 4; ++j) { v[j] = __builtin_nontemporal_load(xr + 64 * j); s += (v[j].x * v[j].x + v[j].y * v[j].y) + (v[j].z * v[j].z + v[j].w * v[j].w); }
            s = wave_sum(s, C.lane);
#pragma unroll
            for (int j = 0; j < 4; ++j) o8[64 * j] = (unsigned long long)pk2(v[j].x, v[j].y) | ((unsigned long long)pk2(v[j].z, v[j].w) << 32);
            if (C.lane == 0) p_SSQ0[m] = s;
        } else {
#pragma unroll
            for (int j = 0; j < 4; ++j) o8[64 * j] = 0ull;
            if (C.lane == 0) p_SSQ0[m] = 0.f;
        }
    }
    const int gt = C.vcu * 512 + C.tid, NGT = C.G * 512;
    for (int e = gt; e < 2 * 8 * 128 * 128; e += NGT) { const int s = e & 127, t = (e >> 7) & 127; const float w = p_sgu_w[e]; p_SGW[e] = (bf16)f2bf(s <= t ? w : 0.f); }
    for (int e = gt; e < 2 * 768; e += NGT) { const int l = e / 768, c = e - 768 * l; p_LB[(l * 3 + 0) * 768 + c] = p_qn_g[e]; p_LB[(l * 3 + 1) * 768 + c] = p_kn_g[e]; p_LB[(l * 3 + 2) * 768 + c] = (l == 0) ? 0.f : 1.0f / (1.0f + __expf(p_lb_logits[c] - p_lb_logits[768 + c])); }
}

DI void wt_item(const Ctx& C, int item) { const float* const p_w_in = ((const float*)INP(6)); const float* const p_w_out = ((const float*)INP(15)); const float* const p_norm_g = ((const float*)INP(5)); bf16* const p_WIN = ((bf16*)WSP(WS_WIN)); bf16* const p_WOUT = ((bf16*)WSP(WS_WOUT));
    constexpr int I_IN1 = (DM / 64) * (NIN / 32), I_OUT1 = (DMIX / 64) * (DM / 32);
    LAS float* scr = (LAS float*)(C.lds + RING_OFF + C.wave * 16384);
#pragma unroll 1
    for (int rep = 0; rep < 4; ++rep) {
        int it = 32 * item + 8 * rep + C.wave;
        if (it < I_OUT1) { p0_transpose_item(p_w_out, DMIX, DM, p_WOUT, nullptr, scr, it, C.lane, true); continue; } it -= I_OUT1;
        if (it < I_IN1) p0_transpose_item(p_w_in + (size_t)DM * NIN, DM, NIN, p_WIN + (size_t)NIN * DM, p_norm_g + DM, scr, it, C.lane, true);
        else if (it < I_IN1 + I_OUT1) p0_transpose_item(p_w_out + (size_t)DMIX * DM, DMIX, DM, p_WOUT + (size_t)DM * DMIX, nullptr, scr, it - I_IN1, C.lane, true);
    }
}

DI void kvout_item(const Ctx& C, int l, int item) { unsigned char* const ws = WSP(0); const bf16* const p_KH = (const bf16*)(ws + WS_KH); const bf16* const p_VH = (const bf16*)(ws + WS_VH); float* const p_out = OUTP();
    const int b = item >> 5, t0 = (item & 31) * 64, tid = C.tid;
    float* ok = p_out + O_KP + ((size_t)l * MPR + (size_t)b * SEQL + t0) * 768; float* ov = p_out + O_VP + ((size_t)l * MPR + (size_t)b * SEQL + t0) * 768;
#pragma unroll 4
    for (int it = 0; it < 12; ++it) { const int idx = tid + 512 * it, tl = idx / 96, hc = idx - 96 * tl, hh = hc >> 3, ch = hc & 7, t = t0 + tl;
        const size_t so = ((size_t)(((b * 12 + hh) * 16 + (t & 15)) * 128 + (t >> 4))) * 64 + 8 * ch; const size_t dofs = (size_t)tl * 768 + hh * 64 + 8 * ch;
        const v4u k8 = *(const v4u*)(p_KH + so), v8 = *(const v4u*)(p_VH + so);
        *(f32x4*)(ok + dofs) = (f32x4){bflo(k8.x), bfhi(k8.x), bflo(k8.y), bfhi(k8.y)}; *(f32x4*)(ok + dofs + 4) = (f32x4){bflo(k8.z), bfhi(k8.z), bflo(k8.w), bfhi(k8.w)};
        *(f32x4*)(ov + dofs) = (f32x4){bflo(v8.x), bfhi(v8.x), bflo(v8.y), bfhi(v8.y)}; *(f32x4*)(ov + dofs + 4) = (f32x4){bflo(v8.z), bfhi(v8.z), bflo(v8.w), bfhi(v8.w)}; }
}
DI float ex2(float x) { return __builtin_amdgcn_exp2f(x); }
DI float lg2(float x) { return __builtin_amdgcn_logf(x); }

constexpr int AP = 144;
DI void cls_tile(const bf16x8 (&qf)[4], LAS const unsigned char* Kl, LAS const unsigned char* Vl, int kr0, int jstart, int lane, f32x16 (&o)[2], float& lse) {
    const int i = lane & 31, h = lane >> 5;
    o[0] = zero16(); o[1] = zero16();
    constexpr float THR = 6.0f;
    float mrun = 0.f, l = 0.f; bool first = true;
    LAS const unsigned char* kp = Kl + (kr0 + 32 * jstart + i) * AP + 16 * h;
    LAS const unsigned char* vp = Vl + (kr0 + 32 * jstart) * AP + tr_lane_off(AP, lane, true);
#pragma unroll 1
    for (int j = jstart; j < 5; ++j, kp += 32 * AP, vp += 32 * AP) {
        f32x16 st = zero16();
#pragma unroll
        for (int s = 0; s < 4; ++s) st = MFMA32(*(LAS const bf16x8*)(kp + 32 * s), qf[s], st);
        if (j == 0) {
#pragma unroll
            for (int r = 0; r < 16; ++r) if (crow(r, h) < i) st[r] = -1e30f;
        }
        if (j == 4) {
#pragma unroll
            for (int r = 0; r < 16; ++r) if (crow(r, h) > i) st[r] = -1e30f;
        }
        float rm = fmaxf(fmaxf(st[0], st[1]), st[2]);
#pragma unroll
        for (int r = 3; r < 15; r += 2) rm = fmaxf(fmaxf(rm, st[r]), st[r + 1]);
        rm = fmaxf(rm, st[15]);
        rm = fmaxf(rm, shx(rm, 32, lane)) - mrun;
        if (first || __any(rm > THR)) {
            const float delta = first ? rm : fmaxf(rm, 0.f); mrun += delta;
            if (!first) { const float alpha = ex2(-delta); l *= alpha;
#pragma unroll
                for (int r = 0; r < 16; ++r) { o[0][r] *= alpha; o[1][r] *= alpha; } }
            first = false;
        }
        float ps0 = 0.f, ps1 = 0.f;
#pragma unroll
        for (int r = 0; r < 16; r += 2) { st[r] = ex2(st[r] - mrun); st[r + 1] = ex2(st[r + 1] - mrun); ps0 += st[r]; ps1 += st[r + 1]; }
        l += ps0 + ps1;
        const bf16x8 pb0 = pack8(st, 0), pb1 = pack8(st, 1);
#pragma unroll
        for (int db = 0; db < 2; ++db) {
            const s16x4 a0 = trd(vp + 64 * db), a1 = trd(vp + 64 * db + 8 * AP), b0 = trd(vp + 64 * db + 16 * AP), b1 = trd(vp + 64 * db + 24 * AP);
            o[db] = MFMA32(__builtin_shufflevector(a0, a1, 0, 1, 2, 3, 4, 5, 6, 7), pb0, o[db]);
            o[db] = MFMA32(__builtin_shufflevector(b0, b1, 0, 1, 2, 3, 4, 5, 6, 7), pb1, o[db]);
        }
    }
    l += shx(l, 32, lane);
    const float inv = 1.0f / l;
#pragma unroll
    for (int r = 0; r < 16; ++r) { o[0][r] *= inv; o[1][r] *= inv; }
    lse = mrun + lg2(l);
}
DI void cls_store(bf16* Ob, float* Lb, size_t m, int hh, int h, const f32x16 (&o)[2], float lse) {
    bf16* op = Ob + m * 768 + hh * 64 + 4 * h;
#pragma unroll
    for (int db = 0; db < 2; ++db)
#pragma unroll
        for (int g4 = 0; g4 < 4; ++g4) { u32x2v w; w.x = cvtpk2(o[db][4 * g4], o[db][4 * g4 + 1]); w.y = cvtpk2(o[db][4 * g4 + 2], o[db][4 * g4 + 3]); *(u32x2v*)(op + 32 * db + 8 * g4) = w; }
    if (h == 0) Lb[m * 16 + hh] = lse;
}
template <int KIND> DI void att23_item(const Ctx& C, int item) { unsigned char* const ws = WSP(0); const bf16* const p_QB = (const bf16*)(ws + WS_QB); const bf16* const p_KB = (const bf16*)(ws + WS_KH); const bf16* const p_VB = (const bf16*)(ws + WS_VH);
    bf16* const p_O = (bf16*)(ws + (KIND == 2 ? WS_O2 : WS_O3)); float* const p_L = (float*)(ws + (KIND == 2 ? WS_L2 : WS_L3));
    const int up = item & 1, hh = (item >> 1) % 12, b = item / 24, lane = C.lane, wave = C.wave, tid = C.tid, i = lane & 31, h = lane >> 5;
    const size_t rb = (size_t)b * SEQL;
    LAS unsigned char* Kl = C.lds; LAS unsigned char* Vl = C.lds + 512 * AP;
    v4u kr[8], vr[8];
#define A23_TOK(u, row) (KIND == 2 ? (4 * (row) + (u)) : (16 * ((row) & 127) + 4 * (u) + ((row) >> 7)))
#define A23_SRC(u, idx) ((size_t)(((b * 12 + hh) * 16 + (KIND == 2 ? 4 * ((idx) >> 10) + (u) : 4 * (u) + ((idx) >> 10))) * 128 + (((idx) >> 3) & 127)) * 64 + 8 * ((idx) & 7))
#define A23_ROW(idx) (KIND == 2 ? 4 * (((idx) >> 3) & 127) + ((idx) >> 10) : ((idx) >> 3))
#define A23_ISSUE(u) do { _Pragma("unroll") for (int it = 0; it < 8; ++it) { const int idx = tid + 512 * it; const size_t go = A23_SRC(u, idx); \
        kr[it] = *(const v4u*)(p_KB + go); vr[it] = *(const v4u*)(p_VB + go); } } while (0)
    A23_ISSUE(2 * up);
#pragma unroll 1
    for (int u = 2 * up; u < 2 * up + 2; ++u) {
        __syncthreads();
#pragma unroll
        for (int it = 0; it < 8; ++it) { const int idx = tid + 512 * it, row = A23_ROW(idx), ch = idx & 7; *(LAS v4u*)(Kl + row * AP + ch * 16) = kr[it]; *(LAS v4u*)(Vl + row * AP + ch * 16) = vr[it]; }
        __syncthreads();
        int cb0, qa, qb;
        if (KIND == 2) { cb0 = 0; qa = 64 * wave; qb = qa + 32; } else { cb0 = (wave >> 1) * 128; qa = (wave & 1) ? 32 : 0; qb = (wave & 1) ? 64 : 96; }
        const size_t ma = rb + A23_TOK(u, cb0 + qa + i), mb = rb + A23_TOK(u, cb0 + qb + i);
        bf16x8 qfa[4], qfb[4];
#pragma unroll
        for (int s = 0; s < 4; ++s) qfa[s] = *(const bf16x8*)(p_QB + ma * 768 + hh * 64 + 8 * h + 16 * s);
        if (u == 2 * up) A23_ISSUE(u + 1);
        f32x16 o[2]; float lse;
        cls_tile(qfa, Kl + cb0 * AP, Vl + cb0 * AP, qa - 128, qa >= 128 ? 0 : (128 - qa) >> 5, lane, o, lse);
        cls_store(p_O, p_L, ma, hh, h, o, lse);
#pragma unroll
        for (int s = 0; s < 4; ++s) qfb[s] = *(const bf16x8*)(p_QB + mb * 768 + hh * 64 + 8 * h + 16 * s);
        cls_tile(qfb, Kl + cb0 * AP, Vl + cb0 * AP, qb - 128, qb >= 128 ? 0 : (128 - qb) >> 5, lane, o, lse);
        cls_store(p_O, p_L, mb, hh, h, o, lse);
    }
#undef A23_ISSUE
#undef A23_TOK
#undef A23_SRC
#undef A23_ROW
}
DI void att1_item(const Ctx& C, int item) { unsigned char* const ws = WSP(0); const bf16* const p_QB = (const bf16*)(ws + WS_QB); const bf16* const p_KB = (const bf16*)(ws + WS_KH); const bf16* const p_VB = (const bf16*)(ws + WS_VH);
    const bf16* const p_O2 = (const bf16*)(ws + WS_O2); const float* const p_L2 = (const float*)(ws + WS_L2); const bf16* const p_O3 = (const bf16*)(ws + WS_O3); const float* const p_L3 = (const float*)(ws + WS_L3); const bf16* const p_ZB = (const bf16*)(ws + WS_ZB); bf16* const p_YB = (bf16*)(ws + WS_YB);
    const int qtr = item & 3, hh = (item >> 2) % 12, b = item / 48, lane = C.lane, wave = C.wave, tid = C.tid, i = lane & 31, h = lane >> 5;
    const size_t rb = (size_t)b * SEQL;
    LAS unsigned char* Kl = C.lds; LAS unsigned char* Vl = C.lds + 384 * AP;
    v4u kr[6], vr[6];
#define A1_ISSUE(T) do { const int m30_ = 16 * (T) - 8; _Pragma("unroll") for (int it = 0; it < 6; ++it) { const int idx = tid + 512 * it, r16 = idx / 192, rem = idx - 192 * r16; int m3 = m30_ + (rem >> 3); if (m3 < 0) m3 = 0; \
        const size_t go = (size_t)(((b * 12 + hh) * 16 + r16) * 128 + m3) * 64 + 8 * (rem & 7); kr[it] = *(const v4u*)(p_KB + go); vr[it] = *(const v4u*)(p_VB + go); } } while (0)
    A1_ISSUE(2 * qtr);
#pragma unroll 1
    for (int u = 0; u < 2; ++u) {
        const int T = 2 * qtr + u;
        __syncthreads();
#pragma unroll
        for (int it = 0; it < 6; ++it) { const int idx = tid + 512 * it, r16 = idx / 192, rem = idx - 192 * r16, row = 16 * (rem >> 3) + r16, ch = rem & 7; *(LAS v4u*)(Kl + row * AP + ch * 16) = kr[it]; *(LAS v4u*)(Vl + row * AP + ch * 16) = vr[it]; }
        __syncthreads();
        const int tq0 = 256 * T + 32 * wave; const size_t m = rb + tq0 + i;
        bf16x8 qf[4];
#pragma unroll
        for (int s = 0; s < 4; ++s) qf[s] = *(const bf16x8*)(p_QB + m * 768 + hh * 64 + 8 * h + 16 * s);
        const bf16* o2p = p_O2 + m * 768 + hh * 64 + 4 * h; const bf16* o3p = p_O3 + m * 768 + hh * 64 + 4 * h; const bf16* zp = p_ZB + m * 2048 + hh * 64 + 4 * h; bf16* yp = p_YB + m * 2048 + hh * 64 + 4 * h;
        const float l2 = p_L2[m * 16 + hh], l3 = p_L3[m * 16 + hh];
        u32x2v a2[8], a3[8];
#pragma unroll
        for (int c8 = 0; c8 < 8; ++c8) { a2[c8] = *(const u32x2v*)(o2p + 8 * c8); a3[c8] = *(const u32x2v*)(o3p + 8 * c8); }
        if (u < 1) A1_ISSUE(T + 1);
        f32x16 o[2]; float lse;
        cls_tile(qf, Kl, Vl, 32 * wave, tq0 >= 128 ? 0 : (128 - tq0) >> 5, lane, o, lse);
        const float M = fmaxf(lse, fmaxf(l2, l3)), L = M + lg2(ex2(lse - M) + ex2(l2 - M) + ex2(l3 - M));
        const float w1 = ex2(lse - L), w2 = ex2(l2 - L), w3 = ex2(l3 - L);
#pragma unroll
        for (int db = 0; db < 2; ++db)
#pragma unroll
            for (int g4 = 0; g4 < 4; ++g4) { const int c8 = 4 * db + g4; const u32x2v x2 = a2[c8], x3 = a3[c8], z = *(const u32x2v*)(zp + 8 * c8); u32x2v w;
                const float y0 = w1 * o[db][4 * g4] + w2 * bflo(x2.x) + w3 * bflo(x3.x), y1 = w1 * o[db][4 * g4 + 1] + w2 * bfhi(x2.x) + w3 * bfhi(x3.x);
                const float y2 = w1 * o[db][4 * g4 + 2] + w2 * bflo(x2.y) + w3 * bflo(x3.y), y3 = w1 * o[db][4 * g4 + 3] + w2 * bfhi(x2.y) + w3 * bfhi(x3.y);
                w.x = cvtpk2(y0 * bflo(z.x), y1 * bfhi(z.x)); w.y = cvtpk2(y2 * bflo(z.y), y3 * bfhi(z.y)); *(u32x2v*)(yp + 8 * c8) = w; }
    }
#undef A1_ISSUE
}

DI void sgu_item(const Ctx& C, int l, int item) { bf16* const p_BU = ((bf16*)WSP(WS_BU)); bf16* const p_BV = ((bf16*)WSP(WS_BV)); bf16* const p_SGW = ((bf16*)WSP(WS_SGW)); bf16* const p_YB = ((bf16*)WSP(WS_YB)); bf16* const p_ZB = ((bf16*)WSP(WS_ZB)); const float* const p_ln_b = ((const float*)INP(10)); const float* const p_ln_g = ((const float*)INP(9)); const float* const p_sgu_b = ((const float*)INP(12));
    const int b = item >> 4, ch = item & 15, lane = C.lane, wave = C.wave, i = lane & 31, h = lane >> 5; const size_t m0 = (size_t)b * SEQL + ch * 128;
    constexpr int VP = 1088;
    { const f32x4 g0 = *(const f32x4*)(p_ln_g + l * 512 + 8 * lane), g1 = *(const f32x4*)(p_ln_g + l * 512 + 8 * lane + 4), b0 = *(const f32x4*)(p_ln_b + l * 512 + 8 * lane), b1 = *(const f32x4*)(p_ln_b + l * 512 + 8 * lane + 4);
      v4u raw[16]; float s1[16], s2[16];
#pragma unroll
      for (int tt = 0; tt < 16; ++tt) raw[tt] = *(const v4u*)(p_BV + (m0 + 16 * wave + tt) * 512 + 8 * lane);
#pragma unroll
      for (int tt = 0; tt < 16; ++tt) { const v4u r = raw[tt]; const float x0 = bflo(r.x), x1 = bfhi(r.x), x2 = bflo(r.y), x3 = bfhi(r.y), x4 = bflo(r.z), x5 = bfhi(r.z), x6 = bflo(r.w), x7 = bfhi(r.w);
        s1[tt] = ((x0 + x1) + (x2 + x3)) + ((x4 + x5) + (x6 + x7)); s2[tt] = ((x0 * x0 + x1 * x1) + (x2 * x2 + x3 * x3)) + ((x4 * x4 + x5 * x5) + (x6 * x6 + x7 * x7)); }
#pragma unroll
      for (int o = 1; o < 64; o <<= 1) {
#pragma unroll
        for (int tt = 0; tt < 16; ++tt) { s1[tt] += shx(s1[tt], o, lane); s2[tt] += shx(s2[tt], o, lane); } }
#pragma unroll
      for (int tt = 0; tt < 16; ++tt) { const int t = 16 * wave + tt; const v4u r = raw[tt];
        const float mean = s1[tt] * (1.0f / 512.0f), var = fmaxf(s2[tt] * (1.0f / 512.0f) - mean * mean, 0.f), rstd = __builtin_amdgcn_rsqf(var + EPSF);
        float x[8] = {bflo(r.x), bfhi(r.x), bflo(r.y), bfhi(r.y), bflo(r.z), bfhi(r.z), bflo(r.w), bfhi(r.w)};
#pragma unroll
        for (int e = 0; e < 8; ++e) x[e] = (x[e] - mean) * rstd;
        v4u w; w.x = cvtpk2(x[0] * g0[0] + b0[0], x[1] * g0[1] + b0[1]); w.y = cvtpk2(x[2] * g0[2] + b0[2], x[3] * g0[3] + b0[3]);
        w.z = cvtpk2(x[4] * g1[0] + b1[0], x[5] * g1[1] + b1[1]); w.w = cvtpk2(x[6] * g1[2] + b1[2], x[7] * g1[3] + b1[3]);
        *(LAS v4u*)(C.lds + t * VP + lane * 16) = w; } }
    __syncthreads();
    const int g = wave; const bf16* Wg = p_SGW + (size_t)((l * 8 + g) * 128) * 128; const int troff = tr_lane_off(VP, lane, false);
#pragma unroll
    for (int tb = 0; tb < 4; ++tb) {
        f32x16 acc[2]; acc[0] = zero16(); acc[1] = zero16();
#pragma unroll
        for (int ks = 0; ks < 2 * tb + 2; ++ks) {
            const bf16x8 wf = *(const bf16x8*)(Wg + (32 * tb + i) * 128 + 16 * ks + 8 * h);
#pragma unroll
            for (int cb = 0; cb < 2; ++cb) acc[cb] = MFMA32(trfrag(C.lds, VP, 16 * ks, 64 * g + 32 * cb, troff, false), wf, acc[cb]);
        }
        const int t = 32 * tb + i; const float bias = p_sgu_b[(l * 8 + g) * 128 + t]; const size_t m = m0 + t;
#pragma unroll
        for (int cb = 0; cb < 2; ++cb)
#pragma unroll
            for (int g4 = 0; g4 < 4; ++g4) { const int c0 = 64 * g + 32 * cb + 8 * g4 + 4 * h;
                const u32x2v u = *(const u32x2v*)(p_BU + m * 512 + c0), z = *(const u32x2v*)(p_ZB + m * 2048 + 768 + c0); u32x2v w;
                w.x = cvtpk2(bflo(u.x) * (acc[cb][4 * g4] + bias) * bflo(z.x), bfhi(u.x) * (acc[cb][4 * g4 + 1] + bias) * bfhi(z.x));
                w.y = cvtpk2(bflo(u.y) * (acc[cb][4 * g4 + 2] + bias) * bflo(z.y), bfhi(u.y) * (acc[cb][4 * g4 + 3] + bias) * bfhi(z.y));
                *(u32x2v*)(p_YB + m * 2048 + 768 + c0) = w; }
    }
}

DI void hgp_item(const Ctx& C, int l, int item) { unsigned char* const ws = WSP(0); const bf16* const p_CK = (const bf16*)(ws + WS_CK); const bf16* const p_CI = (const bf16*)(ws + WS_CI); const float* const p_DJ = (const float*)(ws + WS_DJ); float* const p_SNAP = (float*)(ws + WS_DS); float* const p_out = OUTP();
    const int bh = item, b = bh / 6, hh = bh % 6, tid = C.tid, lane = C.lane, wave = C.wave, i = lane & 31, h = lane >> 5;
    constexpr int PT = 272, TB = 32 * PT, BUF = 2 * TB;
    LAS unsigned char* L = C.lds;
    const int row = tid >> 4, chn = tid & 15, kb = wave >> 1, vb0 = 2 * (wave & 1), troff = tr_lane_off(PT, lane, false);
    const size_t g0 = ((size_t)b * SEQL + row) * 768 + hh * 128 + chn * 8;
    const float* djp = p_DJ + ((size_t)b * 64) * 768 + hh * 128 + 32 * kb + i;
    v4u kreg = *(const v4u*)(p_CK + g0), vreg = *(const v4u*)(p_CI + g0); float djn = djp[0];
    *(LAS v4u*)(L + row * PT + chn * 16) = kreg; *(LAS v4u*)(L + TB + row * PT + chn * 16) = vreg;
    __syncthreads();
    f32x16 acc[2]; acc[0] = zero16(); acc[1] = zero16();
#pragma unroll 1
    for (int j = 0; j < 64; ++j) {
        LAS const unsigned char* cur = L + (j & 1) * BUF; LAS unsigned char* nxt = L + ((j + 1) & 1) * BUF;
        const float dj = djn;
        if (j < 63) { const size_t g = g0 + (size_t)(32 * (j + 1)) * 768; kreg = *(const v4u*)(p_CK + g); vreg = *(const v4u*)(p_CI + g); djn = djp[(size_t)(j + 1) * 768]; }
#pragma unroll
        for (int s2 = 0; s2 < 2; ++s2) { const bf16x8 kfr = trfrag(cur, PT, 16 * s2, 32 * kb, troff, false);
#pragma unroll
            for (int j2 = 0; j2 < 2; ++j2) acc[j2] = MFMA32(trfrag(cur + TB, PT, 16 * s2, 32 * (vb0 + j2), troff, false), kfr, acc[j2]); }
#pragma unroll
        for (int r = 0; r < 16; ++r) { acc[0][r] *= dj; acc[1][r] *= dj; }
        if ((j & 15) == 15) {
            float* dst = (j == 63) ? p_out + O_HP + (size_t)(l * 48 + bh) * 16384 : p_SNAP + (size_t)(bh * 3 + (j >> 4)) * 16384;
            dst += (size_t)(32 * kb + i) * 128 + 4 * h;
#pragma unroll
            for (int j2 = 0; j2 < 2; ++j2)
#pragma unroll
                for (int g4 = 0; g4 < 4; ++g4) *(f32x4*)(dst + 32 * (vb0 + j2) + 8 * g4) = (f32x4){acc[j2][4 * g4], acc[j2][4 * g4 + 1], acc[j2][4 * g4 + 2], acc[j2][4 * g4 + 3]};
        }
        if (j < 63) { *(LAS v4u*)(nxt + row * PT + chn * 16) = kreg; *(LAS v4u*)(nxt + TB + row * PT + chn * 16) = vreg; }
        __syncthreads();
    }
}
DI void hg3_item(const Ctx& C, int l, int item) { unsigned char* const ws = WSP(0); const bf16* const p_CE = (const bf16*)(ws + WS_CE); const float* const p_DJ = (const float*)(ws + WS_DJ); const bf16* const p_CI = (const bf16*)(ws + WS_CI); const bf16* const p_CK = (const bf16*)(ws + WS_CK); const bf16* const p_CQ = (const bf16*)(ws + WS_CQ); const float* const p_SNAP = (const float*)(ws + WS_DS); bf16* const p_YB = (bf16*)(ws + WS_YB); const bf16* const p_ZB = (const bf16*)(ws + WS_ZB); const float* const p_hn_g = ((const float*)INP(14));
    const int qt = item & 3, bh = item >> 2, b = bh / 6, hh = bh % 6, tid = C.tid, lane = C.lane, wave = C.wave, i = lane & 31, h = lane >> 5;
    constexpr int PT = 272, IMG = 64 * PT, SBB = 128 * PT;
    LAS unsigned char *QT = C.lds, *KD = C.lds + IMG, *VV = C.lds + 2 * IMG, *SB = C.lds + 3 * IMG;
    LAS float* RS = (LAS float*)(C.lds + 3 * IMG + 2 * SBB);
    f32x16 sacc[4];
    const int kb = wave & 3;
    if (wave >= 4) {
        if (qt == 0) {
#pragma unroll
            for (int vb = 0; vb < 4; ++vb) { sacc[vb] = zero16();
#pragma unroll
                for (int g4 = 0; g4 < 4; ++g4) *(LAS u32x2v*)(SB + (32 * kb + i) * PT + (32 * vb + 8 * g4 + 4 * h) * 2) = (u32x2v){0u, 0u}; }
        } else {
            const float* sp = p_SNAP + (size_t)(bh * 3 + qt - 1) * 16384 + (size_t)(32 * kb + i) * 128 + 4 * h;
#pragma unroll
            for (int vb = 0; vb < 4; ++vb)
#pragma unroll
                for (int g4 = 0; g4 < 4; ++g4) { const f32x4 tt = *(const f32x4*)(sp + 32 * vb + 8 * g4); sacc[vb][4 * g4] = tt[0]; sacc[vb][4 * g4 + 1] = tt[1]; sacc[vb][4 * g4 + 2] = tt[2]; sacc[vb][4 * g4 + 3] = tt[3];
                    u32x2v w; w.x = cvtpk2(tt[0], tt[1]); w.y = cvtpk2(tt[2], tt[3]); *(LAS u32x2v*)(SB + (32 * kb + i) * PT + (32 * vb + 8 * g4 + 4 * h) * 2) = w; }
        }
    }
    const int tro_n = tr_lane_off(PT, lane, false), tro_p = tr_lane_off(PT, lane, true);
    v4u rq[2], re[2], rk[2], rv[2];
#define HG3_ISSUE(sgx) do { const size_t mm_ = (size_t)b * SEQL + (8 * qt + (sgx)) * 64; _Pragma("unroll") for (int it = 0; it < 2; ++it) { const int idx = tid + 512 * it, row = idx >> 4, chn = idx & 15; \
        const size_t go = (mm_ + row) * 768 + hh * 128 + chn * 8; rq[it] = *(const v4u*)(p_CQ + go); re[it] = *(const v4u*)(p_CE + go); rk[it] = *(const v4u*)(p_CK + go); rv[it] = *(const v4u*)(p_CI + go); } } while (0)
#define HG3_FILL() do { _Pragma("unroll") for (int it = 0; it < 2; ++it) { const int idx = tid + 512 * it, row = idx >> 4, chn = idx & 15; const v4u q8 = rq[it], e8 = re[it]; v4u w; \
            w.x = cvtpk2(bflo(q8.x) * bflo(e8.x), bfhi(q8.x) * bfhi(e8.x)); w.y = cvtpk2(bflo(q8.y) * bflo(e8.y), bfhi(q8.y) * bfhi(e8.y)); \
            w.z = cvtpk2(bflo(q8.z) * bflo(e8.z), bfhi(q8.z) * bfhi(e8.z)); w.w = cvtpk2(bflo(q8.w) * bflo(e8.w), bfhi(q8.w) * bfhi(e8.w)); \
            *(LAS v4u*)(QT + row * PT + chn * 16) = w; *(LAS v4u*)(KD + row * PT + chn * 16) = rk[it]; *(LAS v4u*)(VV + row * PT + chn * 16) = rv[it]; } } while (0)
    HG3_ISSUE(0);
    if (wave < 4) {
        const int vb = wave;
#pragma unroll 1
        for (int sg = 0; sg < 8; ++sg) {
            const size_t m0 = (size_t)b * SEQL + (8 * qt + sg) * 64;
            HG3_FILL();
            if (sg < 7) HG3_ISSUE(sg + 1);
            __syncthreads();
#pragma unroll 1
            for (int j = 0; j < 2; ++j) {
                const int g = 2 * sg + j; LAS const unsigned char* SBr = SB + (g & 1) * SBB; LAS float* RSg = RS + (g & 1) * 128;
                u32x2v zr[4]; f32x4 gnv[4];
#pragma unroll
                for (int g4 = 0; g4 < 4; ++g4) { zr[g4] = *(const u32x2v*)(p_ZB + (m0 + 32 * j + i) * 2048 + 1280 + hh * 128 + 32 * vb + 8 * g4 + 4 * h); gnv[g4] = *(const f32x4*)(p_hn_g + l * 768 + hh * 128 + 32 * vb + 8 * g4 + 4 * h); }
                bf16x8 qfr[8];
#pragma unroll
                for (int ks = 0; ks < 8; ++ks) qfr[ks] = *(LAS const bf16x8*)(QT + (32 * j + i) * PT + (16 * ks + 8 * h) * 2);
                f32x16 x0 = zero16(), x1 = zero16();
#pragma unroll
                for (int ks = 0; ks < 8; ks += 2) { x0 = MFMA32(*(LAS const bf16x8*)(KD + (32 * j + i) * PT + (16 * ks + 8 * h) * 2), qfr[ks], x0);
                                                    x1 = MFMA32(*(LAS const bf16x8*)(KD + (32 * j + i) * PT + (16 * ks + 16 + 8 * h) * 2), qfr[ks + 1], x1); }
#pragma unroll
                for (int r = 0; r < 16; ++r) { const float xs = x0[r] + x1[r]; x0[r] = (crow(r, h) > i) ? 0.f : xs; }
                const bf16x8 pb0 = pack8(x0, 0), pb1 = pack8(x0, 1);
                f32x16 oa = zero16(), ob = zero16();
#pragma unroll
                for (int ks = 0; ks < 8; ks += 2) { oa = MFMA32(trfrag(SBr, PT, 16 * ks, 32 * vb, tro_n, false), qfr[ks], oa); ob = MFMA32(trfrag(SBr, PT, 16 * ks + 16, 32 * vb, tro_n, false), qfr[ks + 1], ob); }
                oa = MFMA32(trfrag(VV, PT, 32 * j, 32 * vb, tro_p, true), pb0, oa);
                ob = MFMA32(trfrag(VV, PT, 32 * j + 16, 32 * vb, tro_p, true), pb1, ob);
                float ss = 0.f;
#pragma unroll
                for (int r = 0; r < 16; ++r) { oa[r] += ob[r]; ss += oa[r] * oa[r]; }
                ss += shx(ss, 32, lane);
                if (h == 0) RSg[vb * 32 + i] = ss;
                __syncthreads();
                const float tot = RSg[i] + RSg[32 + i] + RSg[64 + i] + RSg[96 + i], rstd = __builtin_amdgcn_rsqf(tot * (1.0f / 128.0f) + EPSF);
                const size_t m = m0 + 32 * j + i;
#pragma unroll
                for (int g4 = 0; g4 < 4; ++g4) { const int v0 = hh * 128 + 32 * vb + 8 * g4 + 4 * h; const f32x4 gn = gnv[g4]; const u32x2v z = zr[g4]; u32x2v w;
                    w.x = cvtpk2(oa[4 * g4] * rstd * gn[0] * bflo(z.x), oa[4 * g4 + 1] * rstd * gn[1] * bfhi(z.x)); w.y = cvtpk2(oa[4 * g4 + 2] * rstd * gn[2] * bflo(z.y), oa[4 * g4 + 3] * rstd * gn[3] * bfhi(z.y));
                    *(u32x2v*)(p_YB + m * 2048 + 1280 + v0) = w; }
            }
        }
    } else {
#pragma unroll 1
        for (int sg = 0; sg < 8; ++sg) {
            const size_t m0 = (size_t)b * SEQL + (8 * qt + sg) * 64;
            HG3_FILL();
            float dv[2];
#pragma unroll
            for (int j = 0; j < 2; ++j) dv[j] = p_DJ[((m0 >> 5) + j) * 768 + hh * 128 + 32 * kb + i];
            if (sg < 7) HG3_ISSUE(sg + 1);
            __syncthreads();
#pragma unroll 1
            for (int j = 0; j < 2; ++j) {
                const int g = 2 * sg + j; LAS unsigned char* SBw = SB + ((g + 1) & 1) * SBB;
#pragma unroll
                for (int s2 = 0; s2 < 2; ++s2) { const bf16x8 kfr = trfrag(KD, PT, 32 * j + 16 * s2, 32 * kb, tro_n, false);
#pragma unroll
                    for (int vb = 0; vb < 4; ++vb) sacc[vb] = MFMA32(trfrag(VV, PT, 32 * j + 16 * s2, 32 * vb, tro_n, false), kfr, sacc[vb]); }
                const float d = (j == 0) ? dv[0] : dv[1];
#pragma unroll
                for (int vb = 0; vb < 4; ++vb)
#pragma unroll
                    for (int r = 0; r < 16; ++r) sacc[vb][r] *= d;
#pragma unroll
                for (int vb = 0; vb < 4; ++vb)
#pragma unroll
                    for (int g4 = 0; g4 < 4; ++g4) { u32x2v w; w.x = cvtpk2(sacc[vb][4 * g4], sacc[vb][4 * g4 + 1]); w.y = cvtpk2(sacc[vb][4 * g4 + 2], sacc[vb][4 * g4 + 3]); *(LAS u32x2v*)(SBw + (32 * kb + i) * PT + (32 * vb + 8 * g4 + 4 * h) * 2) = w; }
                __syncthreads();
            }
        }
    }
#undef HG3_ISSUE
#undef HG3_FILL
}
DI void samp_attn_item(const Ctx& C, int l, int item) { const float* const p_cache_k = ((const float*)INP(2)); const float* const p_cache_v = ((const float*)INP(3)); bf16* const p_QB = ((bf16*)WSP(WS_QB)); bf16* const p_KB = ((bf16*)WSP(WS_KB)); bf16* const p_VB = ((bf16*)WSP(WS_VB)); bf16* const p_ZB = ((bf16*)WSP(WS_ZB)); bf16* const p_YB = ((bf16*)WSP(WS_YB));
    const int b = item / 12, hh = item % 12, wave = C.wave, lane = C.lane, tid = C.tid; const size_t row = MPR + b;
    LAS float* sc = (LAS float*)C.lds;
    LAS float* po = sc + 400;
    const float* ck = p_cache_k + ((size_t)(l * 32 + b) * 2048) * 768 + hh * 64; const float* cv = p_cache_v + ((size_t)(l * 32 + b) * 2048) * 768 + hh * 64;
    const int grp = tid >> 4, dl = 4 * (tid & 15);
    const u32x2v qraw = *(const u32x2v*)(p_QB + row * 768 + hh * 64 + dl); const float q0 = bflo(qraw.x), q1 = bfhi(qraw.x), q2 = bflo(qraw.y), q3 = bfhi(qraw.y);
    const u32x2v knraw = *(const u32x2v*)(p_KB + row * 768 + hh * 64 + dl);
    const f32x4 knew = (f32x4){bflo(knraw.x), bfhi(knraw.x), bflo(knraw.y), bfhi(knraw.y)};
    f32x4 kv[13];
#pragma unroll
    for (int it = 0; it < 13; ++it) { int slot = 32 * it + grp; if (slot > 386) slot = 386; const int pp = slot / 129, jj = slot - 129 * pp, idx = 2048 - (jj << (2 * pp));
        kv[it] = knew; if (idx < 2048) kv[it] = __builtin_nontemporal_load((const f32x4*)(ck + (size_t)idx * 768 + dl)); }
#pragma unroll
    for (int it = 0; it < 13; ++it) { const int slot = 32 * it + grp;
        float part = (q0 * kv[it][0] + q1 * kv[it][1]) + (q2 * kv[it][2] + q3 * kv[it][3]);
        part += shx(part, 1, lane); part += shx(part, 2, lane); part += shx(part, 4, lane); part += shx(part, 8, lane);
        if ((tid & 15) == 0 && slot < 387) sc[slot] = part; }
    __syncthreads();
    float mx = -1e30f;
    for (int t = lane; t < 387; t += 64) mx = fmaxf(mx, sc[t]);
    mx = wave_max(mx, lane);
    float sm = 0.f;
    for (int t = lane; t < 387; t += 64) sm += ex2(sc[t] - mx);
    sm = wave_sum(sm, lane);
    const u32x2v vnraw = *(const u32x2v*)(p_VB + row * 768 + hh * 64 + dl);
    const f32x4 vnewv = (f32x4){bflo(vnraw.x), bfhi(vnraw.x), bflo(vnraw.y), bfhi(vnraw.y)};
    f32x4 vv[13];
#pragma unroll
    for (int it = 0; it < 13; ++it) { int slot = 32 * it + grp; if (slot > 386) slot = 386; const int pp = slot / 129, jj = slot - 129 * pp, idx = 2048 - (jj << (2 * pp));
        vv[it] = vnewv; if (idx < 2048) vv[it] = __builtin_nontemporal_load((const f32x4*)(cv + (size_t)idx * 768 + dl)); }
    f32x4 o4 = (f32x4){0.f, 0.f, 0.f, 0.f};
#pragma unroll
    for (int it = 0; it < 13; ++it) { const int slot = 32 * it + grp; if (slot < 387) o4 += vv[it] * ex2(sc[slot] - mx); }
#pragma unroll
    for (int e = 0; e < 4; ++e) { o4[e] += shx(o4[e], 16, lane); o4[e] += shx(o4[e], 32, lane); }
    if (lane < 16) *(LAS f32x4*)(po + wave * 64 + dl) = o4;
    __syncthreads();
    if (wave == 0) { float t = 0.f;
#pragma unroll
        for (int w = 0; w < 8; ++w) t += po[w * 64 + lane];
        t *= 1.0f / sm;
        p_YB[row * 2048 + hh * 64 + lane] = (bf16)f2bf(t * bf2f(p_ZB[row * 2048 + hh * 64 + lane])); }
}
DI void samp_sgu_item(const Ctx& C, int l, int item) { bf16* const p_BU = ((bf16*)WSP(WS_BU)); bf16* const p_BV = ((bf16*)WSP(WS_BV)); bf16* const p_YB = ((bf16*)WSP(WS_YB)); bf16* const p_ZB = ((bf16*)WSP(WS_ZB)); const float* const p_ln_b = ((const float*)INP(10)); const float* const p_ln_g = ((const float*)INP(9)); float* const p_out = OUTP(); const float* const p_sgu_b = ((const float*)INP(12)); const float* const p_sgu_w = ((const float*)INP(11));
    const int b = 8 * item + C.wave, lane = C.lane; const size_t row = MPR + b;
    const v4u raw = *(const v4u*)(p_BV + row * 512 + 8 * lane);
    float x[8] = {bflo(raw.x), bfhi(raw.x), bflo(raw.y), bfhi(raw.y), bflo(raw.z), bfhi(raw.z), bflo(raw.w), bfhi(raw.w)};
    float s = 0.f;
#pragma unroll
    for (int e = 0; e < 8; ++e) s += x[e];
    const float mean = wave_sum(s, lane) * (1.0f / 512.0f); float q = 0.f;
#pragma unroll
    for (int e = 0; e < 8; ++e) { x[e] -= mean; q += x[e] * x[e]; }
    const float rstd = __builtin_amdgcn_rsqf(wave_sum(q, lane) * (1.0f / 512.0f) + EPSF);
    const int g = lane >> 3; const float w00 = p_sgu_w[(size_t)((l * 8 + g) * 128) * 128], bb = p_sgu_b[(l * 8 + g) * 128];
    const v4u ur = *(const v4u*)(p_BU + row * 512 + 8 * lane), zr = *(const v4u*)(p_ZB + row * 2048 + 768 + 8 * lane);
    const float uu[8] = {bflo(ur.x), bfhi(ur.x), bflo(ur.y), bfhi(ur.y), bflo(ur.z), bfhi(ur.z), bflo(ur.w), bfhi(ur.w)};
    const float zz[8] = {bflo(zr.x), bfhi(zr.x), bflo(zr.y), bfhi(zr.y), bflo(zr.z), bfhi(zr.z), bflo(zr.w), bfhi(zr.w)};
    float vn[8], y[8];
#pragma unroll
    for (int e = 0; e < 8; ++e) { vn[e] = x[e] * rstd * p_ln_g[l * 512 + 8 * lane + e] + p_ln_b[l * 512 + 8 * lane + e]; y[e] = uu[e] * (w00 * vn[e] + bb) * zz[e]; }
    float* od = p_out + O_SGU + (size_t)(l * 32 + b) * 512 + 8 * lane;
    *(f32x4*)od = (f32x4){vn[0], vn[1], vn[2], vn[3]}; *(f32x4*)(od + 4) = (f32x4){vn[4], vn[5], vn[6], vn[7]};
    v4u w; w.x = cvtpk2(y[0], y[1]); w.y = cvtpk2(y[2], y[3]); w.z = cvtpk2(y[4], y[5]); w.w = cvtpk2(y[6], y[7]);
    *(v4u*)(p_YB + row * 2048 + 768 + 8 * lane) = w;
}
DI void samp_hgrn_item(const Ctx& C, int l, int item) { bf16* const p_CE = ((bf16*)WSP(WS_CE)); bf16* const p_CI = ((bf16*)WSP(WS_CI)); bf16* const p_CK = ((bf16*)WSP(WS_CK)); bf16* const p_CQ = ((bf16*)WSP(WS_CQ)); bf16* const p_YB = ((bf16*)WSP(WS_YB)); bf16* const p_ZB = ((bf16*)WSP(WS_ZB)); const float* const p_hn_g = ((const float*)INP(14)); float* const p_out = OUTP(); const float* const p_state = ((const float*)INP(4));
    const int b = item / 6, hh = item % 6, tid = C.tid; const size_t row = MPR + b;
    LAS float* qs = (LAS float*)C.lds; LAS float* eg = qs + 128; LAS float* kx = eg + 128; LAS float* vv = kx + 128; LAS float* po = vv + 128; LAS float* ov = po + 2048; LAS float* pr = ov + 128;
    if (tid < 128) { const size_t o = row * 768 + hh * 128 + tid; qs[tid] = bf2f(p_CQ[o]); eg[tid] = bf2f(p_CE[o]); kx[tid] = bf2f(p_CK[o]); vv[tid] = bf2f(p_CI[o]); }
    __syncthreads();
    const int v4 = (tid & 31) * 4, kq = tid >> 5;
    const f32x4 vloc = *(LAS const f32x4*)(vv + v4); f32x4 acc = (f32x4){0.f, 0.f, 0.f, 0.f};
    const float* S0 = p_state + (size_t)((l * 32 + b) * 6 + hh) * 16384; float* S1 = p_out + O_HS + (size_t)((l * 32 + b) * 6 + hh) * 16384;
#pragma unroll
    for (int kk = 0; kk < 8; ++kk) { const int k = 8 * kq + kk; const f32x4 s = __builtin_nontemporal_load((const f32x4*)(S0 + k * 128 + v4)); const f32x4 sn = s * eg[k] + vloc * kx[k]; __builtin_nontemporal_store(sn, (f32x4*)(S1 + k * 128 + v4)); acc += sn * qs[k]; }
    *(LAS f32x4*)(po + kq * 128 + v4) = acc;
    __syncthreads();
    float o = 0.f;
    if (tid < 128) {
#pragma unroll
        for (int q4 = 0; q4 < 16; ++q4) o += po[q4 * 128 + tid];
        const float ss = wave_sum(o * o, C.lane); if (C.lane == 0) pr[C.wave] = ss; }
    __syncthreads();
    if (tid < 128) { const float rstd = __builtin_amdgcn_rsqf((pr[0] + pr[1]) * (1.0f / 128.0f) + EPSF);
        p_YB[row * 2048 + 1280 + hh * 128 + tid] = (bf16)f2bf(o * rstd * p_hn_g[l * 768 + hh * 128 + tid] * bf2f(p_ZB[row * 2048 + 1280 + hh * 128 + tid])); }
}
DI void samp_out_item(const Ctx& C, int l, int item) { const float* const p_x_sample = ((const float*)INP(1)); float* const p_SSQ1 = ((float*)WSP(WS_CTL + CTL_SSQ1)); bf16* const p_WOUT = ((bf16*)WSP(WS_WOUT)); float* const p_X1 = ((float*)WSP(WS_X1)); bf16* const p_XB = ((bf16*)WSP(WS_XB)); bf16* const p_YB = ((bf16*)WSP(WS_YB)); float* const p_out = OUTP();
    const int lane = C.lane, wave = C.wave, i = lane & 31, h = lane >> 5, n0 = 32 * item;
    const bf16* A = p_YB + (size_t)(MPR + i) * 2048 + 256 * wave + 8 * h; const bf16* B = p_WOUT + ((size_t)l * DM + n0 + i) * 2048 + 256 * wave + 8 * h;
    f32x16 acc = zero16();
#pragma unroll
    for (int ks = 0; ks < 16; ++ks) acc = MFMA32(*(const bf16x8*)(A + 16 * ks), *(const bf16x8*)(B + 16 * ks), acc);
    LAS float* red = (LAS float*)C.lds;
#pragma unroll
    for (int r = 0; r < 16; ++r) red[(wave * 16 + r) * 64 + lane] = acc[r];
    __syncthreads();
    const int tl = C.tid & 63, i2 = tl & 31, h2 = tl >> 5;
#pragma unroll
    for (int e = 0; e < 2; ++e) { const int r = (C.tid >> 6) * 2 + e; float s = 0.f;
#pragma unroll
        for (int w = 0; w < 8; ++w) s += red[(w * 16 + r) * 64 + tl];
        const int bb = crow(r, h2), n = n0 + i2;
        if (l == 0) { const float o = p_x_sample[(size_t)bb * DM + n] + s; p_XB[(size_t)(MPR + bb) * DM + n] = (bf16)f2bf(o);
            float ss = o * o; ss += shx(ss, 1, lane); ss += shx(ss, 2, lane); ss += shx(ss, 4, lane); ss += shx(ss, 8, lane); ss += shx(ss, 16, lane);
            if (i2 == 0) atomicAdd(p_SSQ1 + MPR + bb, ss); }
        else { p_out[O_YS + (size_t)bb * DM + n] = bf2f(p_XB[(size_t)(MPR + bb) * DM + n]) + s; } }
}
DI int fetch_item(Ctx& C, int q) { gu32* const p_ctl = ((gu32*)WSP(WS_CTL));
    __syncthreads();
    if (C.tid == 0) C.MISC[0] = __hip_atomic_fetch_add((unsigned*)(p_ctl + CW_Q + 64 * q), 1u, __ATOMIC_RELAXED, __HIP_MEMORY_SCOPE_AGENT);
    __syncthreads();
    const int it = (int)C.MISC[0];
    { int t_ = C.tid; asm volatile("" : "+v"(t_)); C.tid = t_; C.lane = t_ & 63; C.wave = __builtin_amdgcn_readfirstlane(t_ >> 6);
      LAS unsigned char* lp_ = C.lds; asm volatile("" : "+s"(lp_)); C.lds = lp_; C.MISC = (volatile LAS unsigned*)(lp_ + MISC_OFF); }
    return it;
}
#ifndef G1_STAGGER_TICKS
#define G1_STAGGER_TICKS 0
#endif
#ifndef RPT_PHASE
#define RPT_PHASE -1
#define RPT_N 0
#endif
#ifndef RPT_IMASK
#define RPT_IMASK 0xffff
#endif
#ifndef RPT_MASK
#define RPT_MASK 0
#endif
#ifndef PH_MASK
#define PH_MASK 2047
#endif
constexpr int N_ATT = 384, N_HG = 192, N_HGP = 48, N_A1 = 384, N_SGU = 128, N_SAT = 384, N_SHG = 192, N_SSG = 4;
constexpr int N_M1 = N_HGP + N_ATT + N_SAT + N_SHG + N_SSG, N_WT = 184, N_KVO = 0;
constexpr int N_SOUT = 32;

template <int KIND, int L> DI void run_kind(Ctx& C, int im, int bx_) {
    constexpr int l = L;
    if constexpr (KIND == 0) { p0_prologue(C); }
    else if constexpr (KIND == 1) {
        pg8::Gemm g{((bf16*)WSP(WS_XB)), ((bf16*)WSP(WS_WIN)) + (size_t)l * NIN * DM, MPAD, NIN, DM}; pg8::StaticOrder S; S.init(MPAD, NIN, NGRID, bx_);
        pg8::EpiProj E{l == 0 ? ((float*)WSP(WS_CTL + CTL_SSQ0)) : ((float*)WSP(WS_CTL + CTL_SSQ1)), ((float*)WSP(WS_LB)) + l * 3 * 768, WSP(0), OUTP(), l, (im & 2048) ? 0 : 1,
                       WS_QB, WS_KB - WS_QB, WS_ZB, WS_BU, WS_BV - WS_BU, WS_CQ, WS_CK - WS_CQ, WS_CE, WS_DJ, WS_KH, WS_VH - WS_KH,
                       O_KP + (size_t)l * MPR * 768, O_VP - O_KP, O_KS + (size_t)l * 32 * 768, O_VS - O_KS};
#if G1_STAGGER_TICKS > 0
        { const unsigned long long t0 = __builtin_amdgcn_s_memrealtime(), dt = (unsigned long long)((bx_ >> 3) & 3) * G1_STAGGER_TICKS;
          while (__builtin_amdgcn_s_memrealtime() - t0 < dt) __builtin_amdgcn_s_sleep(8); }
#endif
        pg8::gemm_phase<pg8::EpiProj, pg8::StaticOrder, true, true>(C.lds + RING_OFF, g, S, E);
    } else if constexpr (KIND == 2) {
        for (;;) { int it = fetch_item(C, 3 * l + 0); if (it >= N_M1 + N_KVO + (l == 0 ? N_WT : 0)) break;
            if (it < N_HGP) { if (im & 8) hgp_item(C, l, it); continue; } it -= N_HGP;
            if (it < N_ATT) { if (im & 4) { if (it < 192) att23_item<2>(C, it); else att23_item<3>(C, it - 192); } continue; } it -= N_ATT;
            if (it < N_SAT) { if (im & 16) samp_attn_item(C, l, it); continue; } it -= N_SAT;
            if (it < N_SHG) { if (im & 64) samp_hgrn_item(C, l, it); continue; } it -= N_SHG;
            if (it < N_SSG) { if (im & 128) samp_sgu_item(C, l, it); continue; } it -= N_SSG;
            if (it < N_KVO) { if (im & 128) kvout_item(C, l, it); continue; } it -= N_KVO;
            if (im & 128) wt_item(C, it); }
    } else if constexpr (KIND == 4) {
        for (;;) { int it = fetch_item(C, 3 * l + 2); if (it >= N_HG + N_A1 + N_SGU + N_SOUT) break;
            if (it < N_HG) { if (im & 256) hg3_item(C, l, it); continue; } it -= N_HG;
            if (it < N_SGU) { if (im & 32) sgu_item(C, l, it); continue; } it -= N_SGU;
            if (it < N_A1) { if (im & 512) att1_item(C, it); continue; } it -= N_A1;
            if (im & 1024) samp_out_item(C, l, it); }
    } else {
        pg8::Gemm g{((bf16*)WSP(WS_YB)), ((bf16*)WSP(WS_WOUT)) + (size_t)l * DM * DMIX, MPR, DM, DMIX}; pg8::StaticOrder S; S.init(MPR, DM, NGRID, bx_);
        pg8::EpiOut E{l == 0 ? ((const float*)INP(0)) : nullptr, l == 0 ? nullptr : ((bf16*)WSP(WS_XB)), l == 0 ? nullptr : (OUTP()) + O_YP, l == 0 ? ((bf16*)WSP(WS_XB)) : nullptr, l == 0 ? ((float*)WSP(WS_CTL + CTL_SSQ1)) : nullptr};
        pg8::gemm_phase<pg8::EpiOut, pg8::StaticOrder, true, true>(C.lds + RING_OFF, g, S, E);
    }
}

__global__ void __launch_bounds__(NWAVES * 64, 2) mega_fwd(Args args) {
    extern __shared__ __attribute__((aligned(16))) unsigned char lds[];
    Ctx C;
    C.lds = (LAS unsigned char*)lds; C.MISC = (volatile LAS unsigned*)(C.lds + MISC_OFF);
    C.tid = threadIdx.x; C.lane = C.tid & 63; C.wave = __builtin_amdgcn_readfirstlane(C.tid >> 6);
    C.G = NGRID; C.vcu = 0;
    for (int u = C.tid; u < (LDS_BYTES - MISC_OFF) / 4; u += NWAVES * 64) ((LAS unsigned*)(C.lds + MISC_OFF))[u] = 0u;
    __syncthreads();
    XcdBarrier bar; bar.bar = (unsigned*)(((gu32*)WSP(WS_CTL)) + CW_BAR); bar.x = 0; bar.st = nullptr;
    if (N_LAUNCHES == 1) bar = xcd_barrier_post((unsigned*)(((gu32*)WSP(WS_CTL)) + CW_BAR), C.MISC + 8);
    const int lo = args.ph_lo, hi = args.ph_hi, im = args.imask;
    const int wave_s = __builtin_amdgcn_readfirstlane(threadIdx.x >> 6);
#define RELAUNDER() do { int t_ = (wave_s << 6) | (int)__builtin_amdgcn_mbcnt_hi(~0u, __builtin_amdgcn_mbcnt_lo(~0u, 0u)); asm volatile("" : "+v"(t_)); C.tid = t_; C.lane = t_ & 63; C.wave = __builtin_amdgcn_readfirstlane(t_ >> 6); \
        LAS unsigned char* lp_ = (LAS unsigned char*)lds; asm volatile("" : "+s"(lp_)); C.lds = lp_; C.MISC = (volatile LAS unsigned*)(lp_ + MISC_OFF); } while (0)
#define PHASE(p, KIND, L) if (lo <= (p) && (p) < hi) { RELAUNDER(); int bx_ = blockIdx.x; asm volatile("" : "+s"(bx_)); C.vcu = (bx_ & 7) * (NGRID >> 3) + (bx_ >> 3); run_kind<KIND, L>(C, im, bx_); \
        if (N_LAUNCHES == 1 && (p) + 1 < hi) { XcdBarrier b2; b2.bar = (unsigned*)(((gu32*)WSP(WS_CTL)) + CW_BAR); unsigned x2_ = bar.x; asm volatile("" : "+s"(x2_)); b2.x = x2_; b2.st = C.MISC + 8; xcd_barrier(b2); } }
    PHASE(0, 0, 0)
    PHASE(1, 1, 0) PHASE(2, 2, 0) PHASE(3, 4, 0) PHASE(4, 5, 0)
    PHASE(5, 1, 1) PHASE(6, 2, 1) PHASE(7, 4, 1) PHASE(8, 5, 1)
#undef PHASE
#undef RELAUNDER
}

extern "C" void kernel_launch(void* const* d_in, const int* in_sizes, int n_in, void* d_out, int out_size, void* d_ws, size_t ws_size, hipStream_t stream) {
    static int grid = 0;
    if (grid == 0) {
        if (n_in != 16 || (size_t)out_size != O_END || ws_size < WS_END) { fprintf(stderr, "kernel_launch: unexpected shapes: n_in %d out %d ws %zu (need %zu)\n", n_in, out_size, ws_size, (size_t)WS_END); grid = -1; return; }
        int dev = 0, cus = 0, per_cu = 0;
        if (hipGetDevice(&dev) != hipSuccess || hipDeviceGetAttribute(&cus, hipDeviceAttributeMultiprocessorCount, dev) != hipSuccess) { grid = -1; return; }
        if (hipFuncSetAttribute((const void*)mega_fwd, hipFuncAttributeMaxDynamicSharedMemorySize, LDS_BYTES) != hipSuccess) { fprintf(stderr, "kernel_launch: hipFuncSetAttribute failed\n"); grid = -1; return; }
        if (hipOccupancyMaxActiveBlocksPerMultiprocessor(&per_cu, (const void*)mega_fwd, NWAVES * 64, LDS_BYTES) != hipSuccess || per_cu < 1) { fprintf(stderr, "kernel_launch: occupancy query says %d\n", per_cu); (void)hipGetLastError(); per_cu = 1; }
        if (cus < NGRID) { fprintf(stderr, "kernel_launch: %d CUs < %d workgroups: not co-resident\n", cus, NGRID); grid = -1; return; }
        grid = NGRID;
    }
    if (grid < 0) return;
    (void)hipMemsetAsync((char*)d_ws + WS_CTL, 0, CTL_ZERO_BYTES, stream);
    Args a{};
    for (int i = 0; i < 16; ++i) a.in[i] = (const float*)d_in[i];
    a.out = (float*)d_out; a.ws = (unsigned char*)d_ws; a.imask = 0xffff;
    if (N_LAUNCHES == 1) { a.ph_lo = 0; a.ph_hi = N_PHASES; hipLaunchKernelGGL(mega_fwd, dim3(grid), dim3(NWAVES * 64), LDS_BYTES, stream, a); }
    else for (int p = 0; p < N_PHASES; ++p) { a.ph_lo = p; a.ph_hi = p + 1;
        const int nl = 1 + ((p == RPT_PHASE) ? RPT_N : 0);
        for (int r = 0; r < nl; ++r) {
            if (r > 0 && p >= 1) { const int l = (p - 1) / 4, k = (p - 1) % 4; if (k == 1 || k == 2) (void)hipMemsetAsync((char*)d_ws + WS_CTL + (size_t)(CW_Q + 64 * (3 * l + (k == 1 ? 0 : 2))) * 4, 0, 4, stream); }
            a.imask = (r > 0) ? RPT_IMASK : 0xffff;
            hipLaunchKernelGGL(mega_fwd, dim3(grid), dim3(NWAVES * 64), LDS_BYTES, stream, a); } }
}
```

```cpp
#include <hip/hip_runtime.h>
#include <cstdio>
#include <cstdint>
namespace pg8 {
#define PG8_LAS __attribute__((address_space(3)))
typedef unsigned short bf16_t;
typedef short bf16x8 __attribute__((ext_vector_type(8)));
typedef float f32x4 __attribute__((ext_vector_type(4)));
typedef unsigned u32x4 __attribute__((ext_vector_type(4)));
constexpr int BM = 256, BK = 64, HALF = 128, HTB = HALF * BK * 2  , STAGE_BYTES = 8 * HTB, NXCD = 8, WGM = 8;

__host__ __device__ __forceinline__ int lds_byte(int r, int c) { const int st = (r >> 4) * 2 + (c >> 5), rr = r & 15, cc = c & 31, ob = rr * 64 + cc * 2; return st * 1024 + (ob ^ (((ob >> 9) & 1) << 5)); }
__host__ __device__ __forceinline__ void stage_rc(int b, int& R, int& C) { const int st = b / 1024, sb = b % 1024, swz = sb ^ (((sb >> 9) & 1) << 5); R = (st >> 1) * 16 + swz / 64; C = (st & 1) * 32 + (swz % 64) / 2; }
__host__ __device__ __forceinline__ int perm32(int rho) { const int n = rho >> 4, i = rho & 15; return 8 * (i >> 2) + 4 * n + (i & 3); }

struct Unit { int pm, pn; };
struct Gemm { const bf16_t* A; const bf16_t* Bt; int M, N, K; };

struct StaticOrder {
    int nM, nN, nwg, G, c;
    __host__ __device__ void init(int M, int N, int G_, int c_) { nM = M / BM; nN = N / BM; nwg = nM * nN; G = G_; c = c_; }
    __host__ __device__ bool next(int i, Unit& u) const {
        const long L = (long)i * G + c; if (L >= nwg) return false;
        int wgid = (int)L; { const int q = nwg / NXCD, r = nwg % NXCD, xcd = wgid % NXCD, off = wgid / NXCD; wgid = (xcd < r ? xcd * (q + 1) : r * (q + 1) + (xcd - r) * q) + off; }
        const int nig = WGM * nN, gid = wgid / nig, fm = gid * WGM, gsz = (nM - fm) < WGM ? (nM - fm) : WGM;
        u.pm = fm + ((wgid % nig) % gsz); u.pn = (wgid % nig) / gsz; return true;
    }
    __device__ __forceinline__ void a_ready(const Unit&) const {}
    __device__ __forceinline__ void done(const Unit&) const {}
};

struct TailOrder {
    StaticOrder so; int xm, extra;
    __host__ __device__ bool next(int i, Unit& u) const {
        if (so.next(i, u)) return true;
        const long L = (long)i * so.G + so.c - so.nwg; if (L >= extra) return false;
        u.pm = xm; u.pn = so.nN + (int)L; return true;
    }
    __device__ __forceinline__ void a_ready(const Unit&) const {}
    __device__ __forceinline__ void done(const Unit&) const {}
};
struct ItemOrder {
    int pm, pn0, n;
    __host__ __device__ bool next(int i, Unit& u) const { if (i >= n) return false; u.pm = pm; u.pn = pn0 + i; return true; }
    __device__ __forceinline__ void a_ready(const Unit&) const {}
    __device__ __forceinline__ void done(const Unit&) const {}
};


typedef float f32x2 __attribute__((ext_vector_type(2)));
typedef unsigned u32x2 __attribute__((ext_vector_type(2)));
typedef __bf16 bf16x2_t __attribute__((ext_vector_type(2)));
__device__ __forceinline__ unsigned cvtpk(float lo, float hi) { f32x2 v = {lo, hi}; bf16x2_t b = __builtin_convertvector(v, bf16x2_t); return __builtin_bit_cast(unsigned, b); }
__device__ __forceinline__ float fast_sigmoid(float x) { return __builtin_amdgcn_rcpf(1.0f + __expf(-x)); }
__device__ __forceinline__ float silu_f(float x) { return x * fast_sigmoid(x); }

template <int CTRL> __device__ __forceinline__ float dpp_f(float x) { return __builtin_bit_cast(float, __builtin_amdgcn_update_dpp(0, __builtin_bit_cast(int, x), CTRL, 0xf, 0xf, false)); }
template <int CTRL> __device__ __forceinline__ float dpp_f1(float x) { return __builtin_bit_cast(float, __builtin_amdgcn_update_dpp(0x3f800000, __builtin_bit_cast(int, x), CTRL, 0xf, 0xf, false)); }
__device__ __forceinline__ float row_prefprod16(float x) { x *= dpp_f1<0x111>(x); x *= dpp_f1<0x112>(x); x *= dpp_f1<0x114>(x); x *= dpp_f1<0x118>(x); return x; }
__device__ __forceinline__ float row_bcast15(float x) { return __builtin_bit_cast(float, __builtin_amdgcn_update_dpp(0, __builtin_bit_cast(int, x), 0x15F, 0xf, 0xf, false)); }
__device__ __forceinline__ float row_prefix16(float x) { x += dpp_f<0x111>(x); x += dpp_f<0x112>(x); x += dpp_f<0x114>(x); x += dpp_f<0x118>(x); return x; }
struct EpiProj {
    static constexpr bool PERM = true, AFTER_DRAIN = false, HEADPERM = true;
    const float* ssq;
    const float* gtab;
    unsigned char* ws; float* out; int l; int skip;
    size_t o_qkv, s_qkv, o_zb, o_bu, s_bu, o_cq, s_cq, o_ce, o_dj, o_kh, s_kh;
    size_t o_kp, s_kp, o_ks, s_ks;
    __device__ __forceinline__ void st8(bf16_t* p, const f32x4& a, const f32x4& b) const {
        u32x4 w; w.x = cvtpk(a[0], a[1]); w.y = cvtpk(a[2], a[3]); w.z = cvtpk(b[0], b[1]); w.w = cvtpk(b[2], b[3]); *(u32x4*)p = w; }
    __device__ __forceinline__ void operator()(const f32x4 (&acc)[2][2][4][2], const Unit& u, int wr, int wc, int fr, int fq) const {
        if (skip) return;
        const int pn = u.pn;
        int seg, seg0;
        if (pn < 12) { seg = pn / 3; seg0 = seg * 3; }
        else if (pn < 18) { seg = 4 + (pn - 12) / 2; seg0 = 12 + (seg - 4) * 2; }
        else { seg = 7 + (pn - 18) / 3; seg0 = 18 + (seg - 7) * 3; }
        const int cl = (pn - seg0) * 256 + wc * 64 + 8 * fq;
        const int rowb = u.pm * BM + wr * 64 + fr;
        const bool sample = (u.pm == 64);
        f32x4 gv[2][2];
        { const int gi = (seg == 0) ? 0 : (seg == 1 ? 1 : 2); const float* gp = gtab + gi * 768 + (seg == 0 || seg == 1 || seg == 8 ? cl : 0);
#pragma unroll
          for (int bj = 0; bj < 2; ++bj)
#pragma unroll
              for (int n = 0; n < 2; ++n) gv[bj][n] = *(const f32x4*)(gp + 32 * bj + 4 * n); }
        if (seg == 8) {
            const int lane_hi15 = ((fq << 4) | 15);
            float rsc[2][4];
#pragma unroll
            for (int ai = 0; ai < 2; ++ai)
#pragma unroll
                for (int m = 0; m < 4; ++m) rsc[ai][m] = ssq[rowb + ai * HALF + m * 16];
#pragma unroll
            for (int ai = 0; ai < 2; ++ai)
#pragma unroll
                for (int mp = 0; mp < 2; ++mp) {
                    const int rowA = rowb + ai * HALF + mp * 32, rowB = rowA + 16;
                    const float rsA = __builtin_amdgcn_rsqf(rsc[ai][2 * mp] * (1.0f / 1024.0f) + 1e-6f), rsB = __builtin_amdgcn_rsqf(rsc[ai][2 * mp + 1] * (1.0f / 1024.0f) + 1e-6f);
#pragma unroll
                    for (int bj = 0; bj < 2; ++bj) {
                        f32x4 eA[2], eB[2], kA[2], kB[2], dl[2];
#pragma unroll
                        for (int n = 0; n < 2; ++n)
#pragma unroll
                            for (int e = 0; e < 4; ++e) { const float lbv = gv[bj][n][e], omlb = 1.0f - lbv;
                                const float sa = fast_sigmoid(acc[ai][bj][2 * mp][n][e] * rsA), sb = fast_sigmoid(acc[ai][bj][2 * mp + 1][n][e] * rsB);
                                float ka = omlb - omlb * sa, kb = omlb - omlb * sb, pa = lbv + omlb * sa, pb = lbv + omlb * sb;
                                if (!sample) { pa = row_prefprod16(pa); const float t0 = row_bcast15(pa); pb = row_prefprod16(pb) * t0; dl[n][e] = row_bcast15(pb);
                                    ka *= __builtin_amdgcn_rcpf(pa); kb *= __builtin_amdgcn_rcpf(pb); }
                                eA[n][e] = pa; eB[n][e] = pb; kA[n][e] = ka; kB[n][e] = kb; }
                        bf16_t* dkA = (bf16_t*)(ws + o_cq + s_cq) + (size_t)rowA * 768 + cl + 32 * bj; bf16_t* deA = (bf16_t*)(ws + o_ce) + (size_t)rowA * 768 + cl + 32 * bj;
                        st8(dkA, kA[0], kA[1]); st8(dkA + 16 * 768, kB[0], kB[1]); st8(deA, eA[0], eA[1]); st8(deA + 16 * 768, eB[0], eB[1]);
                        if (!sample && fr == 0) { float* dd = (float*)(ws + o_dj) + (size_t)(rowA >> 5) * 768 + cl + 32 * bj; *(f32x4*)dd = dl[0]; *(f32x4*)(dd + 4) = dl[1]; }
                    }
                    asm volatile("" ::: "memory");
                }
            return;
        }
        float rsv[2][4];
#pragma unroll
        for (int ai = 0; ai < 2; ++ai)
#pragma unroll
            for (int m = 0; m < 4; ++m) rsv[ai][m] = ssq[rowb + ai * HALF + m * 16];
#pragma unroll
        for (int ai = 0; ai < 2; ++ai)
#pragma unroll
            for (int m = 0; m < 4; ++m) {
                const int row = rowb + ai * HALF + m * 16;
                const float rs = __builtin_amdgcn_rsqf(rsv[ai][m] * (1.0f / 1024.0f) + 1e-6f);
                f32x4 v[2][2];
#pragma unroll
                for (int bj = 0; bj < 2; ++bj)
#pragma unroll
                    for (int n = 0; n < 2; ++n) v[bj][n] = acc[ai][bj][m][n] * rs;
                if (seg <= 1) {
                    float ss = 0.f;
#pragma unroll
                    for (int bj = 0; bj < 2; ++bj)
#pragma unroll
                        for (int n = 0; n < 2; ++n) { const f32x4 x = v[bj][n]; ss += (x[0] * x[0] + x[1] * x[1]) + (x[2] * x[2] + x[3] * x[3]); }
                    ss += __shfl_xor(ss, 16); ss += __shfl_xor(ss, 32);
                    float r2 = __builtin_amdgcn_rsqf(ss * (1.0f / 64.0f) + 1e-6f);
                    if (seg == 0) r2 *= 0.125f * 1.4426950408889634f;
#pragma unroll
                    for (int bj = 0; bj < 2; ++bj)
#pragma unroll
                        for (int n = 0; n < 2; ++n) v[bj][n] = v[bj][n] * gv[bj][n] * r2;
                }
                if (seg <= 2) {
                    if (seg == 0 || sample) {
                        bf16_t* dst = (bf16_t*)(ws + o_qkv + (size_t)seg * s_qkv) + (size_t)row * 768 + cl;
#pragma unroll
                        for (int bj = 0; bj < 2; ++bj) st8(dst + 32 * bj, v[bj][0], v[bj][1]);
                    } else {
                        const int t = row & 2047, bb = row >> 11, head = cl >> 6;
                        bf16_t* dst = (bf16_t*)(ws + o_kh + (size_t)(seg - 1) * s_kh) + ((size_t)(((bb * 12 + head) * 16 + (t & 15)) * 128 + (t >> 4))) * 64 + (cl & 63);
#pragma unroll
                        for (int bj = 0; bj < 2; ++bj) st8(dst + 32 * bj, v[bj][0], v[bj][1]);
                    }
                    if (seg >= 1) {
                        const bool okp = !sample, oks = sample && (row - 16384 < 32);
                        float* o = out + (okp ? o_kp + (size_t)(seg - 1) * s_kp + (size_t)row * 768 : o_ks + (size_t)(seg - 1) * s_ks + (size_t)(row - 16384) * 768) + cl;
                        if (okp || oks) {
#pragma unroll
                            for (int bj = 0; bj < 2; ++bj) { __builtin_nontemporal_store(v[bj][0], (f32x4*)(o + 32 * bj)); __builtin_nontemporal_store(v[bj][1], (f32x4*)(o + 32 * bj + 4)); }
                        }
                    }
                } else if (seg == 3 || seg == 6 || seg == 10 || seg == 7) {
#pragma unroll
                    for (int bj = 0; bj < 2; ++bj)
#pragma unroll
                        for (int n = 0; n < 2; ++n)
#pragma unroll
                            for (int e = 0; e < 4; ++e) v[bj][n][e] = silu_f(v[bj][n][e]);
                    const size_t zo = (seg == 7) ? o_cq + ((size_t)row * 768 + cl) * 2 : o_zb + ((size_t)row * 2048 + (seg == 3 ? 0 : (seg == 6 ? 768 : 1280)) + cl) * 2;
                    bf16_t* dst = (bf16_t*)(ws + zo);
#pragma unroll
                    for (int bj = 0; bj < 2; ++bj) st8(dst + 32 * bj, v[bj][0], v[bj][1]);
                } else if (seg == 4 || seg == 5) {
                    bf16_t* dst = (bf16_t*)(ws + o_bu + (size_t)(seg - 4) * s_bu) + (size_t)row * 512 + cl;
#pragma unroll
                    for (int bj = 0; bj < 2; ++bj) st8(dst + 32 * bj, v[bj][0], v[bj][1]);
                } else if (seg == 9) {
                    bf16_t* dst = (bf16_t*)(ws + o_cq + 2 * s_cq) + (size_t)row * 768 + cl;
#pragma unroll
                    for (int bj = 0; bj < 2; ++bj) st8(dst + 32 * bj, v[bj][0], v[bj][1]);
                }
                asm volatile("" ::: "memory");
            }
    }
};
struct EpiOut {
    static constexpr bool PERM = false, AFTER_DRAIN = false, HEADPERM = false;
    const float* res; const bf16_t* resb; float* out; bf16_t* xb; float* ssq;
    __device__ __forceinline__ f32x4 ldres(size_t off) const {
        if (res) return __builtin_nontemporal_load((const f32x4*)(res + off));
        const u32x2 w = *(const u32x2*)(resb + off); return (f32x4){__uint_as_float(w.x << 16), __uint_as_float(w.x & 0xffff0000u), __uint_as_float(w.y << 16), __uint_as_float(w.y & 0xffff0000u)}; }
    __device__ __forceinline__ void operator()(const f32x4 (&acc)[2][2][4][2], const Unit& u, int wr, int wc, int fr, int fq) const {
        const int col0 = u.pn * BM + wc * 32 + 4 * fq;
        const size_t off0 = (size_t)(u.pm * BM + wr * 64 + fr) * 1024 + col0;
        f32x4 rcur[2][2], rnxt[2][2];
#pragma unroll
        for (int bj = 0; bj < 2; ++bj)
#pragma unroll
            for (int n = 0; n < 2; ++n) rcur[bj][n] = ldres(off0 + bj * HALF + n * 16);
#pragma unroll
        for (int it = 0; it < 8; ++it) {
            const int ai = it >> 2, m = it & 3;
            const int row = u.pm * BM + ai * HALF + wr * 64 + m * 16 + fr; const size_t off = (size_t)row * 1024 + col0; float ss = 0.f;
            if (it < 7) { const int ai2 = (it + 1) >> 2, m2 = (it + 1) & 3; const size_t offn = off0 + (size_t)(ai2 * HALF + m2 * 16) * 1024;
#pragma unroll
                for (int bj = 0; bj < 2; ++bj)
#pragma unroll
                    for (int n = 0; n < 2; ++n) rnxt[bj][n] = ldres(offn + bj * HALF + n * 16); }
#pragma unroll
            for (int bj = 0; bj < 2; ++bj)
#pragma unroll
                for (int n = 0; n < 2; ++n) { const f32x4 o = rcur[bj][n] + acc[ai][bj][m][n];
                    if (out) __builtin_nontemporal_store(o, (f32x4*)(out + off + bj * HALF + n * 16));
                    ss += (o[0] * o[0] + o[1] * o[1]) + (o[2] * o[2] + o[3] * o[3]);
                    if (xb) { u32x2 w; w.x = cvtpk(o[0], o[1]); w.y = cvtpk(o[2], o[3]); *(u32x2*)(xb + off + bj * HALF + n * 16) = w; } }
            if (ssq) { ss += __shfl_xor(ss, 16); ss += __shfl_xor(ss, 32); if (fq == 0) atomicAdd(ssq + row, ss); }
#pragma unroll
            for (int bj = 0; bj < 2; ++bj)
#pragma unroll
                for (int n = 0; n < 2; ++n) rcur[bj][n] = rnxt[bj][n];
        }
    }
};
template <class Epi, class Sched, bool ALIGN_EPI = false, bool SP2 = false>
__device__ __forceinline__ void gemm_phase(PG8_LAS unsigned char* lds, const Gemm g, const Sched& S, const Epi& E, int tid_in) {
    int tid_ = tid_in; asm volatile("" : "+v"(tid_));
    const int tid = tid_, wid = __builtin_amdgcn_readfirstlane(tid >> 6), lane = tid & 63, wr = wid >> 2, wc = wid & 3, fr = lane & 15, fq = lane >> 4;
    const int K = g.K, nt = K / BK;
    unsigned voffA[2], voffB[2];
#pragma unroll
    for (int i = 0; i < 2; ++i) { int R, C; stage_rc(tid * 16 + i * 8192, R, C); const int Rb = Epi::HEADPERM ? (64 * (R >> 5) + perm32(R & 31)) : (Epi::PERM ? ((R & ~31) + perm32(R & 31)) : R);
        voffA[i] = (unsigned)(R * K + C) * 2u; voffB[i] = (unsigned)(Rb * K + C) * 2u; }
    const size_t kstep = (size_t)(BK * 2);
    const size_t hstep = (size_t)HALF * K * 2;
    const size_t tstep = 2 * hstep; const size_t hstepB = Epi::HEADPERM ? (size_t)32 * K * 2 : hstep;
    const unsigned ldsw = (unsigned)wid * 1024u;
    const int aoff = lds_byte(wr * 64 + fr, fq * 8), boff = lds_byte(wc * 32 + fr, fq * 8);
#define PG8_SA(b, h) (((b) * 2 + (h)) * HTB)
#define PG8_SB(b, h) ((4 + (b) * 2 + (h)) * HTB)
#define PG8_STAGE(bufoff, gbase, voff) do { _Pragma("unroll") for (int _i = 0; _i < 2; ++_i) \
        __builtin_amdgcn_global_load_lds((const unsigned*)((const char*)(gbase) + (voff)[_i]), (PG8_LAS unsigned*)(lds + (bufoff) + ldsw + _i * 8192), 16, 0, 0); } while (0)
#define PG8_LDA(dst, b, h) do { _Pragma("unroll") for (int m = 0; m < 4; ++m) _Pragma("unroll") for (int k = 0; k < 2; ++k) dst[m][k] = *(const PG8_LAS bf16x8*)(lds + PG8_SA(b, h) + aoff + m * 2048 + k * 1024); } while (0)
#define PG8_LDB(dst, b, h) do { _Pragma("unroll") for (int n = 0; n < 2; ++n) _Pragma("unroll") for (int k = 0; k < 2; ++k) dst[n][k] = *(const PG8_LAS bf16x8*)(lds + PG8_SB(b, h) + boff + n * 2048 + k * 1024); } while (0)
#define PG8_MMA(ai, bj, At, Bt) do { __builtin_amdgcn_s_setprio(1); _Pragma("unroll") for (int m = 0; m < 4; ++m) _Pragma("unroll") for (int n = 0; n < 2; ++n) _Pragma("unroll") for (int k = 0; k < 2; ++k) \
        acc[ai][bj][m][n] = __builtin_amdgcn_mfma_f32_16x16x32_bf16(Bt[n][k], At[m][k], acc[ai][bj][m][n], 0, 0, 0); __builtin_amdgcn_s_setprio(0); } while (0)
#define PG8_WAIT_V(n) asm volatile("s_waitcnt vmcnt(" #n ")" ::: "memory")
#define PG8_WAIT_L(n) asm volatile("s_waitcnt lgkmcnt(" #n ")" ::: "memory")
#define PG8_BAR __builtin_amdgcn_s_barrier()
#define PG8_SCHED __builtin_amdgcn_sched_barrier(0)
    Unit cur, nxt; int ui = 0;
    if (!S.next(0, cur)) return;
    f32x4 acc[2][2][4][2];
#pragma unroll
    for (int a = 0; a < 2; ++a)
#pragma unroll
        for (int b = 0; b < 2; ++b)
#pragma unroll
            for (int m = 0; m < 4; ++m)
#pragma unroll
                for (int n = 0; n < 2; ++n) acc[a][b][m][n] = (f32x4){0.f, 0.f, 0.f, 0.f};
    bf16x8 At[4][2], B0[2][2], B1[2][2];
    const char* cA = (const char*)g.A + (size_t)cur.pm * tstep; const char* cB = (const char*)g.Bt + (size_t)cur.pn * tstep;
    S.a_ready(cur);
    if constexpr (SP2) {
        PG8_STAGE(PG8_SB(0, 0), cB, voffB); PG8_STAGE(PG8_SB(0, 1), cB + hstepB, voffB); PG8_STAGE(PG8_SA(0, 0), cA, voffA); PG8_STAGE(PG8_SA(0, 1), cA + hstep, voffA);
        if (wr == 1) PG8_BAR;
        PG8_WAIT_V(2); PG8_BAR;
        PG8_STAGE(PG8_SB(1, 0), cB + kstep, voffB); PG8_STAGE(PG8_SA(1, 0), cA + kstep, voffA); PG8_STAGE(PG8_SB(1, 1), cB + hstepB + kstep, voffB);
        PG8_WAIT_V(6); PG8_BAR;
    } else {
        PG8_STAGE(PG8_SB(0, 0), cB, voffB); PG8_STAGE(PG8_SA(0, 0), cA, voffA); PG8_STAGE(PG8_SB(0, 1), cB + hstepB, voffB); PG8_STAGE(PG8_SA(0, 1), cA + hstep, voffA);
        if (wr == 1) PG8_BAR;
        PG8_WAIT_V(4); PG8_BAR;
        PG8_STAGE(PG8_SB(1, 0), cB + kstep, voffB); PG8_STAGE(PG8_SA(1, 0), cA + kstep, voffA); PG8_STAGE(PG8_SB(1, 1), cB + hstepB + kstep, voffB);
        PG8_WAIT_V(6); PG8_BAR;
    }
    for (;;) {
        const bool has_next = S.next(ui + 1, nxt);
        const char* nA = has_next ? (const char*)g.A + (size_t)nxt.pm * tstep : cA; const char* nB = has_next ? (const char*)g.Bt + (size_t)nxt.pn * tstep : cB;
        for (int t = 0; t < nt; t += 2) {
            const bool last = (t == nt - 2);
            const char* a1 = cA + (size_t)(t + 1) * kstep;
            const char* a2 = last ? nA : cA + (size_t)(t + 2) * kstep; const char* b2 = last ? nB : cB + (size_t)(t + 2) * kstep;
            const char* a3 = a2 + kstep; const char* b3 = b2 + kstep;
            if (last && has_next) S.a_ready(nxt);
            if constexpr (SP2) {
            PG8_LDB(B0, 0, 0); PG8_LDB(B1, 0, 1); PG8_SCHED; PG8_LDA(At, 0, 0); PG8_STAGE(PG8_SA(1, 1), a1 + hstep, voffA);
            PG8_WAIT_V(8); PG8_WAIT_L(0); PG8_BAR; PG8_MMA(0, 0, At, B0); PG8_MMA(0, 1, At, B1); PG8_BAR; PG8_SCHED;
            PG8_LDA(At, 0, 1); PG8_STAGE(PG8_SB(0, 0), b2, voffB); PG8_STAGE(PG8_SB(0, 1), b2 + hstepB, voffB); PG8_STAGE(PG8_SA(0, 0), a2, voffA);
            PG8_WAIT_V(8); PG8_WAIT_L(0); PG8_BAR; PG8_MMA(1, 0, At, B0); PG8_MMA(1, 1, At, B1); PG8_BAR; PG8_SCHED;
            PG8_LDB(B0, 1, 0); PG8_LDB(B1, 1, 1); PG8_SCHED; PG8_LDA(At, 1, 0); PG8_STAGE(PG8_SA(0, 1), a2 + hstep, voffA);
            PG8_WAIT_V(8); PG8_WAIT_L(0); PG8_BAR; PG8_MMA(0, 0, At, B0); PG8_MMA(0, 1, At, B1); PG8_BAR; PG8_SCHED;
            PG8_LDA(At, 1, 1); PG8_STAGE(PG8_SB(1, 0), b3, voffB); PG8_STAGE(PG8_SB(1, 1), b3 + hstepB, voffB); PG8_STAGE(PG8_SA(1, 0), a3, voffA);
            PG8_WAIT_V(8); PG8_WAIT_L(0); PG8_BAR; PG8_MMA(1, 0, At, B0); PG8_MMA(1, 1, At, B1); PG8_BAR; PG8_SCHED;
            } else {
            PG8_LDB(B0, 0, 0); PG8_SCHED; PG8_LDA(At, 0, 0); PG8_STAGE(PG8_SA(1, 1), a1 + hstep, voffA);
            PG8_WAIT_L(8); PG8_BAR; PG8_WAIT_L(0); PG8_MMA(0, 0, At, B0); PG8_BAR; PG8_SCHED;
            PG8_LDB(B1, 0, 1); PG8_STAGE(PG8_SB(0, 0), b2, voffB);
            PG8_BAR; PG8_WAIT_L(0); PG8_MMA(0, 1, At, B1); PG8_BAR;
            PG8_LDA(At, 0, 1); PG8_STAGE(PG8_SA(0, 0), a2, voffA);
            PG8_BAR; PG8_WAIT_L(0); PG8_MMA(1, 0, At, B0); PG8_BAR; PG8_SCHED;
            PG8_STAGE(PG8_SB(0, 1), b2 + hstepB, voffB);
            PG8_WAIT_V(6); PG8_BAR; PG8_MMA(1, 1, At, B1); PG8_BAR;
            PG8_LDB(B0, 1, 0); PG8_SCHED; PG8_LDA(At, 1, 0); PG8_STAGE(PG8_SA(0, 1), a2 + hstep, voffA);
            PG8_WAIT_L(8); PG8_BAR; PG8_WAIT_L(0); PG8_MMA(0, 0, At, B0); PG8_BAR; PG8_SCHED;
            PG8_LDB(B1, 1, 1); PG8_STAGE(PG8_SB(1, 0), b3, voffB);
            PG8_BAR; PG8_WAIT_L(0); PG8_MMA(0, 1, At, B1); PG8_BAR;
            PG8_LDA(At, 1, 1); PG8_STAGE(PG8_SA(1, 0), a3, voffA);
            PG8_BAR; PG8_WAIT_L(0); PG8_MMA(1, 0, At, B0); PG8_BAR; PG8_SCHED;
            PG8_STAGE(PG8_SB(1, 1), b3 + hstepB, voffB);
            PG8_WAIT_V(6); PG8_BAR; PG8_MMA(1, 1, At, B1); PG8_BAR;
            }
        }
        if constexpr (ALIGN_EPI) { if (wr == 0) PG8_BAR; }
        if constexpr (!Epi::AFTER_DRAIN) { E(acc, cur, wr, wc, fr, fq); S.done(cur); }
        if (!has_next) break;
#pragma unroll
        for (int a = 0; a < 2; ++a)
#pragma unroll
            for (int b = 0; b < 2; ++b)
#pragma unroll
                for (int m = 0; m < 4; ++m)
#pragma unroll
                    for (int n = 0; n < 2; ++n) acc[a][b][m][n] = (f32x4){0.f, 0.f, 0.f, 0.f};
        cur = nxt; cA = nA; cB = nB; ++ui;
        if constexpr (ALIGN_EPI) { if (wr == 1) PG8_BAR; }
    }
    PG8_WAIT_V(0);
    if constexpr (!ALIGN_EPI) { if (wr == 0) PG8_BAR; }
    PG8_BAR;
    if constexpr (Epi::AFTER_DRAIN) { E.fused(acc, cur, wr, wc, fr, fq, lds, wid, lane); S.done(cur); }
#undef PG8_SA
#undef PG8_SB
#undef PG8_STAGE
#undef PG8_LDA
#undef PG8_LDB
#undef PG8_MMA
#undef PG8_WAIT_V
#undef PG8_WAIT_L
#undef PG8_BAR
#undef PG8_SCHED
}
}
#define GAS __attribute__((address_space(1)))
#define LAS __attribute__((address_space(3)))
typedef unsigned short bf16;
typedef unsigned v4u __attribute__((ext_vector_type(4)));
typedef float f32x4 __attribute__((ext_vector_type(4)));
typedef short bf16x8 __attribute__((ext_vector_type(8)));
typedef GAS unsigned gu32;
typedef GAS unsigned long long gu64;
#define RLX_AGENT __ATOMIC_RELAXED, __HIP_MEMORY_SCOPE_AGENT
#define LDS_WAIT() asm volatile("s_waitcnt lgkmcnt(0)" ::: "memory")
#define VM_WAIT() asm volatile("s_waitcnt vmcnt(0)" ::: "memory")
__device__ __forceinline__ unsigned long long rt() { return __builtin_amdgcn_s_memrealtime(); }
__device__ __forceinline__ unsigned f2bf(float f) { unsigned u = __builtin_bit_cast(unsigned, f); return (u + 0x7fffu + ((u >> 16) & 1u)) >> 16; }
__device__ __forceinline__ unsigned pk2(float lo, float hi) { return f2bf(lo) | (f2bf(hi) << 16); }

#define XB_TMO      128
#define XB_XCNT(j)  (256  + 64 * (j))
#define XB_XSUB(j)  (1280 + 64 * (j))
#define XB_XGEN(j)  (2304 + 64 * (j))
#define XB_TOP      3328
#define XB_TOPGEN   3392
#define XCD_BAR_WORDS 3456
#define XB_SPIN_CAP (1u << 18)

__device__ __forceinline__ unsigned xb_ld(unsigned* p)              { return __hip_atomic_load(p, __ATOMIC_RELAXED, __HIP_MEMORY_SCOPE_AGENT); }
__device__ __forceinline__ unsigned xb_add(unsigned* p, unsigned v) { return __hip_atomic_fetch_add(p, v, __ATOMIC_RELAXED, __HIP_MEMORY_SCOPE_AGENT); }
__device__ __forceinline__ unsigned xb_xcc_id() { return (unsigned)__builtin_amdgcn_s_getreg((3 << 11) | 20) & 0xFu; }
#define XB_SPIN(cond, bar) do { unsigned _sp = 0; while (cond) { __builtin_amdgcn_s_sleep(1); \
    if ((++_sp & 255u) == 0u) { if (xb_ld(&(bar)[XB_TMO])) break; if (_sp > XB_SPIN_CAP) { atomicAdd(&(bar)[XB_TMO], 1u); break; } } } } while (0)

struct XcdBarrier {
    unsigned* bar; unsigned x;
    volatile LAS unsigned* st;
};

__device__ __forceinline__ XcdBarrier xcd_barrier_post(unsigned* bar, volatile LAS unsigned* st) {
    XcdBarrier b; b.bar = bar; b.x = xb_xcc_id(); b.st = st;
    if (threadIdx.x == 0) (void)xb_add(&bar[XB_XCNT(b.x)], 1u);
    return b;
}
__device__ __forceinline__ void xcd_barrier_complete(unsigned* bar, unsigned x, unsigned& nloc, unsigned& nx) {
    const unsigned G = 256u;
    unsigned sum, cnt, mine, sp = 0u;
    for (;;) {
        sum = 0u; cnt = 0u; mine = 0u;
#pragma unroll
        for (unsigned j = 0; j < 16; ++j) { const unsigned c = xb_ld(&bar[XB_XCNT(j)]); sum += c; cnt += (c > 0u) ? 1u : 0u; mine = (j == x) ? c : mine; }
        if (sum == G) break;
        __builtin_amdgcn_s_sleep(1);
        if ((++sp & 255u) == 0u) { if (xb_ld(&bar[XB_TMO])) break; if (sp > XB_SPIN_CAP) { atomicAdd(&bar[XB_TMO], 1u); break; } }
    }
    nloc = mine > 0u ? mine : 1u; nx = cnt > 0u ? cnt : 1u;
}

__device__ __forceinline__ void xcd_barrier(const XcdBarrier& b, int tid) {
    asm volatile("s_waitcnt vmcnt(0)" ::: "memory");
    __syncthreads();
    if (tid == 0) {
        unsigned* bar = b.bar;
        __builtin_amdgcn_s_waitcnt(0);
        unsigned nloc = b.st[0], nx = b.st[1];
        if (nloc == 0u) { xcd_barrier_complete(bar, b.x, nloc, nx); b.st[0] = nloc; b.st[1] = nx; }
        const unsigned old = xb_add(&bar[XB_XSUB(b.x)], 1u);
        const unsigned gen = old / nloc;
        if (old + 1u == (gen + 1u) * nloc) {
            __builtin_amdgcn_fence(__ATOMIC_RELEASE, "agent");
            asm volatile("s_waitcnt vmcnt(0)" ::: "memory");
            const unsigned og = xb_add(&bar[XB_TOP], 1u);
            const unsigned tg = og / nx;
            if (og + 1u == (tg + 1u) * nx) xb_add(&bar[XB_TOPGEN], 1u);
            else XB_SPIN(xb_ld(&bar[XB_TOPGEN]) == tg, bar);
            __builtin_amdgcn_fence(__ATOMIC_ACQUIRE, "agent");
            xb_add(&bar[XB_XGEN(b.x)], 1u);
            asm volatile("s_waitcnt vmcnt(0)" ::: "memory");
        } else {
            XB_SPIN(xb_ld(&bar[XB_XGEN(b.x)]) == gen, bar);
            __builtin_amdgcn_fence(__ATOMIC_ACQUIRE, "agent");
            asm volatile("s_waitcnt vmcnt(0)" ::: "memory");
        }
    }
    __syncthreads();
}
#ifndef MK_N_LAUNCHES
#define MK_N_LAUNCHES 1
#endif
constexpr int NWAVES = 8, NGRID = 256;
constexpr int N_PHASES = 9;
constexpr int N_LAUNCHES = MK_N_LAUNCHES;
constexpr int DM = 1024, NIN = 7680, DMIX = 2048;
constexpr int MPR = 16384, MSA = 32, MPAD = 16640, SEQL = 2048;
constexpr float EPSF = 1e-6f;
constexpr size_t O_YP = 0, O_YS = 16777216, O_KP = O_YS + 32768, O_VP = O_KP + 25165824, O_KS = O_VP + 25165824, O_VS = O_KS + 49152,
                 O_SGU = O_VS + 49152, O_HP = O_SGU + 32768, O_HS = O_HP + 1572864, O_END = O_HS + 6291456;
constexpr size_t MiB = 1u << 20;
constexpr size_t alup(size_t x) { return (x + MiB - 1) / MiB * MiB; }
constexpr size_t WS_CTL = 0, CTL_ZERO_BYTES = MiB;
constexpr size_t WS_WIN = MiB;
constexpr size_t WS_WOUT = WS_WIN + alup((size_t)2 * NIN * DM * 2);
constexpr size_t WS_SGW = WS_WOUT + alup((size_t)2 * DM * DMIX * 2);
constexpr size_t WS_LB = WS_SGW + alup((size_t)2 * 8 * 128 * 128 * 2);
constexpr size_t WS_XB = WS_LB + MiB;
constexpr size_t WS_QB = WS_XB + alup((size_t)MPAD * DM * 2);
constexpr size_t WS_KB = WS_QB + alup((size_t)MPAD * 768 * 2);
constexpr size_t WS_VB = WS_KB + alup((size_t)MPAD * 768 * 2);
constexpr size_t WS_ZB = WS_VB + alup((size_t)MPAD * 768 * 2);
constexpr size_t WS_BU = WS_ZB + alup((size_t)MPAD * 2048 * 2);
constexpr size_t WS_BV = WS_BU + alup((size_t)MPAD * 512 * 2);
constexpr size_t WS_CQ = WS_BV + alup((size_t)MPAD * 512 * 2);
constexpr size_t WS_CK = WS_CQ + alup((size_t)MPAD * 768 * 2);
constexpr size_t WS_CI = WS_CK + alup((size_t)MPAD * 768 * 2);
constexpr size_t WS_CG = WS_CI + alup((size_t)MPAD * 768 * 2);
constexpr size_t WS_CE = WS_CG;
constexpr size_t WS_DJ = WS_CG + alup((size_t)MPAD * 768 * 2);
constexpr size_t WS_YB = WS_CG + alup((size_t)MPAD * 768 * 4);
constexpr size_t WS_X1 = WS_YB + alup((size_t)MPAD * 2048 * 2);
constexpr size_t WS_DS = WS_X1 + alup((size_t)MPAD * DM * 4);
constexpr size_t WS_DEC = WS_DS + alup((size_t)48 * 16 * 128 * 128 * 4);
constexpr size_t WS_O2 = WS_DEC + alup((size_t)48 * 16 * 128 * 4);
constexpr size_t WS_O3 = WS_O2 + alup((size_t)MPAD * 768 * 2);
constexpr size_t WS_L2 = WS_O3 + alup((size_t)MPAD * 768 * 2);
constexpr size_t WS_L3 = WS_L2 + alup((size_t)MPAD * 16 * 4);
constexpr size_t WS_KH = WS_L3 + alup((size_t)MPAD * 16 * 4);
constexpr size_t WS_VH = WS_KH + alup((size_t)MPR * 768 * 2);
constexpr size_t WS_END = WS_VH + alup((size_t)MPR * 768 * 2);
constexpr int CW_TMO = 0, CW_CODE = 1, CW_BAR = 4096, CW_Q = 8192;
constexpr size_t CTL_SSQ0 = 256 * 1024, CTL_SSQ1 = 512 * 1024;
constexpr int RING_OFF = 0, LDS_BYTES = 163840, MISC_OFF = LDS_BYTES - 1024;
static_assert(WS_VB - WS_KB == WS_KB - WS_QB && WS_CI - WS_CK == WS_CK - WS_CQ, "equally spaced buffer groups (addressed arithmetically in the in-projection epilogue)");
#define DI __device__ __forceinline__
typedef float f32x16 __attribute__((ext_vector_type(16)));
typedef short s16x4 __attribute__((ext_vector_type(4)));
typedef short v4i16_t __attribute__((ext_vector_type(4)));
typedef float f32x2v __attribute__((ext_vector_type(2)));
typedef unsigned u32x2v __attribute__((ext_vector_type(2)));
typedef __bf16 bf16x2v __attribute__((ext_vector_type(2)));
#define MFMA32(a, b, c) __builtin_amdgcn_mfma_f32_32x32x16_bf16((a), (b), (c), 0, 0, 0)
DI unsigned cvtpk2(float lo, float hi) { f32x2v v = {lo, hi}; bf16x2v b = __builtin_convertvector(v, bf16x2v); return __builtin_bit_cast(unsigned, b); }
DI float bf2f(bf16 u) { return __uint_as_float((unsigned)u << 16); }
DI float bflo(unsigned w) { return __uint_as_float(w << 16); }
DI float bfhi(unsigned w) { return __uint_as_float(w & 0xffff0000u); }
DI int crow(int r, int h) { return (r & 3) + 8 * (r >> 2) + 4 * h; }
DI float shx(float v, int mask, int lane) { return __builtin_bit_cast(float, __builtin_amdgcn_ds_bpermute((lane ^ mask) << 2, __builtin_bit_cast(int, v))); }
DI float wave_sum(float v, int lane) {
#pragma unroll
    for (int o = 1; o < 64; o <<= 1) v += shx(v, o, lane);
    return v;
}
DI float wave_max(float v, int lane) {
#pragma unroll
    for (int o = 1; o < 64; o <<= 1) v = fmaxf(v, shx(v, o, lane));
    return v;
}
DI s16x4 trd(LAS const unsigned char* p) { return __builtin_bit_cast(s16x4, __builtin_amdgcn_ds_read_tr16_b64_v4i16((LAS v4i16_t*)p)); }
DI int tr_lane_off(int pitch, int lane, bool perm) { const int i16 = lane & 15, q = i16 >> 2, p = i16 & 3, blk = (lane >> 4) & 1, h = lane >> 5; return ((perm ? 4 * h : 8 * h) + q) * pitch + (16 * blk + 4 * p) * 2; }
DI bf16x8 trfrag(LAS const unsigned char* base, int pitch, int k0, int c0, int laneoff, bool perm) {
    LAS const unsigned char* a = base + k0 * pitch + c0 * 2 + laneoff;
    const s16x4 lo = trd(a), hi = trd(a + (perm ? 8 : 4) * pitch);
    return __builtin_shufflevector(lo, hi, 0, 1, 2, 3, 4, 5, 6, 7);
}
DI bf16x8 pack8(const f32x16& x, int s) { v4u p; p.x = cvtpk2(x[8 * s], x[8 * s + 1]); p.y = cvtpk2(x[8 * s + 2], x[8 * s + 3]); p.z = cvtpk2(x[8 * s + 4], x[8 * s + 5]); p.w = cvtpk2(x[8 * s + 6], x[8 * s + 7]); return __builtin_bit_cast(bf16x8, p); }
DI f32x16 zero16() { f32x16 z;
#pragma unroll
    for (int i = 0; i < 16; ++i) z[i] = 0.f; return z; }

struct Args { const float* in[16]; float* out; unsigned char* ws; int ph_lo, ph_hi, imask, pad; };
struct Ctx {
    LAS unsigned char* lds; volatile LAS unsigned* MISC;
    int tid, lane, wave, vcu, G;
};
typedef __attribute__((address_space(4))) const Args* kaptr_t;
DI kaptr_t kargs() { kaptr_t kp = (kaptr_t)__builtin_amdgcn_kernarg_segment_ptr(); asm volatile("" : "+s"(kp)); return kp; }
#define INP(i) (kargs()->in[i])
#define WSP(off) (kargs()->ws + (off))
#define OUTP() (kargs()->out)
DI void p0_transpose_item(const float* W, int K, int N, bf16* WT, const float* gk, LAS float* scr, int item, int lane, bool nts = false) {
    const int nblk = N / 32, kb = item / nblk, nb = item % nblk, k0 = 64 * kb, n0 = 32 * nb;
#pragma unroll 8
    for (int i = 0; i < 32; ++i) { const int kk = 2 * i + (lane >> 5); float w = __builtin_nontemporal_load(W + (size_t)(k0 + kk) * N + n0 + (lane & 31)); if (gk) w *= gk[k0 + kk]; scr[kk * 33 + (lane & 31)] = w; }
    LDS_WAIT(); asm volatile("" ::: "memory");
    const int c = lane & 7;
#pragma unroll
    for (int j = 0; j < 4; ++j) { const int n = (lane >> 3) + 8 * j; const LAS float* s = scr + (8 * c) * 33 + n;
        v4u o; o.x = pk2(s[0 * 33], s[1 * 33]); o.y = pk2(s[2 * 33], s[3 * 33]); o.z = pk2(s[4 * 33], s[5 * 33]); o.w = pk2(s[6 * 33], s[7 * 33]);
        if (nts) __builtin_nontemporal_store(o, (v4u*)(WT + (size_t)(n0 + n) * K + k0 + 8 * c)); else *(GAS v4u*)(WT + (size_t)(n0 + n) * K + k0 + 8 * c) = o; }
    LDS_WAIT(); asm volatile("" ::: "memory");
}
DI void p0_prologue(Ctx& C) { const float* const p_qn_g = ((const float*)INP(7)); const float* const p_kn_g = ((const float*)INP(8)); float* const p_LB = ((float*)WSP(WS_LB)); bf16* const p_SGW = ((bf16*)WSP(WS_SGW)); float* const p_SSQ0 = ((float*)WSP(WS_CTL + CTL_SSQ0)); bf16* const p_WIN = ((bf16*)WSP(WS_WIN)); bf16* const p_WOUT = ((bf16*)WSP(WS_WOUT)); bf16* const p_XB = ((bf16*)WSP(WS_XB)); const float* const p_lb_logits = ((const float*)INP(13)); const float* const p_norm_g = ((const float*)INP(5)); const float* const p_sgu_w = ((const float*)INP(11)); const float* const p_w_in = ((const float*)INP(6)); const float* const p_w_out = ((const float*)INP(15)); const float* const p_x_prompt = ((const float*)INP(0)); const float* const p_x_sample = ((const float*)INP(1));
    LAS float* scr = (LAS float*)(C.lds + RING_OFF + C.wave * 16384);
    const int gw = C.vcu * NWAVES + C.wave, NGW = C.G * NWAVES;
    constexpr int I_IN1 = (DM / 64) * (NIN / 32), I_OUT1 = (DMIX / 64) * (DM / 32);
    for (int it = gw; it < I_IN1; it += NGW) p0_transpose_item(p_w_in, DM, NIN, p_WIN, p_norm_g, scr, it, C.lane);
    for (int m = gw; m < MPAD; m += NGW) {
        GAS unsigned long long* o8 = (GAS unsigned long long*)(p_XB + (size_t)m * DM) + C.lane;
        if (m < MPR + MSA) {
            const float* xrow = (m < MPR) ? p_x_prompt + (size_t)m * DM : p_x_sample + (size_t)(m - MPR) * DM;
            const GAS f32x4* xr = (const GAS f32x4*)xrow + C.lane; f32x4 v[4]; float s = 0.f;
#pragma unroll
            for (int j = 0; j < 4; ++j) { v[j] = __builtin_nontemporal_load(xr + 64 * j); s += (v[j].x * v[j].x + v[j].y * v[j].y) + (v[j].z * v[j].z + v[j].w * v[j].w); }
            s = wave_sum(s, C.lane);
#pragma unroll
            for (int j = 0; j < 4; ++j) o8[64 * j] = (unsigned long long)pk2(v[j].x, v[j].y) | ((unsigned long long)pk2(v[j].z, v[j].w) << 32);
            if (C.lane == 0) p_SSQ0[m] = s;
        } else {
#pragma unroll
            for (int j = 0; j < 4; ++j) o8[64 * j] = 0ull;
            if (C.lane == 0) p_SSQ0[m] = 0.f;
        }
    }
    const int gt = C.vcu * 512 + C.tid, NGT = C.G * 512;
    for (int e = gt; e < 2 * 8 * 128 * 128; e += NGT) { const int s = e & 127, t = (e >> 7) & 127; const float w = p_sgu_w[e]; p_SGW[e] = (bf16)f2bf(s <= t ? w : 0.f); }
    for (int e = gt; e < 2 * 768; e += NGT) { const int l = e / 768, c = e - 768 * l; p_LB[(l * 3 + 0) * 768 + c] = p_qn_g[e]; p_LB[(l * 3 + 1) * 768 + c] = p_kn_g[e]; p_LB[(l * 3 + 2) * 768 + c] = (l == 0) ? 0.f : 1.0f / (1.0f + __expf(p_lb_logits[c] - p_lb_logits[768 + c])); }
}

DI void wt_item(const Ctx& C, int item) { const float* const p_w_in = ((const float*)INP(6)); const float* const p_w_out = ((const float*)INP(15)); const float* const p_norm_g = ((const float*)INP(5)); bf16* const p_WIN = ((bf16*)WSP(WS_WIN)); bf16* const p_WOUT = ((bf16*)WSP(WS_WOUT));
    constexpr int I_IN1 = (DM / 64) * (NIN / 32), I_OUT1 = (DMIX / 64) * (DM / 32);
    LAS float* scr = (LAS float*)(C.lds + RING_OFF + C.wave * 16384);
#pragma unroll 1
    for (int rep = 0; rep < 4; ++rep) {
        int it = 32 * item + 8 * rep + C.wave;
        if (it < I_OUT1) { p0_transpose_item(p_w_out, DMIX, DM, p_WOUT, nullptr, scr, it, C.lane, true); continue; } it -= I_OUT1;
        if (it < I_IN1) p0_transpose_item(p_w_in + (size_t)DM * NIN, DM, NIN, p_WIN + (size_t)NIN * DM, p_norm_g + DM, scr, it, C.lane, true);
        else if (it < I_IN1 + I_OUT1) p0_transpose_item(p_w_out + (size_t)DMIX * DM, DMIX, DM, p_WOUT + (size_t)DM * DMIX, nullptr, scr, it - I_IN1, C.lane, true);
    }
}

DI void kvout_item(const Ctx& C, int l, int item) { unsigned char* const ws = WSP(0); const bf16* const p_KH = (const bf16*)(ws + WS_KH); const bf16* const p_VH = (const bf16*)(ws + WS_VH); float* const p_out = OUTP();
    const int b = item >> 5, t0 = (item & 31) * 64, tid = C.tid;
    float* ok = p_out + O_KP + ((size_t)l * MPR + (size_t)b * SEQL + t0) * 768; float* ov = p_out + O_VP + ((size_t)l * MPR + (size_t)b * SEQL + t0) * 768;
#pragma unroll 4
    for (int it = 0; it < 12; ++it) { const int idx = tid + 512 * it, tl = idx / 96, hc = idx - 96 * tl, hh = hc >> 3, ch = hc & 7, t = t0 + tl;
        const size_t so = ((size_t)(((b * 12 + hh) * 16 + (t & 15)) * 128 + (t >> 4))) * 64 + 8 * ch; const size_t dofs = (size_t)tl * 768 + hh * 64 + 8 * ch;
        const v4u k8 = *(const v4u*)(p_KH + so), v8 = *(const v4u*)(p_VH + so);
        *(f32x4*)(ok + dofs) = (f32x4){bflo(k8.x), bfhi(k8.x), bflo(k8.y), bfhi(k8.y)}; *(f32x4*)(ok + dofs + 4) = (f32x4){bflo(k8.z), bfhi(k8.z), bflo(k8.w), bfhi(k8.w)};
        *(f32x4*)(ov + dofs) = (f32x4){bflo(v8.x), bfhi(v8.x), bflo(v8.y), bfhi(v8.y)}; *(f32x4*)(ov + dofs + 4) = (f32x4){bflo(v8.z), bfhi(v8.z), bflo(v8.w), bfhi(v8.w)}; }
}
DI float ex2(float x) { return __builtin_amdgcn_exp2f(x); }
DI float lg2(float x) { return __builtin_amdgcn_logf(x); }

constexpr int AP = 144;
DI void cls_tile(const bf16x8 (&qf)[4], LAS const unsigned char* Kl, LAS const unsigned char* Vl, int kr0, int jstart, int lane, f32x16 (&o)[2], float& lse) {
    const int i = lane & 31, h = lane >> 5;
    o[0] = zero16(); o[1] = zero16();
    constexpr float THR = 6.0f;
    float mrun = 0.f, l = 0.f; bool first = true;
    LAS const unsigned char* kp = Kl + (kr0 + 32 * jstart + i) * AP + 16 * h;
    LAS const unsigned char* vp = Vl + (kr0 + 32 * jstart) * AP + tr_lane_off(AP, lane, true);
#pragma unroll 1
    for (int j = jstart; j < 5; ++j, kp += 32 * AP, vp += 32 * AP) {
        f32x16 st = zero16();
#pragma unroll
        for (int s = 0; s < 4; ++s) st = MFMA32(*(LAS const bf16x8*)(kp + 32 * s), qf[s], st);
        if (j == 0) {
#pragma unroll
            for (int r = 0; r < 16; ++r) if (crow(r, h) < i) st[r] = -1e30f;
        }
        if (j == 4) {
#pragma unroll
            for (int r = 0; r < 16; ++r) if (crow(r, h) > i) st[r] = -1e30f;
        }
        float rm = fmaxf(fmaxf(st[0], st[1]), st[2]);
#pragma unroll
        for (int r = 3; r < 15; r += 2) rm = fmaxf(fmaxf(rm, st[r]), st[r + 1]);
        rm = fmaxf(rm, st[15]);
        rm = fmaxf(rm, shx(rm, 32, lane)) - mrun;
        if (first || __any(rm > THR)) {
            const float delta = first ? rm : fmaxf(rm, 0.f); mrun += delta;
            if (!first) { const float alpha = ex2(-delta); l *= alpha;
#pragma unroll
                for (int r = 0; r < 16; ++r) { o[0][r] *= alpha; o[1][r] *= alpha; } }
            first = false;
        }
        float ps0 = 0.f, ps1 = 0.f;
#pragma unroll
        for (int r = 0; r < 16; r += 2) { st[r] = ex2(st[r] - mrun); st[r + 1] = ex2(st[r + 1] - mrun); ps0 += st[r]; ps1 += st[r + 1]; }
        l += ps0 + ps1;
        const bf16x8 pb0 = pack8(st, 0), pb1 = pack8(st, 1);
#pragma unroll
        for (int db = 0; db < 2; ++db) {
            const s16x4 a0 = trd(vp + 64 * db), a1 = trd(vp + 64 * db + 8 * AP), b0 = trd(vp + 64 * db + 16 * AP), b1 = trd(vp + 64 * db + 24 * AP);
            o[db] = MFMA32(__builtin_shufflevector(a0, a1, 0, 1, 2, 3, 4, 5, 6, 7), pb0, o[db]);
            o[db] = MFMA32(__builtin_shufflevector(b0, b1, 0, 1, 2, 3, 4, 5, 6, 7), pb1, o[db]);
        }
    }
    l += shx(l, 32, lane);
    const float inv = 1.0f / l;
#pragma unroll
    for (int r = 0; r < 16; ++r) { o[0][r] *= inv; o[1][r] *= inv; }
    lse = mrun + lg2(l);
}
DI void cls_store(bf16* Ob, float* Lb, size_t m, int hh, int h, const f32x16 (&o)[2], float lse) {
    bf16* op = Ob + m * 768 + hh * 64 + 4 * h;
#pragma unroll
    for (int db = 0; db < 2; ++db)
#pragma unroll
        for (int g4 = 0; g4 < 4; ++g4) { u32x2v w; w.x = cvtpk2(o[db][4 * g4], o[db][4 * g4 + 1]); w.y = cvtpk2(o[db][4 * g4 + 2], o[db][4 * g4 + 3]); *(u32x2v*)(op + 32 * db + 8 * g4) = w; }
    if (h == 0) Lb[m * 16 + hh] = lse;
}
template <int KIND> DI void att23_item(const Ctx& C, int item) { unsigned char* const ws = WSP(0); const bf16* const p_QB = (const bf16*)(ws + WS_QB); const bf16* const p_KB = (const bf16*)(ws + WS_KH); const bf16* const p_VB = (const bf16*)(ws + WS_VH);
    bf16* const p_O = (bf16*)(ws + (KIND == 2 ? WS_O2 : WS_O3)); float* const p_L = (float*)(ws + (KIND == 2 ? WS_L2 : WS_L3));
    const int up = item & 1, hh = (item >> 1) % 12, b = item / 24, lane = C.lane, wave = C.wave, tid = C.tid, i = lane & 31, h = lane >> 5;
    const size_t rb = (size_t)b * SEQL;
    LAS unsigned char* Kl = C.lds; LAS unsigned char* Vl = C.lds + 512 * AP;
    v4u kr[8], vr[8];
#define A23_TOK(u, row) (KIND == 2 ? (4 * (row) + (u)) : (16 * ((row) & 127) + 4 * (u) + ((row) >> 7)))
#define A23_SRC(u, idx) ((size_t)(((b * 12 + hh) * 16 + (KIND == 2 ? 4 * ((idx) >> 10) + (u) : 4 * (u) + ((idx) >> 10))) * 128 + (((idx) >> 3) & 127)) * 64 + 8 * ((idx) & 7))
#define A23_ROW(idx) (KIND == 2 ? 4 * (((idx) >> 3) & 127) + ((idx) >> 10) : ((idx) >> 3))
#define A23_ISSUE(u) do { _Pragma("unroll") for (int it = 0; it < 8; ++it) { const int idx = tid + 512 * it; const size_t go = A23_SRC(u, idx); \
        kr[it] = *(const v4u*)(p_KB + go); vr[it] = *(const v4u*)(p_VB + go); } } while (0)
    A23_ISSUE(2 * up);
#pragma unroll 1
    for (int u = 2 * up; u < 2 * up + 2; ++u) {
        __syncthreads();
#pragma unroll
        for (int it = 0; it < 8; ++it) { const int idx = tid + 512 * it, row = A23_ROW(idx), ch = idx & 7; *(LAS v4u*)(Kl + row * AP + ch * 16) = kr[it]; *(LAS v4u*)(Vl + row * AP + ch * 16) = vr[it]; }
        __syncthreads();
        int cb0, qa, qb;
        if (KIND == 2) { cb0 = 0; qa = 64 * wave; qb = qa + 32; } else { cb0 = (wave >> 1) * 128; qa = (wave & 1) ? 32 : 0; qb = (wave & 1) ? 64 : 96; }
        const size_t ma = rb + A23_TOK(u, cb0 + qa + i), mb = rb + A23_TOK(u, cb0 + qb + i);
        bf16x8 qfa[4], qfb[4];
#pragma unroll
        for (int s = 0; s < 4; ++s) qfa[s] = *(const bf16x8*)(p_QB + ma * 768 + hh * 64 + 8 * h + 16 * s);
        if (u == 2 * up) A23_ISSUE(u + 1);
        f32x16 o[2]; float lse;
        cls_tile(qfa, Kl + cb0 * AP, Vl + cb0 * AP, qa - 128, qa >= 128 ? 0 : (128 - qa) >> 5, lane, o, lse);
        cls_store(p_O, p_L, ma, hh, h, o, lse);
#pragma unroll
        for (int s = 0; s < 4; ++s) qfb[s] = *(const bf16x8*)(p_QB + mb * 768 + hh * 64 + 8 * h + 16 * s);
        cls_tile(qfb, Kl + cb0 * AP, Vl + cb0 * AP, qb - 128, qb >= 128 ? 0 : (128 - qb) >> 5, lane, o, lse);
        cls_store(p_O, p_L, mb, hh, h, o, lse);
    }
#undef A23_ISSUE
#undef A23_TOK
#undef A23_SRC
#undef A23_ROW
}
DI void att1_item(const Ctx& C, int item) { unsigned char* const ws = WSP(0); const bf16* const p_QB = (const bf16*)(ws + WS_QB); const bf16* const p_KB = (const bf16*)(ws + WS_KH); const bf16* const p_VB = (const bf16*)(ws + WS_VH);
    const bf16* const p_O2 = (const bf16*)(ws + WS_O2); const float* const p_L2 = (const float*)(ws + WS_L2); const bf16* const p_O3 = (const bf16*)(ws + WS_O3); const float* const p_L3 = (const float*)(ws + WS_L3); const bf16* const p_ZB = (const bf16*)(ws + WS_ZB); bf16* const p_YB = (bf16*)(ws + WS_YB);
    const int qtr = item & 3, hh = (item >> 2) % 12, b = item / 48, lane = C.lane, wave = C.wave, tid = C.tid, i = lane & 31, h = lane >> 5;
    const size_t rb = (size_t)b * SEQL;
    LAS unsigned char* Kl = C.lds; LAS unsigned char* Vl = C.lds + 384 * AP;
    v4u kr[6], vr[6];
#define A1_ISSUE(T) do { const int m30_ = 16 * (T) - 8; _Pragma("unroll") for (int it = 0; it < 6; ++it) { const int idx = tid + 512 * it, r16 = idx / 192, rem = idx - 192 * r16; int m3 = m30_ + (rem >> 3); if (m3 < 0) m3 = 0; \
        const size_t go = (size_t)(((b * 12 + hh) * 16 + r16) * 128 + m3) * 64 + 8 * (rem & 7); kr[it] = *(const v4u*)(p_KB + go); vr[it] = *(const v4u*)(p_VB + go); } } while (0)
    A1_ISSUE(2 * qtr);
#pragma unroll 1
    for (int u = 0; u < 2; ++u) {
        const int T = 2 * qtr + u;
        __syncthreads();
#pragma unroll
        for (int it = 0; it < 6; ++it) { const int idx = tid + 512 * it, r16 = idx / 192, rem = idx - 192 * r16, row = 16 * (rem >> 3) + r16, ch = rem & 7; *(LAS v4u*)(Kl + row * AP + ch * 16) = kr[it]; *(LAS v4u*)(Vl + row * AP + ch * 16) = vr[it]; }
        __syncthreads();
        const int tq0 = 256 * T + 32 * wave; const size_t m = rb + tq0 + i;
        bf16x8 qf[4];
#pragma unroll
        for (int s = 0; s < 4; ++s) qf[s] = *(const bf16x8*)(p_QB + m * 768 + hh * 64 + 8 * h + 16 * s);
        const bf16* o2p = p_O2 + m * 768 + hh * 64 + 4 * h; const bf16* o3p = p_O3 + m * 768 + hh * 64 + 4 * h; const bf16* zp = p_ZB + m * 2048 + hh * 64 + 4 * h; bf16* yp = p_YB + m * 2048 + hh * 64 + 4 * h;
        const float l2 = p_L2[m * 16 + hh], l3 = p_L3[m * 16 + hh];
        u32x2v a2[8], a3[8];
#pragma unroll
        for (int c8 = 0; c8 < 8; ++c8) { a2[c8] = *(const u32x2v*)(o2p + 8 * c8); a3[c8] = *(const u32x2v*)(o3p + 8 * c8); }
        if (u < 1) A1_ISSUE(T + 1);
        f32x16 o[2]; float lse;
        cls_tile(qf, Kl, Vl, 32 * wave, tq0 >= 128 ? 0 : (128 - tq0) >> 5, lane, o, lse);
        const float M = fmaxf(lse, fmaxf(l2, l3)), L = M + lg2(ex2(lse - M) + ex2(l2 - M) + ex2(l3 - M));
        const float w1 = ex2(lse - L), w2 = ex2(l2 - L), w3 = ex2(l3 - L);
#pragma unroll
        for (int db = 0; db < 2; ++db)
#pragma unroll
            for (int g4 = 0; g4 < 4; ++g4) { const int c8 = 4 * db + g4; const u32x2v x2 = a2[c8], x3 = a3[c8], z = *(const u32x2v*)(zp + 8 * c8); u32x2v w;
                const float y0 = w1 * o[db][4 * g4] + w2 * bflo(x2.x) + w3 * bflo(x3.x), y1 = w1 * o[db][4 * g4 + 1] + w2 * bfhi(x2.x) + w3 * bfhi(x3.x);
                const float y2 = w1 * o[db][4 * g4 + 2] + w2 * bflo(x2.y) + w3 * bflo(x3.y), y3 = w1 * o[db][4 * g4 + 3] + w2 * bfhi(x2.y) + w3 * bfhi(x3.y);
                w.x = cvtpk2(y0 * bflo(z.x), y1 * bfhi(z.x)); w.y = cvtpk2(y2 * bflo(z.y), y3 * bfhi(z.y)); *(u32x2v*)(yp + 8 * c8) = w; }
    }
#undef A1_ISSUE
}

DI void sgu_item(const Ctx& C, int l, int item) { bf16* const p_BU = ((bf16*)WSP(WS_BU)); bf16* const p_BV = ((bf16*)WSP(WS_BV)); bf16* const p_SGW = ((bf16*)WSP(WS_SGW)); bf16* const p_YB = ((bf16*)WSP(WS_YB)); bf16* const p_ZB = ((bf16*)WSP(WS_ZB)); const float* const p_ln_b = ((const float*)INP(10)); const float* const p_ln_g = ((const float*)INP(9)); const float* const p_sgu_b = ((const float*)INP(12));
    const int b = item >> 4, ch = item & 15, lane = C.lane, wave = C.wave, i = lane & 31, h = lane >> 5; const size_t m0 = (size_t)b * SEQL + ch * 128;
    constexpr int VP = 1088;
    { const f32x4 g0 = *(const f32x4*)(p_ln_g + l * 512 + 8 * lane), g1 = *(const f32x4*)(p_ln_g + l * 512 + 8 * lane + 4), b0 = *(const f32x4*)(p_ln_b + l * 512 + 8 * lane), b1 = *(const f32x4*)(p_ln_b + l * 512 + 8 * lane + 4);
      v4u raw[16]; float s1[16], s2[16];
#pragma unroll
      for (int tt = 0; tt < 16; ++tt) raw[tt] = *(const v4u*)(p_BV + (m0 + 16 * wave + tt) * 512 + 8 * lane);
#pragma unroll
      for (int tt = 0; tt < 16; ++tt) { const v4u r = raw[tt]; const float x0 = bflo(r.x), x1 = bfhi(r.x), x2 = bflo(r.y), x3 = bfhi(r.y), x4 = bflo(r.z), x5 = bfhi(r.z), x6 = bflo(r.w), x7 = bfhi(r.w);
        s1[tt] = ((x0 + x1) + (x2 + x3)) + ((x4 + x5) + (x6 + x7)); s2[tt] = ((x0 * x0 + x1 * x1) + (x2 * x2 + x3 * x3)) + ((x4 * x4 + x5 * x5) + (x6 * x6 + x7 * x7)); }
#pragma unroll
      for (int o = 1; o < 64; o <<= 1) {
#pragma unroll
        for (int tt = 0; tt < 16; ++tt) { s1[tt] += shx(s1[tt], o, lane); s2[tt] += shx(s2[tt], o, lane); } }
#pragma unroll
      for (int tt = 0; tt < 16; ++tt) { const int t = 16 * wave + tt; const v4u r = raw[tt];
        const float mean = s1[tt] * (1.0f / 512.0f), var = fmaxf(s2[tt] * (1.0f / 512.0f) - mean * mean, 0.f), rstd = __builtin_amdgcn_rsqf(var + EPSF);
        float x[8] = {bflo(r.x), bfhi(r.x), bflo(r.y), bfhi(r.y), bflo(r.z), bfhi(r.z), bflo(r.w), bfhi(r.w)};
#pragma unroll
        for (int e = 0; e < 8; ++e) x[e] = (x[e] - mean) * rstd;
        v4u w; w.x = cvtpk2(x[0] * g0[0] + b0[0], x[1] * g0[1] + b0[1]); w.y = cvtpk2(x[2] * g0[2] + b0[2], x[3] * g0[3] + b0[3]);
        w.z = cvtpk2(x[4] * g1[0] + b1[0], x[5] * g1[1] + b1[1]); w.w = cvtpk2(x[6] * g1[2] + b1[2], x[7] * g1[3] + b1[3]);
        *(LAS v4u*)(C.lds + t * VP + lane * 16) = w; } }
    __syncthreads();
    const int g = wave; const bf16* Wg = p_SGW + (size_t)((l * 8 + g) * 128) * 128; const int troff = tr_lane_off(VP, lane, false);
#pragma unroll
    for (int tb = 0; tb < 4; ++tb) {
        f32x16 acc[2]; acc[0] = zero16(); acc[1] = zero16();
#pragma unroll
        for (int ks = 0; ks < 2 * tb + 2; ++ks) {
            const bf16x8 wf = *(const bf16x8*)(Wg + (32 * tb + i) * 128 + 16 * ks + 8 * h);
#pragma unroll
            for (int cb = 0; cb < 2; ++cb) acc[cb] = MFMA32(trfrag(C.lds, VP, 16 * ks, 64 * g + 32 * cb, troff, false), wf, acc[cb]);
        }
        const int t = 32 * tb + i; const float bias = p_sgu_b[(l * 8 + g) * 128 + t]; const size_t m = m0 + t;
#pragma unroll
        for (int cb = 0; cb < 2; ++cb)
#pragma unroll
            for (int g4 = 0; g4 < 4; ++g4) { const int c0 = 64 * g + 32 * cb + 8 * g4 + 4 * h;
                const u32x2v u = *(const u32x2v*)(p_BU + m * 512 + c0), z = *(const u32x2v*)(p_ZB + m * 2048 + 768 + c0); u32x2v w;
                w.x = cvtpk2(bflo(u.x) * (acc[cb][4 * g4] + bias) * bflo(z.x), bfhi(u.x) * (acc[cb][4 * g4 + 1] + bias) * bfhi(z.x));
                w.y = cvtpk2(bflo(u.y) * (acc[cb][4 * g4 + 2] + bias) * bflo(z.y), bfhi(u.y) * (acc[cb][4 * g4 + 3] + bias) * bfhi(z.y));
                *(u32x2v*)(p_YB + m * 2048 + 768 + c0) = w; }
    }
}

DI void hgp_item(const Ctx& C, int l, int item) { unsigned char* const ws = WSP(0); const bf16* const p_CK = (const bf16*)(ws + WS_CK); const bf16* const p_CI = (const bf16*)(ws + WS_CI); const float* const p_DJ = (const float*)(ws + WS_DJ); float* const p_SNAP = (float*)(ws + WS_DS); float* const p_out = OUTP();
    const int bh = item, b = bh / 6, hh = bh % 6, tid = C.tid, lane = C.lane, wave = C.wave, i = lane & 31, h = lane >> 5;
    constexpr int PT = 272, TB = 32 * PT, BUF = 2 * TB;
    LAS unsigned char* L = C.lds;
    const int row = tid >> 4, chn = tid & 15, kb = wave >> 1, vb0 = 2 * (wave & 1), troff = tr_lane_off(PT, lane, false);
    const size_t g0 = ((size_t)b * SEQL + row) * 768 + hh * 128 + chn * 8;
    const float* djp = p_DJ + ((size_t)b * 64) * 768 + hh * 128 + 32 * kb + i;
    v4u kreg = *(const v4u*)(p_CK + g0), vreg = *(const v4u*)(p_CI + g0); float djn = djp[0];
    *(LAS v4u*)(L + row * PT + chn * 16) = kreg; *(LAS v4u*)(L + TB + row * PT + chn * 16) = vreg;
    __syncthreads();
    f32x16 acc[2]; acc[0] = zero16(); acc[1] = zero16();
#pragma unroll 1
    for (int j = 0; j < 64; ++j) {
        LAS const unsigned char* cur = L + (j & 1) * BUF; LAS unsigned char* nxt = L + ((j + 1) & 1) * BUF;
        const float dj = djn;
        if (j < 63) { const size_t g = g0 + (size_t)(32 * (j + 1)) * 768; kreg = *(const v4u*)(p_CK + g); vreg = *(const v4u*)(p_CI + g); djn = djp[(size_t)(j + 1) * 768]; }
#pragma unroll
        for (int s2 = 0; s2 < 2; ++s2) { const bf16x8 kfr = trfrag(cur, PT, 16 * s2, 32 * kb, troff, false);
#pragma unroll
            for (int j2 = 0; j2 < 2; ++j2) acc[j2] = MFMA32(trfrag(cur + TB, PT, 16 * s2, 32 * (vb0 + j2), troff, false), kfr, acc[j2]); }
#pragma unroll
        for (int r = 0; r < 16; ++r) { acc[0][r] *= dj; acc[1][r] *= dj; }
        if ((j & 15) == 15) {
            float* dst = (j == 63) ? p_out + O_HP + (size_t)(l * 48 + bh) * 16384 : p_SNAP + (size_t)(bh * 3 + (j >> 4)) * 16384;
            dst += (size_t)(32 * kb + i) * 128 + 4 * h;
#pragma unroll
            for (int j2 = 0; j2 < 2; ++j2)
#pragma unroll
                for (int g4 = 0; g4 < 4; ++g4) *(f32x4*)(dst + 32 * (vb0 + j2) + 8 * g4) = (f32x4){acc[j2][4 * g4], acc[j2][4 * g4 + 1], acc[j2][4 * g4 + 2], acc[j2][4 * g4 + 3]};
        }
        if (j < 63) { *(LAS v4u*)(nxt + row * PT + chn * 16) = kreg; *(LAS v4u*)(nxt + TB + row * PT + chn * 16) = vreg; }
        __syncthreads();
    }
}
DI void hg3_item(const Ctx& C, int l, int item) { unsigned char* const ws = WSP(0); const bf16* const p_CE = (const bf16*)(ws + WS_CE); const float* const p_DJ = (const float*)(ws + WS_DJ); const bf16* const p_CI = (const bf16*)(ws + WS_CI); const bf16* const p_CK = (const bf16*)(ws + WS_CK); const bf16* const p_CQ = (const bf16*)(ws + WS_CQ); const float* const p_SNAP = (const float*)(ws + WS_DS); bf16* const p_YB = (bf16*)(ws + WS_YB); const bf16* const p_ZB = (const bf16*)(ws + WS_ZB); const float* const p_hn_g = ((const float*)INP(14));
    const int qt = item & 3, bh = item >> 2, b = bh / 6, hh = bh % 6, tid = C.tid, lane = C.lane, wave = C.wave, i = lane & 31, h = lane >> 5;
    constexpr int PT = 272, IMG = 64 * PT, SBB = 128 * PT;
    LAS unsigned char *QT = C.lds, *KD = C.lds + IMG, *VV = C.lds + 2 * IMG, *SB = C.lds + 3 * IMG;
    LAS float* RS = (LAS float*)(C.lds + 3 * IMG + 2 * SBB);
    f32x16 sacc[4];
    const int kb = wave & 3;
    if (wave >= 4) {
        if (qt == 0) {
#pragma unroll
            for (int vb = 0; vb < 4; ++vb) { sacc[vb] = zero16();
#pragma unroll
                for (int g4 = 0; g4 < 4; ++g4) *(LAS u32x2v*)(SB + (32 * kb + i) * PT + (32 * vb + 8 * g4 + 4 * h) * 2) = (u32x2v){0u, 0u}; }
        } else {
            const float* sp = p_SNAP + (size_t)(bh * 3 + qt - 1) * 16384 + (size_t)(32 * kb + i) * 128 + 4 * h;
#pragma unroll
            for (int vb = 0; vb < 4; ++vb)
#pragma unroll
                for (int g4 = 0; g4 < 4; ++g4) { const f32x4 tt = *(const f32x4*)(sp + 32 * vb + 8 * g4); sacc[vb][4 * g4] = tt[0]; sacc[vb][4 * g4 + 1] = tt[1]; sacc[vb][4 * g4 + 2] = tt[2]; sacc[vb][4 * g4 + 3] = tt[3];
                    u32x2v w; w.x = cvtpk2(tt[0], tt[1]); w.y = cvtpk2(tt[2], tt[3]); *(LAS u32x2v*)(SB + (32 * kb + i) * PT + (32 * vb + 8 * g4 + 4 * h) * 2) = w; }
        }
    }
    const int tro_n = tr_lane_off(PT, lane, false), tro_p = tr_lane_off(PT, lane, true);
    v4u rq[2], re[2], rk[2], rv[2];
#define HG3_ISSUE(sgx) do { const size_t mm_ = (size_t)b * SEQL + (8 * qt + (sgx)) * 64; _Pragma("unroll") for (int it = 0; it < 2; ++it) { const int idx = tid + 512 * it, row = idx >> 4, chn = idx & 15; \
        const size_t go = (mm_ + row) * 768 + hh * 128 + chn * 8; rq[it] = *(const v4u*)(p_CQ + go); re[it] = *(const v4u*)(p_CE + go); rk[it] = *(const v4u*)(p_CK + go); rv[it] = *(const v4u*)(p_CI + go); } } while (0)
#define HG3_FILL() do { _Pragma("unroll") for (int it = 0; it < 2; ++it) { const int idx = tid + 512 * it, row = idx >> 4, chn = idx & 15; const v4u q8 = rq[it], e8 = re[it]; v4u w; \
            w.x = cvtpk2(bflo(q8.x) * bflo(e8.x), bfhi(q8.x) * bfhi(e8.x)); w.y = cvtpk2(bflo(q8.y) * bflo(e8.y), bfhi(q8.y) * bfhi(e8.y)); \
            w.z = cvtpk2(bflo(q8.z) * bflo(e8.z), bfhi(q8.z) * bfhi(e8.z)); w.w = cvtpk2(bflo(q8.w) * bflo(e8.w), bfhi(q8.w) * bfhi(e8.w)); \
            *(LAS v4u*)(QT + row * PT + chn * 16) = w; *(LAS v4u*)(KD + row * PT + chn * 16) = rk[it]; *(LAS v4u*)(VV + row * PT + chn * 16) = rv[it]; } } while (0)
    HG3_ISSUE(0);
    if (wave < 4) {
        const int vb = wave;
#pragma unroll 1
        for (int sg = 0; sg < 8; ++sg) {
            const size_t m0 = (size_t)b * SEQL + (8 * qt + sg) * 64;
            HG3_FILL();
            if (sg < 7) HG3_ISSUE(sg + 1);
            __syncthreads();
#pragma unroll 1
            for (int j = 0; j < 2; ++j) {
                const int g = 2 * sg + j; LAS const unsigned char* SBr = SB + (g & 1) * SBB; LAS float* RSg = RS + (g & 1) * 128;
                u32x2v zr[4]; f32x4 gnv[4];
#pragma unroll
                for (int g4 = 0; g4 < 4; ++g4) { zr[g4] = *(const u32x2v*)(p_ZB + (m0 + 32 * j + i) * 2048 + 1280 + hh * 128 + 32 * vb + 8 * g4 + 4 * h); gnv[g4] = *(const f32x4*)(p_hn_g + l * 768 + hh * 128 + 32 * vb + 8 * g4 + 4 * h); }
                bf16x8 qfr[8];
#pragma unroll
                for (int ks = 0; ks < 8; ++ks) qfr[ks] = *(LAS const bf16x8*)(QT + (32 * j + i) * PT + (16 * ks + 8 * h) * 2);
                f32x16 x0 = zero16(), x1 = zero16();
#pragma unroll
                for (int ks = 0; ks < 8; ks += 2) { x0 = MFMA32(*(LAS const bf16x8*)(KD + (32 * j + i) * PT + (16 * ks + 8 * h) * 2), qfr[ks], x0);
                                                    x1 = MFMA32(*(LAS const bf16x8*)(KD + (32 * j + i) * PT + (16 * ks + 16 + 8 * h) * 2), qfr[ks + 1], x1); }
#pragma unroll
                for (int r = 0; r < 16; ++r) { const float xs = x0[r] + x1[r]; x0[r] = (crow(r, h) > i) ? 0.f : xs; }
                const bf16x8 pb0 = pack8(x0, 0), pb1 = pack8(x0, 1);
                f32x16 oa = zero16(), ob = zero16();
#pragma unroll
                for (int ks = 0; ks < 8; ks += 2) { oa = MFMA32(trfrag(SBr, PT, 16 * ks, 32 * vb, tro_n, false), qfr[ks], oa); ob = MFMA32(trfrag(SBr, PT, 16 * ks + 16, 32 * vb, tro_n, false), qfr[ks + 1], ob); }
                oa = MFMA32(trfrag(VV, PT, 32 * j, 32 * vb, tro_p, true), pb0, oa);
                ob = MFMA32(trfrag(VV, PT, 32 * j + 16, 32 * vb, tro_p, true), pb1, ob);
                float ss = 0.f;
#pragma unroll
                for (int r = 0; r < 16; ++r) { oa[r] += ob[r]; ss += oa[r] * oa[r]; }
                ss += shx(ss, 32, lane);
                if (h == 0) RSg[vb * 32 + i] = ss;
                __syncthreads();
                const float tot = RSg[i] + RSg[32 + i] + RSg[64 + i] + RSg[96 + i], rstd = __builtin_amdgcn_rsqf(tot * (1.0f / 128.0f) + EPSF);
                const size_t m = m0 + 32 * j + i;
#pragma unroll
                for (int g4 = 0; g4 < 4; ++g4) { const int v0 = hh * 128 + 32 * vb + 8 * g4 + 4 * h; const f32x4 gn = gnv[g4]; const u32x2v z = zr[g4]; u32x2v w;
                    w.x = cvtpk2(oa[4 * g4] * rstd * gn[0] * bflo(z.x), oa[4 * g4 + 1] * rstd * gn[1] * bfhi(z.x)); w.y = cvtpk2(oa[4 * g4 + 2] * rstd * gn[2] * bflo(z.y), oa[4 * g4 + 3] * rstd * gn[3] * bfhi(z.y));
                    *(u32x2v*)(p_YB + m * 2048 + 1280 + v0) = w; }
            }
        }
    } else {
#pragma unroll 1
        for (int sg = 0; sg < 8; ++sg) {
            const size_t m0 = (size_t)b * SEQL + (8 * qt + sg) * 64;
            HG3_FILL();
            float dv[2];
#pragma unroll
            for (int j = 0; j < 2; ++j) dv[j] = p_DJ[((m0 >> 5) + j) * 768 + hh * 128 + 32 * kb + i];
            if (sg < 7) HG3_ISSUE(sg + 1);
            __syncthreads();
#pragma unroll 1
            for (int j = 0; j < 2; ++j) {
                const int g = 2 * sg + j; LAS unsigned char* SBw = SB + ((g + 1) & 1) * SBB;
#pragma unroll
                for (int s2 = 0; s2 < 2; ++s2) { const bf16x8 kfr = trfrag(KD, PT, 32 * j + 16 * s2, 32 * kb, tro_n, false);
#pragma unroll
                    for (int vb = 0; vb < 4; ++vb) sacc[vb] = MFMA32(trfrag(VV, PT, 32 * j + 16 * s2, 32 * vb, tro_n, false), kfr, sacc[vb]); }
                const float d = (j == 0) ? dv[0] : dv[1];
#pragma unroll
                for (int vb = 0; vb < 4; ++vb)
#pragma unroll
                    for (int r = 0; r < 16; ++r) sacc[vb][r] *= d;
#pragma unroll
                for (int vb = 0; vb < 4; ++vb)
#pragma unroll
                    for (int g4 = 0; g4 < 4; ++g4) { u32x2v w; w.x = cvtpk2(sacc[vb][4 * g4], sacc[vb][4 * g4 + 1]); w.y = cvtpk2(sacc[vb][4 * g4 + 2], sacc[vb][4 * g4 + 3]); *(LAS u32x2v*)(SBw + (32 * kb + i) * PT + (32 * vb + 8 * g4 + 4 * h) * 2) = w; }
                __syncthreads();
            }
        }
    }
#undef HG3_ISSUE
#undef HG3_FILL
}
DI void samp_attn_item(const Ctx& C, int l, int item) { const float* const p_cache_k = ((const float*)INP(2)); const float* const p_cache_v = ((const float*)INP(3)); bf16* const p_QB = ((bf16*)WSP(WS_QB)); bf16* const p_KB = ((bf16*)WSP(WS_KB)); bf16* const p_VB = ((bf16*)WSP(WS_VB)); bf16* const p_ZB = ((bf16*)WSP(WS_ZB)); bf16* const p_YB = ((bf16*)WSP(WS_YB));
    const int b = item / 12, hh = item % 12, wave = C.wave, lane = C.lane, tid = C.tid; const size_t row = MPR + b;
    LAS float* sc = (LAS float*)C.lds;
    LAS float* po = sc + 400;
    const float* ck = p_cache_k + ((size_t)(l * 32 + b) * 2048) * 768 + hh * 64; const float* cv = p_cache_v + ((size_t)(l * 32 + b) * 2048) * 768 + hh * 64;
    const int grp = tid >> 4, dl = 4 * (tid & 15);
    const u32x2v qraw = *(const u32x2v*)(p_QB + row * 768 + hh * 64 + dl); const float q0 = bflo(qraw.x), q1 = bfhi(qraw.x), q2 = bflo(qraw.y), q3 = bfhi(qraw.y);
    const u32x2v knraw = *(const u32x2v*)(p_KB + row * 768 + hh * 64 + dl);
    const f32x4 knew = (f32x4){bflo(knraw.x), bfhi(knraw.x), bflo(knraw.y), bfhi(knraw.y)};
    f32x4 kv[13];
#pragma unroll
    for (int it = 0; it < 13; ++it) { int slot = 32 * it + grp; if (slot > 386) slot = 386; const int pp = slot / 129, jj = slot - 129 * pp, idx = 2048 - (jj << (2 * pp));
        kv[it] = knew; if (idx < 2048) kv[it] = __builtin_nontemporal_load((const f32x4*)(ck + (size_t)idx * 768 + dl)); }
#pragma unroll
    for (int it = 0; it < 13; ++it) { const int slot = 32 * it + grp;
        float part = (q0 * kv[it][0] + q1 * kv[it][1]) + (q2 * kv[it][2] + q3 * kv[it][3]);
        part += shx(part, 1, lane); part += shx(part, 2, lane); part += shx(part, 4, lane); part += shx(part, 8, lane);
        if ((tid & 15) == 0 && slot < 387) sc[slot] = part; }
    __syncthreads();
    float mx = -1e30f;
    for (int t = lane; t < 387; t += 64) mx = fmaxf(mx, sc[t]);
    mx = wave_max(mx, lane);
    float sm = 0.f;
    for (int t = lane; t < 387; t += 64) sm += ex2(sc[t] - mx);
    sm = wave_sum(sm, lane);
    const u32x2v vnraw = *(const u32x2v*)(p_VB + row * 768 + hh * 64 + dl);
    const f32x4 vnewv = (f32x4){bflo(vnraw.x), bfhi(vnraw.x), bflo(vnraw.y), bfhi(vnraw.y)};
    f32x4 vv[13];
#pragma unroll
    for (int it = 0; it < 13; ++it) { int slot = 32 * it + grp; if (slot > 386) slot = 386; const int pp = slot / 129, jj = slot - 129 * pp, idx = 2048 - (jj << (2 * pp));
        vv[it] = vnewv; if (idx < 2048) vv[it] = __builtin_nontemporal_load((const f32x4*)(cv + (size_t)idx * 768 + dl)); }
    f32x4 o4 = (f32x4){0.f, 0.f, 0.f, 0.f};
#pragma unroll
    for (int it = 0; it < 13; ++it) { const int slot = 32 * it + grp; if (slot < 387) o4 += vv[it] * ex2(sc[slot] - mx); }
#pragma unroll
    for (int e = 0; e < 4; ++e) { o4[e] += shx(o4[e], 16, lane); o4[e] += shx(o4[e], 32, lane); }
    if (lane < 16) *(LAS f32x4*)(po + wave * 64 + dl) = o4;
    __syncthreads();
    if (wave == 0) { float t = 0.f;
#pragma unroll
        for (int w = 0; w < 8; ++w) t += po[w * 64 + lane];
        t *= 1.0f / sm;
        p_YB[row * 2048 + hh * 64 + lane] = (bf16)f2bf(t * bf2f(p_ZB[row * 2048 + hh * 64 + lane])); }
}
DI void samp_sgu_item(const Ctx& C, int l, int item) { bf16* const p_BU = ((bf16*)WSP(WS_BU)); bf16* const p_BV = ((bf16*)WSP(WS_BV)); bf16* const p_YB = ((bf16*)WSP(WS_YB)); bf16* const p_ZB = ((bf16*)WSP(WS_ZB)); const float* const p_ln_b = ((const float*)INP(10)); const float* const p_ln_g = ((const float*)INP(9)); float* const p_out = OUTP(); const float* const p_sgu_b = ((const float*)INP(12)); const float* const p_sgu_w = ((const float*)INP(11));
    const int b = 8 * item + C.wave, lane = C.lane; const size_t row = MPR + b;
    const v4u raw = *(const v4u*)(p_BV + row * 512 + 8 * lane);
    float x[8] = {bflo(raw.x), bfhi(raw.x), bflo(raw.y), bfhi(raw.y), bflo(raw.z), bfhi(raw.z), bflo(raw.w), bfhi(raw.w)};
    float s = 0.f;
#pragma unroll
    for (int e = 0; e < 8; ++e) s += x[e];
    const float mean = wave_sum(s, lane) * (1.0f / 512.0f); float q = 0.f;
#pragma unroll
    for (int e = 0; e < 8; ++e) { x[e] -= mean; q += x[e] * x[e]; }
    const float rstd = __builtin_amdgcn_rsqf(wave_sum(q, lane) * (1.0f / 512.0f) + EPSF);
    const int g = lane >> 3; const float w00 = p_sgu_w[(size_t)((l * 8 + g) * 128) * 128], bb = p_sgu_b[(l * 8 + g) * 128];
    const v4u ur = *(const v4u*)(p_BU + row * 512 + 8 * lane), zr = *(const v4u*)(p_ZB + row * 2048 + 768 + 8 * lane);
    const float uu[8] = {bflo(ur.x), bfhi(ur.x), bflo(ur.y), bfhi(ur.y), bflo(ur.z), bfhi(ur.z), bflo(ur.w), bfhi(ur.w)};
    const float zz[8] = {bflo(zr.x), bfhi(zr.x), bflo(zr.y), bfhi(zr.y), bflo(zr.z), bfhi(zr.z), bflo(zr.w), bfhi(zr.w)};
    float vn[8], y[8];
#pragma unroll
    for (int e = 0; e < 8; ++e) { vn[e] = x[e] * rstd * p_ln_g[l * 512 + 8 * lane + e] + p_ln_b[l * 512 + 8 * lane + e]; y[e] = uu[e] * (w00 * vn[e] + bb) * zz[e]; }
    float* od = p_out + O_SGU + (size_t)(l * 32 + b) * 512 + 8 * lane;
    *(f32x4*)od = (f32x4){vn[0], vn[1], vn[2], vn[3]}; *(f32x4*)(od + 4) = (f32x4){vn[4], vn[5], vn[6], vn[7]};
    v4u w; w.x = cvtpk2(y[0], y[1]); w.y = cvtpk2(y[2], y[3]); w.z = cvtpk2(y[4], y[5]); w.w = cvtpk2(y[6], y[7]);
    *(v4u*)(p_YB + row * 2048 + 768 + 8 * lane) = w;
}
DI void samp_hgrn_item(const Ctx& C, int l, int item) { bf16* const p_CE = ((bf16*)WSP(WS_CE)); bf16* const p_CI = ((bf16*)WSP(WS_CI)); bf16* const p_CK = ((bf16*)WSP(WS_CK)); bf16* const p_CQ = ((bf16*)WSP(WS_CQ)); bf16* const p_YB = ((bf16*)WSP(WS_YB)); bf16* const p_ZB = ((bf16*)WSP(WS_ZB)); const float* const p_hn_g = ((const float*)INP(14)); float* const p_out = OUTP(); const float* const p_state = ((const float*)INP(4));
    const int b = item / 6, hh = item % 6, tid = C.tid; const size_t row = MPR + b;
    LAS float* qs = (LAS float*)C.lds; LAS float* eg = qs + 128; LAS float* kx = eg + 128; LAS float* vv = kx + 128; LAS float* po = vv + 128; LAS float* ov = po + 2048; LAS float* pr = ov + 128;
    if (tid < 128) { const size_t o = row * 768 + hh * 128 + tid; qs[tid] = bf2f(p_CQ[o]); eg[tid] = bf2f(p_CE[o]); kx[tid] = bf2f(p_CK[o]); vv[tid] = bf2f(p_CI[o]); }
    __syncthreads();
    const int v4 = (tid & 31) * 4, kq = tid >> 5;
    const f32x4 vloc = *(LAS const f32x4*)(vv + v4); f32x4 acc = (f32x4){0.f, 0.f, 0.f, 0.f};
    const float* S0 = p_state + (size_t)((l * 32 + b) * 6 + hh) * 16384; float* S1 = p_out + O_HS + (size_t)((l * 32 + b) * 6 + hh) * 16384;
#pragma unroll
    for (int kk = 0; kk < 8; ++kk) { const int k = 8 * kq + kk; const f32x4 s = __builtin_nontemporal_load((const f32x4*)(S0 + k * 128 + v4)); const f32x4 sn = s * eg[k] + vloc * kx[k]; __builtin_nontemporal_store(sn, (f32x4*)(S1 + k * 128 + v4)); acc += sn * qs[k]; }
    *(LAS f32x4*)(po + kq * 128 + v4) = acc;
    __syncthreads();
    float o = 0.f;
    if (tid < 128) {
#pragma unroll
        for (int q4 = 0; q4 < 16; ++q4) o += po[q4 * 128 + tid];
        const float ss = wave_sum(o * o, C.lane); if (C.lane == 0) pr[C.wave] = ss; }
    __syncthreads();
    if (tid < 128) { const float rstd = __builtin_amdgcn_rsqf((pr[0] + pr[1]) * (1.0f / 128.0f) + EPSF);
        p_YB[row * 2048 + 1280 + hh * 128 + tid] = (bf16)f2bf(o * rstd * p_hn_g[l * 768 + hh * 128 + tid] * bf2f(p_ZB[row * 2048 + 1280 + hh * 128 + tid])); }
}
DI void samp_out_item(const Ctx& C, int l, int item) { const float* const p_x_sample = ((const float*)INP(1)); float* const p_SSQ1 = ((float*)WSP(WS_CTL + CTL_SSQ1)); bf16* const p_WOUT = ((bf16*)WSP(WS_WOUT)); float* const p_X1 = ((float*)WSP(WS_X1)); bf16* const p_XB = ((bf16*)WSP(WS_XB)); bf16* const p_YB = ((bf16*)WSP(WS_YB)); float* const p_out = OUTP();
    const int lane = C.lane, wave = C.wave, i = lane & 31, h = lane >> 5, n0 = 32 * item;
    const bf16* A = p_YB + (size_t)(MPR + i) * 2048 + 256 * wave + 8 * h; const bf16* B = p_WOUT + ((size_t)l * DM + n0 + i) * 2048 + 256 * wave + 8 * h;
    f32x16 acc = zero16();
#pragma unroll
    for (int ks = 0; ks < 16; ++ks) acc = MFMA32(*(const bf16x8*)(A + 16 * ks), *(const bf16x8*)(B + 16 * ks), acc);
    LAS float* red = (LAS float*)C.lds;
#pragma unroll
    for (int r = 0; r < 16; ++r) red[(wave * 16 + r) * 64 + lane] = acc[r];
    __syncthreads();
    const int tl = C.tid & 63, i2 = tl & 31, h2 = tl >> 5;
#pragma unroll
    for (int e = 0; e < 2; ++e) { const int r = (C.tid >> 6) * 2 + e; float s = 0.f;
#pragma unroll
        for (int w = 0; w < 8; ++w) s += red[(w * 16 + r) * 64 + tl];
        const int bb = crow(r, h2), n = n0 + i2;
        if (l == 0) { const float o = p_x_sample[(size_t)bb * DM + n] + s; p_XB[(size_t)(MPR + bb) * DM + n] = (bf16)f2bf(o);
            float ss = o * o; ss += shx(ss, 1, lane); ss += shx(ss, 2, lane); ss += shx(ss, 4, lane); ss += shx(ss, 8, lane); ss += shx(ss, 16, lane);
            if (i2 == 0) atomicAdd(p_SSQ1 + MPR + bb, ss); }
        else { p_out[O_YS + (size_t)bb * DM + n] = bf2f(p_XB[(size_t)(MPR + bb) * DM + n]) + s; } }
}
DI int fetch_item(Ctx& C, int q) { gu32* const p_ctl = ((gu32*)WSP(WS_CTL));
    __syncthreads();
    if (C.tid == 0) C.MISC[0] = __hip_atomic_fetch_add((unsigned*)(p_ctl + CW_Q + 64 * q), 1u, __ATOMIC_RELAXED, __HIP_MEMORY_SCOPE_AGENT);
    __syncthreads();
    const int it = (int)C.MISC[0];
    { int t_ = C.tid; asm volatile("" : "+v"(t_)); C.tid = t_; C.lane = t_ & 63; C.wave = __builtin_amdgcn_readfirstlane(t_ >> 6);
      LAS unsigned char* lp_ = C.lds; asm volatile("" : "+s"(lp_)); C.lds = lp_; C.MISC = (volatile LAS unsigned*)(lp_ + MISC_OFF); }
    return it;
}
#ifndef G1_STAGGER_TICKS
#define G1_STAGGER_TICKS 0
#endif
#ifndef RPT_PHASE
#define RPT_PHASE -1
#define RPT_N 0
#endif
#ifndef RPT_IMASK
#define RPT_IMASK 0xffff
#endif
#ifndef RPT_MASK
#define RPT_MASK 0
#endif
#ifndef PH_MASK
#define PH_MASK 2047
#endif
constexpr int N_ATT = 384, N_HG = 192, N_HGP = 48, N_A1 = 384, N_SGU = 128, N_SAT = 384, N_SHG = 192, N_SSG = 4;
constexpr int N_M1 = N_HGP + N_ATT + N_SAT + N_SHG + N_SSG, N_WT = 184, N_KVO = 0;
constexpr int N_SOUT = 32;

constexpr int G1_NCOL = 27, N_GZ = 64;
#define MK_EPIPROJ(l, im) pg8::EpiProj{(l) == 0 ? ((float*)WSP(WS_CTL + CTL_SSQ0)) : ((float*)WSP(WS_CTL + CTL_SSQ1)), ((float*)WSP(WS_LB)) + (l) * 3 * 768, WSP(0), OUTP(), (l), ((im) & 2048) ? 0 : 1, \
                       WS_QB, WS_KB - WS_QB, WS_ZB, WS_BU, WS_BV - WS_BU, WS_CQ, WS_CK - WS_CQ, WS_CE, WS_DJ, WS_KH, WS_VH - WS_KH, \
                       O_KP + (size_t)(l) * MPR * 768, O_VP - O_KP, O_KS + (size_t)(l) * 32 * 768, O_VS - O_KS}
template <int KIND, int L> DI void run_kind(Ctx& C, int im, int bx_) {
    constexpr int l = L;
    if constexpr (KIND == 0) { p0_prologue(C); }
    else if constexpr (KIND == 1) {
        pg8::Gemm g{((bf16*)WSP(WS_XB)), ((bf16*)WSP(WS_WIN)) + (size_t)l * NIN * DM, MPAD, NIN, DM}; pg8::TailOrder S; S.so.init(MPAD, G1_NCOL * 256, NGRID, bx_); S.xm = 64; S.extra = 30 - G1_NCOL;
        pg8::EpiProj E = MK_EPIPROJ(l, im);
        pg8::gemm_phase<pg8::EpiProj, pg8::TailOrder, true, true>(C.lds + RING_OFF, g, S, E, C.tid);
    } else if constexpr (KIND == 2) {
        for (;;) { int it = fetch_item(C, 3 * l + 0); if (it >= N_GZ + N_M1 + N_KVO + (l == 0 ? N_WT : 0)) break;
            if (it < N_GZ) { if (im & 2) { pg8::Gemm g{((bf16*)WSP(WS_XB)), ((bf16*)WSP(WS_WIN)) + (size_t)l * NIN * DM, MPAD, NIN, DM}; pg8::ItemOrder S{__builtin_amdgcn_readfirstlane(it), G1_NCOL, 30 - G1_NCOL};
                                           pg8::EpiProj E = MK_EPIPROJ(l, im); pg8::gemm_phase<pg8::EpiProj, pg8::ItemOrder, true, true>(C.lds + RING_OFF, g, S, E, C.tid); } continue; } it -= N_GZ;
            if (it < N_HGP) { if (im & 8) hgp_item(C, l, it); continue; } it -= N_HGP;
            if (it < N_ATT) { if (im & 4) { if (it < 192) att23_item<2>(C, it); else att23_item<3>(C, it - 192); } continue; } it -= N_ATT;
            if (it < N_SAT) { if (im & 16) samp_attn_item(C, l, it); continue; } it -= N_SAT;
            if (it < N_SHG) { if (im & 64) samp_hgrn_item(C, l, it); continue; } it -= N_SHG;
            if (it < N_SSG) { if (im & 128) samp_sgu_item(C, l, it); continue; } it -= N_SSG;
            if (it < N_KVO) { if (im & 128) kvout_item(C, l, it); continue; } it -= N_KVO;
            if (im & 128) wt_item(C, it); }
    } else if constexpr (KIND == 4) {
        for (;;) { int it = fetch_item(C, 3 * l + 2); if (it >= N_HG + N_A1 + N_SGU + N_SOUT) break;
            if (it < N_HG) { if (im & 256) hg3_item(C, l, it); continue; } it -= N_HG;
            if (it < N_SGU) { if (im & 32) sgu_item(C, l, it); continue; } it -= N_SGU;
            if (it < N_A1) { if (im & 512) att1_item(C, it); continue; } it -= N_A1;
            if (im & 1024) samp_out_item(C, l, it); }
    } else {
        pg8::Gemm g{((bf16*)WSP(WS_YB)), ((bf16*)WSP(WS_WOUT)) + (size_t)l * DM * DMIX, MPR, DM, DMIX}; pg8::StaticOrder S; S.init(MPR, DM, NGRID, bx_);
        pg8::EpiOut E{l == 0 ? ((const float*)INP(0)) : nullptr, l == 0 ? nullptr : ((bf16*)WSP(WS_XB)), l == 0 ? nullptr : (OUTP()) + O_YP, l == 0 ? ((bf16*)WSP(WS_XB)) : nullptr, l == 0 ? ((float*)WSP(WS_CTL + CTL_SSQ1)) : nullptr};
        pg8::gemm_phase<pg8::EpiOut, pg8::StaticOrder, true, true>(C.lds + RING_OFF, g, S, E, C.tid);
    }
}

__global__ void __launch_bounds__(NWAVES * 64, 2) mega_fwd(Args args) {
    extern __shared__ __attribute__((aligned(16))) unsigned char lds[];
    Ctx C;
    C.lds = (LAS unsigned char*)lds; C.MISC = (volatile LAS unsigned*)(C.lds + MISC_OFF);
    C.tid = threadIdx.x; C.lane = C.tid & 63; C.wave = __builtin_amdgcn_readfirstlane(C.tid >> 6);
    C.G = NGRID; C.vcu = 0;
    for (int u = C.tid; u < (LDS_BYTES - MISC_OFF) / 4; u += NWAVES * 64) ((LAS unsigned*)(C.lds + MISC_OFF))[u] = 0u;
    __syncthreads();
    XcdBarrier bar; bar.bar = (unsigned*)(((gu32*)WSP(WS_CTL)) + CW_BAR); bar.x = 0; bar.st = nullptr;
    if (N_LAUNCHES == 1) bar = xcd_barrier_post((unsigned*)(((gu32*)WSP(WS_CTL)) + CW_BAR), C.MISC + 8);
    const int lo = args.ph_lo, hi = args.ph_hi, im = args.imask;
    const int wave_s = __builtin_amdgcn_readfirstlane(threadIdx.x >> 6);
#define RELAUNDER() do { int t_ = (wave_s << 6) | (int)__builtin_amdgcn_mbcnt_hi(~0u, __builtin_amdgcn_mbcnt_lo(~0u, 0u)); asm volatile("" : "+v"(t_)); C.tid = t_; C.lane = t_ & 63; C.wave = __builtin_amdgcn_readfirstlane(t_ >> 6); \
        LAS unsigned char* lp_ = (LAS unsigned char*)lds; asm volatile("" : "+s"(lp_)); C.lds = lp_; C.MISC = (volatile LAS unsigned*)(lp_ + MISC_OFF); } while (0)
#define PHASE(p, KIND, L) if (lo <= (p) && (p) < hi) { RELAUNDER(); int bx_ = blockIdx.x; asm volatile("" : "+s"(bx_)); C.vcu = (bx_ & 7) * (NGRID >> 3) + (bx_ >> 3); run_kind<KIND, L>(C, im, bx_); \
        if (N_LAUNCHES == 1 && (p) + 1 < hi) { XcdBarrier b2; b2.bar = (unsigned*)(((gu32*)WSP(WS_CTL)) + CW_BAR); unsigned x2_ = bar.x; asm volatile("" : "+s"(x2_)); b2.x = x2_; b2.st = C.MISC + 8; xcd_barrier(b2, C.tid); } }
    PHASE(0, 0, 0)
    PHASE(1, 1, 0) PHASE(2, 2, 0) PHASE(3, 4, 0) PHASE(4, 5, 0)
    PHASE(5, 1, 1) PHASE(6, 2, 1) PHASE(7, 4, 1) PHASE(8, 5, 1)
#undef PHASE
#undef RELAUNDER
}

extern "C" void kernel_launch(void* const* d_in, const int* in_sizes, int n_in, void* d_out, int out_size, void* d_ws, size_t ws_size, hipStream_t stream) {
    static int grid = 0;
    if (grid == 0) {
        if (n_in != 16 || (size_t)out_size != O_END || ws_size < WS_END) { fprintf(stderr, "kernel_launch: unexpected shapes: n_in %d out %d ws %zu (need %zu)\n", n_in, out_size, ws_size, (size_t)WS_END); grid = -1; return; }
        int dev = 0, cus = 0, per_cu = 0;
        if (hipGetDevice(&dev) != hipSuccess || hipDeviceGetAttribute(&cus, hipDeviceAttributeMultiprocessorCount, dev) != hipSuccess) { grid = -1; return; }
        if (hipFuncSetAttribute((const void*)mega_fwd, hipFuncAttributeMaxDynamicSharedMemorySize, LDS_BYTES) != hipSuccess) { fprintf(stderr, "kernel_launch: hipFuncSetAttribute failed\n"); grid = -1; return; }
        if (hipOccupancyMaxActiveBlocksPerMultiprocessor(&per_cu, (const void*)mega_fwd, NWAVES * 64, LDS_BYTES) != hipSuccess || per_cu < 1) { fprintf(stderr, "kernel_launch: occupancy query says %d\n", per_cu); (void)hipGetLastError(); per_cu = 1; }
        if (cus < NGRID) { fprintf(stderr, "kernel_launch: %d CUs < %d workgroups: not co-resident\n", cus, NGRID); grid = -1; return; }
        grid = NGRID;
    }
    if (grid < 0) return;
    (void)hipMemsetAsync((char*)d_ws + WS_CTL, 0, CTL_ZERO_BYTES, stream);
    Args a{};
    for (int i = 0; i < 16; ++i) a.in[i] = (const float*)d_in[i];
    a.out = (float*)d_out; a.ws = (unsigned char*)d_ws; a.imask = 0xffff;
    if (N_LAUNCHES == 1) { a.ph_lo = 0; a.ph_hi = N_PHASES; hipLaunchKernelGGL(mega_fwd, dim3(grid), dim3(NWAVES * 64), LDS_BYTES, stream, a); }
    else for (int p = 0; p < N_PHASES; ++p) { a.ph_lo = p; a.ph_hi = p + 1;
        const int nl = 1 + ((p == RPT_PHASE) ? RPT_N : 0);
        for (int r = 0; r < nl; ++r) {
            if (r > 0 && p >= 1) { const int l = (p - 1) / 4, k = (p - 1) % 4; if (k == 1 || k == 2) (void)hipMemsetAsync((char*)d_ws + WS_CTL + (size_t)(CW_Q + 64 * (3 * l + (k == 1 ? 0 : 2))) * 4, 0, 4, stream); }
            a.imask = (r > 0) ? RPT_IMASK : 0xffff;
            hipLaunchKernelGGL(mega_fwd, dim3(grid), dim3(NWAVES * 64), LDS_BYTES, stream, a); } }
}
```

```cpp
#include <hip/hip_runtime.h>
#include <cstdio>
#include <cstdint>
namespace pg8 {
#define PG8_LAS __attribute__((address_space(3)))
typedef unsigned short bf16_t;
typedef short bf16x8 __attribute__((ext_vector_type(8)));
typedef float f32x4 __attribute__((ext_vector_type(4)));
typedef unsigned u32x4 __attribute__((ext_vector_type(4)));
constexpr int BM = 256, BK = 64, HALF = 128, HTB = HALF * BK * 2  , STAGE_BYTES = 8 * HTB, NXCD = 8, WGM = 8;

__host__ __device__ __forceinline__ int lds_byte(int r, int c) { const int st = (r >> 4) * 2 + (c >> 5), rr = r & 15, cc = c & 31, ob = rr * 64 + cc * 2; return st * 1024 + (ob ^ (((ob >> 9) & 1) << 5)); }
__host__ __device__ __forceinline__ void stage_rc(int b, int& R, int& C) { const int st = b / 1024, sb = b % 1024, swz = sb ^ (((sb >> 9) & 1) << 5); R = (st >> 1) * 16 + swz / 64; C = (st & 1) * 32 + (swz % 64) / 2; }
__host__ __device__ __forceinline__ int perm32(int rho) { const int n = rho >> 4, i = rho & 15; return 8 * (i >> 2) + 4 * n + (i & 3); }

struct Unit { int pm, pn; };
struct Gemm { const bf16_t* A; const bf16_t* Bt; int M, N, K; };

struct StaticOrder {
    int nM, nN, nwg, G, c;
    __host__ __device__ void init(int M, int N, int G_, int c_) { nM = M / BM; nN = N / BM; nwg = nM * nN; G = G_; c = c_; }
    __host__ __device__ bool next(int i, Unit& u) const {
        const long L = (long)i * G + c; if (L >= nwg) return false;
        int wgid = (int)L; { const int q = nwg / NXCD, r = nwg % NXCD, xcd = wgid % NXCD, off = wgid / NXCD; wgid = (xcd < r ? xcd * (q + 1) : r * (q + 1) + (xcd - r) * q) + off; }
        const int nig = WGM * nN, gid = wgid / nig, fm = gid * WGM, gsz = (nM - fm) < WGM ? (nM - fm) : WGM;
        u.pm = fm + ((wgid % nig) % gsz); u.pn = (wgid % nig) / gsz; return true;
    }
    __device__ __forceinline__ void a_ready(const Unit&) const {}
    __device__ __forceinline__ void done(const Unit&) const {}
};

struct TailOrder {
    StaticOrder so; int xm, extra, fill;
    __host__ __device__ bool next(int i, Unit& u) const {
        if (so.next(i, u)) return true;
        const long L = (long)i * so.G + so.c - so.nwg; if (L >= extra + fill) return false;
        if (L < extra) { u.pm = xm; u.pn = so.nN + (int)L; } else { const int k = (int)L - extra; u.pm = k / extra; u.pn = so.nN + k % extra; }
        return true;
    }
    __device__ __forceinline__ void a_ready(const Unit&) const {}
    __device__ __forceinline__ void done(const Unit&) const {}
};
struct ItemOrder {
    int pm, pn0, n;
    __host__ __device__ bool next(int i, Unit& u) const { if (i >= n) return false; u.pm = pm; u.pn = pn0 + i; return true; }
    __device__ __forceinline__ void a_ready(const Unit&) const {}
    __device__ __forceinline__ void done(const Unit&) const {}
};


typedef float f32x2 __attribute__((ext_vector_type(2)));
typedef unsigned u32x2 __attribute__((ext_vector_type(2)));
typedef __bf16 bf16x2_t __attribute__((ext_vector_type(2)));
__device__ __forceinline__ unsigned cvtpk(float lo, float hi) { f32x2 v = {lo, hi}; bf16x2_t b = __builtin_convertvector(v, bf16x2_t); return __builtin_bit_cast(unsigned, b); }
__device__ __forceinline__ float fast_sigmoid(float x) { return __builtin_amdgcn_rcpf(1.0f + __expf(-x)); }
__device__ __forceinline__ float silu_f(float x) { return x * fast_sigmoid(x); }

template <int CTRL> __device__ __forceinline__ float dpp_f(float x) { return __builtin_bit_cast(float, __builtin_amdgcn_update_dpp(0, __builtin_bit_cast(int, x), CTRL, 0xf, 0xf, false)); }
template <int CTRL> __device__ __forceinline__ float dpp_f1(float x) { return __builtin_bit_cast(float, __builtin_amdgcn_update_dpp(0x3f800000, __builtin_bit_cast(int, x), CTRL, 0xf, 0xf, false)); }
__device__ __forceinline__ float row_prefprod16(float x) { x *= dpp_f1<0x111>(x); x *= dpp_f1<0x112>(x); x *= dpp_f1<0x114>(x); x *= dpp_f1<0x118>(x); return x; }
__device__ __forceinline__ float row_bcast15(float x) { return __builtin_bit_cast(float, __builtin_amdgcn_update_dpp(0, __builtin_bit_cast(int, x), 0x15F, 0xf, 0xf, false)); }
__device__ __forceinline__ float row_prefix16(float x) { x += dpp_f<0x111>(x); x += dpp_f<0x112>(x); x += dpp_f<0x114>(x); x += dpp_f<0x118>(x); return x; }
struct EpiProj {
    static constexpr bool PERM = true, AFTER_DRAIN = false, HEADPERM = true;
    const float* ssq;
    const float* gtab;
    unsigned char* ws; float* out; int l; int skip;
    size_t o_qkv, s_qkv, o_zb, o_bu, s_bu, o_cq, s_cq, o_ce, o_dj, o_kh, s_kh;
    size_t o_kp, s_kp, o_ks, s_ks;
    __device__ __forceinline__ void st8(bf16_t* p, const f32x4& a, const f32x4& b) const {
        u32x4 w; w.x = cvtpk(a[0], a[1]); w.y = cvtpk(a[2], a[3]); w.z = cvtpk(b[0], b[1]); w.w = cvtpk(b[2], b[3]); *(u32x4*)p = w; }
    __device__ __forceinline__ void operator()(const f32x4 (&acc)[2][2][4][2], const Unit& u, int wr, int wc, int fr, int fq) const {
        if (skip) return;
        const int pn = u.pn;
        int seg, seg0;
        if (pn < 12) { seg = pn / 3; seg0 = seg * 3; }
        else if (pn < 18) { seg = 4 + (pn - 12) / 2; seg0 = 12 + (seg - 4) * 2; }
        else { seg = 7 + (pn - 18) / 3; seg0 = 18 + (seg - 7) * 3; }
        const int cl = (pn - seg0) * 256 + wc * 64 + 8 * fq;
        const int rowb = u.pm * BM + wr * 64 + fr;
        const bool sample = (u.pm == 64);
        f32x4 gv[2][2];
        { const int gi = (seg == 0) ? 0 : (seg == 1 ? 1 : 2); const float* gp = gtab + gi * 768 + (seg == 0 || seg == 1 || seg == 8 ? cl : 0);
#pragma unroll
          for (int bj = 0; bj < 2; ++bj)
#pragma unroll
              for (int n = 0; n < 2; ++n) gv[bj][n] = *(const f32x4*)(gp + 32 * bj + 4 * n); }
        if (seg == 8) {
            const int lane_hi15 = ((fq << 4) | 15);
            float rsc[2][4];
#pragma unroll
            for (int ai = 0; ai < 2; ++ai)
#pragma unroll
                for (int m = 0; m < 4; ++m) rsc[ai][m] = ssq[rowb + ai * HALF + m * 16];
#pragma unroll
            for (int ai = 0; ai < 2; ++ai)
#pragma unroll
                for (int mp = 0; mp < 2; ++mp) {
                    const int rowA = rowb + ai * HALF + mp * 32, rowB = rowA + 16;
                    const float rsA = __builtin_amdgcn_rsqf(rsc[ai][2 * mp] * (1.0f / 1024.0f) + 1e-6f), rsB = __builtin_amdgcn_rsqf(rsc[ai][2 * mp + 1] * (1.0f / 1024.0f) + 1e-6f);
#pragma unroll
                    for (int bj = 0; bj < 2; ++bj) {
                        f32x4 eA[2], eB[2], kA[2], kB[2], dl[2];
#pragma unroll
                        for (int n = 0; n < 2; ++n)
#pragma unroll
                            for (int e = 0; e < 4; ++e) { const float lbv = gv[bj][n][e], omlb = 1.0f - lbv;
                                const float sa = fast_sigmoid(acc[ai][bj][2 * mp][n][e] * rsA), sb = fast_sigmoid(acc[ai][bj][2 * mp + 1][n][e] * rsB);
                                float ka = omlb - omlb * sa, kb = omlb - omlb * sb, pa = lbv + omlb * sa, pb = lbv + omlb * sb;
                                if (!sample) { pa = row_prefprod16(pa); const float t0 = row_bcast15(pa); pb = row_prefprod16(pb) * t0; dl[n][e] = row_bcast15(pb);
                                    ka *= __builtin_amdgcn_rcpf(pa); kb *= __builtin_amdgcn_rcpf(pb); }
                                eA[n][e] = pa; eB[n][e] = pb; kA[n][e] = ka; kB[n][e] = kb; }
                        bf16_t* dkA = (bf16_t*)(ws + o_cq + s_cq) + (size_t)rowA * 768 + cl + 32 * bj; bf16_t* deA = (bf16_t*)(ws + o_ce) + (size_t)rowA * 768 + cl + 32 * bj;
                        st8(dkA, kA[0], kA[1]); st8(dkA + 16 * 768, kB[0], kB[1]); st8(deA, eA[0], eA[1]); st8(deA + 16 * 768, eB[0], eB[1]);
                        if (!sample && fr == 0) { float* dd = (float*)(ws + o_dj) + (size_t)(rowA >> 5) * 768 + cl + 32 * bj; *(f32x4*)dd = dl[0]; *(f32x4*)(dd + 4) = dl[1]; }
                    }
                    asm volatile("" ::: "memory");
                }
            return;
        }
        float rsv[2][4];
#pragma unroll
        for (int ai = 0; ai < 2; ++ai)
#pragma unroll
            for (int m = 0; m < 4; ++m) rsv[ai][m] = ssq[rowb + ai * HALF + m * 16];
#pragma unroll
        for (int ai = 0; ai < 2; ++ai)
#pragma unroll
            for (int m = 0; m < 4; ++m) {
                const int row = rowb + ai * HALF + m * 16;
                const float rs = __builtin_amdgcn_rsqf(rsv[ai][m] * (1.0f / 1024.0f) + 1e-6f);
                f32x4 v[2][2];
#pragma unroll
                for (int bj = 0; bj < 2; ++bj)
#pragma unroll
                    for (int n = 0; n < 2; ++n) v[bj][n] = acc[ai][bj][m][n] * rs;
                if (seg <= 1) {
                    float ss = 0.f;
#pragma unroll
                    for (int bj = 0; bj < 2; ++bj)
#pragma unroll
                        for (int n = 0; n < 2; ++n) { const f32x4 x = v[bj][n]; ss += (x[0] * x[0] + x[1] * x[1]) + (x[2] * x[2] + x[3] * x[3]); }
                    ss += __shfl_xor(ss, 16); ss += __shfl_xor(ss, 32);
                    float r2 = __builtin_amdgcn_rsqf(ss * (1.0f / 64.0f) + 1e-6f);
                    if (seg == 0) r2 *= 0.125f * 1.4426950408889634f;
#pragma unroll
                    for (int bj = 0; bj < 2; ++bj)
#pragma unroll
                        for (int n = 0; n < 2; ++n) v[bj][n] = v[bj][n] * gv[bj][n] * r2;
                }
                if (seg <= 2) {
                    if (seg == 0 || sample) {
                        bf16_t* dst = (bf16_t*)(ws + o_qkv + (size_t)seg * s_qkv) + (size_t)row * 768 + cl;
#pragma unroll
                        for (int bj = 0; bj < 2; ++bj) st8(dst + 32 * bj, v[bj][0], v[bj][1]);
                    } else {
                        const int t = row & 2047, bb = row >> 11, head = cl >> 6;
                        bf16_t* dst = (bf16_t*)(ws + o_kh + (size_t)(seg - 1) * s_kh) + ((size_t)(((bb * 12 + head) * 16 + (t & 15)) * 128 + (t >> 4))) * 64 + (cl & 63);
#pragma unroll
                        for (int bj = 0; bj < 2; ++bj) st8(dst + 32 * bj, v[bj][0], v[bj][1]);
                    }
                    if (seg >= 1) {
                        const bool okp = !sample, oks = sample && (row - 16384 < 32);
                        float* o = out + (okp ? o_kp + (size_t)(seg - 1) * s_kp + (size_t)row * 768 : o_ks + (size_t)(seg - 1) * s_ks + (size_t)(row - 16384) * 768) + cl;
                        if (okp || oks) {
#pragma unroll
                            for (int bj = 0; bj < 2; ++bj) { __builtin_nontemporal_store(v[bj][0], (f32x4*)(o + 32 * bj)); __builtin_nontemporal_store(v[bj][1], (f32x4*)(o + 32 * bj + 4)); }
                        }
                    }
                } else if (seg == 3 || seg == 6 || seg == 10 || seg == 7) {
#pragma unroll
                    for (int bj = 0; bj < 2; ++bj)
#pragma unroll
                        for (int n = 0; n < 2; ++n)
#pragma unroll
                            for (int e = 0; e < 4; ++e) v[bj][n][e] = silu_f(v[bj][n][e]);
                    const size_t zo = (seg == 7) ? o_cq + ((size_t)row * 768 + cl) * 2 : o_zb + ((size_t)row * 2048 + (seg == 3 ? 0 : (seg == 6 ? 768 : 1280)) + cl) * 2;
                    bf16_t* dst = (bf16_t*)(ws + zo);
#pragma unroll
                    for (int bj = 0; bj < 2; ++bj) st8(dst + 32 * bj, v[bj][0], v[bj][1]);
                } else if (seg == 4 || seg == 5) {
                    bf16_t* dst = (bf16_t*)(ws + o_bu + (size_t)(seg - 4) * s_bu) + (size_t)row * 512 + cl;
#pragma unroll
                    for (int bj = 0; bj < 2; ++bj) st8(dst + 32 * bj, v[bj][0], v[bj][1]);
                } else if (seg == 9) {
                    bf16_t* dst = (bf16_t*)(ws + o_cq + 2 * s_cq) + (size_t)row * 768 + cl;
#pragma unroll
                    for (int bj = 0; bj < 2; ++bj) st8(dst + 32 * bj, v[bj][0], v[bj][1]);
                }
                asm volatile("" ::: "memory");
            }
    }
};
struct EpiOut {
    static constexpr bool PERM = true, AFTER_DRAIN = false, HEADPERM = false;
    const float* res; const bf16_t* resb; float* out; bf16_t* xb; float* ssq;
    __device__ __forceinline__ void ldres(size_t off, f32x4& r0, f32x4& r1) const {
        if (res) { r0 = __builtin_nontemporal_load((const f32x4*)(res + off)); r1 = __builtin_nontemporal_load((const f32x4*)(res + off + 4)); return; }
        const u32x4 w = *(const u32x4*)(resb + off);
        r0 = (f32x4){__uint_as_float(w.x << 16), __uint_as_float(w.x & 0xffff0000u), __uint_as_float(w.y << 16), __uint_as_float(w.y & 0xffff0000u)};
        r1 = (f32x4){__uint_as_float(w.z << 16), __uint_as_float(w.z & 0xffff0000u), __uint_as_float(w.w << 16), __uint_as_float(w.w & 0xffff0000u)}; }
    __device__ __forceinline__ void operator()(const f32x4 (&acc)[2][2][4][2], const Unit& u, int wr, int wc, int fr, int fq) const {
        const int col0 = u.pn * BM + wc * 32 + 8 * fq;
        const size_t off0 = (size_t)(u.pm * BM + wr * 64 + fr) * 1024 + col0;
        f32x4 rcur[2][2], rnxt[2][2];
#pragma unroll
        for (int bj = 0; bj < 2; ++bj) ldres(off0 + bj * HALF, rcur[bj][0], rcur[bj][1]);
#pragma unroll
        for (int it = 0; it < 8; ++it) {
            const int ai = it >> 2, m = it & 3;
            const int row = u.pm * BM + ai * HALF + wr * 64 + m * 16 + fr; const size_t off = (size_t)row * 1024 + col0; float ss = 0.f;
            if (it < 7) { const int ai2 = (it + 1) >> 2, m2 = (it + 1) & 3; const size_t offn = off0 + (size_t)(ai2 * HALF + m2 * 16) * 1024;
#pragma unroll
                for (int bj = 0; bj < 2; ++bj) ldres(offn + bj * HALF, rnxt[bj][0], rnxt[bj][1]); }
#pragma unroll
            for (int bj = 0; bj < 2; ++bj) { const f32x4 o0 = rcur[bj][0] + acc[ai][bj][m][0], o1 = rcur[bj][1] + acc[ai][bj][m][1];
                if (out) { __builtin_nontemporal_store(o0, (f32x4*)(out + off + bj * HALF)); __builtin_nontemporal_store(o1, (f32x4*)(out + off + bj * HALF + 4)); }
                ss += ((o0[0] * o0[0] + o0[1] * o0[1]) + (o0[2] * o0[2] + o0[3] * o0[3])) + ((o1[0] * o1[0] + o1[1] * o1[1]) + (o1[2] * o1[2] + o1[3] * o1[3]));
                if (xb) { u32x4 w; w.x = cvtpk(o0[0], o0[1]); w.y = cvtpk(o0[2], o0[3]); w.z = cvtpk(o1[0], o1[1]); w.w = cvtpk(o1[2], o1[3]); *(u32x4*)(xb + off + bj * HALF) = w; } }
            if (ssq) { ss += __shfl_xor(ss, 16); ss += __shfl_xor(ss, 32); if (fq == 0) atomicAdd(ssq + row, ss); }
#pragma unroll
            for (int bj = 0; bj < 2; ++bj) { rcur[bj][0] = rnxt[bj][0]; rcur[bj][1] = rnxt[bj][1]; }
        }
    }
};
template <class Epi, class Sched, bool ALIGN_EPI = false, bool SP2 = false>
__device__ __forceinline__ void gemm_phase(PG8_LAS unsigned char* lds, const Gemm g, const Sched& S, const Epi& E, int tid_in) {
    int tid_ = tid_in; asm volatile("" : "+v"(tid_));
    const int tid = tid_, wid = __builtin_amdgcn_readfirstlane(tid >> 6), lane = tid & 63, wr = wid >> 2, wc = wid & 3, fr = lane & 15, fq = lane >> 4;
    const int K = g.K, nt = K / BK;
    unsigned voffA[2], voffB[2];
#pragma unroll
    for (int i = 0; i < 2; ++i) { int R, C; stage_rc(tid * 16 + i * 8192, R, C); const int Rb = Epi::HEADPERM ? (64 * (R >> 5) + perm32(R & 31)) : (Epi::PERM ? ((R & ~31) + perm32(R & 31)) : R);
        voffA[i] = (unsigned)(R * K + C) * 2u; voffB[i] = (unsigned)(Rb * K + C) * 2u; }
    const size_t kstep = (size_t)(BK * 2);
    const size_t hstep = (size_t)HALF * K * 2;
    const size_t tstep = 2 * hstep; const size_t hstepB = Epi::HEADPERM ? (size_t)32 * K * 2 : hstep;
    const unsigned ldsw = (unsigned)wid * 1024u;
    const int aoff = lds_byte(wr * 64 + fr, fq * 8), boff = lds_byte(wc * 32 + fr, fq * 8);
#define PG8_SA(b, h) (((b) * 2 + (h)) * HTB)
#define PG8_SB(b, h) ((4 + (b) * 2 + (h)) * HTB)
#define PG8_STAGE(bufoff, gbase, voff) do { _Pragma("unroll") for (int _i = 0; _i < 2; ++_i) \
        __builtin_amdgcn_global_load_lds((const unsigned*)((const char*)(gbase) + (voff)[_i]), (PG8_LAS unsigned*)(lds + (bufoff) + ldsw + _i * 8192), 16, 0, 0); } while (0)
#define PG8_LDA(dst, b, h) do { _Pragma("unroll") for (int m = 0; m < 4; ++m) _Pragma("unroll") for (int k = 0; k < 2; ++k) dst[m][k] = *(const PG8_LAS bf16x8*)(lds + PG8_SA(b, h) + aoff + m * 2048 + k * 1024); } while (0)
#define PG8_LDB(dst, b, h) do { _Pragma("unroll") for (int n = 0; n < 2; ++n) _Pragma("unroll") for (int k = 0; k < 2; ++k) dst[n][k] = *(const PG8_LAS bf16x8*)(lds + PG8_SB(b, h) + boff + n * 2048 + k * 1024); } while (0)
#define PG8_MMA(ai, bj, At, Bt) do { __builtin_amdgcn_s_setprio(1); _Pragma("unroll") for (int m = 0; m < 4; ++m) _Pragma("unroll") for (int n = 0; n < 2; ++n) _Pragma("unroll") for (int k = 0; k < 2; ++k) \
        acc[ai][bj][m][n] = __builtin_amdgcn_mfma_f32_16x16x32_bf16(Bt[n][k], At[m][k], acc[ai][bj][m][n], 0, 0, 0); __builtin_amdgcn_s_setprio(0); } while (0)
#define PG8_WAIT_V(n) asm volatile("s_waitcnt vmcnt(" #n ")" ::: "memory")
#define PG8_WAIT_L(n) asm volatile("s_waitcnt lgkmcnt(" #n ")" ::: "memory")
#define PG8_BAR __builtin_amdgcn_s_barrier()
#define PG8_SCHED __builtin_amdgcn_sched_barrier(0)
    Unit cur, nxt; int ui = 0;
    if (!S.next(0, cur)) return;
    f32x4 acc[2][2][4][2];
#pragma unroll
    for (int a = 0; a < 2; ++a)
#pragma unroll
        for (int b = 0; b < 2; ++b)
#pragma unroll
            for (int m = 0; m < 4; ++m)
#pragma unroll
                for (int n = 0; n < 2; ++n) acc[a][b][m][n] = (f32x4){0.f, 0.f, 0.f, 0.f};
    bf16x8 At[4][2], B0[2][2], B1[2][2];
    const char* cA = (const char*)g.A + (size_t)cur.pm * tstep; const char* cB = (const char*)g.Bt + (size_t)cur.pn * tstep;
    S.a_ready(cur);
    if constexpr (SP2) {
        PG8_STAGE(PG8_SB(0, 0), cB, voffB); PG8_STAGE(PG8_SB(0, 1), cB + hstepB, voffB); PG8_STAGE(PG8_SA(0, 0), cA, voffA); PG8_STAGE(PG8_SA(0, 1), cA + hstep, voffA);
        if (wr == 1) PG8_BAR;
        PG8_WAIT_V(2); PG8_BAR;
        PG8_STAGE(PG8_SB(1, 0), cB + kstep, voffB); PG8_STAGE(PG8_SA(1, 0), cA + kstep, voffA); PG8_STAGE(PG8_SB(1, 1), cB + hstepB + kstep, voffB);
        PG8_WAIT_V(6); PG8_BAR;
    } else {
        PG8_STAGE(PG8_SB(0, 0), cB, voffB); PG8_STAGE(PG8_SA(0, 0), cA, voffA); PG8_STAGE(PG8_SB(0, 1), cB + hstepB, voffB); PG8_STAGE(PG8_SA(0, 1), cA + hstep, voffA);
        if (wr == 1) PG8_BAR;
        PG8_WAIT_V(4); PG8_BAR;
        PG8_STAGE(PG8_SB(1, 0), cB + kstep, voffB); PG8_STAGE(PG8_SA(1, 0), cA + kstep, voffA); PG8_STAGE(PG8_SB(1, 1), cB + hstepB + kstep, voffB);
        PG8_WAIT_V(6); PG8_BAR;
    }
    for (;;) {
        const bool has_next = S.next(ui + 1, nxt);
        const char* nA = has_next ? (const char*)g.A + (size_t)nxt.pm * tstep : cA; const char* nB = has_next ? (const char*)g.Bt + (size_t)nxt.pn * tstep : cB;
        for (int t = 0; t < nt; t += 2) {
            const bool last = (t == nt - 2);
            const char* a1 = cA + (size_t)(t + 1) * kstep;
            const char* a2 = last ? nA : cA + (size_t)(t + 2) * kstep; const char* b2 = last ? nB : cB + (size_t)(t + 2) * kstep;
            const char* a3 = a2 + kstep; const char* b3 = b2 + kstep;
            if (last && has_next) S.a_ready(nxt);
            if constexpr (SP2) {
            PG8_LDB(B0, 0, 0); PG8_LDB(B1, 0, 1); PG8_SCHED; PG8_LDA(At, 0, 0); PG8_STAGE(PG8_SA(1, 1), a1 + hstep, voffA);
            PG8_WAIT_V(8); PG8_WAIT_L(0); PG8_BAR; PG8_MMA(0, 0, At, B0); PG8_MMA(0, 1, At, B1); PG8_BAR; PG8_SCHED;
            PG8_LDA(At, 0, 1); PG8_STAGE(PG8_SB(0, 0), b2, voffB); PG8_STAGE(PG8_SB(0, 1), b2 + hstepB, voffB); PG8_STAGE(PG8_SA(0, 0), a2, voffA);
            PG8_WAIT_V(8); PG8_WAIT_L(0); PG8_BAR; PG8_MMA(1, 0, At, B0); PG8_MMA(1, 1, At, B1); PG8_BAR; PG8_SCHED;
            PG8_LDB(B0, 1, 0); PG8_LDB(B1, 1, 1); PG8_SCHED; PG8_LDA(At, 1, 0); PG8_STAGE(PG8_SA(0, 1), a2 + hstep, voffA);
            PG8_WAIT_V(8); PG8_WAIT_L(0); PG8_BAR; PG8_MMA(0, 0, At, B0); PG8_MMA(0, 1, At, B1); PG8_BAR; PG8_SCHED;
            PG8_LDA(At, 1, 1); PG8_STAGE(PG8_SB(1, 0), b3, voffB); PG8_STAGE(PG8_SB(1, 1), b3 + hstepB, voffB); PG8_STAGE(PG8_SA(1, 0), a3, voffA);
            PG8_WAIT_V(8); PG8_WAIT_L(0); PG8_BAR; PG8_MMA(1, 0, At, B0); PG8_MMA(1, 1, At, B1); PG8_BAR; PG8_SCHED;
            } else {
            PG8_LDB(B0, 0, 0); PG8_SCHED; PG8_LDA(At, 0, 0); PG8_STAGE(PG8_SA(1, 1), a1 + hstep, voffA);
            PG8_WAIT_L(8); PG8_BAR; PG8_WAIT_L(0); PG8_MMA(0, 0, At, B0); PG8_BAR; PG8_SCHED;
            PG8_LDB(B1, 0, 1); PG8_STAGE(PG8_SB(0, 0), b2, voffB);
            PG8_BAR; PG8_WAIT_L(0); PG8_MMA(0, 1, At, B1); PG8_BAR;
            PG8_LDA(At, 0, 1); PG8_STAGE(PG8_SA(0, 0), a2, voffA);
            PG8_BAR; PG8_WAIT_L(0); PG8_MMA(1, 0, At, B0); PG8_BAR; PG8_SCHED;
            PG8_STAGE(PG8_SB(0, 1), b2 + hstepB, voffB);
            PG8_WAIT_V(6); PG8_BAR; PG8_MMA(1, 1, At, B1); PG8_BAR;
            PG8_LDB(B0, 1, 0); PG8_SCHED; PG8_LDA(At, 1, 0); PG8_STAGE(PG8_SA(0, 1), a2 + hstep, voffA);
            PG8_WAIT_L(8); PG8_BAR; PG8_WAIT_L(0); PG8_MMA(0, 0, At, B0); PG8_BAR; PG8_SCHED;
            PG8_LDB(B1, 1, 1); PG8_STAGE(PG8_SB(1, 0), b3, voffB);
            PG8_BAR; PG8_WAIT_L(0); PG8_MMA(0, 1, At, B1); PG8_BAR;
            PG8_LDA(At, 1, 1); PG8_STAGE(PG8_SA(1, 0), a3, voffA);
            PG8_BAR; PG8_WAIT_L(0); PG8_MMA(1, 0, At, B0); PG8_BAR; PG8_SCHED;
            PG8_STAGE(PG8_SB(1, 1), b3 + hstepB, voffB);
            PG8_WAIT_V(6); PG8_BAR; PG8_MMA(1, 1, At, B1); PG8_BAR;
            }
        }
        if constexpr (ALIGN_EPI) { if (wr == 0) PG8_BAR; }
        if constexpr (!Epi::AFTER_DRAIN) { E(acc, cur, wr, wc, fr, fq); S.done(cur); }
        if (!has_next) break;
#pragma unroll
        for (int a = 0; a < 2; ++a)
#pragma unroll
            for (int b = 0; b < 2; ++b)
#pragma unroll
                for (int m = 0; m < 4; ++m)
#pragma unroll
                    for (int n = 0; n < 2; ++n) acc[a][b][m][n] = (f32x4){0.f, 0.f, 0.f, 0.f};
        cur = nxt; cA = nA; cB = nB; ++ui;
        if constexpr (ALIGN_EPI) { if (wr == 1) PG8_BAR; }
    }
    PG8_WAIT_V(0);
    if constexpr (!ALIGN_EPI) { if (wr == 0) PG8_BAR; }
    PG8_BAR;
    if constexpr (Epi::AFTER_DRAIN) { E.fused(acc, cur, wr, wc, fr, fq, lds, wid, lane); S.done(cur); }
#undef PG8_SA
#undef PG8_SB
#undef PG8_STAGE
#undef PG8_LDA
#undef PG8_LDB
#undef PG8_MMA
#undef PG8_WAIT_V
#undef PG8_WAIT_L
#undef PG8_BAR
#undef PG8_SCHED
}
}
#define GAS __attribute__((address_space(1)))
#define LAS __attribute__((address_space(3)))
typedef unsigned short bf16;
typedef unsigned v4u __attribute__((ext_vector_type(4)));
typedef float f32x4 __attribute__((ext_vector_type(4)));
typedef short bf16x8 __attribute__((ext_vector_type(8)));
typedef GAS unsigned gu32;
typedef GAS unsigned long long gu64;
#define RLX_AGENT __ATOMIC_RELAXED, __HIP_MEMORY_SCOPE_AGENT
#define LDS_WAIT() asm volatile("s_waitcnt lgkmcnt(0)" ::: "memory")
#define VM_WAIT() asm volatile("s_waitcnt vmcnt(0)" ::: "memory")
__device__ __forceinline__ unsigned long long rt() { return __builtin_amdgcn_s_memrealtime(); }
__device__ __forceinline__ unsigned f2bf(float f) { unsigned u = __builtin_bit_cast(unsigned, f); return (u + 0x7fffu + ((u >> 16) & 1u)) >> 16; }
__device__ __forceinline__ unsigned pk2(float lo, float hi) { return f2bf(lo) | (f2bf(hi) << 16); }

#define XB_TMO      128
#define XB_XCNT(j)  (256  + 64 * (j))
#define XB_XSUB(j)  (1280 + 64 * (j))
#define XB_XGEN(j)  (2304 + 64 * (j))
#define XB_TOP      3328
#define XB_TOPGEN   3392
#define XCD_BAR_WORDS 3456
#define XB_SPIN_CAP (1u << 18)

__device__ __forceinline__ unsigned xb_ld(unsigned* p)              { return __hip_atomic_load(p, __ATOMIC_RELAXED, __HIP_MEMORY_SCOPE_AGENT); }
__device__ __forceinline__ unsigned xb_add(unsigned* p, unsigned v) { return __hip_atomic_fetch_add(p, v, __ATOMIC_RELAXED, __HIP_MEMORY_SCOPE_AGENT); }
__device__ __forceinline__ unsigned xb_xcc_id() { return (unsigned)__builtin_amdgcn_s_getreg((3 << 11) | 20) & 0xFu; }
#define XB_SPIN(cond, bar) do { unsigned _sp = 0; while (cond) { __builtin_amdgcn_s_sleep(1); \
    if ((++_sp & 255u) == 0u) { if (xb_ld(&(bar)[XB_TMO])) break; if (_sp > XB_SPIN_CAP) { atomicAdd(&(bar)[XB_TMO], 1u); break; } } } } while (0)

struct XcdBarrier {
    unsigned* bar; unsigned x;
    volatile LAS unsigned* st;
};

__device__ __forceinline__ XcdBarrier xcd_barrier_post(unsigned* bar, volatile LAS unsigned* st) {
    XcdBarrier b; b.bar = bar; b.x = xb_xcc_id(); b.st = st;
    if (threadIdx.x == 0) (void)xb_add(&bar[XB_XCNT(b.x)], 1u);
    return b;
}
__device__ __forceinline__ void xcd_barrier_complete(unsigned* bar, unsigned x, unsigned& nloc, unsigned& nx) {
    const unsigned G = 256u;
    unsigned sum, cnt, mine, sp = 0u;
    for (;;) {
        sum = 0u; cnt = 0u; mine = 0u;
#pragma unroll
        for (unsigned j = 0; j < 16; ++j) { const unsigned c = xb_ld(&bar[XB_XCNT(j)]); sum += c; cnt += (c > 0u) ? 1u : 0u; mine = (j == x) ? c : mine; }
        if (sum == G) break;
        __builtin_amdgcn_s_sleep(1);
        if ((++sp & 255u) == 0u) { if (xb_ld(&bar[XB_TMO])) break; if (sp > XB_SPIN_CAP) { atomicAdd(&bar[XB_TMO], 1u); break; } }
    }
    nloc = mine > 0u ? mine : 1u; nx = cnt > 0u ? cnt : 1u;
}

__device__ __forceinline__ void xcd_barrier(const XcdBarrier& b, int tid) {
    asm volatile("s_waitcnt vmcnt(0)" ::: "memory");
    __syncthreads();
    if (tid == 0) {
        unsigned* bar = b.bar;
        __builtin_amdgcn_s_waitcnt(0);
        unsigned nloc = b.st[0], nx = b.st[1];
        if (nloc == 0u) { xcd_barrier_complete(bar, b.x, nloc, nx); b.st[0] = nloc; b.st[1] = nx; }
        const unsigned old = xb_add(&bar[XB_XSUB(b.x)], 1u);
        const unsigned gen = old / nloc;
        if (old + 1u == (gen + 1u) * nloc) {
            __builtin_amdgcn_fence(__ATOMIC_RELEASE, "agent");
            asm volatile("s_waitcnt vmcnt(0)" ::: "memory");
            const unsigned og = xb_add(&bar[XB_TOP], 1u);
            const unsigned tg = og / nx;
            if (og + 1u == (tg + 1u) * nx) xb_add(&bar[XB_TOPGEN], 1u);
            else XB_SPIN(xb_ld(&bar[XB_TOPGEN]) == tg, bar);
            __builtin_amdgcn_fence(__ATOMIC_ACQUIRE, "agent");
            xb_add(&bar[XB_XGEN(b.x)], 1u);
            asm volatile("s_waitcnt vmcnt(0)" ::: "memory");
        } else {
            XB_SPIN(xb_ld(&bar[XB_XGEN(b.x)]) == gen, bar);
            __builtin_amdgcn_fence(__ATOMIC_ACQUIRE, "agent");
            asm volatile("s_waitcnt vmcnt(0)" ::: "memory");
        }
    }
    __syncthreads();
}
#ifndef MK_N_LAUNCHES
#define MK_N_LAUNCHES 1
#endif
constexpr int NWAVES = 8, NGRID = 256;
constexpr int N_PHASES = 9;
constexpr int N_LAUNCHES = MK_N_LAUNCHES;
constexpr int DM = 1024, NIN = 7680, DMIX = 2048;
constexpr int MPR = 16384, MSA = 32, MPAD = 16640, SEQL = 2048;
constexpr float EPSF = 1e-6f;
constexpr size_t O_YP = 0, O_YS = 16777216, O_KP = O_YS + 32768, O_VP = O_KP + 25165824, O_KS = O_VP + 25165824, O_VS = O_KS + 49152,
                 O_SGU = O_VS + 49152, O_HP = O_SGU + 32768, O_HS = O_HP + 1572864, O_END = O_HS + 6291456;
constexpr size_t MiB = 1u << 20;
constexpr size_t alup(size_t x) { return (x + MiB - 1) / MiB * MiB; }
constexpr size_t WS_CTL = 0, CTL_ZERO_BYTES = 64 * 1024;
constexpr size_t WS_WIN = MiB;
constexpr size_t WS_WOUT = WS_WIN + alup((size_t)2 * NIN * DM * 2);
constexpr size_t WS_SGW = WS_WOUT + alup((size_t)2 * DM * DMIX * 2);
constexpr size_t WS_LB = WS_SGW + alup((size_t)2 * 8 * 128 * 128 * 2);
constexpr size_t WS_XB = WS_LB + MiB;
constexpr size_t WS_QB = WS_XB + alup((size_t)MPAD * DM * 2);
constexpr size_t WS_KB = WS_QB + alup((size_t)MPAD * 768 * 2);
constexpr size_t WS_VB = WS_KB + alup((size_t)MPAD * 768 * 2);
constexpr size_t WS_ZB = WS_VB + alup((size_t)MPAD * 768 * 2);
constexpr size_t WS_BU = WS_ZB + alup((size_t)MPAD * 2048 * 2);
constexpr size_t WS_BV = WS_BU + alup((size_t)MPAD * 512 * 2);
constexpr size_t WS_CQ = WS_BV + alup((size_t)MPAD * 512 * 2);
constexpr size_t WS_CK = WS_CQ + alup((size_t)MPAD * 768 * 2);
constexpr size_t WS_CI = WS_CK + alup((size_t)MPAD * 768 * 2);
constexpr size_t WS_CG = WS_CI + alup((size_t)MPAD * 768 * 2);
constexpr size_t WS_CE = WS_CG;
constexpr size_t WS_DJ = WS_CG + alup((size_t)MPAD * 768 * 2);
constexpr size_t WS_YB = WS_CG + alup((size_t)MPAD * 768 * 4);
constexpr size_t WS_X1 = WS_YB + alup((size_t)MPAD * 2048 * 2);
constexpr size_t WS_DS = WS_X1 + alup((size_t)MPAD * DM * 4);
constexpr size_t WS_DEC = WS_DS + alup((size_t)48 * 16 * 128 * 128 * 4);
constexpr size_t WS_O2 = WS_DEC + alup((size_t)48 * 16 * 128 * 4);
constexpr size_t WS_O3 = WS_O2 + alup((size_t)MPAD * 768 * 2);
constexpr size_t WS_L2 = WS_O3 + alup((size_t)MPAD * 768 * 2);
constexpr size_t WS_L3 = WS_L2 + alup((size_t)MPAD * 16 * 4);
constexpr size_t WS_KH = WS_L3 + alup((size_t)MPAD * 16 * 4);
constexpr size_t WS_VH = WS_KH + alup((size_t)MPR * 768 * 2);
constexpr size_t WS_END = WS_VH + alup((size_t)MPR * 768 * 2);
constexpr int CW_TMO = 0, CW_CODE = 1, CW_BAR = 4096, CW_Q = 8192;
constexpr size_t CTL_SSQ0 = 256 * 1024, CTL_SSQ1 = 512 * 1024;
constexpr int RING_OFF = 0, LDS_BYTES = 163840, MISC_OFF = LDS_BYTES - 1024;
static_assert(WS_VB - WS_KB == WS_KB - WS_QB && WS_CI - WS_CK == WS_CK - WS_CQ, "equally spaced buffer groups (addressed arithmetically in the in-projection epilogue)");
#define DI __device__ __forceinline__
typedef float f32x16 __attribute__((ext_vector_type(16)));
typedef short s16x4 __attribute__((ext_vector_type(4)));
typedef short v4i16_t __attribute__((ext_vector_type(4)));
typedef float f32x2v __attribute__((ext_vector_type(2)));
typedef unsigned u32x2v __attribute__((ext_vector_type(2)));
typedef __bf16 bf16x2v __attribute__((ext_vector_type(2)));
DI void swap_pair(u32x2v& a, u32x2v& b) {
    auto r0 = __builtin_amdgcn_permlane32_swap(a.x, b.x, false, false); a.x = r0[0]; b.x = r0[1];
    auto r1 = __builtin_amdgcn_permlane32_swap(a.y, b.y, false, false); a.y = r1[0]; b.y = r1[1];
}
#define MFMA32(a, b, c) __builtin_amdgcn_mfma_f32_32x32x16_bf16((a), (b), (c), 0, 0, 0)
DI unsigned cvtpk2(float lo, float hi) { f32x2v v = {lo, hi}; bf16x2v b = __builtin_convertvector(v, bf16x2v); return __builtin_bit_cast(unsigned, b); }
DI float bf2f(bf16 u) { return __uint_as_float((unsigned)u << 16); }
DI float bflo(unsigned w) { return __uint_as_float(w << 16); }
DI float bfhi(unsigned w) { return __uint_as_float(w & 0xffff0000u); }
DI int crow(int r, int h) { return (r & 3) + 8 * (r >> 2) + 4 * h; }
DI float shx(float v, int mask, int lane) { return __builtin_bit_cast(float, __builtin_amdgcn_ds_bpermute((lane ^ mask) << 2, __builtin_bit_cast(int, v))); }
DI float wave_sum(float v, int lane) {
#pragma unroll
    for (int o = 1; o < 64; o <<= 1) v += shx(v, o, lane);
    return v;
}
DI float wave_max(float v, int lane) {
#pragma unroll
    for (int o = 1; o < 64; o <<= 1) v = fmaxf(v, shx(v, o, lane));
    return v;
}
DI s16x4 trd(LAS const unsigned char* p) { return __builtin_bit_cast(s16x4, __builtin_amdgcn_ds_read_tr16_b64_v4i16((LAS v4i16_t*)p)); }
DI int tr_lane_off(int pitch, int lane, bool perm) { const int i16 = lane & 15, q = i16 >> 2, p = i16 & 3, blk = (lane >> 4) & 1, h = lane >> 5; return ((perm ? 4 * h : 8 * h) + q) * pitch + (16 * blk + 4 * p) * 2; }
DI bf16x8 trfrag(LAS const unsigned char* base, int pitch, int k0, int c0, int laneoff, bool perm) {
    LAS const unsigned char* a = base + k0 * pitch + c0 * 2 + laneoff;
    const s16x4 lo = trd(a), hi = trd(a + (perm ? 8 : 4) * pitch);
    return __builtin_shufflevector(lo, hi, 0, 1, 2, 3, 4, 5, 6, 7);
}
DI bf16x8 pack8(const f32x16& x, int s) { v4u p; p.x = cvtpk2(x[8 * s], x[8 * s + 1]); p.y = cvtpk2(x[8 * s + 2], x[8 * s + 3]); p.z = cvtpk2(x[8 * s + 4], x[8 * s + 5]); p.w = cvtpk2(x[8 * s + 6], x[8 * s + 7]); return __builtin_bit_cast(bf16x8, p); }
DI f32x16 zero16() { f32x16 z;
#pragma unroll
    for (int i = 0; i < 16; ++i) z[i] = 0.f; return z; }

struct Args { const float* in[16]; float* out; unsigned char* ws; int ph_lo, ph_hi, imask, pad; };
struct Ctx {
    LAS unsigned char* lds; volatile LAS unsigned* MISC;
    int tid, lane, wave, vcu, G;
};
typedef __attribute__((address_space(4))) const Args* kaptr_t;
DI kaptr_t kargs() { kaptr_t kp = (kaptr_t)__builtin_amdgcn_kernarg_segment_ptr(); asm volatile("" : "+s"(kp)); return kp; }
#define INP(i) (kargs()->in[i])
#define WSP(off) (kargs()->ws + (off))
#define OUTP() (kargs()->out)
DI void p0_transpose_item(const float* W, int K, int N, bf16* WT, const float* gk, LAS float* scr, int item, int lane, bool nts = false) {
    const int nblk = N / 32, kb = item / nblk, nb = item % nblk, k0 = 64 * kb, n0 = 32 * nb;
#pragma unroll 8
    for (int i = 0; i < 32; ++i) { const int kk = 2 * i + (lane >> 5); float w = __builtin_nontemporal_load(W + (size_t)(k0 + kk) * N + n0 + (lane & 31)); if (gk) w *= gk[k0 + kk]; scr[kk * 33 + (lane & 31)] = w; }
    LDS_WAIT(); asm volatile("" ::: "memory");
    const int c = lane & 7;
#pragma unroll
    for (int j = 0; j < 4; ++j) { const int n = (lane >> 3) + 8 * j; const LAS float* s = scr + (8 * c) * 33 + n;
        v4u o; o.x = pk2(s[0 * 33], s[1 * 33]); o.y = pk2(s[2 * 33], s[3 * 33]); o.z = pk2(s[4 * 33], s[5 * 33]); o.w = pk2(s[6 * 33], s[7 * 33]);
        if (nts) __builtin_nontemporal_store(o, (v4u*)(WT + (size_t)(n0 + n) * K + k0 + 8 * c)); else *(GAS v4u*)(WT + (size_t)(n0 + n) * K + k0 + 8 * c) = o; }
    LDS_WAIT(); asm volatile("" ::: "memory");
}
DI void p0_prologue(Ctx& C) { const float* const p_qn_g = ((const float*)INP(7)); const float* const p_kn_g = ((const float*)INP(8)); float* const p_LB = ((float*)WSP(WS_LB)); bf16* const p_SGW = ((bf16*)WSP(WS_SGW)); float* const p_SSQ0 = ((float*)WSP(WS_CTL + CTL_SSQ0)); bf16* const p_WIN = ((bf16*)WSP(WS_WIN)); bf16* const p_WOUT = ((bf16*)WSP(WS_WOUT)); bf16* const p_XB = ((bf16*)WSP(WS_XB)); const float* const p_lb_logits = ((const float*)INP(13)); const float* const p_norm_g = ((const float*)INP(5)); const float* const p_sgu_w = ((const float*)INP(11)); const float* const p_w_in = ((const float*)INP(6)); const float* const p_w_out = ((const float*)INP(15)); const float* const p_x_prompt = ((const float*)INP(0)); const float* const p_x_sample = ((const float*)INP(1));
    LAS float* scr = (LAS float*)(C.lds + RING_OFF + C.wave * 16384);
    const int gw = C.vcu * NWAVES + C.wave, NGW = C.G * NWAVES;
    constexpr int I_IN1 = (DM / 64) * (NIN / 32), I_OUT1 = (DMIX / 64) * (DM / 32);
    for (int it = gw; it < I_IN1; it += NGW) p0_transpose_item(p_w_in, DM, NIN, p_WIN, p_norm_g, scr, it, C.lane);
    for (int m = gw; m < MPAD; m += NGW) {
        GAS unsigned long long* o8 = (GAS unsigned long long*)(p_XB + (size_t)m * DM) + C.lane;
        if (m < MPR + MSA) {
            const float* xrow = (m < MPR) ? p_x_prompt + (size_t)m * DM : p_x_sample + (size_t)(m - MPR) * DM;
            const GAS f32x4* xr = (const GAS f32x4*)xrow + C.lane; f32x4 v[4]; float s = 0.f;
#pragma unroll
            for (int j = 0; j < 4; ++j) { v[j] = __builtin_nontemporal_load(xr + 64 * j); s += (v[j].x * v[j].x + v[j].y * v[j].y) + (v[j].z * v[j].z + v[j].w * v[j].w); }
            s = wave_sum(s, C.lane);
#pragma unroll
            for (int j = 0; j < 4; ++j) o8[64 * j] = (unsigned long long)pk2(v[j].x, v[j].y) | ((unsigned long long)pk2(v[j].z, v[j].w) << 32);
            if (C.lane == 0) p_SSQ0[m] = s;
        } else {
#pragma unroll
            for (int j = 0; j < 4; ++j) o8[64 * j] = 0ull;
            if (C.lane == 0) p_SSQ0[m] = 0.f;
        }
    }
    const int gt = C.vcu * 512 + C.tid, NGT = C.G * 512;
    for (int e = gt; e < MPAD; e += NGT) ((float*)WSP(WS_CTL + CTL_SSQ1))[e] = 0.f;
    for (int e = gt; e < 2 * 8 * 128 * 128; e += NGT) { const int s = e & 127, t = (e >> 7) & 127; const float w = p_sgu_w[e]; p_SGW[e] = (bf16)f2bf(s <= t ? w : 0.f); }
    for (int e = gt; e < 2 * 768; e += NGT) { const int l = e / 768, c = e - 768 * l; p_LB[(l * 3 + 0) * 768 + c] = p_qn_g[e]; p_LB[(l * 3 + 1) * 768 + c] = p_kn_g[e]; p_LB[(l * 3 + 2) * 768 + c] = (l == 0) ? 0.f : 1.0f / (1.0f + __expf(p_lb_logits[c] - p_lb_logits[768 + c])); }
}

DI void wt_item(const Ctx& C, int item) { const float* const p_w_in = ((const float*)INP(6)); const float* const p_w_out = ((const float*)INP(15)); const float* const p_norm_g = ((const float*)INP(5)); bf16* const p_WIN = ((bf16*)WSP(WS_WIN)); bf16* const p_WOUT = ((bf16*)WSP(WS_WOUT));
    constexpr int I_IN1 = (DM / 64) * (NIN / 32), I_OUT1 = (DMIX / 64) * (DM / 32);
    LAS float* scr = (LAS float*)(C.lds + RING_OFF + C.wave * 16384);
#pragma unroll 1
    for (int rep = 0; rep < 4; ++rep) {
        int it = 32 * item + 8 * rep + C.wave;
        if (it < I_OUT1) { p0_transpose_item(p_w_out, DMIX, DM, p_WOUT, nullptr, scr, it, C.lane, true); continue; } it -= I_OUT1;
        if (it < I_IN1) p0_transpose_item(p_w_in + (size_t)DM * NIN, DM, NIN, p_WIN + (size_t)NIN * DM, p_norm_g + DM, scr, it, C.lane, true);
        else if (it < I_IN1 + I_OUT1) p0_transpose_item(p_w_out + (size_t)DMIX * DM, DMIX, DM, p_WOUT + (size_t)DM * DMIX, nullptr, scr, it - I_IN1, C.lane, true);
    }
}

DI void kvout_item(const Ctx& C, int l, int item) { unsigned char* const ws = WSP(0); const bf16* const p_KH = (const bf16*)(ws + WS_KH); const bf16* const p_VH = (const bf16*)(ws + WS_VH); float* const p_out = OUTP();
    const int b = item >> 5, t0 = (item & 31) * 64, tid = C.tid;
    float* ok = p_out + O_KP + ((size_t)l * MPR + (size_t)b * SEQL + t0) * 768; float* ov = p_out + O_VP + ((size_t)l * MPR + (size_t)b * SEQL + t0) * 768;
#pragma unroll 4
    for (int it = 0; it < 12; ++it) { const int idx = tid + 512 * it, tl = idx / 96, hc = idx - 96 * tl, hh = hc >> 3, ch = hc & 7, t = t0 + tl;
        const size_t so = ((size_t)(((b * 12 + hh) * 16 + (t & 15)) * 128 + (t >> 4))) * 64 + 8 * ch; const size_t dofs = (size_t)tl * 768 + hh * 64 + 8 * ch;
        const v4u k8 = *(const v4u*)(p_KH + so), v8 = *(const v4u*)(p_VH + so);
        *(f32x4*)(ok + dofs) = (f32x4){bflo(k8.x), bfhi(k8.x), bflo(k8.y), bfhi(k8.y)}; *(f32x4*)(ok + dofs + 4) = (f32x4){bflo(k8.z), bfhi(k8.z), bflo(k8.w), bfhi(k8.w)};
        *(f32x4*)(ov + dofs) = (f32x4){bflo(v8.x), bfhi(v8.x), bflo(v8.y), bfhi(v8.y)}; *(f32x4*)(ov + dofs + 4) = (f32x4){bflo(v8.z), bfhi(v8.z), bflo(v8.w), bfhi(v8.w)}; }
}
DI float ex2(float x) { return __builtin_amdgcn_exp2f(x); }
DI float lg2(float x) { return __builtin_amdgcn_logf(x); }

constexpr int AP = 144;
DI void cls_tile(const bf16x8 (&qf)[4], LAS const unsigned char* Kl, LAS const unsigned char* Vl, int kr0, int jstart, int lane, f32x16 (&o)[2], float& lse) {
    const int i = lane & 31, h = lane >> 5;
    o[0] = zero16(); o[1] = zero16();
    constexpr float THR = 6.0f;
    float mrun = 0.f, l = 0.f; bool first = true;
    LAS const unsigned char* kp = Kl + (kr0 + 32 * jstart + i) * AP + 16 * h;
    LAS const unsigned char* vp = Vl + (kr0 + 32 * jstart) * AP + tr_lane_off(AP, lane, true);
#pragma unroll 1
    for (int j = jstart; j < 5; ++j, kp += 32 * AP, vp += 32 * AP) {
        f32x16 st = zero16();
#pragma unroll
        for (int s = 0; s < 4; ++s) st = MFMA32(*(LAS const bf16x8*)(kp + 32 * s), qf[s], st);
        if (j == 0) {
#pragma unroll
            for (int r = 0; r < 16; ++r) if (crow(r, h) < i) st[r] = -1e30f;
        }
        if (j == 4) {
#pragma unroll
            for (int r = 0; r < 16; ++r) if (crow(r, h) > i) st[r] = -1e30f;
        }
        float rm = fmaxf(fmaxf(st[0], st[1]), st[2]);
#pragma unroll
        for (int r = 3; r < 15; r += 2) rm = fmaxf(fmaxf(rm, st[r]), st[r + 1]);
        rm = fmaxf(rm, st[15]);
        rm = fmaxf(rm, shx(rm, 32, lane)) - mrun;
        if (first || __any(rm > THR)) {
            const float delta = first ? rm : fmaxf(rm, 0.f); mrun += delta;
            if (!first) { const float alpha = ex2(-delta); l *= alpha;
#pragma unroll
                for (int r = 0; r < 16; ++r) { o[0][r] *= alpha; o[1][r] *= alpha; } }
            first = false;
        }
        float ps0 = 0.f, ps1 = 0.f;
#pragma unroll
        for (int r = 0; r < 16; r += 2) { st[r] = ex2(st[r] - mrun); st[r + 1] = ex2(st[r + 1] - mrun); ps0 += st[r]; ps1 += st[r + 1]; }
        l += ps0 + ps1;
        const bf16x8 pb0 = pack8(st, 0), pb1 = pack8(st, 1);
#pragma unroll
        for (int db = 0; db < 2; ++db) {
            const s16x4 a0 = trd(vp + 64 * db), a1 = trd(vp + 64 * db + 8 * AP), b0 = trd(vp + 64 * db + 16 * AP), b1 = trd(vp + 64 * db + 24 * AP);
            o[db] = MFMA32(__builtin_shufflevector(a0, a1, 0, 1, 2, 3, 4, 5, 6, 7), pb0, o[db]);
            o[db] = MFMA32(__builtin_shufflevector(b0, b1, 0, 1, 2, 3, 4, 5, 6, 7), pb1, o[db]);
        }
    }
    l += shx(l, 32, lane);
    const float inv = 1.0f / l;
#pragma unroll
    for (int r = 0; r < 16; ++r) { o[0][r] *= inv; o[1][r] *= inv; }
    lse = mrun + lg2(l);
}
DI void cls_store(bf16* Ob, float* Lb, size_t m, int hh, int h, const f32x16 (&o)[2], float lse) {
    bf16* op = Ob + m * 768 + hh * 64 + 8 * h;
#pragma unroll
    for (int db = 0; db < 2; ++db)
#pragma unroll
        for (int gp = 0; gp < 2; ++gp) { u32x2v wa, wb; const int g4 = 2 * gp;
            wa.x = cvtpk2(o[db][4 * g4], o[db][4 * g4 + 1]); wa.y = cvtpk2(o[db][4 * g4 + 2], o[db][4 * g4 + 3]); wb.x = cvtpk2(o[db][4 * g4 + 4], o[db][4 * g4 + 5]); wb.y = cvtpk2(o[db][4 * g4 + 6], o[db][4 * g4 + 7]);
            swap_pair(wa, wb); *(v4u*)(op + 32 * db + 16 * gp) = (v4u){wa.x, wa.y, wb.x, wb.y}; }
    if (h == 0) Lb[((m >> 11) * 12 + hh) * 2048 + (m & 2047)] = lse;
}
template <int KIND> DI void att23_item(const Ctx& C, int item) { unsigned char* const ws = WSP(0); const bf16* const p_QB = (const bf16*)(ws + WS_QB); const bf16* const p_KB = (const bf16*)(ws + WS_KH); const bf16* const p_VB = (const bf16*)(ws + WS_VH);
    bf16* const p_O = (bf16*)(ws + (KIND == 2 ? WS_O2 : WS_O3)); float* const p_L = (float*)(ws + (KIND == 2 ? WS_L2 : WS_L3));
    const int up = item & 1, hh = (item >> 1) % 12, b = item / 24, lane = C.lane, wave = C.wave, tid = C.tid, i = lane & 31, h = lane >> 5;
    const size_t rb = (size_t)b * SEQL;
    LAS unsigned char* Kl = C.lds; LAS unsigned char* Vl = C.lds + 512 * AP;
    v4u kr[8], vr[8];
#define A23_TOK(u, row) (KIND == 2 ? (4 * (row) + (u)) : (16 * ((row) & 127) + 4 * (u) + ((row) >> 7)))
#define A23_SRC(u, idx) ((size_t)(((b * 12 + hh) * 16 + (KIND == 2 ? 4 * ((idx) >> 10) + (u) : 4 * (u) + ((idx) >> 10))) * 128 + (((idx) >> 3) & 127)) * 64 + 8 * ((idx) & 7))
#define A23_ROW(idx) (KIND == 2 ? 4 * (((idx) >> 3) & 127) + ((idx) >> 10) : ((idx) >> 3))
#define A23_ISSUE(u) do { int tl_ = tid; asm volatile("" : "+v"(tl_)); _Pragma("unroll") for (int it = 0; it < 8; ++it) { const int idx = tl_ + 512 * it; const size_t go = A23_SRC(u, idx); \
        kr[it] = *(const v4u*)(p_KB + go); vr[it] = *(const v4u*)(p_VB + go); } } while (0)
    A23_ISSUE(2 * up);
#pragma unroll 1
    for (int u = 2 * up; u < 2 * up + 2; ++u) {
        __syncthreads();
#pragma unroll
        for (int it = 0; it < 8; ++it) { const int idx = tid + 512 * it, row = A23_ROW(idx), ch = idx & 7; *(LAS v4u*)(Kl + row * AP + ch * 16) = kr[it]; *(LAS v4u*)(Vl + row * AP + ch * 16) = vr[it]; }
        __syncthreads();
        int cb0, qa, qb;
        if (KIND == 2) { cb0 = 0; qa = 64 * wave; qb = qa + 32; } else { cb0 = (wave >> 1) * 128; qa = (wave & 1) ? 32 : 0; qb = (wave & 1) ? 64 : 96; }
        const size_t ma = rb + A23_TOK(u, cb0 + qa + i), mb = rb + A23_TOK(u, cb0 + qb + i);
        bf16x8 qfa[4], qfb[4];
#pragma unroll
        for (int s = 0; s < 4; ++s) qfa[s] = *(const bf16x8*)(p_QB + ma * 768 + hh * 64 + 8 * h + 16 * s);
#pragma unroll
        for (int s = 0; s < 4; ++s) qfb[s] = *(const bf16x8*)(p_QB + mb * 768 + hh * 64 + 8 * h + 16 * s);
        if (u == 2 * up) A23_ISSUE(u + 1);
        f32x16 o[2]; float lse;
        cls_tile(qfa, Kl + cb0 * AP, Vl + cb0 * AP, qa - 128, qa >= 128 ? 0 : (128 - qa) >> 5, lane, o, lse);
        cls_store(p_O, p_L, ma, hh, h, o, lse);
        cls_tile(qfb, Kl + cb0 * AP, Vl + cb0 * AP, qb - 128, qb >= 128 ? 0 : (128 - qb) >> 5, lane, o, lse);
        cls_store(p_O, p_L, mb, hh, h, o, lse);
    }
#undef A23_ISSUE
#undef A23_TOK
#undef A23_SRC
#undef A23_ROW
}
DI void att1_item(const Ctx& C, int item, int T0, int nu) { unsigned char* const ws = WSP(0); const bf16* const p_QB = (const bf16*)(ws + WS_QB); const bf16* const p_KB = (const bf16*)(ws + WS_KH); const bf16* const p_VB = (const bf16*)(ws + WS_VH);
    const bf16* const p_O2 = (const bf16*)(ws + WS_O2); const float* const p_L2 = (const float*)(ws + WS_L2); const bf16* const p_O3 = (const bf16*)(ws + WS_O3); const float* const p_L3 = (const float*)(ws + WS_L3); const bf16* const p_ZB = (const bf16*)(ws + WS_ZB); bf16* const p_YB = (bf16*)(ws + WS_YB);
    const int qtr = item & 3, hh = (item >> 2) % 12, b = item / 48, lane = C.lane, wave = C.wave, tid = C.tid, i = lane & 31, h = lane >> 5;
    const size_t rb = (size_t)b * SEQL;
    LAS unsigned char* Kl = C.lds; LAS unsigned char* Vl = C.lds + 384 * AP;
    v4u kr[6], vr[6];
#define A1_ISSUE(T) do { const int m30_ = 16 * (T) - 8; _Pragma("unroll") for (int it = 0; it < 6; ++it) { const int idx = tid + 512 * it, r16 = idx / 192, rem = idx - 192 * r16; int m3 = m30_ + (rem >> 3); if (m3 < 0) m3 = 0; \
        const size_t go = (size_t)(((b * 12 + hh) * 16 + r16) * 128 + m3) * 64 + 8 * (rem & 7); kr[it] = *(const v4u*)(p_KB + go); vr[it] = *(const v4u*)(p_VB + go); } } while (0)
    A1_ISSUE(T0);
#pragma unroll 1
    for (int u = 0; u < nu; ++u) {
        const int T = T0 + u;
        __syncthreads();
#pragma unroll
        for (int it = 0; it < 6; ++it) { const int idx = tid + 512 * it, r16 = idx / 192, rem = idx - 192 * r16, row = 16 * (rem >> 3) + r16, ch = rem & 7; *(LAS v4u*)(Kl + row * AP + ch * 16) = kr[it]; *(LAS v4u*)(Vl + row * AP + ch * 16) = vr[it]; }
        __syncthreads();
        const int tq0 = 256 * T + 32 * wave; const size_t m = rb + tq0 + i;
        bf16x8 qf[4];
#pragma unroll
        for (int s = 0; s < 4; ++s) qf[s] = *(const bf16x8*)(p_QB + m * 768 + hh * 64 + 8 * h + 16 * s);
        const bf16* o2p = p_O2 + m * 768 + hh * 64 + 8 * h; const bf16* o3p = p_O3 + m * 768 + hh * 64 + 8 * h; const bf16* zp = p_ZB + m * 2048 + hh * 64 + 8 * h; bf16* yp = p_YB + m * 2048 + hh * 64 + 8 * h;
        const size_t lo_ = ((m >> 11) * 12 + hh) * 2048 + (m & 2047); const float l2 = p_L2[lo_], l3 = p_L3[lo_];
        v4u a2[4], a3[4];
#pragma unroll
        for (int q = 0; q < 4; ++q) { a2[q] = *(const v4u*)(o2p + 16 * q); a3[q] = *(const v4u*)(o3p + 16 * q); }
        if (u + 1 < nu) A1_ISSUE(T + 1);
        f32x16 o[2]; float lse;
        cls_tile(qf, Kl, Vl, 32 * wave, tq0 >= 128 ? 0 : (128 - tq0) >> 5, lane, o, lse);
        const float M = fmaxf(lse, fmaxf(l2, l3)), L = M + lg2(ex2(lse - M) + ex2(l2 - M) + ex2(l3 - M));
        const float w1 = ex2(lse - L), w2 = ex2(l2 - L), w3 = ex2(l3 - L);
#pragma unroll
        for (int db = 0; db < 2; ++db)
#pragma unroll
            for (int gp = 0; gp < 2; ++gp) { const int q = 2 * db + gp, g4 = 2 * gp; const v4u A2 = a2[q], A3 = a3[q], Z = *(const v4u*)(zp + 16 * q);
                u32x2v x2a = {A2.x, A2.y}, x2b = {A2.z, A2.w}, x3a = {A3.x, A3.y}, x3b = {A3.z, A3.w}, za = {Z.x, Z.y}, zb = {Z.z, Z.w}, wa, wb;
                swap_pair(x2a, x2b); swap_pair(x3a, x3b); swap_pair(za, zb);
                { const float y0 = w1 * o[db][4 * g4] + w2 * bflo(x2a.x) + w3 * bflo(x3a.x), y1 = w1 * o[db][4 * g4 + 1] + w2 * bfhi(x2a.x) + w3 * bfhi(x3a.x);
                  const float y2 = w1 * o[db][4 * g4 + 2] + w2 * bflo(x2a.y) + w3 * bflo(x3a.y), y3 = w1 * o[db][4 * g4 + 3] + w2 * bfhi(x2a.y) + w3 * bfhi(x3a.y);
                  wa.x = cvtpk2(y0 * bflo(za.x), y1 * bfhi(za.x)); wa.y = cvtpk2(y2 * bflo(za.y), y3 * bfhi(za.y)); }
                { const float y0 = w1 * o[db][4 * g4 + 4] + w2 * bflo(x2b.x) + w3 * bflo(x3b.x), y1 = w1 * o[db][4 * g4 + 5] + w2 * bfhi(x2b.x) + w3 * bfhi(x3b.x);
                  const float y2 = w1 * o[db][4 * g4 + 6] + w2 * bflo(x2b.y) + w3 * bflo(x3b.y), y3 = w1 * o[db][4 * g4 + 7] + w2 * bfhi(x2b.y) + w3 * bfhi(x3b.y);
                  wb.x = cvtpk2(y0 * bflo(zb.x), y1 * bfhi(zb.x)); wb.y = cvtpk2(y2 * bflo(zb.y), y3 * bfhi(zb.y)); }
                swap_pair(wa, wb); *(v4u*)(yp + 16 * q) = (v4u){wa.x, wa.y, wb.x, wb.y}; }
    }
#undef A1_ISSUE
}

DI void sgu_item(const Ctx& C, int l, int item) { bf16* const p_BU = ((bf16*)WSP(WS_BU)); bf16* const p_BV = ((bf16*)WSP(WS_BV)); bf16* const p_SGW = ((bf16*)WSP(WS_SGW)); bf16* const p_YB = ((bf16*)WSP(WS_YB)); bf16* const p_ZB = ((bf16*)WSP(WS_ZB)); const float* const p_ln_b = ((const float*)INP(10)); const float* const p_ln_g = ((const float*)INP(9)); const float* const p_sgu_b = ((const float*)INP(12));
    const int b = item >> 4, ch = item & 15, lane = C.lane, wave = C.wave, i = lane & 31, h = lane >> 5; const size_t m0 = (size_t)b * SEQL + ch * 128;
    constexpr int VP = 1088;
    { const f32x4 g0 = *(const f32x4*)(p_ln_g + l * 512 + 8 * lane), g1 = *(const f32x4*)(p_ln_g + l * 512 + 8 * lane + 4), b0 = *(const f32x4*)(p_ln_b + l * 512 + 8 * lane), b1 = *(const f32x4*)(p_ln_b + l * 512 + 8 * lane + 4);
      v4u raw[16]; float s1[16], s2[16];
#pragma unroll
      for (int tt = 0; tt < 16; ++tt) raw[tt] = *(const v4u*)(p_BV + (m0 + 16 * wave + tt) * 512 + 8 * lane);
#pragma unroll
      for (int tt = 0; tt < 16; ++tt) { const v4u r = raw[tt]; const float x0 = bflo(r.x), x1 = bfhi(r.x), x2 = bflo(r.y), x3 = bfhi(r.y), x4 = bflo(r.z), x5 = bfhi(r.z), x6 = bflo(r.w), x7 = bfhi(r.w);
        s1[tt] = ((x0 + x1) + (x2 + x3)) + ((x4 + x5) + (x6 + x7)); s2[tt] = ((x0 * x0 + x1 * x1) + (x2 * x2 + x3 * x3)) + ((x4 * x4 + x5 * x5) + (x6 * x6 + x7 * x7)); }
#pragma unroll
      for (int o = 1; o < 64; o <<= 1) {
#pragma unroll
        for (int tt = 0; tt < 16; ++tt) { s1[tt] += shx(s1[tt], o, lane); s2[tt] += shx(s2[tt], o, lane); } }
#pragma unroll
      for (int tt = 0; tt < 16; ++tt) { const int t = 16 * wave + tt; const v4u r = raw[tt];
        const float mean = s1[tt] * (1.0f / 512.0f), var = fmaxf(s2[tt] * (1.0f / 512.0f) - mean * mean, 0.f), rstd = __builtin_amdgcn_rsqf(var + EPSF);
        float x[8] = {bflo(r.x), bfhi(r.x), bflo(r.y), bfhi(r.y), bflo(r.z), bfhi(r.z), bflo(r.w), bfhi(r.w)};
#pragma unroll
        for (int e = 0; e < 8; ++e) x[e] = (x[e] - mean) * rstd;
        v4u w; w.x = cvtpk2(x[0] * g0[0] + b0[0], x[1] * g0[1] + b0[1]); w.y = cvtpk2(x[2] * g0[2] + b0[2], x[3] * g0[3] + b0[3]);
        w.z = cvtpk2(x[4] * g1[0] + b1[0], x[5] * g1[1] + b1[1]); w.w = cvtpk2(x[6] * g1[2] + b1[2], x[7] * g1[3] + b1[3]);
        *(LAS v4u*)(C.lds + t * VP + lane * 16) = w; } }
    __syncthreads();
    const int g = wave; const bf16* Wg = p_SGW + (size_t)((l * 8 + g) * 128) * 128; const int troff = tr_lane_off(VP, lane, false);
#pragma unroll
    for (int tb = 0; tb < 4; ++tb) {
        f32x16 acc[2]; acc[0] = zero16(); acc[1] = zero16();
#pragma unroll
        for (int ks = 0; ks < 2 * tb + 2; ++ks) {
            const bf16x8 wf = *(const bf16x8*)(Wg + (32 * tb + i) * 128 + 16 * ks + 8 * h);
#pragma unroll
            for (int cb = 0; cb < 2; ++cb) acc[cb] = MFMA32(trfrag(C.lds, VP, 16 * ks, 64 * g + 32 * cb, troff, false), wf, acc[cb]);
        }
        const int t = 32 * tb + i; const float bias = p_sgu_b[(l * 8 + g) * 128 + t]; const size_t m = m0 + t;
#pragma unroll
        for (int cb = 0; cb < 2; ++cb)
#pragma unroll
            for (int gp = 0; gp < 2; ++gp) { const int c0 = 64 * g + 32 * cb + 16 * gp + 8 * h, g4 = 2 * gp;
                const v4u U = *(const v4u*)(p_BU + m * 512 + c0), Z = *(const v4u*)(p_ZB + m * 2048 + 768 + c0);
                u32x2v ua = {U.x, U.y}, ub = {U.z, U.w}, za = {Z.x, Z.y}, zb = {Z.z, Z.w}, wa, wb; swap_pair(ua, ub); swap_pair(za, zb);
                wa.x = cvtpk2(bflo(ua.x) * (acc[cb][4 * g4] + bias) * bflo(za.x), bfhi(ua.x) * (acc[cb][4 * g4 + 1] + bias) * bfhi(za.x));
                wa.y = cvtpk2(bflo(ua.y) * (acc[cb][4 * g4 + 2] + bias) * bflo(za.y), bfhi(ua.y) * (acc[cb][4 * g4 + 3] + bias) * bfhi(za.y));
                wb.x = cvtpk2(bflo(ub.x) * (acc[cb][4 * g4 + 4] + bias) * bflo(zb.x), bfhi(ub.x) * (acc[cb][4 * g4 + 5] + bias) * bfhi(zb.x));
                wb.y = cvtpk2(bflo(ub.y) * (acc[cb][4 * g4 + 6] + bias) * bflo(zb.y), bfhi(ub.y) * (acc[cb][4 * g4 + 7] + bias) * bfhi(zb.y));
                swap_pair(wa, wb); *(v4u*)(p_YB + m * 2048 + 768 + c0) = (v4u){wa.x, wa.y, wb.x, wb.y}; }
    }
}

DI void hgp_item(const Ctx& C, int l, int item) { unsigned char* const ws = WSP(0); const bf16* const p_CK = (const bf16*)(ws + WS_CK); const bf16* const p_CI = (const bf16*)(ws + WS_CI); const float* const p_DJ = (const float*)(ws + WS_DJ); float* const p_SNAP = (float*)(ws + WS_DS); float* const p_out = OUTP();
    const int bh = item, b = bh / 6, hh = bh % 6, tid = C.tid, lane = C.lane, wave = C.wave, i = lane & 31, h = lane >> 5;
    constexpr int PT = 272, TB = 32 * PT, BUF = 2 * TB;
    LAS unsigned char* L = C.lds;
    const int row = tid >> 4, chn = tid & 15, kb = wave >> 1, vb0 = 2 * (wave & 1), troff = tr_lane_off(PT, lane, false);
    const size_t g0 = ((size_t)b * SEQL + row) * 768 + hh * 128 + chn * 8;
    const float* djp = p_DJ + ((size_t)b * 64) * 768 + hh * 128 + 32 * kb + i;
    v4u kreg = *(const v4u*)(p_CK + g0), vreg = *(const v4u*)(p_CI + g0); float djn = djp[0];
    *(LAS v4u*)(L + row * PT + chn * 16) = kreg; *(LAS v4u*)(L + TB + row * PT + chn * 16) = vreg;
    __syncthreads();
    f32x16 acc[2]; acc[0] = zero16(); acc[1] = zero16();
#pragma unroll 1
    for (int j = 0; j < 64; ++j) {
        LAS const unsigned char* cur = L + (j & 1) * BUF; LAS unsigned char* nxt = L + ((j + 1) & 1) * BUF;
        const float dj = djn;
        if (j < 63) { const size_t g = g0 + (size_t)(32 * (j + 1)) * 768; kreg = *(const v4u*)(p_CK + g); vreg = *(const v4u*)(p_CI + g); djn = djp[(size_t)(j + 1) * 768]; }
#pragma unroll
        for (int s2 = 0; s2 < 2; ++s2) { const bf16x8 kfr = trfrag(cur, PT, 16 * s2, 32 * kb, troff, false);
#pragma unroll
            for (int j2 = 0; j2 < 2; ++j2) acc[j2] = MFMA32(trfrag(cur + TB, PT, 16 * s2, 32 * (vb0 + j2), troff, false), kfr, acc[j2]); }
#pragma unroll
        for (int r = 0; r < 16; ++r) { acc[0][r] *= dj; acc[1][r] *= dj; }
        if ((j & 15) == 15) {
            float* dst = (j == 63) ? p_out + O_HP + (size_t)(l * 48 + bh) * 16384 : p_SNAP + (size_t)(bh * 3 + (j >> 4)) * 16384;
            dst += (size_t)(32 * kb + i) * 128 + 4 * h;
#pragma unroll
            for (int j2 = 0; j2 < 2; ++j2)
#pragma unroll
                for (int g4 = 0; g4 < 4; ++g4) *(f32x4*)(dst + 32 * (vb0 + j2) + 8 * g4) = (f32x4){acc[j2][4 * g4], acc[j2][4 * g4 + 1], acc[j2][4 * g4 + 2], acc[j2][4 * g4 + 3]};
        }
        if (j < 63) { *(LAS v4u*)(nxt + row * PT + chn * 16) = kreg; *(LAS v4u*)(nxt + TB + row * PT + chn * 16) = vreg; }
        __syncthreads();
    }
}
DI void hg3_item(const Ctx& C, int l, int item) { unsigned char* const ws = WSP(0); const bf16* const p_CE = (const bf16*)(ws + WS_CE); const float* const p_DJ = (const float*)(ws + WS_DJ); const bf16* const p_CI = (const bf16*)(ws + WS_CI); const bf16* const p_CK = (const bf16*)(ws + WS_CK); const bf16* const p_CQ = (const bf16*)(ws + WS_CQ); const float* const p_SNAP = (const float*)(ws + WS_DS); bf16* const p_YB = (bf16*)(ws + WS_YB); const bf16* const p_ZB = (const bf16*)(ws + WS_ZB); const float* const p_hn_g = ((const float*)INP(14));
    const int qt = item & 3, bh = item >> 2, b = bh / 6, hh = bh % 6, tid = C.tid, lane = C.lane, wave = C.wave, i = lane & 31, h = lane >> 5;
    constexpr int PT = 272, IMG = 64 * PT, SBB = 128 * PT;
    LAS unsigned char *QT = C.lds, *KD = C.lds + IMG, *VV = C.lds + 2 * IMG, *SB = C.lds + 3 * IMG;
    LAS float* RS = (LAS float*)(C.lds + 3 * IMG + 2 * SBB);
    f32x16 sacc[4];
    const int kb = wave & 3;
    if (wave >= 4) {
        if (qt == 0) {
#pragma unroll
            for (int vb = 0; vb < 4; ++vb) { sacc[vb] = zero16();
#pragma unroll
                for (int g4 = 0; g4 < 4; ++g4) *(LAS u32x2v*)(SB + (32 * kb + i) * PT + (32 * vb + 8 * g4 + 4 * h) * 2) = (u32x2v){0u, 0u}; }
        } else {
            const float* sp = p_SNAP + (size_t)(bh * 3 + qt - 1) * 16384 + (size_t)(32 * kb + i) * 128 + 4 * h;
#pragma unroll
            for (int vb = 0; vb < 4; ++vb)
#pragma unroll
                for (int g4 = 0; g4 < 4; ++g4) { const f32x4 tt = *(const f32x4*)(sp + 32 * vb + 8 * g4); sacc[vb][4 * g4] = tt[0]; sacc[vb][4 * g4 + 1] = tt[1]; sacc[vb][4 * g4 + 2] = tt[2]; sacc[vb][4 * g4 + 3] = tt[3];
                    u32x2v w; w.x = cvtpk2(tt[0], tt[1]); w.y = cvtpk2(tt[2], tt[3]); *(LAS u32x2v*)(SB + (32 * kb + i) * PT + (32 * vb + 8 * g4 + 4 * h) * 2) = w; }
        }
    }
    const int tro_n = tr_lane_off(PT, lane, false), tro_p = tr_lane_off(PT, lane, true);
    v4u rq[2], re[2], rk[2], rv[2];
#define HG3_ISSUE(sgx) do { const size_t mm_ = (size_t)b * SEQL + (8 * qt + (sgx)) * 64; _Pragma("unroll") for (int it = 0; it < 2; ++it) { const int idx = tid + 512 * it, row = idx >> 4, chn = idx & 15; \
        const size_t go = (mm_ + row) * 768 + hh * 128 + chn * 8; rq[it] = *(const v4u*)(p_CQ + go); re[it] = *(const v4u*)(p_CE + go); rk[it] = *(const v4u*)(p_CK + go); rv[it] = *(const v4u*)(p_CI + go); } } while (0)
#define HG3_FILL() do { _Pragma("unroll") for (int it = 0; it < 2; ++it) { const int idx = tid + 512 * it, row = idx >> 4, chn = idx & 15; const v4u q8 = rq[it], e8 = re[it]; v4u w; \
            w.x = cvtpk2(bflo(q8.x) * bflo(e8.x), bfhi(q8.x) * bfhi(e8.x)); w.y = cvtpk2(bflo(q8.y) * bflo(e8.y), bfhi(q8.y) * bfhi(e8.y)); \
            w.z = cvtpk2(bflo(q8.z) * bflo(e8.z), bfhi(q8.z) * bfhi(e8.z)); w.w = cvtpk2(bflo(q8.w) * bflo(e8.w), bfhi(q8.w) * bfhi(e8.w)); \
            *(LAS v4u*)(QT + row * PT + chn * 16) = w; *(LAS v4u*)(KD + row * PT + chn * 16) = rk[it]; *(LAS v4u*)(VV + row * PT + chn * 16) = rv[it]; } } while (0)
    HG3_ISSUE(0);
    if (wave < 4) {
        const int vb = wave;
#pragma unroll 1
        for (int sg = 0; sg < 8; ++sg) {
            const size_t m0 = (size_t)b * SEQL + (8 * qt + sg) * 64;
            HG3_FILL();
            if (sg < 7) HG3_ISSUE(sg + 1);
            __syncthreads();
#pragma unroll 1
            for (int j = 0; j < 2; ++j) {
                const int g = 2 * sg + j; LAS const unsigned char* SBr = SB + (g & 1) * SBB; LAS float* RSg = RS + (g & 1) * 128;
                v4u zr[2]; f32x4 gnv[4];
#pragma unroll
                for (int gp = 0; gp < 2; ++gp) zr[gp] = *(const v4u*)(p_ZB + (m0 + 32 * j + i) * 2048 + 1280 + hh * 128 + 32 * vb + 16 * gp + 8 * h);
#pragma unroll
                for (int g4 = 0; g4 < 4; ++g4) gnv[g4] = *(const f32x4*)(p_hn_g + l * 768 + hh * 128 + 32 * vb + 8 * g4 + 4 * h);
                bf16x8 qfr[8];
#pragma unroll
                for (int ks = 0; ks < 8; ++ks) qfr[ks] = *(LAS const bf16x8*)(QT + (32 * j + i) * PT + (16 * ks + 8 * h) * 2);
                f32x16 x0 = zero16(), x1 = zero16();
#pragma unroll
                for (int ks = 0; ks < 8; ks += 2) { x0 = MFMA32(*(LAS const bf16x8*)(KD + (32 * j + i) * PT + (16 * ks + 8 * h) * 2), qfr[ks], x0);
                                                    x1 = MFMA32(*(LAS const bf16x8*)(KD + (32 * j + i) * PT + (16 * ks + 16 + 8 * h) * 2), qfr[ks + 1], x1); }
#pragma unroll
                for (int r = 0; r < 16; ++r) { const float xs = x0[r] + x1[r]; x0[r] = (crow(r, h) > i) ? 0.f : xs; }
                const bf16x8 pb0 = pack8(x0, 0), pb1 = pack8(x0, 1);
                f32x16 oa = zero16(), ob = zero16();
#pragma unroll
                for (int ks = 0; ks < 8; ks += 2) { oa = MFMA32(trfrag(SBr, PT, 16 * ks, 32 * vb, tro_n, false), qfr[ks], oa); ob = MFMA32(trfrag(SBr, PT, 16 * ks + 16, 32 * vb, tro_n, false), qfr[ks + 1], ob); }
                oa = MFMA32(trfrag(VV, PT, 32 * j, 32 * vb, tro_p, true), pb0, oa);
                ob = MFMA32(trfrag(VV, PT, 32 * j + 16, 32 * vb, tro_p, true), pb1, ob);
                float ss = 0.f;
#pragma unroll
                for (int r = 0; r < 16; ++r) { oa[r] += ob[r]; ss += oa[r] * oa[r]; }
                ss += shx(ss, 32, lane);
                if (h == 0) RSg[vb * 32 + i] = ss;
                __syncthreads();
                const float tot = RSg[i] + RSg[32 + i] + RSg[64 + i] + RSg[96 + i], rstd = __builtin_amdgcn_rsqf(tot * (1.0f / 128.0f) + EPSF);
                const size_t m = m0 + 32 * j + i;
#pragma unroll
                for (int gp = 0; gp < 2; ++gp) { const int v0 = hh * 128 + 32 * vb + 16 * gp + 8 * h, g4 = 2 * gp; const f32x4 ga = gnv[g4], gb = gnv[g4 + 1]; const v4u Z = zr[gp];
                    u32x2v za = {Z.x, Z.y}, zb = {Z.z, Z.w}, wa, wb; swap_pair(za, zb);
                    wa.x = cvtpk2(oa[4 * g4] * rstd * ga[0] * bflo(za.x), oa[4 * g4 + 1] * rstd * ga[1] * bfhi(za.x)); wa.y = cvtpk2(oa[4 * g4 + 2] * rstd * ga[2] * bflo(za.y), oa[4 * g4 + 3] * rstd * ga[3] * bfhi(za.y));
                    wb.x = cvtpk2(oa[4 * g4 + 4] * rstd * gb[0] * bflo(zb.x), oa[4 * g4 + 5] * rstd * gb[1] * bfhi(zb.x)); wb.y = cvtpk2(oa[4 * g4 + 6] * rstd * gb[2] * bflo(zb.y), oa[4 * g4 + 7] * rstd * gb[3] * bfhi(zb.y));
                    swap_pair(wa, wb); *(v4u*)(p_YB + m * 2048 + 1280 + v0) = (v4u){wa.x, wa.y, wb.x, wb.y}; }
            }
        }
    } else {
#pragma unroll 1
        for (int sg = 0; sg < 8; ++sg) {
            const size_t m0 = (size_t)b * SEQL + (8 * qt + sg) * 64;
            HG3_FILL();
            float dv[2];
#pragma unroll
            for (int j = 0; j < 2; ++j) dv[j] = p_DJ[((m0 >> 5) + j) * 768 + hh * 128 + 32 * kb + i];
            if (sg < 7) HG3_ISSUE(sg + 1);
            __syncthreads();
#pragma unroll 1
            for (int j = 0; j < 2; ++j) {
                const int g = 2 * sg + j; LAS unsigned char* SBw = SB + ((g + 1) & 1) * SBB;
#pragma unroll
                for (int s2 = 0; s2 < 2; ++s2) { const bf16x8 kfr = trfrag(KD, PT, 32 * j + 16 * s2, 32 * kb, tro_n, false);
#pragma unroll
                    for (int vb = 0; vb < 4; ++vb) sacc[vb] = MFMA32(trfrag(VV, PT, 32 * j + 16 * s2, 32 * vb, tro_n, false), kfr, sacc[vb]); }
                const float d = (j == 0) ? dv[0] : dv[1];
#pragma unroll
                for (int vb = 0; vb < 4; ++vb)
#pragma unroll
                    for (int r = 0; r < 16; ++r) sacc[vb][r] *= d;
#pragma unroll
                for (int vb = 0; vb < 4; ++vb)
#pragma unroll
                    for (int g4 = 0; g4 < 4; ++g4) { u32x2v w; w.x = cvtpk2(sacc[vb][4 * g4], sacc[vb][4 * g4 + 1]); w.y = cvtpk2(sacc[vb][4 * g4 + 2], sacc[vb][4 * g4 + 3]); *(LAS u32x2v*)(SBw + (32 * kb + i) * PT + (32 * vb + 8 * g4 + 4 * h) * 2) = w; }
                __syncthreads();
            }
        }
    }
#undef HG3_ISSUE
#undef HG3_FILL
}
DI void samp_attn_item(const Ctx& C, int l, int item) { const float* const p_cache_k = ((const float*)INP(2)); const float* const p_cache_v = ((const float*)INP(3)); bf16* const p_QB = ((bf16*)WSP(WS_QB)); bf16* const p_KB = ((bf16*)WSP(WS_KB)); bf16* const p_VB = ((bf16*)WSP(WS_VB)); bf16* const p_ZB = ((bf16*)WSP(WS_ZB)); bf16* const p_YB = ((bf16*)WSP(WS_YB));
    const int b = item / 12, hh = item % 12, wave = C.wave, lane = C.lane, tid = C.tid; const size_t row = MPR + b;
    LAS float* sc = (LAS float*)C.lds;
    LAS float* po = sc + 400;
    const float* ck = p_cache_k + ((size_t)(l * 32 + b) * 2048) * 768 + hh * 64; const float* cv = p_cache_v + ((size_t)(l * 32 + b) * 2048) * 768 + hh * 64;
    const int grp = tid >> 4, dl = 4 * (tid & 15);
    const u32x2v qraw = *(const u32x2v*)(p_QB + row * 768 + hh * 64 + dl); const float q0 = bflo(qraw.x), q1 = bfhi(qraw.x), q2 = bflo(qraw.y), q3 = bfhi(qraw.y);
    const u32x2v knraw = *(const u32x2v*)(p_KB + row * 768 + hh * 64 + dl);
    const f32x4 knew = (f32x4){bflo(knraw.x), bfhi(knraw.x), bflo(knraw.y), bfhi(knraw.y)};
    f32x4 kv[13];
#pragma unroll
    for (int it = 0; it < 13; ++it) { int slot = 32 * it + grp; if (slot > 386) slot = 386; const int pp = slot / 129, jj = slot - 129 * pp, idx = 2048 - (jj << (2 * pp));
        kv[it] = knew; if (idx < 2048) kv[it] = __builtin_nontemporal_load((const f32x4*)(ck + (size_t)idx * 768 + dl)); }
    const u32x2v vnraw = *(const u32x2v*)(p_VB + row * 768 + hh * 64 + dl);
    const f32x4 vnewv = (f32x4){bflo(vnraw.x), bfhi(vnraw.x), bflo(vnraw.y), bfhi(vnraw.y)};
    f32x4 vv[13];
#pragma unroll
    for (int it = 0; it < 13; ++it) { int slot = 32 * it + grp; if (slot > 386) slot = 386; const int pp = slot / 129, jj = slot - 129 * pp, idx = 2048 - (jj << (2 * pp));
        vv[it] = vnewv; if (idx < 2048) vv[it] = __builtin_nontemporal_load((const f32x4*)(cv + (size_t)idx * 768 + dl)); }
#pragma unroll
    for (int it = 0; it < 13; ++it) { const int slot = 32 * it + grp;
        float part = (q0 * kv[it][0] + q1 * kv[it][1]) + (q2 * kv[it][2] + q3 * kv[it][3]);
        part += shx(part, 1, lane); part += shx(part, 2, lane); part += shx(part, 4, lane); part += shx(part, 8, lane);
        if ((tid & 15) == 0 && slot < 387) sc[slot] = part; }
    __syncthreads();
    float mx = -1e30f;
    for (int t = lane; t < 387; t += 64) mx = fmaxf(mx, sc[t]);
    mx = wave_max(mx, lane);
    float sm = 0.f;
    for (int t = lane; t < 387; t += 64) sm += ex2(sc[t] - mx);
    sm = wave_sum(sm, lane);
    f32x4 o4 = (f32x4){0.f, 0.f, 0.f, 0.f};
#pragma unroll
    for (int it = 0; it < 13; ++it) { const int slot = 32 * it + grp; if (slot < 387) o4 += vv[it] * ex2(sc[slot] - mx); }
#pragma unroll
    for (int e = 0; e < 4; ++e) { o4[e] += shx(o4[e], 16, lane); o4[e] += shx(o4[e], 32, lane); }
    if (lane < 16) *(LAS f32x4*)(po + wave * 64 + dl) = o4;
    __syncthreads();
    if (wave == 0) { float t = 0.f;
#pragma unroll
        for (int w = 0; w < 8; ++w) t += po[w * 64 + lane];
        t *= 1.0f / sm;
        p_YB[row * 2048 + hh * 64 + lane] = (bf16)f2bf(t * bf2f(p_ZB[row * 2048 + hh * 64 + lane])); }
}
DI void samp_sgu_item(const Ctx& C, int l, int item) { bf16* const p_BU = ((bf16*)WSP(WS_BU)); bf16* const p_BV = ((bf16*)WSP(WS_BV)); bf16* const p_YB = ((bf16*)WSP(WS_YB)); bf16* const p_ZB = ((bf16*)WSP(WS_ZB)); const float* const p_ln_b = ((const float*)INP(10)); const float* const p_ln_g = ((const float*)INP(9)); float* const p_out = OUTP(); const float* const p_sgu_b = ((const float*)INP(12)); const float* const p_sgu_w = ((const float*)INP(11));
    const int b = 8 * item + C.wave, lane = C.lane; const size_t row = MPR + b;
    const v4u raw = *(const v4u*)(p_BV + row * 512 + 8 * lane);
    float x[8] = {bflo(raw.x), bfhi(raw.x), bflo(raw.y), bfhi(raw.y), bflo(raw.z), bfhi(raw.z), bflo(raw.w), bfhi(raw.w)};
    float s = 0.f;
#pragma unroll
    for (int e = 0; e < 8; ++e) s += x[e];
    const float mean = wave_sum(s, lane) * (1.0f / 512.0f); float q = 0.f;
#pragma unroll
    for (int e = 0; e < 8; ++e) { x[e] -= mean; q += x[e] * x[e]; }
    const float rstd = __builtin_amdgcn_rsqf(wave_sum(q, lane) * (1.0f / 512.0f) + EPSF);
    const int g = lane >> 3; const float w00 = p_sgu_w[(size_t)((l * 8 + g) * 128) * 128], bb = p_sgu_b[(l * 8 + g) * 128];
    const v4u ur = *(const v4u*)(p_BU + row * 512 + 8 * lane), zr = *(const v4u*)(p_ZB + row * 2048 + 768 + 8 * lane);
    const float uu[8] = {bflo(ur.x), bfhi(ur.x), bflo(ur.y), bfhi(ur.y), bflo(ur.z), bfhi(ur.z), bflo(ur.w), bfhi(ur.w)};
    const float zz[8] = {bflo(zr.x), bfhi(zr.x), bflo(zr.y), bfhi(zr.y), bflo(zr.z), bfhi(zr.z), bflo(zr.w), bfhi(zr.w)};
    float vn[8], y[8];
#pragma unroll
    for (int e = 0; e < 8; ++e) { vn[e] = x[e] * rstd * p_ln_g[l * 512 + 8 * lane + e] + p_ln_b[l * 512 + 8 * lane + e]; y[e] = uu[e] * (w00 * vn[e] + bb) * zz[e]; }
    float* od = p_out + O_SGU + (size_t)(l * 32 + b) * 512 + 8 * lane;
    *(f32x4*)od = (f32x4){vn[0], vn[1], vn[2], vn[3]}; *(f32x4*)(od + 4) = (f32x4){vn[4], vn[5], vn[6], vn[7]};
    v4u w; w.x = cvtpk2(y[0], y[1]); w.y = cvtpk2(y[2], y[3]); w.z = cvtpk2(y[4], y[5]); w.w = cvtpk2(y[6], y[7]);
    *(v4u*)(p_YB + row * 2048 + 768 + 8 * lane) = w;
}
DI void samp_hgrn_item(const Ctx& C, int l, int item) { bf16* const p_CE = ((bf16*)WSP(WS_CE)); bf16* const p_CI = ((bf16*)WSP(WS_CI)); bf16* const p_CK = ((bf16*)WSP(WS_CK)); bf16* const p_CQ = ((bf16*)WSP(WS_CQ)); bf16* const p_YB = ((bf16*)WSP(WS_YB)); bf16* const p_ZB = ((bf16*)WSP(WS_ZB)); const float* const p_hn_g = ((const float*)INP(14)); float* const p_out = OUTP(); const float* const p_state = ((const float*)INP(4));
    const int b = item / 6, hh = item % 6, tid = C.tid; const size_t row = MPR + b;
    LAS float* qs = (LAS float*)C.lds; LAS float* eg = qs + 128; LAS float* kx = eg + 128; LAS float* vv = kx + 128; LAS float* po = vv + 128; LAS float* ov = po + 2048; LAS float* pr = ov + 128;
    if (tid < 128) { const size_t o = row * 768 + hh * 128 + tid; qs[tid] = bf2f(p_CQ[o]); eg[tid] = bf2f(p_CE[o]); kx[tid] = bf2f(p_CK[o]); vv[tid] = bf2f(p_CI[o]); }
    __syncthreads();
    const int v4 = (tid & 31) * 4, kq = tid >> 5;
    const f32x4 vloc = *(LAS const f32x4*)(vv + v4); f32x4 acc = (f32x4){0.f, 0.f, 0.f, 0.f};
    const float* S0 = p_state + (size_t)((l * 32 + b) * 6 + hh) * 16384; float* S1 = p_out + O_HS + (size_t)((l * 32 + b) * 6 + hh) * 16384;
#pragma unroll
    for (int kk = 0; kk < 8; ++kk) { const int k = 8 * kq + kk; const f32x4 s = __builtin_nontemporal_load((const f32x4*)(S0 + k * 128 + v4)); const f32x4 sn = s * eg[k] + vloc * kx[k]; __builtin_nontemporal_store(sn, (f32x4*)(S1 + k * 128 + v4)); acc += sn * qs[k]; }
    *(LAS f32x4*)(po + kq * 128 + v4) = acc;
    __syncthreads();
    float o = 0.f;
    if (tid < 128) {
#pragma unroll
        for (int q4 = 0; q4 < 16; ++q4) o += po[q4 * 128 + tid];
        const float ss = wave_sum(o * o, C.lane); if (C.lane == 0) pr[C.wave] = ss; }
    __syncthreads();
    if (tid < 128) { const float rstd = __builtin_amdgcn_rsqf((pr[0] + pr[1]) * (1.0f / 128.0f) + EPSF);
        p_YB[row * 2048 + 1280 + hh * 128 + tid] = (bf16)f2bf(o * rstd * p_hn_g[l * 768 + hh * 128 + tid] * bf2f(p_ZB[row * 2048 + 1280 + hh * 128 + tid])); }
}
DI void samp_out_item(const Ctx& C, int l, int item) { const float* const p_x_sample = ((const float*)INP(1)); float* const p_SSQ1 = ((float*)WSP(WS_CTL + CTL_SSQ1)); bf16* const p_WOUT = ((bf16*)WSP(WS_WOUT)); float* const p_X1 = ((float*)WSP(WS_X1)); bf16* const p_XB = ((bf16*)WSP(WS_XB)); bf16* const p_YB = ((bf16*)WSP(WS_YB)); float* const p_out = OUTP();
    const int lane = C.lane, wave = C.wave, i = lane & 31, h = lane >> 5, n0 = 32 * item;
    const bf16* A = p_YB + (size_t)(MPR + i) * 2048 + 256 * wave + 8 * h; const bf16* B = p_WOUT + ((size_t)l * DM + n0 + i) * 2048 + 256 * wave + 8 * h;
    f32x16 acc = zero16();
#pragma unroll
    for (int ks = 0; ks < 16; ++ks) acc = MFMA32(*(const bf16x8*)(A + 16 * ks), *(const bf16x8*)(B + 16 * ks), acc);
    LAS float* red = (LAS float*)C.lds;
#pragma unroll
    for (int r = 0; r < 16; ++r) red[(wave * 16 + r) * 64 + lane] = acc[r];
    __syncthreads();
    const int tl = C.tid & 63, i2 = tl & 31, h2 = tl >> 5;
#pragma unroll
    for (int e = 0; e < 2; ++e) { const int r = (C.tid >> 6) * 2 + e; float s = 0.f;
#pragma unroll
        for (int w = 0; w < 8; ++w) s += red[(w * 16 + r) * 64 + tl];
        const int bb = crow(r, h2), n = n0 + i2;
        if (l == 0) { const float o = p_x_sample[(size_t)bb * DM + n] + s; p_XB[(size_t)(MPR + bb) * DM + n] = (bf16)f2bf(o);
            float ss = o * o; ss += shx(ss, 1, lane); ss += shx(ss, 2, lane); ss += shx(ss, 4, lane); ss += shx(ss, 8, lane); ss += shx(ss, 16, lane);
            if (i2 == 0) atomicAdd(p_SSQ1 + MPR + bb, ss); }
        else { p_out[O_YS + (size_t)bb * DM + n] = bf2f(p_XB[(size_t)(MPR + bb) * DM + n]) + s; } }
}
DI int fetch_item(Ctx& C, int q) { gu32* const p_ctl = ((gu32*)WSP(WS_CTL));
    __syncthreads();
    if (C.tid == 0) C.MISC[0] = __hip_atomic_fetch_add((unsigned*)(p_ctl + CW_Q + 64 * q), 1u, __ATOMIC_RELAXED, __HIP_MEMORY_SCOPE_AGENT);
    __syncthreads();
    const int it = (int)C.MISC[0];
    { int t_ = C.tid; asm volatile("" : "+v"(t_)); C.tid = t_; C.lane = t_ & 63; C.wave = __builtin_amdgcn_readfirstlane(t_ >> 6);
      LAS unsigned char* lp_ = C.lds; asm volatile("" : "+s"(lp_)); C.lds = lp_; C.MISC = (volatile LAS unsigned*)(lp_ + MISC_OFF); }
    return it;
}
#ifndef G1_STAGGER_TICKS
#define G1_STAGGER_TICKS 0
#endif
#ifndef RPT_PHASE
#define RPT_PHASE -1
#define RPT_N 0
#endif
#ifndef RPT_IMASK
#define RPT_IMASK 0xffff
#endif
#ifndef RPT_MASK
#define RPT_MASK 0
#endif
#ifndef PH_MASK
#define PH_MASK 2047
#endif
constexpr int N_ATT = 384, N_HG = 192, N_HGP = 48, N_A1 = 384, N_SGU = 128, N_SAT = 384, N_SHG = 192, N_SSG = 4;
constexpr int N_M1 = N_HGP + N_ATT + N_SAT + N_SHG + N_SSG, N_WT_ALL = 184, N_KVO = 0;
constexpr int G1_TILES = 65 * 27 + 3, G1_FULL = G1_TILES - (G1_TILES / NGRID) * NGRID, N_WT_G1 = NGRID - G1_FULL, N_WT = N_WT_ALL - N_WT_G1;
constexpr int N_SOUT = 32, N_A1D = 384;

#ifndef G2_F32_RES
#define G2_F32_RES 0
#endif
constexpr int G1_NCOL = 27;
#define MK_EPIPROJ(l, im) pg8::EpiProj{(l) == 0 ? ((float*)WSP(WS_CTL + CTL_SSQ0)) : ((float*)WSP(WS_CTL + CTL_SSQ1)), ((float*)WSP(WS_LB)) + (l) * 3 * 768, WSP(0), OUTP(), (l), ((im) & 2048) ? 0 : 1, \
                       WS_QB, WS_KB - WS_QB, WS_ZB, WS_BU, WS_BV - WS_BU, WS_CQ, WS_CK - WS_CQ, WS_CE, WS_DJ, WS_KH, WS_VH - WS_KH, \
                       O_KP + (size_t)(l) * MPR * 768, O_VP - O_KP, O_KS + (size_t)(l) * 32 * 768, O_VS - O_KS}
template <int KIND, int L> DI void run_kind(Ctx& C, int im, int bx_) {
    constexpr int l = L;
    constexpr int GZ_ROW0 = (l == 1) ? 11 : 0, N_GZ = 64 - GZ_ROW0;
    if constexpr (KIND == 0) { p0_prologue(C); }
    else if constexpr (KIND == 1) {
        pg8::Gemm g{((bf16*)WSP(WS_XB)), ((bf16*)WSP(WS_WIN)) + (size_t)l * NIN * DM, MPAD, NIN, DM}; pg8::TailOrder S; S.so.init(MPAD, G1_NCOL * 256, NGRID, bx_); S.xm = 64; S.extra = 30 - G1_NCOL; S.fill = (30 - G1_NCOL) * GZ_ROW0;
        pg8::EpiProj E = MK_EPIPROJ(l, im);
        pg8::gemm_phase<pg8::EpiProj, pg8::TailOrder, true, true>(C.lds + RING_OFF, g, S, E, C.tid);
        if constexpr (l == 0) { if (bx_ >= G1_FULL) { __syncthreads(); if (im & 128) wt_item(C, bx_ - G1_FULL); } }
    } else if constexpr (KIND == 2) {
        for (;;) { int it = fetch_item(C, 3 * l + 0); if (it >= N_GZ + N_M1 + N_KVO + (l == 0 ? N_WT : 0)) break;
            if (it < N_GZ) { if (im & 2) { pg8::Gemm g{((bf16*)WSP(WS_XB)), ((bf16*)WSP(WS_WIN)) + (size_t)l * NIN * DM, MPAD, NIN, DM}; pg8::ItemOrder S{__builtin_amdgcn_readfirstlane(it) + GZ_ROW0, G1_NCOL, 30 - G1_NCOL};
                                           pg8::EpiProj E = MK_EPIPROJ(l, im); pg8::gemm_phase<pg8::EpiProj, pg8::ItemOrder, true, true>(C.lds + RING_OFF, g, S, E, C.tid); } continue; } it -= N_GZ;
            if (it < N_HGP) { if (im & 8) hgp_item(C, l, it); continue; } it -= N_HGP;
            if (l == 0) { if (it < N_WT) { if (im & 128) wt_item(C, it + N_WT_G1); continue; } it -= N_WT; }
            if (it < N_ATT) { if (im & 4) { if (it < 192) att23_item<2>(C, it); else att23_item<3>(C, it - 192); } continue; } it -= N_ATT;
            if (it < N_SAT) { if (im & 16) samp_attn_item(C, l, it); continue; } it -= N_SAT;
            if (it < N_SHG) { if (im & 64) samp_hgrn_item(C, l, it); continue; } it -= N_SHG;
            if (it < N_SSG) { if (im & 128) samp_sgu_item(C, l, it); continue; } it -= N_SSG;
            if (it < N_KVO) { if (im & 128) kvout_item(C, l, it); continue; } it -= N_KVO;
            }
    } else if constexpr (KIND == 4) {
        for (;;) { int it = fetch_item(C, 3 * l + 2); if (it >= N_HG + N_A1D + 2 * (N_A1 - N_A1D) + N_SGU + N_SOUT) break;
            if (it < N_HG) { if (im & 256) hg3_item(C, l, it); continue; } it -= N_HG;
            if (it < N_SGU) { if (im & 32) sgu_item(C, l, it); continue; } it -= N_SGU;
            if (it < N_A1D) { if (im & 512) att1_item(C, it, 2 * (it & 3), 2); continue; } it -= N_A1D;
            if (it < 2 * (N_A1 - N_A1D)) { if (im & 512) { const int item = N_A1D + (it >> 1); att1_item(C, item, 2 * (item & 3) + (it & 1), 1); } continue; } it -= 2 * (N_A1 - N_A1D);
            if (im & 1024) samp_out_item(C, l, it); }
    } else {
        pg8::Gemm g{((bf16*)WSP(WS_YB)), ((bf16*)WSP(WS_WOUT)) + (size_t)l * DM * DMIX, MPR, DM, DMIX}; pg8::StaticOrder S; S.init(MPR, DM, NGRID, bx_);
        pg8::EpiOut E{(G2_F32_RES && l == 0) ? ((const float*)INP(0)) : nullptr, (G2_F32_RES && l == 0) ? nullptr : ((bf16*)WSP(WS_XB)), l == 0 ? nullptr : (OUTP()) + O_YP, l == 0 ? ((bf16*)WSP(WS_XB)) : nullptr, l == 0 ? ((float*)WSP(WS_CTL + CTL_SSQ1)) : nullptr};
        pg8::gemm_phase<pg8::EpiOut, pg8::StaticOrder, true, true>(C.lds + RING_OFF, g, S, E, C.tid);
    }
}

__global__ void __launch_bounds__(NWAVES * 64, 2) mega_fwd(Args args) {
    extern __shared__ __attribute__((aligned(16))) unsigned char lds[];
    Ctx C;
    C.lds = (LAS unsigned char*)lds; C.MISC = (volatile LAS unsigned*)(C.lds + MISC_OFF);
    C.tid = threadIdx.x; C.lane = C.tid & 63; C.wave = __builtin_amdgcn_readfirstlane(C.tid >> 6);
    C.G = NGRID; C.vcu = 0;
    for (int u = C.tid; u < (LDS_BYTES - MISC_OFF) / 4; u += NWAVES * 64) ((LAS unsigned*)(C.lds + MISC_OFF))[u] = 0u;
    __syncthreads();
    XcdBarrier bar; bar.bar = (unsigned*)(((gu32*)WSP(WS_CTL)) + CW_BAR); bar.x = 0; bar.st = nullptr;
    if (N_LAUNCHES == 1) bar = xcd_barrier_post((unsigned*)(((gu32*)WSP(WS_CTL)) + CW_BAR), C.MISC + 8);
    const int lo = args.ph_lo, hi = args.ph_hi, im = args.imask;
    const int wave_s = __builtin_amdgcn_readfirstlane(threadIdx.x >> 6);
#define RELAUNDER() do { int t_ = (wave_s << 6) | (int)__builtin_amdgcn_mbcnt_hi(~0u, __builtin_amdgcn_mbcnt_lo(~0u, 0u)); asm volatile("" : "+v"(t_)); C.tid = t_; C.lane = t_ & 63; C.wave = __builtin_amdgcn_readfirstlane(t_ >> 6); \
        LAS unsigned char* lp_ = (LAS unsigned char*)lds; asm volatile("" : "+s"(lp_)); C.lds = lp_; C.MISC = (volatile LAS unsigned*)(lp_ + MISC_OFF); } while (0)
#define PHASE(p, KIND, L) if (lo <= (p) && (p) < hi) { RELAUNDER(); int bx_ = blockIdx.x; asm volatile("" : "+s"(bx_)); C.vcu = (bx_ & 7) * (NGRID >> 3) + (bx_ >> 3); run_kind<KIND, L>(C, im, bx_); \
        if (N_LAUNCHES == 1 && (p) + 1 < hi) { XcdBarrier b2; b2.bar = (unsigned*)(((gu32*)WSP(WS_CTL)) + CW_BAR); unsigned x2_ = bar.x; asm volatile("" : "+s"(x2_)); b2.x = x2_; b2.st = C.MISC + 8; xcd_barrier(b2, C.tid); } }
    PHASE(0, 0, 0)
    PHASE(1, 1, 0) PHASE(2, 2, 0) PHASE(3, 4, 0) PHASE(4, 5, 0)
    PHASE(5, 1, 1) PHASE(6, 2, 1) PHASE(7, 4, 1) PHASE(8, 5, 1)
#undef PHASE
#undef RELAUNDER
}

extern "C" void kernel_launch(void* const* d_in, const int* in_sizes, int n_in, void* d_out, int out_size, void* d_ws, size_t ws_size, hipStream_t stream) {
    static int grid = 0;
    if (grid == 0) {
        if (n_in != 16 || (size_t)out_size != O_END || ws_size < WS_END) { fprintf(stderr, "kernel_launch: unexpected shapes: n_in %d out %d ws %zu (need %zu)\n", n_in, out_size, ws_size, (size_t)WS_END); grid = -1; return; }
        int dev = 0, cus = 0, per_cu = 0;
        if (hipGetDevice(&dev) != hipSuccess || hipDeviceGetAttribute(&cus, hipDeviceAttributeMultiprocessorCount, dev) != hipSuccess) { grid = -1; return; }
        if (hipFuncSetAttribute((const void*)mega_fwd, hipFuncAttributeMaxDynamicSharedMemorySize, LDS_BYTES) != hipSuccess) { fprintf(stderr, "kernel_launch: hipFuncSetAttribute failed\n"); grid = -1; return; }
        if (hipOccupancyMaxActiveBlocksPerMultiprocessor(&per_cu, (const void*)mega_fwd, NWAVES * 64, LDS_BYTES) != hipSuccess || per_cu < 1) { fprintf(stderr, "kernel_launch: occupancy query says %d\n", per_cu); (void)hipGetLastError(); per_cu = 1; }
        if (cus < NGRID) { fprintf(stderr, "kernel_launch: %d CUs < %d workgroups: not co-resident\n", cus, NGRID); grid = -1; return; }
        grid = NGRID;
    }
    if (grid < 0) return;
    (void)hipMemsetAsync((char*)d_ws + WS_CTL, 0, CTL_ZERO_BYTES, stream);
    Args a{};
    for (int i = 0; i < 16; ++i) a.in[i] = (const float*)d_in[i];
    a.out = (float*)d_out; a.ws = (unsigned char*)d_ws; a.imask = 0xffff;
    if (N_LAUNCHES == 1) { a.ph_lo = 0; a.ph_hi = N_PHASES; hipLaunchKernelGGL(mega_fwd, dim3(grid), dim3(NWAVES * 64), LDS_BYTES, stream, a); }
    else for (int p = 0; p < N_PHASES; ++p) { a.ph_lo = p; a.ph_hi = p + 1;
        const int nl = 1 + ((p == RPT_PHASE) ? RPT_N : 0);
        for (int r = 0; r < nl; ++r) {
            if (r > 0 && p >= 1) { const int l = (p - 1) / 4, k = (p - 1) % 4; if (k == 1 || k == 2) (void)hipMemsetAsync((char*)d_ws + WS_CTL + (size_t)(CW_Q + 64 * (3 * l + (k == 1 ? 0 : 2))) * 4, 0, 4, stream); }
            a.imask = (r > 0) ? RPT_IMASK : 0xffff;
            hipLaunchKernelGGL(mega_fwd, dim3(grid), dim3(NWAVES * 64), LDS_BYTES, stream, a); } }
}
```
